# Optimizing an MI355X kernel written in HIP

```python
import jax
import jax.numpy as jnp
from jax import lax
import numpy as np

D_MODEL = 2048
BATCH = 1
SEQ = 8192
DEPTH = 2

GRID_W = 64
CTX_LEN = 256
NORM_EPS = 1e-6

RWKV_HEAD = 64
RWKV_W = D_MODEL // 4
RWKV_HEADS = RWKV_W // RWKV_HEAD
DECAY_LORA = 64
ICLR_LORA = 64
GATE_LORA = 128
RWKV_GN_EPS = 64e-5
RWKV_SPLIT = (RWKV_W, RWKV_W, RWKV_W, DECAY_LORA, DECAY_LORA, ICLR_LORA, ICLR_LORA, GATE_LORA)
RWKV_PROJ = sum(RWKV_SPLIT)

GM_W = D_MODEL // 4
GM_GROUPS = 8
GM_CHUNK = 128
GM_PROJ = 2 * GM_W

ATTN_HEAD = 64
ATTN_W = D_MODEL // 2
ATTN_HEADS = ATTN_W // ATTN_HEAD
ATTN_KV_HEADS = ATTN_HEADS // 4
ATTN_KV_W = ATTN_KV_HEADS * ATTN_HEAD
ATTN_WINDOW = 128
ATTN_BLOCK = 128
ROPE_THETA = 10000.0
ATTN_PROJ = ATTN_W + 2 * ATTN_KV_W

IN_PROJ = RWKV_PROJ + GM_PROJ + ATTN_PROJ
MIX_W = RWKV_W + GM_W + ATTN_W

N_EXPERTS = 64
EXPERT_FF = 512
SHARED_FF = 512
TOP_K = 8
N_EXPERT_GROUPS = 8
TOPK_GROUPS = 4
ROUTED_SCALE = 2.5
EXPERT_BLOCK = 128

kernel_name = 'hybrid_rwkv7_gmlp_swa_moe_dit'


def split_cols(t, widths):
    return jnp.split(t, [int(i) for i in np.cumsum(widths)[:-1]], axis=-1)


def rms_norm(x, g):
    xf = x.astype(jnp.float32)
    y = xf * lax.rsqrt(jnp.mean(xf * xf, axis=-1, keepdims=True) + NORM_EPS)
    return (y * g.astype(jnp.float32)).astype(x.dtype)


def modulate(h, shift, scale):
    return h * (1.0 + scale) + shift


def swiglu(h, wg, wu, wd):
    return (jax.nn.silu(h @ wg) * (h @ wu)) @ wd


def centred_shift(p, mu_prev, mu_next):
    prev = jnp.pad(p, ((0, 0), (1, 0), (0, 0)))[:, :-1]
    nxt = jnp.pad(p, ((0, 0), (0, 1), (0, 0)))[:, 1:]
    return p + mu_prev * (prev - p) + mu_next * (nxt - p)


def rwkv7_scan(s0, r, decay, k, v, kk, a, reverse, emit):
    def step(S, inp):
        r_t, w_t, k_t, v_t, kk_t, a_t = inp
        sa = jnp.einsum('bhij,bhj->bhi', S, -kk_t)
        S = (S * w_t[:, :, None, :] + sa[..., None] * (kk_t * a_t)[:, :, None, :]
             + v_t[..., None] * k_t[:, :, None, :])
        y = jnp.einsum('bhij,bhj->bhi', S, r_t) if emit else None
        return S, y
    xs = tuple(jnp.swapaxes(t, 0, 1) for t in (r, decay, k, v, kk, a))
    s_fin, y = lax.scan(step, s0, xs, reverse=reverse)
    return s_fin, (jnp.swapaxes(y, 0, 1) if emit else None)


def rwkv7_mixer(p, s0_fwd, s0_bwd, prm, readout):
    out_dtype = p.dtype
    p = centred_shift(p.astype(jnp.float32), prm['mu'][0], prm['mu'][1])
    r, k, v, wd_f, wd_b, ad_f, ad_b, gd = split_cols(p, RWKV_SPLIT)
    B, T, _ = r.shape

    def heads(t):
        return t.reshape(B, T, RWKV_HEADS, RWKV_HEAD)

    kk = heads(k * prm['k_k'])
    kk = kk / jnp.maximum(jnp.sqrt(jnp.sum(kk * kk, axis=-1, keepdims=True)), 1e-12)
    ys, states = [], []
    for d, (wd, ad, s0) in enumerate(((wd_f, ad_f, s0_fwd), (wd_b, ad_b, s0_bwd))):
        w_log = -jax.nn.softplus(-(prm['w0'][d] + jnp.tanh(wd) @ prm['w2'][d])) - 0.5
        decay = jnp.exp(-jnp.exp(w_log))
        a = jax.nn.sigmoid(prm['a0'][d] + ad @ prm['a2'][d])
        k_d = k * (1.0 + (a - 1.0) * prm['k_a'])
        s_fin, y = rwkv7_scan(s0, heads(r), heads(decay), heads(k_d), heads(v), kk, heads(a),
                              reverse=(d == 1), emit=readout)
        ys.append(y)
        states.append(s_fin)
    if not readout:
        return None, states[0], states[1]
    y = ys[0] + ys[1]
    mean = jnp.mean(y, axis=-1, keepdims=True)
    var = jnp.mean(jnp.square(y - mean), axis=-1, keepdims=True)
    y = ((y - mean) * lax.rsqrt(var + RWKV_GN_EPS)).reshape(B, T, RWKV_W) * prm['ln_g'] + prm['ln_b']
    bonus = (jnp.sum(heads(r) * heads(k) * prm['r_k'], axis=-1, keepdims=True) * heads(v)).reshape(B, T, RWKV_W)
    g = jax.nn.sigmoid(gd) @ prm['g2']
    return ((y + bonus) * g).astype(out_dtype), states[0], states[1]


def chunk_gmlp(p, norm_g, ws, bs):
    u, v = jnp.split(p, 2, axis=-1)
    u = jax.nn.gelu(u)
    v = rms_norm(jax.nn.gelu(v), norm_g)
    B, T, C = v.shape
    vr = v.reshape(B, T // GM_CHUNK, GM_CHUNK, GM_GROUPS, C // GM_GROUPS)
    s = jnp.einsum('gpq,bnqgc->bnpgc', ws, vr) + bs.T[:, :, None]
    return u * s.reshape(B, T, C)


def attn_q(p, q_g):
    B, T, _ = p.shape
    return rms_norm(p[..., :ATTN_W].reshape(B, T, ATTN_HEADS, ATTN_HEAD), q_g)


def attn_kv(p, k_g):
    B, T, _ = p.shape
    k = p[..., ATTN_W:ATTN_W + ATTN_KV_W].reshape(B, T, ATTN_KV_HEADS, ATTN_HEAD)
    v = p[..., ATTN_W + ATTN_KV_W:].reshape(B, T, ATTN_KV_HEADS, ATTN_HEAD)
    return rms_norm(k, k_g), v


def axial_rope_angles(n_tokens):
    rows = n_tokens // GRID_W
    row = jnp.repeat(jnp.arange(rows, dtype=jnp.float32), GRID_W)
    col = jnp.tile(jnp.arange(GRID_W, dtype=jnp.float32), rows)
    n_freq = ATTN_HEAD // 4
    inv_freq = ROPE_THETA ** (-jnp.arange(n_freq, dtype=jnp.float32) / n_freq)
    return row[:, None] * inv_freq, col[:, None] * inv_freq


def rotate_half_pairs(x, ang):
    x1, x2 = jnp.split(x, 2, axis=-1)
    cos = jnp.cos(ang)[None, :, None, :]
    sin = jnp.sin(ang)[None, :, None, :]
    return jnp.concatenate([x1 * cos - x2 * sin, x2 * cos + x1 * sin], axis=-1)


def axial_rope(x, ang_row, ang_col):
    xr, xc = jnp.split(x.astype(jnp.float32), 2, axis=-1)
    return jnp.concatenate([rotate_half_pairs(xr, ang_row), rotate_half_pairs(xc, ang_col)], axis=-1).astype(x.dtype)


def sink_column(sink, B, kvh, g, n_q):
    return jnp.broadcast_to(sink.reshape(kvh, g)[None, :, :, None, None].astype(jnp.float32), (B, kvh, g, n_q, 1))


def windowed_attention(q, k, v, k_ctx, v_ctx, sink):
    B, S, H, D = q.shape
    KVH = k.shape[2]
    G = H // KVH
    C = k_ctx.shape[1]
    L = ATTN_BLOCK
    nb = S // L
    scale = D ** -0.5
    qb = jnp.moveaxis(q.reshape(B, nb, L, KVH, G, D), 1, 0)

    def band(t):
        tp = jnp.pad(t, ((0, 0), (L, L), (0, 0), (0, 0))).reshape(B, nb + 2, L, KVH, D)
        w = jnp.concatenate([tp[:, :-2], tp[:, 1:-1], tp[:, 2:]], axis=2)
        return jnp.moveaxis(w, 1, 0)

    kb, vb = band(k), band(v)
    qi = jnp.arange(L)[:, None]
    kj = jnp.arange(3 * L)[None, :]
    key_pos = (jnp.arange(nb)[:, None, None] - 1) * L + kj
    valid = (jnp.abs(kj - L - qi) <= ATTN_WINDOW) & (key_pos >= 0) & (key_pos < S)
    sink_b = sink_column(sink, B, KVH, G, L)
    kc = k_ctx.astype(jnp.float32)
    vc = v_ctx.astype(jnp.float32)

    def block(args):
        q_blk, k_blk, v_blk, m_blk = args
        qf = q_blk.astype(jnp.float32) * scale
        s_loc = jnp.einsum('bqkgd,bskd->bkgqs', qf, k_blk.astype(jnp.float32))
        s_loc = jnp.where(m_blk[None, None, None], s_loc, -jnp.inf)
        s_ctx = jnp.einsum('bqkgd,bskd->bkgqs', qf, kc)
        prob = jax.nn.softmax(jnp.concatenate([s_loc, s_ctx, sink_b], axis=-1), axis=-1)
        out = (jnp.einsum('bkgqs,bskd->bqkgd', prob[..., :3 * L], v_blk.astype(jnp.float32))
               + jnp.einsum('bkgqs,bskd->bqkgd', prob[..., 3 * L:3 * L + C], vc))
        return out.astype(q.dtype)

    out = lax.map(block, (qb, kb, vb, valid))
    return jnp.moveaxis(out, 0, 1).reshape(B, S, H * D)


def context_attention(q, k, v, sink):
    B, C, H, D = q.shape
    KVH = k.shape[2]
    G = H // KVH
    qf = q.reshape(B, C, KVH, G, D).astype(jnp.float32) * D ** -0.5
    s = jnp.einsum('bqkgd,bskd->bkgqs', qf, k.astype(jnp.float32))
    prob = jax.nn.softmax(jnp.concatenate([s, sink_column(sink, B, KVH, G, C)], axis=-1), axis=-1)[..., :C]
    out = jnp.einsum('bkgqs,bskd->bqkgd', prob, v.astype(jnp.float32))
    return out.reshape(B, C, H * D).astype(q.dtype)


def routed_experts(h, idx, wts, wg, wu, wd):
    n_tok, d = h.shape
    n_assign = idx.shape[0] * idx.shape[1]
    flat_e = idx.reshape(-1)
    order = jnp.argsort(flat_e)
    sorted_e = flat_e[order]
    counts = jnp.bincount(flat_e, length=N_EXPERTS)
    padded = (counts + EXPERT_BLOCK - 1) // EXPERT_BLOCK * EXPERT_BLOCK
    pad_end = jnp.cumsum(padded)
    pad_start = pad_end - padded
    seg_start = jnp.cumsum(counts) - counts
    dest = pad_start[sorted_e] + jnp.arange(n_assign) - seg_start[sorted_e]
    n_blocks = -(-n_assign // EXPERT_BLOCK) + N_EXPERTS
    cap = n_blocks * EXPERT_BLOCK
    slot_tok = jnp.zeros((cap,), jnp.int32).at[dest].set((order // idx.shape[1]).astype(jnp.int32))
    slot_w = jnp.zeros((cap,), wts.dtype).at[dest].set(wts.reshape(-1)[order])
    block_e = jnp.minimum(jnp.searchsorted(pad_end, jnp.arange(n_blocks) * EXPERT_BLOCK, side='right'), N_EXPERTS - 1)

    def run_block(args):
        tok_b, w_b, e = args
        return swiglu(h[tok_b], wg[e], wu[e], wd[e]) * w_b[:, None]

    y = lax.map(run_block, (slot_tok.reshape(n_blocks, EXPERT_BLOCK), slot_w.reshape(n_blocks, EXPERT_BLOCK), block_e))
    return jax.ops.segment_sum(y.reshape(cap, d), slot_tok, num_segments=n_tok)


def moe_ffn(h, router, bias, wg, wu, wd, sh_wg, sh_wu, sh_wd):
    n_tok = h.shape[0]
    scores = jax.nn.sigmoid(h.astype(jnp.float32) @ router.astype(jnp.float32))
    biased = scores + bias.astype(jnp.float32)
    per_group = N_EXPERTS // N_EXPERT_GROUPS
    group_score = jnp.sum(lax.top_k(biased.reshape(n_tok, N_EXPERT_GROUPS, per_group), 2)[0], axis=-1)
    top_groups = lax.top_k(group_score, TOPK_GROUPS)[1]
    group_mask = jnp.any(top_groups[:, :, None] == jnp.arange(N_EXPERT_GROUPS), axis=1)
    masked = jnp.where(jnp.repeat(group_mask, per_group, axis=1), biased, -jnp.inf)
    idx = lax.top_k(masked, TOP_K)[1]
    wts = jnp.take_along_axis(scores, idx, axis=1)
    wts = wts / jnp.sum(wts, axis=-1, keepdims=True) * ROUTED_SCALE
    return swiglu(h, sh_wg, sh_wu, sh_wd) + routed_experts(h, idx, wts.astype(h.dtype), wg, wu, wd)


def setup_inputs(seed: int = 0) -> dict:
    key = jax.random.key(seed)
    ks = iter(list(jax.random.split(key, 35)))
    f32 = jnp.float32
    L, D = DEPTH, D_MODEL

    def nrm(shape, scale=1.0):
        return jax.random.normal(next(ks), shape, f32) * scale

    def near(shape, center, noise):
        return center + nrm(shape, noise)

    def unif(shape, lo, hi):
        return jax.random.uniform(next(ks), shape, f32, lo, hi)

    return {
        'x': nrm((BATCH, SEQ, D)),
        'c': nrm((BATCH, D)),
        'ctx': nrm((BATCH, CTX_LEN, D)),
        'c_ctx': nrm((D,)),
        'w_ada': nrm((L, D, 6 * D), 0.5 * D ** -0.5),
        'b_ada': nrm((L, 6 * D), 0.01),
        'norm1_g': near((L, D), 1.0, 0.01),
        'norm2_g': near((L, D), 1.0, 0.01),
        'w_in': nrm((L, D, IN_PROJ), D ** -0.5),
        'w_o': nrm((L, MIX_W, D), MIX_W ** -0.5),
        'rw_mu': unif((L, 2, RWKV_PROJ), 0.0, 0.5),
        'rw_w0': unif((L, 2, RWKV_W), -6.0, 1.0),
        'rw_w2': nrm((L, 2, DECAY_LORA, RWKV_W), 0.5 * DECAY_LORA ** -0.5),
        'rw_a0': nrm((L, 2, RWKV_W), 0.1),
        'rw_a2': nrm((L, 2, ICLR_LORA, RWKV_W), 0.5 * ICLR_LORA ** -0.5),
        'rw_g2': nrm((L, GATE_LORA, RWKV_W), GATE_LORA ** -0.5),
        'rw_kk': near((L, RWKV_W), 0.85, 0.02),
        'rw_ka': near((L, RWKV_W), 1.0, 0.02),
        'rw_rk': nrm((L, RWKV_HEADS, RWKV_HEAD), 0.1),
        'rw_ln_g': near((L, RWKV_W), 1.0, 0.01),
        'rw_ln_b': nrm((L, RWKV_W), 0.01),
        'gm_norm_g': near((L, GM_W), 1.0, 0.01),
        'gm_ws': nrm((L, GM_GROUPS, GM_CHUNK, GM_CHUNK), 0.5 * GM_CHUNK ** -0.5),
        'gm_b': near((L, GM_GROUPS, GM_CHUNK), 1.0, 0.01),
        'at_qn': near((L, ATTN_HEAD), 1.0, 0.01),
        'at_kn': near((L, ATTN_HEAD), 1.0, 0.01),
        'at_sink': nrm((L, ATTN_HEADS), 1.0),
        'moe_router': nrm((L, D, N_EXPERTS), D ** -0.5),
        'moe_bias': nrm((L, N_EXPERTS), 0.01),
        'moe_wg': nrm((L, N_EXPERTS, D, EXPERT_FF), D ** -0.5),
        'moe_wu': nrm((L, N_EXPERTS, D, EXPERT_FF), D ** -0.5),
        'moe_wd': nrm((L, N_EXPERTS, EXPERT_FF, D), EXPERT_FF ** -0.5),
        'sh_wg': nrm((L, D, SHARED_FF), D ** -0.5),
        'sh_wu': nrm((L, D, SHARED_FF), D ** -0.5),
        'sh_wd': nrm((L, SHARED_FF, D), SHARED_FF ** -0.5),
    }


def reference(x, c, ctx, c_ctx, w_ada, b_ada, norm1_g, norm2_g, w_in, w_o,
              rw_mu, rw_w0, rw_w2, rw_a0, rw_a2, rw_g2, rw_kk, rw_ka, rw_rk, rw_ln_g, rw_ln_b,
              gm_norm_g, gm_ws, gm_b, at_qn, at_kn, at_sink,
              moe_router, moe_bias, moe_wg, moe_wu, moe_wd, sh_wg, sh_wu, sh_wd):
    B, S, D = x.shape
    C = ctx.shape[1]
    ang_row, ang_col = axial_rope_angles(S)
    cond = jax.nn.silu(c)
    cond_ctx = jax.nn.silu(c_ctx)
    split_pts = [RWKV_PROJ, RWKV_PROJ + GM_PROJ]
    for l in range(DEPTH):
        last = l == DEPTH - 1
        sh1, sc1, g1, sh2, sc2, g2 = [t[:, None, :] for t in jnp.split(cond @ w_ada[l] + b_ada[l], 6, axis=-1)]
        csh1, csc1, cg1, csh2, csc2, cg2 = jnp.split(cond_ctx @ w_ada[l] + b_ada[l], 6, axis=-1)

        h = modulate(rms_norm(x, norm1_g[l]), sh1, sc1)
        hc = modulate(rms_norm(ctx, norm1_g[l]), csh1, csc1)
        p_rw, p_gm, p_at = jnp.split(h @ w_in[l], split_pts, axis=-1)
        pc_rw, pc_gm, pc_at = jnp.split(hc @ w_in[l], split_pts, axis=-1)

        rw = {'mu': rw_mu[l], 'w0': rw_w0[l], 'w2': rw_w2[l], 'a0': rw_a0[l], 'a2': rw_a2[l],
              'g2': rw_g2[l], 'k_k': rw_kk[l], 'k_a': rw_ka[l], 'r_k': rw_rk[l],
              'ln_g': rw_ln_g[l], 'ln_b': rw_ln_b[l]}
        s0 = jnp.zeros((B, RWKV_HEADS, RWKV_HEAD, RWKV_HEAD), jnp.float32)
        yc_rw, s_fwd, s_bwd = rwkv7_mixer(pc_rw, s0, s0, rw, readout=not last)
        y_rw, _, _ = rwkv7_mixer(p_rw, s_fwd, s_bwd, rw, readout=True)

        y_gm = chunk_gmlp(p_gm, gm_norm_g[l], gm_ws[l], gm_b[l])

        kc, vc = attn_kv(pc_at, at_kn[l])
        q = axial_rope(attn_q(p_at, at_qn[l]), ang_row, ang_col)
        k, v = attn_kv(p_at, at_kn[l])
        k = axial_rope(k, ang_row, ang_col)
        y_at = windowed_attention(q, k, v, kc, vc, at_sink[l])

        x = x + g1 * (jnp.concatenate([y_rw, y_gm, y_at], axis=-1) @ w_o[l])

        moe_p = (moe_router[l], moe_bias[l], moe_wg[l], moe_wu[l], moe_wd[l], sh_wg[l], sh_wu[l], sh_wd[l])
        h2 = modulate(rms_norm(x, norm2_g[l]), sh2, sc2).reshape(B * S, D)
        if last:
            x = x + g2 * moe_ffn(h2, *moe_p).reshape(B, S, D)
        else:
            yc_gm = chunk_gmlp(pc_gm, gm_norm_g[l], gm_ws[l], gm_b[l])
            yc_at = context_attention(attn_q(pc_at, at_qn[l]), kc, vc, at_sink[l])
            ctx = ctx + cg1 * (jnp.concatenate([yc_rw, yc_gm, yc_at], axis=-1) @ w_o[l])
            hc2 = modulate(rms_norm(ctx, norm2_g[l]), csh2, csc2).reshape(B * C, D)
            f = moe_ffn(jnp.concatenate([hc2, h2], axis=0), *moe_p)
            ctx = ctx + cg2 * f[:B * C].reshape(B, C, D)
            x = x + g2 * f[B * C:].reshape(B, S, D)
    return x
```

```cpp
#include <hip/hip_runtime.h>
#include <stdint.h>
#include <stdio.h>

typedef unsigned short bf16_t;
typedef short bf16x8 __attribute__((ext_vector_type(8)));
typedef float f32x4 __attribute__((ext_vector_type(4)));
typedef unsigned u32x4 __attribute__((ext_vector_type(4)));
typedef unsigned u32x2 __attribute__((ext_vector_type(2)));

constexpr int D = 2048, SEQ = 8192, CTXL = 256, NTOK = SEQ + CTXL, DEPTH = 2;
constexpr int RW = 512, RWP = 1920, GMW = 512, INP = 4480;
constexpr int COL_GM = 1920, COL_AT = 2944, COL_K = 3968, COL_V = 4224;
constexpr int NE = 64, NEX = 65, EFF = 512, TOPK = 8;
constexpr int SLOT_CAP = 84224;
constexpr int MAX_TILES = SLOT_CAP / 128;

constexpr size_t al256(size_t x) { return (x + 255) & ~(size_t)255; }
constexpr size_t WS_BAR = 0;
constexpr size_t WS_CNT = 16384;
constexpr size_t WS_MOD = WS_CNT + 1024;
constexpr size_t WS_ZERO_END = al256(WS_MOD + (size_t)2 * 2 * 12288 * 4);
constexpr size_t WS_WINT = WS_ZERO_END;
constexpr size_t WS_WOT = WS_WINT + (size_t)2 * INP * D * 2;
constexpr size_t WS_W13T = WS_WOT + (size_t)2 * D * D * 2;
constexpr size_t WS_W2T = WS_W13T + (size_t)2 * NEX * 1024 * D * 2;
constexpr size_t WS_H = WS_W2T + (size_t)2 * NEX * D * EFF * 2;
constexpr size_t WS_P = WS_H + (size_t)NTOK * D * 2;
constexpr size_t WS_REC = WS_P + (size_t)NTOK * INP * 4;
constexpr size_t WS_YD = WS_REC + (size_t)2 * 8 * NTOK * 384 * 4;
constexpr size_t WS_G = WS_YD + (size_t)2 * NTOK * RW * 4;
constexpr size_t WS_BV = WS_G + (size_t)NTOK * RW * 4;
constexpr size_t WS_GMR = WS_BV + (size_t)NTOK * RW * 4;
constexpr size_t WS_YCAT = al256(WS_GMR + (size_t)NTOK * 4);
constexpr size_t WS_Q = WS_YCAT + (size_t)NTOK * D * 2;
constexpr size_t WS_K = WS_Q + (size_t)NTOK * 1024 * 4;
constexpr size_t WS_X1 = WS_K + (size_t)NTOK * 256 * 4;
constexpr size_t WS_X2C = WS_X1 + (size_t)NTOK * D * 4;
constexpr size_t WS_TOKE = WS_X2C + (size_t)CTXL * D * 4;
constexpr size_t WS_TOKP = WS_TOKE + (size_t)NTOK * 8 * 4;
constexpr size_t WS_TOKW = WS_TOKP + (size_t)NTOK * 8 * 4;
constexpr size_t WS_SLOTT = WS_TOKW + (size_t)NTOK * 8 * 4;
constexpr size_t WS_SLOTW = al256(WS_SLOTT + (size_t)SLOT_CAP * 4);
constexpr size_t WS_TILE = al256(WS_SLOTW + (size_t)SLOT_CAP * 4);
constexpr size_t WS_ACT = al256(WS_TILE + (size_t)(MAX_TILES + 64) * 4);
constexpr size_t WS_MODP = WS_ACT + (size_t)SLOT_CAP * EFF * 2;
constexpr size_t WS_TOKS = WS_MODP + (size_t)2 * 2 * 32 * 12288 * 4;
constexpr size_t WS_OUTS = WS_TOKS + (size_t)NTOK * 8 * 4;
constexpr size_t WS_END = WS_OUTS + (size_t)SLOT_CAP * D * 2;

struct Params {
    const float *x, *c, *ctx, *c_ctx, *w_ada, *b_ada, *norm1_g, *norm2_g, *w_in, *w_o;
    const float *rw_mu, *rw_w0, *rw_w2, *rw_a0, *rw_a2, *rw_g2, *rw_kk, *rw_ka, *rw_rk, *rw_ln_g, *rw_ln_b;
    const float *gm_norm_g, *gm_ws, *gm_b, *at_qn, *at_kn, *at_sink;
    const float *moe_router, *moe_bias, *moe_wg, *moe_wu, *moe_wd, *sh_wg, *sh_wu, *sh_wd;
    float* out;
    char* ws;
};

__device__ __forceinline__ bf16_t f2bf(float f) {
    unsigned u = __float_as_uint(f);
    u += 0x7fffu + ((u >> 16) & 1u);
    return (bf16_t)(u >> 16);
}
__device__ __forceinline__ float bf2f(bf16_t h) { return __uint_as_float(((unsigned)h) << 16); }
__device__ __forceinline__ unsigned pack_bf2(float lo, float hi) { return (unsigned)f2bf(lo) | ((unsigned)f2bf(hi) << 16); }
__device__ __forceinline__ float wave_sum(float v) {
#pragma unroll
    for (int o = 32; o >= 1; o >>= 1) v += __shfl_xor(v, o);
    return v;
}
__device__ __forceinline__ float wave_max(float v) {
#pragma unroll
    for (int o = 32; o >= 1; o >>= 1) v = fmaxf(v, __shfl_xor(v, o));
    return v;
}
__device__ __forceinline__ float sigmoidf_(float x) { return 1.f / (1.f + expf(-x)); }
__device__ __forceinline__ float siluf_(float x) { return x / (1.f + expf(-x)); }
__device__ __forceinline__ float gelu_tanh(float x) {
    const float u = 0.7978845608028654f * (x + 0.044715f * x * x * x);
    return 0.5f * x * (1.f + tanhf(u));
}
__device__ __forceinline__ float softplusf_(float x) { return fmaxf(x, 0.f) + log1pf(expf(-fabsf(x))); }

struct RowSrc { const float* a; const float* b; };
__device__ __forceinline__ const float* rowp(const RowSrc& r, int row) { return row < SEQ ? r.a + (size_t)row * D : r.b + (size_t)(row - SEQ) * D; }
struct RowDst { float* a; float* b; };
__device__ __forceinline__ float* rowp(const RowDst& r, int row) { return row < SEQ ? r.a + (size_t)row * D : r.b + (size_t)(row - SEQ) * D; }

__device__ __forceinline__ RowSrc layer_in(const Params& p, int l) {
    RowSrc r; if (l == 0) { r.a = p.x; r.b = p.ctx; } else { float* x1 = (float*)(p.ws + WS_X1); r.a = x1; r.b = x1 + (size_t)SEQ * D; } return r;
}
__device__ __forceinline__ RowDst layer_out(const Params& p, int l) {
    RowDst r; if (l == 0) { float* x1 = (float*)(p.ws + WS_X1); r.a = x1; r.b = x1 + (size_t)SEQ * D; } else { r.a = p.out; r.b = (float*)(p.ws + WS_X2C); } return r;
}
__device__ __forceinline__ const float* modp(const Params& p, int l, int row, int which) {
    return (const float*)(p.ws + WS_MOD) + ((size_t)(l * 2 + (row < SEQ ? 0 : 1)) * 6 + which) * D;
}

__device__ void phase_ada(const Params& p, int bid, int nb) {
    float* part = (float*)(p.ws + WS_MODP);
    const int tid = threadIdx.x;
    for (int u = bid; u < 2 * 12 * 32; u += nb) {
        const int l = u / (12 * 32), r = u % (12 * 32), cg = r / 32, kc = r % 32;
        const int n = cg * 1024 + tid * 4;
        const float* w = p.w_ada + (size_t)l * D * 12288 + (size_t)(kc * 64) * 12288 + n;
        f32x4 a0 = {0, 0, 0, 0}, a1 = {0, 0, 0, 0};
#pragma unroll 8
        for (int k = 0; k < 64; ++k) {
            const f32x4 wv = *(const f32x4*)(w + (size_t)k * 12288);
            const float c0 = siluf_(p.c[kc * 64 + k]), c1 = siluf_(p.c_ctx[kc * 64 + k]);
            a0 += wv * c0; a1 += wv * c1;
        }
        *(f32x4*)(part + ((size_t)((l * 2 + 0) * 32 + kc)) * 12288 + n) = a0;
        *(f32x4*)(part + ((size_t)((l * 2 + 1) * 32 + kc)) * 12288 + n) = a1;
    }
}
__device__ void phase_ada2(const Params& p, int bid, int nb) {
    const float* part = (const float*)(p.ws + WS_MODP);
    float* mod = (float*)(p.ws + WS_MOD);
    for (int i = bid * 256 + threadIdx.x; i < 2 * 2 * 12288; i += nb * 256) {
        const int ls = i / 12288, n = i % 12288, l = ls >> 1;
        float acc = p.b_ada[(size_t)l * 12288 + n];
        for (int kc = 0; kc < 32; ++kc) acc += part[((size_t)(ls * 32 + kc)) * 12288 + n];
        mod[i] = acc;
    }
}

struct TJob { const float* src; bf16_t* dst; int K, N, batch; size_t sstride, dstride; int mode; };
__device__ __forceinline__ int tjob_tiles(const TJob& j) { return j.batch * (j.K / 64) * (j.N / 64); }
__device__ void tconv_tile(const TJob& j, int t, float* tile  ) {
    const int tid = threadIdx.x;
    const int tk = j.K / 64, tn = j.N / 64;
    const int b = t / (tk * tn), r = t % (tk * tn), kt = r / tn, nt = r % tn;
    const float* src = j.src + (size_t)b * j.sstride + (size_t)(kt * 64) * j.N + nt * 64;
    __syncthreads();
#pragma unroll
    for (int i = 0; i < 4; ++i) {
        const int k = i * 16 + (tid >> 4), n = (tid & 15) * 4;
        const f32x4 v = *(const f32x4*)(src + (size_t)k * j.N + n);
        tile[k * 65 + n + 0] = v[0]; tile[k * 65 + n + 1] = v[1]; tile[k * 65 + n + 2] = v[2]; tile[k * 65 + n + 3] = v[3];
    }
    __syncthreads();
    const int n = tid >> 2, kq = (tid & 3) * 16;
    int ng = nt * 64 + n;
    if (j.mode == 1) ng = 32 * (ng >> 4) + (ng & 15);
    else if (j.mode == 2) ng = 32 * (ng >> 4) + 16 + (ng & 15);
    bf16_t* dst = j.dst + (size_t)b * j.dstride + (size_t)ng * j.K + kt * 64 + kq;
    unsigned w[8];
#pragma unroll
    for (int i = 0; i < 8; ++i) w[i] = pack_bf2(tile[(kq + 2 * i) * 65 + n], tile[(kq + 2 * i + 1) * 65 + n]);
    *(uint4*)(dst) = make_uint4(w[0], w[1], w[2], w[3]);
    *(uint4*)(dst + 8) = make_uint4(w[4], w[5], w[6], w[7]);
}
__device__ void phase_tconv(const TJob& j, int bid, int nb, float* tile) {
    const int nt = tjob_tiles(j);
    for (int t = bid; t < nt; t += nb) tconv_tile(j, t, tile);
}
__device__ void phase_convert_layer(const Params& p, int l, int bid, int nb, float* tile) {
    TJob j;
    j = {p.w_in + (size_t)l * D * INP, (bf16_t*)(p.ws + WS_WINT) + (size_t)l * INP * D, D, INP, 1, 0, 0, 0}; phase_tconv(j, bid, nb, tile);
    j = {p.w_o + (size_t)l * D * D, (bf16_t*)(p.ws + WS_WOT) + (size_t)l * D * D, D, D, 1, 0, 0, 0}; phase_tconv(j, bid, nb, tile);
    bf16_t* w13 = (bf16_t*)(p.ws + WS_W13T) + (size_t)l * NEX * 1024 * D;
    bf16_t* w2 = (bf16_t*)(p.ws + WS_W2T) + (size_t)l * NEX * D * EFF;
    j = {p.moe_wg + (size_t)l * NE * D * EFF, w13, D, EFF, NE, (size_t)D * EFF, (size_t)1024 * D, 1}; phase_tconv(j, bid, nb, tile);
    j = {p.moe_wu + (size_t)l * NE * D * EFF, w13, D, EFF, NE, (size_t)D * EFF, (size_t)1024 * D, 2}; phase_tconv(j, bid, nb, tile);
    j = {p.moe_wd + (size_t)l * NE * EFF * D, w2, EFF, D, NE, (size_t)EFF * D, (size_t)D * EFF, 0}; phase_tconv(j, bid, nb, tile);
    j = {p.sh_wg + (size_t)l * D * EFF, w13 + (size_t)NE * 1024 * D, D, EFF, 1, 0, 0, 1}; phase_tconv(j, bid, nb, tile);
    j = {p.sh_wu + (size_t)l * D * EFF, w13 + (size_t)NE * 1024 * D, D, EFF, 1, 0, 0, 2}; phase_tconv(j, bid, nb, tile);
    j = {p.sh_wd + (size_t)l * EFF * D, w2 + (size_t)NE * D * EFF, EFF, D, 1, 0, 0, 0}; phase_tconv(j, bid, nb, tile);
}

__device__ void phase_norm1(const Params& p, int l, int bid, int nb) {
    const RowSrc in = layer_in(p, l);
    bf16_t* H = (bf16_t*)(p.ws + WS_H);
    const float* g = p.norm1_g + (size_t)l * D;
    const int wid = threadIdx.x >> 6, lane = threadIdx.x & 63;
    for (int row = bid * 4 + wid; row < NTOK; row += nb * 4) {
        const float* xr = rowp(in, row);
        const float* sh = modp(p, l, row, 0);
        const float* sc = modp(p, l, row, 1);
        f32x4 v[8]; float ss = 0.f;
#pragma unroll
        for (int i = 0; i < 8; ++i) { v[i] = *(const f32x4*)(xr + i * 256 + lane * 4); ss += v[i][0] * v[i][0] + v[i][1] * v[i][1] + v[i][2] * v[i][2] + v[i][3] * v[i][3]; }
        ss = wave_sum(ss);
        const float rstd = rsqrtf(ss * (1.f / D) + 1e-6f);
#pragma unroll
        for (int i = 0; i < 8; ++i) {
            const int c = i * 256 + lane * 4;
            const f32x4 gv = *(const f32x4*)(g + c), shv = *(const f32x4*)(sh + c), scv = *(const f32x4*)(sc + c);
            float o[4];
#pragma unroll
            for (int j = 0; j < 4; ++j) o[j] = (v[i][j] * rstd * gv[j]) * (1.f + scv[j]) + shv[j];
            *(uint2*)(H + (size_t)row * D + c) = make_uint2(pack_bf2(o[0], o[1]), pack_bf2(o[2], o[3]));
        }
    }
}

constexpr int GT_LD = 72;
constexpr int GT_LDS_BYTES = 2 * 128 * GT_LD * 2;
template <class ARow>
__device__ __forceinline__ void gemm_tile(const bf16_t* __restrict__ A, ARow arow, const bf16_t* __restrict__ Bt, int K, int n0, f32x4 (&acc)[4][4], char* smem) {
    bf16_t* As = (bf16_t*)smem;
    bf16_t* Bs = As + 128 * GT_LD;
    const int tid = threadIdx.x, wid = tid >> 6, lane = tid & 63, wr = wid >> 1, wc = wid & 1, fr = lane & 15, fq = lane >> 4;
    const int lr = tid >> 3, lk = (tid & 7) * 8;
    size_t aoff[4]; const bf16_t* bp[4];
#pragma unroll
    for (int i = 0; i < 4; ++i) { aoff[i] = arow(lr + 32 * i) + lk; bp[i] = Bt + (size_t)(n0 + lr + 32 * i) * K + lk; }
#pragma unroll
    for (int i = 0; i < 4; ++i)
#pragma unroll
        for (int j = 0; j < 4; ++j) acc[i][j] = (f32x4){0.f, 0.f, 0.f, 0.f};
    u32x4 ra[4], rb[4];
#pragma unroll
    for (int i = 0; i < 4; ++i) { ra[i] = *(const u32x4*)(A + aoff[i]); rb[i] = *(const u32x4*)(bp[i]); }
    const int nk = K / 64;
    for (int kt = 0; kt < nk; ++kt) {
        __syncthreads();
#pragma unroll
        for (int i = 0; i < 4; ++i) {
            *(u32x4*)(As + (lr + 32 * i) * GT_LD + lk) = ra[i];
            *(u32x4*)(Bs + (lr + 32 * i) * GT_LD + lk) = rb[i];
        }
        __syncthreads();
        if (kt + 1 < nk) {
#pragma unroll
            for (int i = 0; i < 4; ++i) { ra[i] = *(const u32x4*)(A + aoff[i] + (kt + 1) * 64); rb[i] = *(const u32x4*)(bp[i] + (kt + 1) * 64); }
        }
#pragma unroll
        for (int ks = 0; ks < 2; ++ks) {
            bf16x8 af[4], bf[4];
#pragma unroll
            for (int i = 0; i < 4; ++i) af[i] = *(const bf16x8*)(As + (wr * 64 + i * 16 + fr) * GT_LD + ks * 32 + fq * 8);
#pragma unroll
            for (int j = 0; j < 4; ++j) bf[j] = *(const bf16x8*)(Bs + (wc * 64 + j * 16 + fr) * GT_LD + ks * 32 + fq * 8);
#pragma unroll
            for (int i = 0; i < 4; ++i)
#pragma unroll
                for (int j = 0; j < 4; ++j) acc[i][j] = __builtin_amdgcn_mfma_f32_16x16x32_bf16(bf[j], af[i], acc[i][j], 0, 0, 0);
        }
    }
}
#define GT_IDX const int _tid = threadIdx.x, _wid = _tid >> 6, _lane = _tid & 63, wr = _wid >> 1, wc = _wid & 1, fr = _lane & 15, fq = _lane >> 4

__device__ void phase_inproj(const Params& p, int l, int bid, int nb, char* smem) {
    const bf16_t* H = (const bf16_t*)(p.ws + WS_H);
    const bf16_t* Bt = (const bf16_t*)(p.ws + WS_WINT) + (size_t)l * INP * D;
    float* P = (float*)(p.ws + WS_P);
    constexpr int TM = NTOK / 128, TN = INP / 128;
    GT_IDX;
    for (int u = bid; u < TM * TN; u += nb) {
        const int tm = u / TN, tn = u % TN, m0 = tm * 128, n0 = tn * 128;
        f32x4 acc[4][4];
        gemm_tile(H, [&](int r) { return (size_t)(m0 + r) * D; }, Bt, D, n0, acc, smem);
#pragma unroll
        for (int i = 0; i < 4; ++i)
#pragma unroll
            for (int j = 0; j < 4; ++j) *(f32x4*)(P + (size_t)(m0 + wr * 64 + i * 16 + fr) * INP + n0 + wc * 64 + j * 16 + fq * 4) = acc[i][j];
    }
}

__device__ __forceinline__ int scan_pos(int d, int row) {
    if (row >= SEQ) { const int c = row - SEQ; return d == 0 ? c : (CTXL - 1 - c); }
    return CTXL + (d == 0 ? row : (SEQ - 1 - row));
}
__device__ __forceinline__ int scan_row(int d, int s) {
    if (s < CTXL) return SEQ + (d == 0 ? s : (CTXL - 1 - s));
    const int q = s - CTXL; return d == 0 ? q : (SEQ - 1 - q);
}
constexpr int RP_TB = 8;
__device__ __forceinline__ float shifted(const float* P, int row, int col, float mu0, float mu1) {
    const float cur = P[(size_t)row * INP + col];
    const bool first = (row == 0) || (row == SEQ), last = (row == SEQ - 1) || (row == NTOK - 1);
    const float prev = first ? 0.f : P[(size_t)(row - 1) * INP + col];
    const float nxt = last ? 0.f : P[(size_t)(row + 1) * INP + col];
    return cur + mu0 * (prev - cur) + mu1 * (nxt - cur);
}
__device__ void phase_rwprep(const Params& p, int l, int bid, int nb, char* smem) {
    const float* P = (const float*)(p.ws + WS_P);
    float* REC = (float*)(p.ws + WS_REC);
    float* G = (float*)(p.ws + WS_G);
    float* BV = (float*)(p.ws + WS_BV);
    float* GMR = (float*)(p.ws + WS_GMR);
    float* lin = (float*)smem;
    const float* mu = p.rw_mu + (size_t)l * 2 * RWP;
    const float* w0 = p.rw_w0 + (size_t)l * 2 * RW;
    const float* w2 = p.rw_w2 + (size_t)l * 2 * 64 * RW;
    const float* a0 = p.rw_a0 + (size_t)l * 2 * RW;
    const float* a2 = p.rw_a2 + (size_t)l * 2 * 64 * RW;
    const float* g2 = p.rw_g2 + (size_t)l * 128 * RW;
    const float* kkw = p.rw_kk + (size_t)l * RW;
    const float* kaw = p.rw_ka + (size_t)l * RW;
    const float* rkw = p.rw_rk + (size_t)l * RW;
    const int tid = threadIdx.x, wid = tid >> 6, lane = tid & 63;
    for (int blk = bid; blk < NTOK / RP_TB; blk += nb) {
        const int t0 = blk * RP_TB;
        __syncthreads();
        for (int i = tid; i < RP_TB * 384; i += 256) {
            const int tt = i / 384, j = i % 384, col = 1536 + j;
            const float v = shifted(P, t0 + tt, col, mu[col], mu[RWP + col]);
            lin[i] = j < 128 ? tanhf(v) : (j < 256 ? v : sigmoidf_(v));
        }
        __syncthreads();
#pragma unroll
        for (int q = 0; q < 2; ++q) {
            const int row = t0 + wid * 2 + q; float ss = 0.f;
#pragma unroll
            for (int i = 0; i < 8; ++i) { const float gv = gelu_tanh(P[(size_t)row * INP + COL_GM + GMW + i * 64 + lane]); ss += gv * gv; }
            ss = wave_sum(ss);
            if (lane == 0) GMR[row] = rsqrtf(ss * (1.f / GMW) + 1e-6f);
        }
#pragma unroll
        for (int cc = 0; cc < 2; ++cc) {
            const int c = tid + cc * 256, h = c >> 6, ci = c & 63;
            float lw[2][RP_TB], la[2][RP_TB], lg[RP_TB];
#pragma unroll
            for (int tt = 0; tt < RP_TB; ++tt) { lw[0][tt] = lw[1][tt] = la[0][tt] = la[1][tt] = lg[tt] = 0.f; }
            for (int j = 0; j < 64; ++j) {
                const float wf = w2[(size_t)(0 * 64 + j) * RW + c], wb = w2[(size_t)(1 * 64 + j) * RW + c];
                const float af = a2[(size_t)(0 * 64 + j) * RW + c], ab = a2[(size_t)(1 * 64 + j) * RW + c];
                const float g0 = g2[(size_t)j * RW + c], g1 = g2[(size_t)(j + 64) * RW + c];
#pragma unroll
                for (int tt = 0; tt < RP_TB; ++tt) {
                    const float* li = lin + tt * 384;
                    lw[0][tt] += li[j] * wf; lw[1][tt] += li[64 + j] * wb;
                    la[0][tt] += li[128 + j] * af; la[1][tt] += li[192 + j] * ab;
                    lg[tt] += li[256 + j] * g0 + li[320 + j] * g1;
                }
            }
            const float kkc = kkw[c], kac = kaw[c], rkc = rkw[c];
#pragma unroll
            for (int tt = 0; tt < RP_TB; ++tt) {
                const int row = t0 + tt;
                const float r = shifted(P, row, c, mu[c], mu[RWP + c]);
                const float k = shifted(P, row, 512 + c, mu[512 + c], mu[RWP + 512 + c]);
                const float v = shifted(P, row, 1024 + c, mu[1024 + c], mu[RWP + 1024 + c]);
                float kk = k * kkc;
                const float nrm = sqrtf(wave_sum(kk * kk));
                kk = kk / fmaxf(nrm, 1e-12f);
                const float bon = wave_sum(r * k * rkc);
                G[(size_t)row * RW + c] = lg[tt];
                BV[(size_t)row * RW + c] = bon * v;
#pragma unroll
                for (int d = 0; d < 2; ++d) {
                    const float wlog = -softplusf_(-(w0[d * RW + c] + lw[d][tt])) - 0.5f;
                    const float decay = expf(-expf(wlog));
                    const float a = sigmoidf_(a0[d * RW + c] + la[d][tt]);
                    const float kd = k * (1.f + (a - 1.f) * kac);
                    float* rec = REC + ((size_t)(d * 8 + h) * NTOK + scan_pos(d, row)) * 384;
                    rec[ci] = decay; rec[64 + ci] = kk; rec[128 + ci] = kk * a; rec[192 + ci] = kd; rec[256 + ci] = r; rec[320 + ci] = v;
                }
            }
        }
    }
}

__device__ __forceinline__ float red16(float v) {
    v += __shfl_xor(v, 1); v += __shfl_xor(v, 2); v += __shfl_xor(v, 4); v += __shfl_xor(v, 8); return v;
}
constexpr int SC_TS = 16;
__device__ void phase_scan(const Params& p, int bid, int nb, char* smem) {
    const float* REC = (const float*)(p.ws + WS_REC);
    float* YD = (float*)(p.ws + WS_YD);
    float* buf = (float*)smem;
    const int tid = threadIdx.x, wid = tid >> 6, lane = tid & 63, l16 = lane & 15;
    for (int u = bid; u < 64; u += nb) {
        const int d = u >> 5, h = (u >> 2) & 7, rq = u & 3;
        const int i = rq * 16 + wid * 4 + (lane >> 4);
        const float* rec = REC + (size_t)(d * 8 + h) * NTOK * 384;
        f32x4 S = {0.f, 0.f, 0.f, 0.f};
        f32x4 pre[6];
        __syncthreads();
#pragma unroll
        for (int q = 0; q < 6; ++q) pre[q] = *(const f32x4*)(rec + (size_t)(q * 256 + tid) * 4);
#pragma unroll
        for (int q = 0; q < 6; ++q) *(f32x4*)(buf + (q * 256 + tid) * 4) = pre[q];
        __syncthreads();
        constexpr int NCH = NTOK / SC_TS;
        for (int ch = 0; ch < NCH; ++ch) {
            const float* cur = buf + (ch & 1) * (SC_TS * 384);
            float* nxt = buf + ((ch + 1) & 1) * (SC_TS * 384);
            if (ch + 1 < NCH) {
#pragma unroll
                for (int q = 0; q < 6; ++q) pre[q] = *(const f32x4*)(rec + (size_t)(ch + 1) * SC_TS * 384 + (size_t)(q * 256 + tid) * 4);
            }
#pragma unroll 4
            for (int s = 0; s < SC_TS; ++s) {
                const float* b = cur + s * 384;
                const f32x4 w = *(const f32x4*)(b + 4 * l16), kk = *(const f32x4*)(b + 64 + 4 * l16), bb = *(const f32x4*)(b + 128 + 4 * l16);
                const f32x4 kd = *(const f32x4*)(b + 192 + 4 * l16), r = *(const f32x4*)(b + 256 + 4 * l16);
                const float vi = b[320 + i];
                float sa = S[0] * kk[0] + S[1] * kk[1] + S[2] * kk[2] + S[3] * kk[3];
                sa = -red16(sa);
                S = S * w + bb * sa + kd * vi;
                float y = S[0] * r[0] + S[1] * r[1] + S[2] * r[2] + S[3] * r[3];
                y = red16(y);
                if (l16 == 0) YD[((size_t)d * NTOK + scan_row(d, ch * SC_TS + s)) * RW + h * 64 + i] = y;
            }
            if (ch + 1 < NCH) {
#pragma unroll
                for (int q = 0; q < 6; ++q) *(f32x4*)(nxt + (q * 256 + tid) * 4) = pre[q];
            }
            __syncthreads();
        }
    }
}

__device__ void phase_rwpost(const Params& p, int l, int bid, int nb) {
    const float* YD = (const float*)(p.ws + WS_YD);
    const float* G = (const float*)(p.ws + WS_G);
    const float* BV = (const float*)(p.ws + WS_BV);
    bf16_t* Y = (bf16_t*)(p.ws + WS_YCAT);
    const float* lng = p.rw_ln_g + (size_t)l * RW;
    const float* lnb = p.rw_ln_b + (size_t)l * RW;
    const int wid = threadIdx.x >> 6, lane = threadIdx.x & 63;
    for (int u = bid * 4 + wid; u < NTOK * 8; u += nb * 4) {
        const int row = u >> 3, h = u & 7, c = h * 64 + lane;
        const float y = YD[(size_t)row * RW + c] + YD[((size_t)NTOK + row) * RW + c];
        const float mean = wave_sum(y) * (1.f / 64);
        const float dv = y - mean;
        const float var = wave_sum(dv * dv) * (1.f / 64);
        const float yn = dv * rsqrtf(var + 64e-5f) * lng[c] + lnb[c];
        Y[(size_t)row * D + c] = f2bf((yn + BV[(size_t)row * RW + c]) * G[(size_t)row * RW + c]);
    }
}

__device__ void phase_gmlp(const Params& p, int l, int bid, int nb, char* smem) {
    const float* P = (const float*)(p.ws + WS_P);
    const float* GMR = (const float*)(p.ws + WS_GMR);
    bf16_t* Y = (bf16_t*)(p.ws + WS_YCAT);
    float* vt = (float*)smem;
    const float* ng = p.gm_norm_g + (size_t)l * GMW;
    const int tid = threadIdx.x, c = tid & 63, pq = tid >> 6;
    for (int u = bid; u < (NTOK / 128) * 8; u += nb) {
        const int n = u >> 3, g = u & 7, t0 = n * 128;
        const float* ws = p.gm_ws + ((size_t)l * 8 + g) * 128 * 128;
        const float* bs = p.gm_b + ((size_t)l * 8 + g) * 128;
        __syncthreads();
        for (int i = tid; i < 128 * 64; i += 256) {
            const int q = i >> 6, cc = i & 63;
            vt[i] = gelu_tanh(P[(size_t)(t0 + q) * INP + COL_GM + GMW + g * 64 + cc]) * GMR[t0 + q] * ng[g * 64 + cc];
        }
        __syncthreads();
        for (int pi = 0; pi < 32; ++pi) {
            const int pp = __builtin_amdgcn_readfirstlane(pq * 32 + pi);
            const float* wrow = ws + (size_t)pp * 128;
            float acc = 0.f;
#pragma unroll 16
            for (int q = 0; q < 128; ++q) acc += wrow[q] * vt[q * 64 + c];
            const float uu = gelu_tanh(P[(size_t)(t0 + pp) * INP + COL_GM + g * 64 + c]);
            Y[(size_t)(t0 + pp) * D + 512 + g * 64 + c] = f2bf(uu * (acc + bs[pp]));
        }
    }
}

__device__ void phase_atprep(const Params& p, int l, int bid, int nb) {
    const float* P = (const float*)(p.ws + WS_P);
    float* Q = (float*)(p.ws + WS_Q);
    float* Kf = (float*)(p.ws + WS_K);
    const float* qn = p.at_qn + (size_t)l * 64;
    const float* kn = p.at_kn + (size_t)l * 64;
    const int wid = threadIdx.x >> 6, lane = threadIdx.x & 63;
    const int sec = lane >> 5, dd = lane & 31, f = dd & 15, hf = dd >> 4;
    const float inv_freq = powf(10000.f, -(float)f / 16.f);
    for (int u = bid * 4 + wid; u < NTOK * 20; u += nb * 4) {
        const int row = u / 20, hv = u % 20;
        const bool isq = hv < 16;
        const float xv = P[(size_t)row * INP + (isq ? COL_AT + hv * 64 : COL_K + (hv - 16) * 64) + lane];
        const float ss = wave_sum(xv * xv);
        float y = xv * rsqrtf(ss * (1.f / 64) + 1e-6f) * (isq ? qn[lane] : kn[lane]);
        if (row < SEQ) {
            const float pos = (float)(sec == 0 ? (row >> 6) : (row & 63));
            const float ang = pos * inv_freq;
            const float cs = cosf(ang), sn = sinf(ang);
            const float other = __shfl_xor(y, 16);
            y = hf == 0 ? (y * cs - other * sn) : (y * cs + other * sn);
        }
        if (isq) Q[(size_t)row * 1024 + hv * 64 + lane] = y * 0.125f;
        else Kf[(size_t)row * 256 + (hv - 16) * 64 + lane] = y;
    }
}

__device__ void phase_attn(const Params& p, int l, int bid, int nb, char* smem) {
    const float* P = (const float*)(p.ws + WS_P);
    const float* Q = (const float*)(p.ws + WS_Q);
    const float* Kf = (const float*)(p.ws + WS_K);
    bf16_t* Y = (bf16_t*)(p.ws + WS_YCAT);
    float* Ks = (float*)smem;
    float* Vs = Ks + 64 * 64;
    const int tid = threadIdx.x, g = tid >> 6, qi = tid & 63;
    for (int u = bid; u < (NTOK / 64) * 4; u += nb) {
        const int qt = u >> 2, kvh = u & 3, t0 = qt * 64, row = t0 + qi, head = kvh * 4 + g;
        const bool isx = t0 < SEQ;
        float q[64], o[64];
#pragma unroll
        for (int d4 = 0; d4 < 16; ++d4) { const f32x4 v = *(const f32x4*)(Q + (size_t)row * 1024 + head * 64 + d4 * 4); q[d4 * 4] = v[0]; q[d4 * 4 + 1] = v[1]; q[d4 * 4 + 2] = v[2]; q[d4 * 4 + 3] = v[3]; }
#pragma unroll
        for (int d = 0; d < 64; ++d) o[d] = 0.f;
        float m = p.at_sink[(size_t)l * 16 + head], lsum = 1.f;
        for (int ci = (isx ? 0 : 5); ci < 9; ++ci) {
            int k0; bool local;
            if (ci < 5) { k0 = t0 - 128 + ci * 64; local = true; if (k0 < 0 || k0 >= SEQ) continue; }
            else { k0 = SEQ + (ci - 5) * 64; local = false; }
            __syncthreads();
            for (int i = tid; i < 64 * 16; i += 256) {
                const int kr = i >> 4, d4 = (i & 15) * 4;
                *(f32x4*)(Ks + kr * 64 + d4) = *(const f32x4*)(Kf + (size_t)(k0 + kr) * 256 + kvh * 64 + d4);
                *(f32x4*)(Vs + kr * 64 + d4) = *(const f32x4*)(P + (size_t)(k0 + kr) * INP + COL_V + kvh * 64 + d4);
            }
            __syncthreads();
            for (int j = 0; j < 64; ++j) {
                if (local) { const int dist = (k0 + j) - row; if (dist > 128 || dist < -128) continue; }
                float s = 0.f;
#pragma unroll
                for (int d4 = 0; d4 < 16; ++d4) { const f32x4 kv = *(const f32x4*)(Ks + j * 64 + d4 * 4); s += q[d4 * 4] * kv[0] + q[d4 * 4 + 1] * kv[1] + q[d4 * 4 + 2] * kv[2] + q[d4 * 4 + 3] * kv[3]; }
                if (s > m) {
                    const float al = expf(m - s); lsum *= al;
#pragma unroll
                    for (int d = 0; d < 64; ++d) o[d] *= al;
                    m = s;
                }
                const float pr = expf(s - m); lsum += pr;
#pragma unroll
                for (int d4 = 0; d4 < 16; ++d4) { const f32x4 vv = *(const f32x4*)(Vs + j * 64 + d4 * 4); o[d4 * 4] += pr * vv[0]; o[d4 * 4 + 1] += pr * vv[1]; o[d4 * 4 + 2] += pr * vv[2]; o[d4 * 4 + 3] += pr * vv[3]; }
            }
        }
        const float inv = 1.f / lsum;
        bf16_t* yo = Y + (size_t)row * D + 1024 + head * 64;
#pragma unroll
        for (int d8 = 0; d8 < 8; ++d8) {
            *(uint4*)(yo + d8 * 8) = make_uint4(pack_bf2(o[d8 * 8] * inv, o[d8 * 8 + 1] * inv), pack_bf2(o[d8 * 8 + 2] * inv, o[d8 * 8 + 3] * inv),
                                                pack_bf2(o[d8 * 8 + 4] * inv, o[d8 * 8 + 5] * inv), pack_bf2(o[d8 * 8 + 6] * inv, o[d8 * 8 + 7] * inv));
        }
    }
}

__device__ void phase_oproj(const Params& p, int l, int bid, int nb, char* smem) {
    const bf16_t* Y = (const bf16_t*)(p.ws + WS_YCAT);
    const bf16_t* Bt = (const bf16_t*)(p.ws + WS_WOT) + (size_t)l * D * D;
    const RowSrc in = layer_in(p, l);
    const RowDst out = layer_out(p, l);
    constexpr int TM = NTOK / 128, TN = D / 128;
    GT_IDX;
    for (int u = bid; u < TM * TN; u += nb) {
        const int tm = u / TN, tn = u % TN, m0 = tm * 128, n0 = tn * 128;
        f32x4 acc[4][4];
        gemm_tile(Y, [&](int r) { return (size_t)(m0 + r) * D; }, Bt, D, n0, acc, smem);
#pragma unroll
        for (int i = 0; i < 4; ++i)
#pragma unroll
            for (int j = 0; j < 4; ++j) {
                const int row = m0 + wr * 64 + i * 16 + fr, col = n0 + wc * 64 + j * 16 + fq * 4;
                const f32x4 xin = *(const f32x4*)(rowp(in, row) + col);
                const f32x4 g1 = *(const f32x4*)(modp(p, l, row, 2) + col);
                *(f32x4*)(rowp(out, row) + col) = xin + g1 * acc[i][j];
            }
    }
}

__device__ void phase_norm2_route(const Params& p, int l, int bid, int nb, char* smem) {
    const RowDst xs = layer_out(p, l);
    bf16_t* H = (bf16_t*)(p.ws + WS_H);
    int* cnt = (int*)(p.ws + WS_CNT) + l * 64;
    int* tokE = (int*)(p.ws + WS_TOKE);
    int* tokP = (int*)(p.ws + WS_TOKP);
    float* tokW = (float*)(p.ws + WS_TOKW);
    const float* g = p.norm2_g + (size_t)l * D;
    const float* router = p.moe_router + (size_t)l * D * NE;
    const float* rbias = p.moe_bias + (size_t)l * NE;
    float* hs = (float*)smem;
    float* part = hs + 4 * D;
    const int tid = threadIdx.x, wid = tid >> 6, lane = tid & 63;
    for (int blk = bid; blk < NTOK / 4; blk += nb) {
        const int t0 = blk * 4;
        __syncthreads();
        {
            const int rr = wid, row = t0 + rr;
            const float* xr = rowp(xs, row);
            const float* sh = modp(p, l, row, 3);
            const float* sc = modp(p, l, row, 4);
            f32x4 v[8]; float ss = 0.f;
#pragma unroll
            for (int i = 0; i < 8; ++i) { v[i] = *(const f32x4*)(xr + i * 256 + lane * 4); ss += v[i][0] * v[i][0] + v[i][1] * v[i][1] + v[i][2] * v[i][2] + v[i][3] * v[i][3]; }
            ss = wave_sum(ss);
            const float rstd = rsqrtf(ss * (1.f / D) + 1e-6f);
#pragma unroll
            for (int i = 0; i < 8; ++i) {
                const int c = i * 256 + lane * 4;
                const f32x4 gv = *(const f32x4*)(g + c), shv = *(const f32x4*)(sh + c), scv = *(const f32x4*)(sc + c);
                f32x4 o;
#pragma unroll
                for (int j = 0; j < 4; ++j) o[j] = (v[i][j] * rstd * gv[j]) * (1.f + scv[j]) + shv[j];
                *(f32x4*)(hs + rr * D + c) = o;
                *(uint2*)(H + (size_t)row * D + c) = make_uint2(pack_bf2(o[0], o[1]), pack_bf2(o[2], o[3]));
            }
        }
        __syncthreads();
        {
            float acc[4] = {0.f, 0.f, 0.f, 0.f};
            const float* rp = router + (size_t)(wid * 512) * NE + lane;
            const float* hp = hs + wid * 512;
#pragma unroll 4
            for (int k = 0; k < 512; ++k) {
                const float rv = rp[(size_t)k * NE];
#pragma unroll
                for (int r = 0; r < 4; ++r) acc[r] += hp[r * D + k] * rv;
            }
#pragma unroll
            for (int r = 0; r < 4; ++r) part[(wid * 4 + r) * 64 + lane] = acc[r];
        }
        __syncthreads();
        {
            const int rr = wid, row = t0 + rr;
            const float logit = part[(0 * 4 + rr) * 64 + lane] + part[(1 * 4 + rr) * 64 + lane] + part[(2 * 4 + rr) * 64 + lane] + part[(3 * 4 + rr) * 64 + lane];
            const float score = sigmoidf_(logit);
            const float biased = score + rbias[lane];
            float m1 = biased;
            m1 = fmaxf(m1, __shfl_xor(m1, 1)); m1 = fmaxf(m1, __shfl_xor(m1, 2)); m1 = fmaxf(m1, __shfl_xor(m1, 4));
            const unsigned long long eq = __ballot(biased == m1);
            const int gbase = lane & ~7;
            const unsigned geq = (unsigned)((eq >> gbase) & 0xffull);
            const int first = gbase + (__ffs(geq) - 1);
            float m2 = (lane == first) ? -INFINITY : biased;
            m2 = fmaxf(m2, __shfl_xor(m2, 1)); m2 = fmaxf(m2, __shfl_xor(m2, 2)); m2 = fmaxf(m2, __shfl_xor(m2, 4));
            const float gs = m1 + m2;
            const int mygrp = lane >> 3;
            int rank = 0;
#pragma unroll
            for (int k = 0; k < 8; ++k) { const float o = __shfl(gs, k * 8); rank += (o > gs || (o == gs && k < mygrp)) ? 1 : 0; }
            float val = rank < 4 ? biased : -INFINITY;
            int sel = -1;
#pragma unroll
            for (int j = 0; j < TOPK; ++j) {
                const float mx = wave_max(val);
                const unsigned long long bm = __ballot(val == mx);
                const int win = __ffsll((long long)bm) - 1;
                if (lane == win) { sel = j; val = -INFINITY; }
            }
            const float ssum = wave_sum(sel >= 0 ? score : 0.f);
            if (sel >= 0) {
                const int pos = atomicAdd(cnt + lane, 1);
                tokE[(size_t)row * 8 + sel] = lane; tokP[(size_t)row * 8 + sel] = pos; tokW[(size_t)row * 8 + sel] = score / ssum * 2.5f;
            }
        }
    }
}

__device__ void phase_slots(const Params& p, int l, int bid, int nb, char* smem) {
    const int* cnt = (const int*)(p.ws + WS_CNT) + l * 64;
    const int* tokE = (const int*)(p.ws + WS_TOKE);
    const int* tokP = (const int*)(p.ws + WS_TOKP);
    const float* tokW = (const float*)(p.ws + WS_TOKW);
    int* slotT = (int*)(p.ws + WS_SLOTT);
    float* slotW = (float*)(p.ws + WS_SLOTW);
    int* tile = (int*)(p.ws + WS_TILE);
    int* tokS = (int*)(p.ws + WS_TOKS);
    int* off = (int*)smem;
    const int tid = threadIdx.x;
    __syncthreads();
    if (tid == 0) {
        int o = 0;
        for (int e = 0; e < NE; ++e) { off[e] = o; o += (cnt[e] + 127) / 128 * 128; }
        off[NE] = o; off[NE + 1] = o + NTOK;
    }
    __syncthreads();
    const int gt = bid * 256 + tid, gs = nb * 256;
    for (int i = gt; i < NTOK * 8; i += gs) { const int e = tokE[i]; const int s = off[e] + tokP[i]; slotT[s] = i >> 3; slotW[s] = tokW[i]; tokS[i] = s; }
    for (int i = gt; i < NTOK; i += gs) { slotT[off[NE] + i] = i; slotW[off[NE] + i] = 1.f; }
    for (int i = gt; i < NE * 128; i += gs) { const int e = i >> 7, j = i & 127; const int s = off[e] + cnt[e] + j; if (s < off[e + 1]) { slotT[s] = -1; slotW[s] = 0.f; } }
    if (bid == 0) {
        const int nt = off[NE + 1] / 128;
        if (tid == 0) tile[0] = nt;
        for (int i = tid; i < nt; i += 256) {
            const int s = i * 128; int e = 0;
            for (int k = 1; k <= NE; ++k) if (s >= off[k]) e = k;
            tile[1 + i] = e;
        }
    }
}

__device__ void phase_moe1(const Params& p, int l, int bid, int nb, char* smem) {
    const bf16_t* H = (const bf16_t*)(p.ws + WS_H);
    const bf16_t* W13 = (const bf16_t*)(p.ws + WS_W13T) + (size_t)l * NEX * 1024 * D;
    const int* slotT = (const int*)(p.ws + WS_SLOTT);
    const int* tile = (const int*)(p.ws + WS_TILE);
    bf16_t* ACT = (bf16_t*)(p.ws + WS_ACT);
    const int nt = tile[0];
    GT_IDX;
    for (int u = bid; u < nt * 8; u += nb) {
        const int ti = u >> 3, ct = u & 7, e = tile[1 + ti], s0 = ti * 128, n0 = ct * 128;
        const bf16_t* Bt = W13 + (size_t)e * 1024 * D;
        f32x4 acc[4][4];
        gemm_tile(H, [&](int r) { const int t = slotT[s0 + r]; return (size_t)(t < 0 ? 0 : t) * D; }, Bt, D, n0, acc, smem);
#pragma unroll
        for (int i = 0; i < 4; ++i)
#pragma unroll
            for (int jp = 0; jp < 2; ++jp) {
                const int slot = s0 + wr * 64 + i * 16 + fr, ch = (n0 + wc * 64 + jp * 32) / 2 + fq * 4;
                float a[4];
#pragma unroll
                for (int r = 0; r < 4; ++r) a[r] = siluf_(acc[i][2 * jp][r]) * acc[i][2 * jp + 1][r];
                *(uint2*)(ACT + (size_t)slot * EFF + ch) = make_uint2(pack_bf2(a[0], a[1]), pack_bf2(a[2], a[3]));
            }
    }
}

__device__ void phase_moe2(const Params& p, int l, int bid, int nb, char* smem) {
    const bf16_t* ACT = (const bf16_t*)(p.ws + WS_ACT);
    const bf16_t* W2 = (const bf16_t*)(p.ws + WS_W2T) + (size_t)l * NEX * D * EFF;
    const int* tile = (const int*)(p.ws + WS_TILE);
    bf16_t* OUTS = (bf16_t*)(p.ws + WS_OUTS);
    const int nt = tile[0];
    GT_IDX;
    for (int u = bid; u < nt * 16; u += nb) {
        const int ti = u >> 4, ct = u & 15, e = tile[1 + ti], s0 = ti * 128, n0 = ct * 128;
        const bf16_t* Bt = W2 + (size_t)e * D * EFF;
        f32x4 acc[4][4];
        gemm_tile(ACT, [&](int r) { return (size_t)(s0 + r) * EFF; }, Bt, EFF, n0, acc, smem);
#pragma unroll
        for (int i = 0; i < 4; ++i) {
            const int slot = s0 + wr * 64 + i * 16 + fr;
#pragma unroll
            for (int j = 0; j < 4; ++j) {
                const int col = n0 + wc * 64 + j * 16 + fq * 4;
                *(uint2*)(OUTS + (size_t)slot * D + col) = make_uint2(pack_bf2(acc[i][j][0], acc[i][j][1]), pack_bf2(acc[i][j][2], acc[i][j][3]));
            }
        }
    }
}

__device__ void phase_combine(const Params& p, int l, int bid, int nb, char* smem) {
    const bf16_t* OUTS = (const bf16_t*)(p.ws + WS_OUTS);
    const int* tokS = (const int*)(p.ws + WS_TOKS);
    const float* tokW = (const float*)(p.ws + WS_TOKW);
    const int* cnt = (const int*)(p.ws + WS_CNT) + l * 64;
    const RowDst out = layer_out(p, l);
    int* sh0 = (int*)smem;
    __syncthreads();
    if (threadIdx.x == 0) { int o = 0; for (int e = 0; e < NE; ++e) o += (cnt[e] + 127) / 128 * 128; sh0[0] = o; }
    __syncthreads();
    const int shared0 = sh0[0];
    const int tid = threadIdx.x;
    for (int row = bid; row < NTOK; row += nb) {
        float* xr = rowp(out, row);
        const float* g2 = modp(p, l, row, 5);
        const int c = tid * 8;
        float acc[8];
        {
            const u32x4 v = *(const u32x4*)(OUTS + (size_t)(shared0 + row) * D + c);
#pragma unroll
            for (int q = 0; q < 4; ++q) { acc[2 * q] = __uint_as_float(v[q] << 16); acc[2 * q + 1] = __uint_as_float(v[q] & 0xffff0000u); }
        }
#pragma unroll
        for (int j = 0; j < TOPK; ++j) {
            const int s = tokS[(size_t)row * 8 + j]; const float w = tokW[(size_t)row * 8 + j];
            const u32x4 v = *(const u32x4*)(OUTS + (size_t)s * D + c);
#pragma unroll
            for (int q = 0; q < 4; ++q) { acc[2 * q] += w * __uint_as_float(v[q] << 16); acc[2 * q + 1] += w * __uint_as_float(v[q] & 0xffff0000u); }
        }
        const f32x4 g0 = *(const f32x4*)(g2 + c), g1 = *(const f32x4*)(g2 + c + 4);
        f32x4 x0 = *(const f32x4*)(xr + c), x1 = *(const f32x4*)(xr + c + 4);
#pragma unroll
        for (int q = 0; q < 4; ++q) { x0[q] += g0[q] * acc[q]; x1[q] += g1[q] * acc[4 + q]; }
        *(f32x4*)(xr + c) = x0; *(f32x4*)(xr + c + 4) = x1;
    }
}

#define NB gridDim.x
__global__ void __launch_bounds__(256) k_ada(Params p) { phase_ada(p, blockIdx.x, NB); }
__global__ void __launch_bounds__(256) k_ada2(Params p) { phase_ada2(p, blockIdx.x, NB); }
__global__ void __launch_bounds__(256) k_convert(Params p, int l) { __shared__ __attribute__((aligned(16))) float tile[64 * 65]; phase_convert_layer(p, l, blockIdx.x, NB, tile); }
__global__ void __launch_bounds__(256) k_norm1(Params p, int l) { phase_norm1(p, l, blockIdx.x, NB); }
__global__ void __launch_bounds__(256) k_inproj(Params p, int l) { __shared__ __attribute__((aligned(16))) char sm[GT_LDS_BYTES]; phase_inproj(p, l, blockIdx.x, NB, sm); }
__global__ void __launch_bounds__(256) k_rwprep(Params p, int l) { __shared__ __attribute__((aligned(16))) char sm[RP_TB * 384 * 4]; phase_rwprep(p, l, blockIdx.x, NB, sm); }
__global__ void __launch_bounds__(256) k_scan(Params p) { __shared__ __attribute__((aligned(16))) char sm[2 * SC_TS * 384 * 4]; phase_scan(p, blockIdx.x, NB, sm); }
__global__ void __launch_bounds__(256) k_rwpost(Params p, int l) { phase_rwpost(p, l, blockIdx.x, NB); }
__global__ void __launch_bounds__(256) k_gmlp(Params p, int l) { __shared__ __attribute__((aligned(16))) char sm[128 * 64 * 4]; phase_gmlp(p, l, blockIdx.x, NB, sm); }
__global__ void __launch_bounds__(256) k_atprep(Params p, int l) { phase_atprep(p, l, blockIdx.x, NB); }
__global__ void __launch_bounds__(256) k_attn(Params p, int l) { __shared__ __attribute__((aligned(16))) char sm[2 * 64 * 64 * 4]; phase_attn(p, l, blockIdx.x, NB, sm); }
__global__ void __launch_bounds__(256) k_oproj(Params p, int l) { __shared__ __attribute__((aligned(16))) char sm[GT_LDS_BYTES]; phase_oproj(p, l, blockIdx.x, NB, sm); }
__global__ void __launch_bounds__(256) k_route(Params p, int l) { __shared__ __attribute__((aligned(16))) char sm[4 * D * 4 + 4 * 4 * 64 * 4]; phase_norm2_route(p, l, blockIdx.x, NB, sm); }
__global__ void __launch_bounds__(256) k_slots(Params p, int l) { __shared__ __attribute__((aligned(16))) char sm[512]; phase_slots(p, l, blockIdx.x, NB, sm); }
__global__ void __launch_bounds__(256) k_moe1(Params p, int l) { __shared__ __attribute__((aligned(16))) char sm[GT_LDS_BYTES]; phase_moe1(p, l, blockIdx.x, NB, sm); }
__global__ void __launch_bounds__(256) k_combine(Params p, int l) { __shared__ __attribute__((aligned(16))) char sm[64]; phase_combine(p, l, blockIdx.x, NB, sm); }
__global__ void __launch_bounds__(256) k_moe2(Params p, int l) { __shared__ __attribute__((aligned(16))) char sm[GT_LDS_BYTES]; phase_moe2(p, l, blockIdx.x, NB, sm); }

extern "C" void kernel_launch(void* const* d_in, const int* in_sizes, int n_in, void* d_out, int out_size, void* d_ws, size_t ws_size, hipStream_t stream) {
    if (n_in != 35 || out_size != SEQ * D || ws_size < WS_END) {
        fprintf(stderr, "kernel_launch: unexpected shapes: n_in %d out %d ws %zu (need %zu)\n", n_in, out_size, ws_size, (size_t)WS_END);
        return;
    }
    Params p{};
    const float** f = (const float**)&p;
    for (int i = 0; i < 35; ++i) f[i] = (const float*)d_in[i];
    p.out = (float*)d_out;
    p.ws = (char*)d_ws;
    (void)hipMemsetAsync(d_ws, 0, WS_ZERO_END, stream);
    const dim3 B(256);
    const int G = 2048;
    k_ada<<<768, B, 0, stream>>>(p);
    k_ada2<<<192, B, 0, stream>>>(p);
    for (int l = 0; l < DEPTH; ++l) {
        k_convert<<<G, B, 0, stream>>>(p, l);
        k_norm1<<<G, B, 0, stream>>>(p, l);
        k_inproj<<<G, B, 0, stream>>>(p, l);
        k_rwprep<<<NTOK / RP_TB, B, 0, stream>>>(p, l);
        k_atprep<<<G, B, 0, stream>>>(p, l);
        k_scan<<<64, B, 0, stream>>>(p);
        k_rwpost<<<G, B, 0, stream>>>(p, l);
        k_gmlp<<<528, B, 0, stream>>>(p, l);
        k_attn<<<528, B, 0, stream>>>(p, l);
        k_oproj<<<G, B, 0, stream>>>(p, l);
        k_route<<<G, B, 0, stream>>>(p, l);
        k_slots<<<256, B, 0, stream>>>(p, l);
        k_moe1<<<G, B, 0, stream>>>(p, l);
        k_moe2<<<G, B, 0, stream>>>(p, l);
        k_combine<<<G, B, 0, stream>>>(p, l);
    }
}
```

```cpp
#include <hip/hip_runtime.h>
#include <stdint.h>
#include <stdio.h>

typedef unsigned short bf16_t;
typedef short bf16x8 __attribute__((ext_vector_type(8)));
typedef float f32x4 __attribute__((ext_vector_type(4)));
typedef unsigned u32x4 __attribute__((ext_vector_type(4)));
typedef unsigned u32x2 __attribute__((ext_vector_type(2)));

constexpr int D = 2048, SEQ = 8192, CTXL = 256, NTOK = SEQ + CTXL, DEPTH = 2;
constexpr int RW = 512, RWP = 1920, GMW = 512, INP = 4480;
constexpr int COL_GM = 1920, COL_AT = 2944, COL_K = 3968, COL_V = 4224;
constexpr int NE = 64, NEX = 65, EFF = 512, TOPK = 8;
constexpr int SLOT_CAP = 84224;
constexpr int MAX_TILES = SLOT_CAP / 128;

constexpr size_t al256(size_t x) { return (x + 255) & ~(size_t)255; }
constexpr size_t WS_BAR = 0;
constexpr size_t WS_CNT = 16384;
constexpr size_t WS_MOD = WS_CNT + 1024;
constexpr size_t WS_ZERO_END = al256(WS_MOD + (size_t)2 * 2 * 12288 * 4);
constexpr size_t WS_WINT = WS_ZERO_END;
constexpr size_t WS_WOT = WS_WINT + (size_t)2 * INP * D * 2;
constexpr size_t WS_W13T = WS_WOT + (size_t)2 * D * D * 2;
constexpr size_t WS_W2T = WS_W13T + (size_t)2 * NEX * 1024 * D * 2;
constexpr size_t WS_H = WS_W2T + (size_t)2 * NEX * D * EFF * 2;
constexpr size_t WS_P = WS_H + (size_t)NTOK * D * 2;
constexpr size_t WS_REC = WS_P + (size_t)NTOK * INP * 4;
constexpr size_t WS_YD = WS_REC + (size_t)2 * 8 * NTOK * 384 * 4;
constexpr size_t WS_G = WS_YD + (size_t)2 * NTOK * RW * 4;
constexpr size_t WS_BV = WS_G + (size_t)NTOK * RW * 4;
constexpr size_t WS_GMR = WS_BV + (size_t)NTOK * RW * 4;
constexpr size_t WS_YCAT = al256(WS_GMR + (size_t)NTOK * 4);
constexpr size_t WS_Q = WS_YCAT + (size_t)NTOK * D * 2;
constexpr size_t WS_K = WS_Q + (size_t)NTOK * 1024 * 4;
constexpr size_t WS_X1 = WS_K + (size_t)NTOK * 256 * 4;
constexpr size_t WS_X2C = WS_X1 + (size_t)NTOK * D * 4;
constexpr size_t WS_TOKE = WS_X2C + (size_t)CTXL * D * 4;
constexpr size_t WS_TOKP = WS_TOKE + (size_t)NTOK * 8 * 4;
constexpr size_t WS_TOKW = WS_TOKP + (size_t)NTOK * 8 * 4;
constexpr size_t WS_SLOTT = WS_TOKW + (size_t)NTOK * 8 * 4;
constexpr size_t WS_SLOTW = al256(WS_SLOTT + (size_t)SLOT_CAP * 4);
constexpr size_t WS_TILE = al256(WS_SLOTW + (size_t)SLOT_CAP * 4);
constexpr size_t WS_ACT = al256(WS_TILE + (size_t)(MAX_TILES + 64) * 4);
constexpr size_t WS_MODP = WS_ACT + (size_t)SLOT_CAP * EFF * 2;
constexpr size_t WS_TOKS = WS_MODP + (size_t)2 * 2 * 32 * 12288 * 4;
constexpr size_t WS_OUTS = WS_TOKS + (size_t)NTOK * 8 * 4;
constexpr size_t WS_END = WS_OUTS + (size_t)SLOT_CAP * D * 2;

struct Params {
    const float *x, *c, *ctx, *c_ctx, *w_ada, *b_ada, *norm1_g, *norm2_g, *w_in, *w_o;
    const float *rw_mu, *rw_w0, *rw_w2, *rw_a0, *rw_a2, *rw_g2, *rw_kk, *rw_ka, *rw_rk, *rw_ln_g, *rw_ln_b;
    const float *gm_norm_g, *gm_ws, *gm_b, *at_qn, *at_kn, *at_sink;
    const float *moe_router, *moe_bias, *moe_wg, *moe_wu, *moe_wd, *sh_wg, *sh_wu, *sh_wd;
    float* out;
    char* ws;
};

__device__ __forceinline__ bf16_t f2bf(float f) {
    unsigned u = __float_as_uint(f);
    u += 0x7fffu + ((u >> 16) & 1u);
    return (bf16_t)(u >> 16);
}
__device__ __forceinline__ float bf2f(bf16_t h) { return __uint_as_float(((unsigned)h) << 16); }
__device__ __forceinline__ unsigned pack_bf2(float lo, float hi) { return (unsigned)f2bf(lo) | ((unsigned)f2bf(hi) << 16); }
__device__ __forceinline__ float wave_sum(float v) {
#pragma unroll
    for (int o = 32; o >= 1; o >>= 1) v += __shfl_xor(v, o);
    return v;
}
__device__ __forceinline__ float wave_max(float v) {
#pragma unroll
    for (int o = 32; o >= 1; o >>= 1) v = fmaxf(v, __shfl_xor(v, o));
    return v;
}
__device__ __forceinline__ float sigmoidf_(float x) { return 1.f / (1.f + expf(-x)); }
__device__ __forceinline__ float siluf_(float x) { return x / (1.f + expf(-x)); }
__device__ __forceinline__ float gelu_tanh(float x) {
    const float u = 0.7978845608028654f * (x + 0.044715f * x * x * x);
    return 0.5f * x * (1.f + tanhf(u));
}
__device__ __forceinline__ float softplusf_(float x) { return fmaxf(x, 0.f) + log1pf(expf(-fabsf(x))); }

struct RowSrc { const float* a; const float* b; };
__device__ __forceinline__ const float* rowp(const RowSrc& r, int row) { return row < SEQ ? r.a + (size_t)row * D : r.b + (size_t)(row - SEQ) * D; }
struct RowDst { float* a; float* b; };
__device__ __forceinline__ float* rowp(const RowDst& r, int row) { return row < SEQ ? r.a + (size_t)row * D : r.b + (size_t)(row - SEQ) * D; }

__device__ __forceinline__ RowSrc layer_in(const Params& p, int l) {
    RowSrc r; if (l == 0) { r.a = p.x; r.b = p.ctx; } else { float* x1 = (float*)(p.ws + WS_X1); r.a = x1; r.b = x1 + (size_t)SEQ * D; } return r;
}
__device__ __forceinline__ RowDst layer_out(const Params& p, int l) {
    RowDst r; if (l == 0) { float* x1 = (float*)(p.ws + WS_X1); r.a = x1; r.b = x1 + (size_t)SEQ * D; } else { r.a = p.out; r.b = (float*)(p.ws + WS_X2C); } return r;
}
__device__ __forceinline__ const float* modp(const Params& p, int l, int row, int which) {
    return (const float*)(p.ws + WS_MOD) + ((size_t)(l * 2 + (row < SEQ ? 0 : 1)) * 6 + which) * D;
}

__device__ __forceinline__ int otid() { int t = threadIdx.x; asm volatile("" : "+v"(t)); return t; }

__device__ void phase_ada(const Params& p, int bid, int nb) {
    float* part = (float*)(p.ws + WS_MODP);
    const int tid = otid();
    for (int u = bid; u < 2 * 12 * 32; u += nb) {
        const int l = u / (12 * 32), r = u % (12 * 32), cg = r / 32, kc = r % 32;
        const int n = cg * 1024 + tid * 4;
        const float* w = p.w_ada + (size_t)l * D * 12288 + (size_t)(kc * 64) * 12288 + n;
        f32x4 a0 = {0, 0, 0, 0}, a1 = {0, 0, 0, 0};
#pragma unroll 8
        for (int k = 0; k < 64; ++k) {
            const f32x4 wv = *(const f32x4*)(w + (size_t)k * 12288);
            const float c0 = siluf_(p.c[kc * 64 + k]), c1 = siluf_(p.c_ctx[kc * 64 + k]);
            a0 += wv * c0; a1 += wv * c1;
        }
        *(f32x4*)(part + ((size_t)((l * 2 + 0) * 32 + kc)) * 12288 + n) = a0;
        *(f32x4*)(part + ((size_t)((l * 2 + 1) * 32 + kc)) * 12288 + n) = a1;
    }
}
__device__ void phase_ada2(const Params& p, int bid, int nb) {
    const float* part = (const float*)(p.ws + WS_MODP);
    float* mod = (float*)(p.ws + WS_MOD);
    for (int i = bid * 256 + otid(); i < 2 * 2 * 12288; i += nb * 256) {
        const int ls = i / 12288, n = i % 12288, l = ls >> 1;
        float acc = p.b_ada[(size_t)l * 12288 + n];
        for (int kc = 0; kc < 32; ++kc) acc += part[((size_t)(ls * 32 + kc)) * 12288 + n];
        mod[i] = acc;
    }
}

struct TJob { const float* src; bf16_t* dst; int K, N, batch; size_t sstride, dstride; int mode; };
__device__ __forceinline__ int tjob_tiles(const TJob& j) { return j.batch * (j.K / 64) * (j.N / 64); }
__device__ void tconv_tile(const TJob& j, int t, float* tile  ) {
    const int tid = otid();
    const int tk = j.K / 64, tn = j.N / 64;
    const int b = t / (tk * tn), r = t % (tk * tn), kt = r / tn, nt = r % tn;
    const float* src = j.src + (size_t)b * j.sstride + (size_t)(kt * 64) * j.N + nt * 64;
    __syncthreads();
#pragma unroll
    for (int i = 0; i < 4; ++i) {
        const int k = i * 16 + (tid >> 4), n = (tid & 15) * 4;
        const f32x4 v = *(const f32x4*)(src + (size_t)k * j.N + n);
        tile[k * 65 + n + 0] = v[0]; tile[k * 65 + n + 1] = v[1]; tile[k * 65 + n + 2] = v[2]; tile[k * 65 + n + 3] = v[3];
    }
    __syncthreads();
    const int n = tid >> 2, kq = (tid & 3) * 16;
    int ng = nt * 64 + n;
    if (j.mode == 1) ng = 32 * (ng >> 4) + (ng & 15);
    else if (j.mode == 2) ng = 32 * (ng >> 4) + 16 + (ng & 15);
    bf16_t* dst = j.dst + (size_t)b * j.dstride + (size_t)ng * j.K + kt * 64 + kq;
    unsigned w[8];
#pragma unroll
    for (int i = 0; i < 8; ++i) w[i] = pack_bf2(tile[(kq + 2 * i) * 65 + n], tile[(kq + 2 * i + 1) * 65 + n]);
    *(uint4*)(dst) = make_uint4(w[0], w[1], w[2], w[3]);
    *(uint4*)(dst + 8) = make_uint4(w[4], w[5], w[6], w[7]);
}
__device__ void phase_tconv(const TJob& j, int bid, int nb, float* tile) {
    const int nt = tjob_tiles(j);
    for (int t = bid; t < nt; t += nb) tconv_tile(j, t, tile);
}
__device__ void phase_convert_layer(const Params& p, int l, int bid, int nb, float* tile) {
    TJob j;
    j = {p.w_in + (size_t)l * D * INP, (bf16_t*)(p.ws + WS_WINT) + (size_t)l * INP * D, D, INP, 1, 0, 0, 0}; phase_tconv(j, bid, nb, tile);
    j = {p.w_o + (size_t)l * D * D, (bf16_t*)(p.ws + WS_WOT) + (size_t)l * D * D, D, D, 1, 0, 0, 0}; phase_tconv(j, bid, nb, tile);
    bf16_t* w13 = (bf16_t*)(p.ws + WS_W13T) + (size_t)l * NEX * 1024 * D;
    bf16_t* w2 = (bf16_t*)(p.ws + WS_W2T) + (size_t)l * NEX * D * EFF;
    j = {p.moe_wg + (size_t)l * NE * D * EFF, w13, D, EFF, NE, (size_t)D * EFF, (size_t)1024 * D, 1}; phase_tconv(j, bid, nb, tile);
    j = {p.moe_wu + (size_t)l * NE * D * EFF, w13, D, EFF, NE, (size_t)D * EFF, (size_t)1024 * D, 2}; phase_tconv(j, bid, nb, tile);
    j = {p.moe_wd + (size_t)l * NE * EFF * D, w2, EFF, D, NE, (size_t)EFF * D, (size_t)D * EFF, 0}; phase_tconv(j, bid, nb, tile);
    j = {p.sh_wg + (size_t)l * D * EFF, w13 + (size_t)NE * 1024 * D, D, EFF, 1, 0, 0, 1}; phase_tconv(j, bid, nb, tile);
    j = {p.sh_wu + (size_t)l * D * EFF, w13 + (size_t)NE * 1024 * D, D, EFF, 1, 0, 0, 2}; phase_tconv(j, bid, nb, tile);
    j = {p.sh_wd + (size_t)l * EFF * D, w2 + (size_t)NE * D * EFF, EFF, D, 1, 0, 0, 0}; phase_tconv(j, bid, nb, tile);
}

__device__ void phase_norm1(const Params& p, int l, int bid, int nb) {
    const RowSrc in = layer_in(p, l);
    bf16_t* H = (bf16_t*)(p.ws + WS_H);
    const float* g = p.norm1_g + (size_t)l * D;
    const int wid = otid() >> 6, lane = otid() & 63;
    for (int row = bid * 4 + wid; row < NTOK; row += nb * 4) {
        const float* xr = rowp(in, row);
        const float* sh = modp(p, l, row, 0);
        const float* sc = modp(p, l, row, 1);
        f32x4 v[8]; float ss = 0.f;
#pragma unroll
        for (int i = 0; i < 8; ++i) { v[i] = *(const f32x4*)(xr + i * 256 + lane * 4); ss += v[i][0] * v[i][0] + v[i][1] * v[i][1] + v[i][2] * v[i][2] + v[i][3] * v[i][3]; }
        ss = wave_sum(ss);
        const float rstd = rsqrtf(ss * (1.f / D) + 1e-6f);
#pragma unroll
        for (int i = 0; i < 8; ++i) {
            const int c = i * 256 + lane * 4;
            const f32x4 gv = *(const f32x4*)(g + c), shv = *(const f32x4*)(sh + c), scv = *(const f32x4*)(sc + c);
            float o[4];
#pragma unroll
            for (int j = 0; j < 4; ++j) o[j] = (v[i][j] * rstd * gv[j]) * (1.f + scv[j]) + shv[j];
            *(uint2*)(H + (size_t)row * D + c) = make_uint2(pack_bf2(o[0], o[1]), pack_bf2(o[2], o[3]));
        }
    }
}

constexpr int GT_LD = 72;
constexpr int GT_LDS_BYTES = 2 * 128 * GT_LD * 2;
template <class ARow>
__device__ __forceinline__ void gemm_tile(const bf16_t* __restrict__ A, ARow arow, const bf16_t* __restrict__ Bt, int K, int n0, f32x4 (&acc)[4][4], char* smem) {
    bf16_t* As = (bf16_t*)smem;
    bf16_t* Bs = As + 128 * GT_LD;
    const int tid = otid(), wid = tid >> 6, lane = tid & 63, wr = wid >> 1, wc = wid & 1, fr = lane & 15, fq = lane >> 4;
    const int lr = tid >> 3, lk = (tid & 7) * 8;
    size_t aoff[4]; const bf16_t* bp[4];
#pragma unroll
    for (int i = 0; i < 4; ++i) { aoff[i] = arow(lr + 32 * i) + lk; bp[i] = Bt + (size_t)(n0 + lr + 32 * i) * K + lk; }
#pragma unroll
    for (int i = 0; i < 4; ++i)
#pragma unroll
        for (int j = 0; j < 4; ++j) acc[i][j] = (f32x4){0.f, 0.f, 0.f, 0.f};
    u32x4 ra[4], rb[4];
#pragma unroll
    for (int i = 0; i < 4; ++i) { ra[i] = *(const u32x4*)(A + aoff[i]); rb[i] = *(const u32x4*)(bp[i]); }
    const int nk = K / 64;
    for (int kt = 0; kt < nk; ++kt) {
        __syncthreads();
#pragma unroll
        for (int i = 0; i < 4; ++i) {
            *(u32x4*)(As + (lr + 32 * i) * GT_LD + lk) = ra[i];
            *(u32x4*)(Bs + (lr + 32 * i) * GT_LD + lk) = rb[i];
        }
        __syncthreads();
        if (kt + 1 < nk) {
#pragma unroll
            for (int i = 0; i < 4; ++i) { ra[i] = *(const u32x4*)(A + aoff[i] + (kt + 1) * 64); rb[i] = *(const u32x4*)(bp[i] + (kt + 1) * 64); }
        }
#pragma unroll
        for (int ks = 0; ks < 2; ++ks) {
            bf16x8 af[4], bf[4];
#pragma unroll
            for (int i = 0; i < 4; ++i) af[i] = *(const bf16x8*)(As + (wr * 64 + i * 16 + fr) * GT_LD + ks * 32 + fq * 8);
#pragma unroll
            for (int j = 0; j < 4; ++j) bf[j] = *(const bf16x8*)(Bs + (wc * 64 + j * 16 + fr) * GT_LD + ks * 32 + fq * 8);
#pragma unroll
            for (int i = 0; i < 4; ++i)
#pragma unroll
                for (int j = 0; j < 4; ++j) acc[i][j] = __builtin_amdgcn_mfma_f32_16x16x32_bf16(bf[j], af[i], acc[i][j], 0, 0, 0);
        }
    }
}
#define GT_IDX const int _tid = otid(), _wid = _tid >> 6, _lane = _tid & 63, wr = _wid >> 1, wc = _wid & 1, fr = _lane & 15, fq = _lane >> 4

__device__ void phase_inproj(const Params& p, int l, int bid, int nb, char* smem) {
    const bf16_t* H = (const bf16_t*)(p.ws + WS_H);
    const bf16_t* Bt = (const bf16_t*)(p.ws + WS_WINT) + (size_t)l * INP * D;
    float* P = (float*)(p.ws + WS_P);
    constexpr int TM = NTOK / 128, TN = INP / 128;
    GT_IDX;
    for (int u = bid; u < TM * TN; u += nb) {
        const int tm = u / TN, tn = u % TN, m0 = tm * 128, n0 = tn * 128;
        f32x4 acc[4][4];
        gemm_tile(H, [&](int r) { return (size_t)(m0 + r) * D; }, Bt, D, n0, acc, smem);
#pragma unroll
        for (int i = 0; i < 4; ++i)
#pragma unroll
            for (int j = 0; j < 4; ++j) *(f32x4*)(P + (size_t)(m0 + wr * 64 + i * 16 + fr) * INP + n0 + wc * 64 + j * 16 + fq * 4) = acc[i][j];
    }
}

__device__ __forceinline__ int scan_pos(int d, int row) {
    if (row >= SEQ) { const int c = row - SEQ; return d == 0 ? c : (CTXL - 1 - c); }
    return CTXL + (d == 0 ? row : (SEQ - 1 - row));
}
__device__ __forceinline__ int scan_row(int d, int s) {
    if (s < CTXL) return SEQ + (d == 0 ? s : (CTXL - 1 - s));
    const int q = s - CTXL; return d == 0 ? q : (SEQ - 1 - q);
}
constexpr int RP_TB = 4;
__device__ __forceinline__ float shifted(const float* P, int row, int col, float mu0, float mu1) {
    const float cur = P[(size_t)row * INP + col];
    const bool first = (row == 0) || (row == SEQ), last = (row == SEQ - 1) || (row == NTOK - 1);
    const float prev = first ? 0.f : P[(size_t)(row - 1) * INP + col];
    const float nxt = last ? 0.f : P[(size_t)(row + 1) * INP + col];
    return cur + mu0 * (prev - cur) + mu1 * (nxt - cur);
}
__device__ void phase_rwprep(const Params& p, int l, int bid, int nb, char* smem) {
    const float* P = (const float*)(p.ws + WS_P);
    float* REC = (float*)(p.ws + WS_REC);
    float* G = (float*)(p.ws + WS_G);
    float* BV = (float*)(p.ws + WS_BV);
    float* GMR = (float*)(p.ws + WS_GMR);
    float* lin = (float*)smem;
    const float* mu = p.rw_mu + (size_t)l * 2 * RWP;
    const float* w0 = p.rw_w0 + (size_t)l * 2 * RW;
    const float* w2 = p.rw_w2 + (size_t)l * 2 * 64 * RW;
    const float* a0 = p.rw_a0 + (size_t)l * 2 * RW;
    const float* a2 = p.rw_a2 + (size_t)l * 2 * 64 * RW;
    const float* g2 = p.rw_g2 + (size_t)l * 128 * RW;
    const float* kkw = p.rw_kk + (size_t)l * RW;
    const float* kaw = p.rw_ka + (size_t)l * RW;
    const float* rkw = p.rw_rk + (size_t)l * RW;
    const int tid = otid(), wid = tid >> 6, lane = tid & 63;
    for (int blk = bid; blk < NTOK / RP_TB; blk += nb) {
        const int t0 = blk * RP_TB;
        __syncthreads();
        for (int i = tid; i < RP_TB * 384; i += 256) {
            const int tt = i / 384, j = i % 384, col = 1536 + j;
            const float v = shifted(P, t0 + tt, col, mu[col], mu[RWP + col]);
            lin[i] = j < 128 ? tanhf(v) : (j < 256 ? v : sigmoidf_(v));
        }
        __syncthreads();
        {
            const int row = t0 + wid; float ss = 0.f;
#pragma unroll
            for (int i = 0; i < 8; ++i) { const float gv = gelu_tanh(P[(size_t)row * INP + COL_GM + GMW + i * 64 + lane]); ss += gv * gv; }
            ss = wave_sum(ss);
            if (lane == 0) GMR[row] = rsqrtf(ss * (1.f / GMW) + 1e-6f);
        }
#pragma unroll
        for (int cc = 0; cc < 2; ++cc) {
            const int c = tid + cc * 256, h = c >> 6, ci = c & 63;
            float lw[2][RP_TB], la[2][RP_TB], lg[RP_TB];
#pragma unroll
            for (int tt = 0; tt < RP_TB; ++tt) { lw[0][tt] = lw[1][tt] = la[0][tt] = la[1][tt] = lg[tt] = 0.f; }
            for (int j = 0; j < 64; ++j) {
                const float wf = w2[(size_t)(0 * 64 + j) * RW + c], wb = w2[(size_t)(1 * 64 + j) * RW + c];
                const float af = a2[(size_t)(0 * 64 + j) * RW + c], ab = a2[(size_t)(1 * 64 + j) * RW + c];
                const float g0 = g2[(size_t)j * RW + c], g1 = g2[(size_t)(j + 64) * RW + c];
#pragma unroll
                for (int tt = 0; tt < RP_TB; ++tt) {
                    const float* li = lin + tt * 384;
                    lw[0][tt] += li[j] * wf; lw[1][tt] += li[64 + j] * wb;
                    la[0][tt] += li[128 + j] * af; la[1][tt] += li[192 + j] * ab;
                    lg[tt] += li[256 + j] * g0 + li[320 + j] * g1;
                }
            }
            const float kkc = kkw[c], kac = kaw[c], rkc = rkw[c];
#pragma unroll
            for (int tt = 0; tt < RP_TB; ++tt) {
                const int row = t0 + tt;
                const float r = shifted(P, row, c, mu[c], mu[RWP + c]);
                const float k = shifted(P, row, 512 + c, mu[512 + c], mu[RWP + 512 + c]);
                const float v = shifted(P, row, 1024 + c, mu[1024 + c], mu[RWP + 1024 + c]);
                float kk = k * kkc;
                const float nrm = sqrtf(wave_sum(kk * kk));
                kk = kk / fmaxf(nrm, 1e-12f);
                const float bon = wave_sum(r * k * rkc);
                G[(size_t)row * RW + c] = lg[tt];
                BV[(size_t)row * RW + c] = bon * v;
#pragma unroll
                for (int d = 0; d < 2; ++d) {
                    const float wlog = -softplusf_(-(w0[d * RW + c] + lw[d][tt])) - 0.5f;
                    const float decay = expf(-expf(wlog));
                    const float a = sigmoidf_(a0[d * RW + c] + la[d][tt]);
                    const float kd = k * (1.f + (a - 1.f) * kac);
                    float* rec = REC + ((size_t)(d * 8 + h) * NTOK + scan_pos(d, row)) * 384;
                    rec[ci] = decay; rec[64 + ci] = kk; rec[128 + ci] = kk * a; rec[192 + ci] = kd; rec[256 + ci] = r; rec[320 + ci] = v;
                }
            }
        }
    }
}

__device__ __forceinline__ float red16(float v) {
    v += __shfl_xor(v, 1); v += __shfl_xor(v, 2); v += __shfl_xor(v, 4); v += __shfl_xor(v, 8); return v;
}
constexpr int SC_TS = 16;
__device__ void phase_scan(const Params& p, int bid, int nb, char* smem) {
    const float* REC = (const float*)(p.ws + WS_REC);
    float* YD = (float*)(p.ws + WS_YD);
    float* buf = (float*)smem;
    const int tid = otid(), wid = tid >> 6, lane = tid & 63, l16 = lane & 15;
    for (int u = bid; u < 64; u += nb) {
        const int d = u >> 5, h = (u >> 2) & 7, rq = u & 3;
        const int i = rq * 16 + wid * 4 + (lane >> 4);
        const float* rec = REC + (size_t)(d * 8 + h) * NTOK * 384;
        f32x4 S = {0.f, 0.f, 0.f, 0.f};
        f32x4 pre[6];
        __syncthreads();
#pragma unroll
        for (int q = 0; q < 6; ++q) pre[q] = *(const f32x4*)(rec + (size_t)(q * 256 + tid) * 4);
#pragma unroll
        for (int q = 0; q < 6; ++q) *(f32x4*)(buf + (q * 256 + tid) * 4) = pre[q];
        __syncthreads();
        constexpr int NCH = NTOK / SC_TS;
        for (int ch = 0; ch < NCH; ++ch) {
            const float* cur = buf + (ch & 1) * (SC_TS * 384);
            float* nxt = buf + ((ch + 1) & 1) * (SC_TS * 384);
            if (ch + 1 < NCH) {
#pragma unroll
                for (int q = 0; q < 6; ++q) pre[q] = *(const f32x4*)(rec + (size_t)(ch + 1) * SC_TS * 384 + (size_t)(q * 256 + tid) * 4);
            }
#pragma unroll 4
            for (int s = 0; s < SC_TS; ++s) {
                const float* b = cur + s * 384;
                const f32x4 w = *(const f32x4*)(b + 4 * l16), kk = *(const f32x4*)(b + 64 + 4 * l16), bb = *(const f32x4*)(b + 128 + 4 * l16);
                const f32x4 kd = *(const f32x4*)(b + 192 + 4 * l16), r = *(const f32x4*)(b + 256 + 4 * l16);
                const float vi = b[320 + i];
                float sa = S[0] * kk[0] + S[1] * kk[1] + S[2] * kk[2] + S[3] * kk[3];
                sa = -red16(sa);
                S = S * w + bb * sa + kd * vi;
                float y = S[0] * r[0] + S[1] * r[1] + S[2] * r[2] + S[3] * r[3];
                y = red16(y);
                if (l16 == 0) YD[((size_t)d * NTOK + scan_row(d, ch * SC_TS + s)) * RW + h * 64 + i] = y;
            }
            if (ch + 1 < NCH) {
#pragma unroll
                for (int q = 0; q < 6; ++q) *(f32x4*)(nxt + (q * 256 + tid) * 4) = pre[q];
            }
            __syncthreads();
        }
    }
}

__device__ void phase_rwpost(const Params& p, int l, int bid, int nb) {
    const float* YD = (const float*)(p.ws + WS_YD);
    const float* G = (const float*)(p.ws + WS_G);
    const float* BV = (const float*)(p.ws + WS_BV);
    bf16_t* Y = (bf16_t*)(p.ws + WS_YCAT);
    const float* lng = p.rw_ln_g + (size_t)l * RW;
    const float* lnb = p.rw_ln_b + (size_t)l * RW;
    const int wid = otid() >> 6, lane = otid() & 63;
    for (int u = bid * 4 + wid; u < NTOK * 8; u += nb * 4) {
        const int row = u >> 3, h = u & 7, c = h * 64 + lane;
        const float y = YD[(size_t)row * RW + c] + YD[((size_t)NTOK + row) * RW + c];
        const float mean = wave_sum(y) * (1.f / 64);
        const float dv = y - mean;
        const float var = wave_sum(dv * dv) * (1.f / 64);
        const float yn = dv * rsqrtf(var + 64e-5f) * lng[c] + lnb[c];
        Y[(size_t)row * D + c] = f2bf((yn + BV[(size_t)row * RW + c]) * G[(size_t)row * RW + c]);
    }
}

__device__ void phase_gmlp(const Params& p, int l, int bid, int nb, char* smem) {
    const float* P = (const float*)(p.ws + WS_P);
    const float* GMR = (const float*)(p.ws + WS_GMR);
    bf16_t* Y = (bf16_t*)(p.ws + WS_YCAT);
    float* vt = (float*)smem;
    const float* ng = p.gm_norm_g + (size_t)l * GMW;
    const int tid = otid(), c = tid & 63, pq = tid >> 6;
    for (int u = bid; u < (NTOK / 128) * 8; u += nb) {
        const int n = u >> 3, g = u & 7, t0 = n * 128;
        const float* ws = p.gm_ws + ((size_t)l * 8 + g) * 128 * 128;
        const float* bs = p.gm_b + ((size_t)l * 8 + g) * 128;
        __syncthreads();
        for (int i = tid; i < 128 * 64; i += 256) {
            const int q = i >> 6, cc = i & 63;
            vt[i] = gelu_tanh(P[(size_t)(t0 + q) * INP + COL_GM + GMW + g * 64 + cc]) * GMR[t0 + q] * ng[g * 64 + cc];
        }
        __syncthreads();
        for (int pi = 0; pi < 32; ++pi) {
            const int pp = __builtin_amdgcn_readfirstlane(pq * 32 + pi);
            const float* wrow = ws + (size_t)pp * 128;
            float acc = 0.f;
#pragma unroll 16
            for (int q = 0; q < 128; ++q) acc += wrow[q] * vt[q * 64 + c];
            const float uu = gelu_tanh(P[(size_t)(t0 + pp) * INP + COL_GM + g * 64 + c]);
            Y[(size_t)(t0 + pp) * D + 512 + g * 64 + c] = f2bf(uu * (acc + bs[pp]));
        }
    }
}

__device__ void phase_atprep(const Params& p, int l, int bid, int nb) {
    const float* P = (const float*)(p.ws + WS_P);
    float* Q = (float*)(p.ws + WS_Q);
    float* Kf = (float*)(p.ws + WS_K);
    const float* qn = p.at_qn + (size_t)l * 64;
    const float* kn = p.at_kn + (size_t)l * 64;
    const int wid = otid() >> 6, lane = otid() & 63;
    const int sec = lane >> 5, dd = lane & 31, f = dd & 15, hf = dd >> 4;
    const float inv_freq = powf(10000.f, -(float)f / 16.f);
    for (int u = bid * 4 + wid; u < NTOK * 20; u += nb * 4) {
        const int row = u / 20, hv = u % 20;
        const bool isq = hv < 16;
        const float xv = P[(size_t)row * INP + (isq ? COL_AT + hv * 64 : COL_K + (hv - 16) * 64) + lane];
        const float ss = wave_sum(xv * xv);
        float y = xv * rsqrtf(ss * (1.f / 64) + 1e-6f) * (isq ? qn[lane] : kn[lane]);
        if (row < SEQ) {
            const float pos = (float)(sec == 0 ? (row >> 6) : (row & 63));
            const float ang = pos * inv_freq;
            const float cs = cosf(ang), sn = sinf(ang);
            const float other = __shfl_xor(y, 16);
            y = hf == 0 ? (y * cs - other * sn) : (y * cs + other * sn);
        }
        if (isq) Q[(size_t)row * 1024 + hv * 64 + lane] = y * 0.125f;
        else Kf[(size_t)row * 256 + (hv - 16) * 64 + lane] = y;
    }
}

__device__ void phase_attn(const Params& p, int l, int bid, int nb, char* smem) {
    const float* P = (const float*)(p.ws + WS_P);
    const float* Q = (const float*)(p.ws + WS_Q);
    const float* Kf = (const float*)(p.ws + WS_K);
    bf16_t* Y = (bf16_t*)(p.ws + WS_YCAT);
    float* Ks = (float*)smem;
    float* Vs = Ks + 64 * 64;
    const int tid = otid(), g = tid >> 6, qi = tid & 63;
    for (int u = bid; u < (NTOK / 64) * 4; u += nb) {
        const int qt = u >> 2, kvh = u & 3, t0 = qt * 64, row = t0 + qi, head = kvh * 4 + g;
        const bool isx = t0 < SEQ;
        float q[64], o[64];
#pragma unroll
        for (int d4 = 0; d4 < 16; ++d4) { const f32x4 v = *(const f32x4*)(Q + (size_t)row * 1024 + head * 64 + d4 * 4); q[d4 * 4] = v[0]; q[d4 * 4 + 1] = v[1]; q[d4 * 4 + 2] = v[2]; q[d4 * 4 + 3] = v[3]; }
#pragma unroll
        for (int d = 0; d < 64; ++d) o[d] = 0.f;
        float m = p.at_sink[(size_t)l * 16 + head], lsum = 1.f;
        for (int ci = (isx ? 0 : 5); ci < 9; ++ci) {
            int k0; bool local;
            if (ci < 5) { k0 = t0 - 128 + ci * 64; local = true; if (k0 < 0 || k0 >= SEQ) continue; }
            else { k0 = SEQ + (ci - 5) * 64; local = false; }
            __syncthreads();
            for (int i = tid; i < 64 * 16; i += 256) {
                const int kr = i >> 4, d4 = (i & 15) * 4;
                *(f32x4*)(Ks + kr * 64 + d4) = *(const f32x4*)(Kf + (size_t)(k0 + kr) * 256 + kvh * 64 + d4);
                *(f32x4*)(Vs + kr * 64 + d4) = *(const f32x4*)(P + (size_t)(k0 + kr) * INP + COL_V + kvh * 64 + d4);
            }
            __syncthreads();
            for (int j = 0; j < 64; ++j) {
                if (local) { const int dist = (k0 + j) - row; if (dist > 128 || dist < -128) continue; }
                float s = 0.f;
#pragma unroll
                for (int d4 = 0; d4 < 16; ++d4) { const f32x4 kv = *(const f32x4*)(Ks + j * 64 + d4 * 4); s += q[d4 * 4] * kv[0] + q[d4 * 4 + 1] * kv[1] + q[d4 * 4 + 2] * kv[2] + q[d4 * 4 + 3] * kv[3]; }
                if (s > m) {
                    const float al = expf(m - s); lsum *= al;
#pragma unroll
                    for (int d = 0; d < 64; ++d) o[d] *= al;
                    m = s;
                }
                const float pr = expf(s - m); lsum += pr;
#pragma unroll
                for (int d4 = 0; d4 < 16; ++d4) { const f32x4 vv = *(const f32x4*)(Vs + j * 64 + d4 * 4); o[d4 * 4] += pr * vv[0]; o[d4 * 4 + 1] += pr * vv[1]; o[d4 * 4 + 2] += pr * vv[2]; o[d4 * 4 + 3] += pr * vv[3]; }
            }
        }
        const float inv = 1.f / lsum;
        bf16_t* yo = Y + (size_t)row * D + 1024 + head * 64;
#pragma unroll
        for (int d8 = 0; d8 < 8; ++d8) {
            *(uint4*)(yo + d8 * 8) = make_uint4(pack_bf2(o[d8 * 8] * inv, o[d8 * 8 + 1] * inv), pack_bf2(o[d8 * 8 + 2] * inv, o[d8 * 8 + 3] * inv),
                                                pack_bf2(o[d8 * 8 + 4] * inv, o[d8 * 8 + 5] * inv), pack_bf2(o[d8 * 8 + 6] * inv, o[d8 * 8 + 7] * inv));
        }
    }
}

__device__ void phase_oproj(const Params& p, int l, int bid, int nb, char* smem) {
    const bf16_t* Y = (const bf16_t*)(p.ws + WS_YCAT);
    const bf16_t* Bt = (const bf16_t*)(p.ws + WS_WOT) + (size_t)l * D * D;
    const RowSrc in = layer_in(p, l);
    const RowDst out = layer_out(p, l);
    constexpr int TM = NTOK / 128, TN = D / 128;
    GT_IDX;
    for (int u = bid; u < TM * TN; u += nb) {
        const int tm = u / TN, tn = u % TN, m0 = tm * 128, n0 = tn * 128;
        f32x4 acc[4][4];
        gemm_tile(Y, [&](int r) { return (size_t)(m0 + r) * D; }, Bt, D, n0, acc, smem);
#pragma unroll
        for (int i = 0; i < 4; ++i)
#pragma unroll
            for (int j = 0; j < 4; ++j) {
                const int row = m0 + wr * 64 + i * 16 + fr, col = n0 + wc * 64 + j * 16 + fq * 4;
                const f32x4 xin = *(const f32x4*)(rowp(in, row) + col);
                const f32x4 g1 = *(const f32x4*)(modp(p, l, row, 2) + col);
                *(f32x4*)(rowp(out, row) + col) = xin + g1 * acc[i][j];
            }
    }
}

__device__ void phase_norm2_route(const Params& p, int l, int bid, int nb, char* smem) {
    const RowDst xs = layer_out(p, l);
    bf16_t* H = (bf16_t*)(p.ws + WS_H);
    int* cnt = (int*)(p.ws + WS_CNT) + l * 64;
    int* tokE = (int*)(p.ws + WS_TOKE);
    int* tokP = (int*)(p.ws + WS_TOKP);
    float* tokW = (float*)(p.ws + WS_TOKW);
    const float* g = p.norm2_g + (size_t)l * D;
    const float* router = p.moe_router + (size_t)l * D * NE;
    const float* rbias = p.moe_bias + (size_t)l * NE;
    float* hs = (float*)smem;
    float* part = hs + 4 * D;
    const int tid = otid(), wid = tid >> 6, lane = tid & 63;
    for (int blk = bid; blk < NTOK / 4; blk += nb) {
        const int t0 = blk * 4;
        __syncthreads();
        {
            const int rr = wid, row = t0 + rr;
            const float* xr = rowp(xs, row);
            const float* sh = modp(p, l, row, 3);
            const float* sc = modp(p, l, row, 4);
            f32x4 v[8]; float ss = 0.f;
#pragma unroll
            for (int i = 0; i < 8; ++i) { v[i] = *(const f32x4*)(xr + i * 256 + lane * 4); ss += v[i][0] * v[i][0] + v[i][1] * v[i][1] + v[i][2] * v[i][2] + v[i][3] * v[i][3]; }
            ss = wave_sum(ss);
            const float rstd = rsqrtf(ss * (1.f / D) + 1e-6f);
#pragma unroll
            for (int i = 0; i < 8; ++i) {
                const int c = i * 256 + lane * 4;
                const f32x4 gv = *(const f32x4*)(g + c), shv = *(const f32x4*)(sh + c), scv = *(const f32x4*)(sc + c);
                f32x4 o;
#pragma unroll
                for (int j = 0; j < 4; ++j) o[j] = (v[i][j] * rstd * gv[j]) * (1.f + scv[j]) + shv[j];
                *(f32x4*)(hs + rr * D + c) = o;
                *(uint2*)(H + (size_t)row * D + c) = make_uint2(pack_bf2(o[0], o[1]), pack_bf2(o[2], o[3]));
            }
        }
        __syncthreads();
        {
            float acc[4] = {0.f, 0.f, 0.f, 0.f};
            const float* rp = router + (size_t)(wid * 512) * NE + lane;
            const float* hp = hs + wid * 512;
#pragma unroll 4
            for (int k = 0; k < 512; ++k) {
                const float rv = rp[(size_t)k * NE];
#pragma unroll
                for (int r = 0; r < 4; ++r) acc[r] += hp[r * D + k] * rv;
            }
#pragma unroll
            for (int r = 0; r < 4; ++r) part[(wid * 4 + r) * 64 + lane] = acc[r];
        }
        __syncthreads();
        {
            const int rr = wid, row = t0 + rr;
            const float logit = part[(0 * 4 + rr) * 64 + lane] + part[(1 * 4 + rr) * 64 + lane] + part[(2 * 4 + rr) * 64 + lane] + part[(3 * 4 + rr) * 64 + lane];
            const float score = sigmoidf_(logit);
            const float biased = score + rbias[lane];
            float m1 = biased;
            m1 = fmaxf(m1, __shfl_xor(m1, 1)); m1 = fmaxf(m1, __shfl_xor(m1, 2)); m1 = fmaxf(m1, __shfl_xor(m1, 4));
            const unsigned long long eq = __ballot(biased == m1);
            const int gbase = lane & ~7;
            const unsigned geq = (unsigned)((eq >> gbase) & 0xffull);
            const int first = gbase + (__ffs(geq) - 1);
            float m2 = (lane == first) ? -INFINITY : biased;
            m2 = fmaxf(m2, __shfl_xor(m2, 1)); m2 = fmaxf(m2, __shfl_xor(m2, 2)); m2 = fmaxf(m2, __shfl_xor(m2, 4));
            const float gs = m1 + m2;
            const int mygrp = lane >> 3;
            int rank = 0;
#pragma unroll
            for (int k = 0; k < 8; ++k) { const float o = __shfl(gs, k * 8); rank += (o > gs || (o == gs && k < mygrp)) ? 1 : 0; }
            float val = rank < 4 ? biased : -INFINITY;
            int sel = -1;
#pragma unroll
            for (int j = 0; j < TOPK; ++j) {
                const float mx = wave_max(val);
                const unsigned long long bm = __ballot(val == mx);
                const int win = __ffsll((long long)bm) - 1;
                if (lane == win) { sel = j; val = -INFINITY; }
            }
            const float ssum = wave_sum(sel >= 0 ? score : 0.f);
            if (sel >= 0) {
                const int pos = atomicAdd(cnt + lane, 1);
                tokE[(size_t)row * 8 + sel] = lane; tokP[(size_t)row * 8 + sel] = pos; tokW[(size_t)row * 8 + sel] = score / ssum * 2.5f;
            }
        }
    }
}

__device__ void phase_slots(const Params& p, int l, int bid, int nb, char* smem) {
    const int* cnt = (const int*)(p.ws + WS_CNT) + l * 64;
    const int* tokE = (const int*)(p.ws + WS_TOKE);
    const int* tokP = (const int*)(p.ws + WS_TOKP);
    const float* tokW = (const float*)(p.ws + WS_TOKW);
    int* slotT = (int*)(p.ws + WS_SLOTT);
    float* slotW = (float*)(p.ws + WS_SLOTW);
    int* tile = (int*)(p.ws + WS_TILE);
    int* tokS = (int*)(p.ws + WS_TOKS);
    int* off = (int*)smem;
    const int tid = otid();
    __syncthreads();
    if (tid == 0) {
        int o = 0;
        for (int e = 0; e < NE; ++e) { off[e] = o; o += (cnt[e] + 127) / 128 * 128; }
        off[NE] = o; off[NE + 1] = o + NTOK;
    }
    __syncthreads();
    const int gt = bid * 256 + tid, gs = nb * 256;
    for (int i = gt; i < NTOK * 8; i += gs) { const int e = tokE[i]; const int s = off[e] + tokP[i]; slotT[s] = i >> 3; slotW[s] = tokW[i]; tokS[i] = s; }
    for (int i = gt; i < NTOK; i += gs) { slotT[off[NE] + i] = i; slotW[off[NE] + i] = 1.f; }
    for (int i = gt; i < NE * 128; i += gs) { const int e = i >> 7, j = i & 127; const int s = off[e] + cnt[e] + j; if (s < off[e + 1]) { slotT[s] = -1; slotW[s] = 0.f; } }
    if (bid == 0) {
        const int nt = off[NE + 1] / 128;
        if (tid == 0) tile[0] = nt;
        for (int i = tid; i < nt; i += 256) {
            const int s = i * 128; int e = 0;
            for (int k = 1; k <= NE; ++k) if (s >= off[k]) e = k;
            tile[1 + i] = e;
        }
    }
}

__device__ void phase_moe1(const Params& p, int l, int bid, int nb, char* smem) {
    const bf16_t* H = (const bf16_t*)(p.ws + WS_H);
    const bf16_t* W13 = (const bf16_t*)(p.ws + WS_W13T) + (size_t)l * NEX * 1024 * D;
    const int* slotT = (const int*)(p.ws + WS_SLOTT);
    const int* tile = (const int*)(p.ws + WS_TILE);
    bf16_t* ACT = (bf16_t*)(p.ws + WS_ACT);
    const int nt = tile[0];
    GT_IDX;
    for (int u = bid; u < nt * 8; u += nb) {
        const int ti = u >> 3, ct = u & 7, e = tile[1 + ti], s0 = ti * 128, n0 = ct * 128;
        const bf16_t* Bt = W13 + (size_t)e * 1024 * D;
        f32x4 acc[4][4];
        gemm_tile(H, [&](int r) { const int t = slotT[s0 + r]; return (size_t)(t < 0 ? 0 : t) * D; }, Bt, D, n0, acc, smem);
#pragma unroll
        for (int i = 0; i < 4; ++i)
#pragma unroll
            for (int jp = 0; jp < 2; ++jp) {
                const int slot = s0 + wr * 64 + i * 16 + fr, ch = (n0 + wc * 64 + jp * 32) / 2 + fq * 4;
                float a[4];
#pragma unroll
                for (int r = 0; r < 4; ++r) a[r] = siluf_(acc[i][2 * jp][r]) * acc[i][2 * jp + 1][r];
                *(uint2*)(ACT + (size_t)slot * EFF + ch) = make_uint2(pack_bf2(a[0], a[1]), pack_bf2(a[2], a[3]));
            }
    }
}

__device__ void phase_moe2(const Params& p, int l, int bid, int nb, char* smem) {
    const bf16_t* ACT = (const bf16_t*)(p.ws + WS_ACT);
    const bf16_t* W2 = (const bf16_t*)(p.ws + WS_W2T) + (size_t)l * NEX * D * EFF;
    const int* tile = (const int*)(p.ws + WS_TILE);
    bf16_t* OUTS = (bf16_t*)(p.ws + WS_OUTS);
    const int nt = tile[0];
    GT_IDX;
    for (int u = bid; u < nt * 16; u += nb) {
        const int ti = u >> 4, ct = u & 15, e = tile[1 + ti], s0 = ti * 128, n0 = ct * 128;
        const bf16_t* Bt = W2 + (size_t)e * D * EFF;
        f32x4 acc[4][4];
        gemm_tile(ACT, [&](int r) { return (size_t)(s0 + r) * EFF; }, Bt, EFF, n0, acc, smem);
#pragma unroll
        for (int i = 0; i < 4; ++i) {
            const int slot = s0 + wr * 64 + i * 16 + fr;
#pragma unroll
            for (int j = 0; j < 4; ++j) {
                const int col = n0 + wc * 64 + j * 16 + fq * 4;
                *(uint2*)(OUTS + (size_t)slot * D + col) = make_uint2(pack_bf2(acc[i][j][0], acc[i][j][1]), pack_bf2(acc[i][j][2], acc[i][j][3]));
            }
        }
    }
}

__device__ void phase_combine(const Params& p, int l, int bid, int nb, char* smem) {
    const bf16_t* OUTS = (const bf16_t*)(p.ws + WS_OUTS);
    const int* tokS = (const int*)(p.ws + WS_TOKS);
    const float* tokW = (const float*)(p.ws + WS_TOKW);
    const int* cnt = (const int*)(p.ws + WS_CNT) + l * 64;
    const RowDst out = layer_out(p, l);
    int* sh0 = (int*)smem;
    __syncthreads();
    if (otid() == 0) { int o = 0; for (int e = 0; e < NE; ++e) o += (cnt[e] + 127) / 128 * 128; sh0[0] = o; }
    __syncthreads();
    const int shared0 = sh0[0];
    const int tid = otid();
    for (int row = bid; row < NTOK; row += nb) {
        float* xr = rowp(out, row);
        const float* g2 = modp(p, l, row, 5);
        const int c = tid * 8;
        float acc[8];
        {
            const u32x4 v = *(const u32x4*)(OUTS + (size_t)(shared0 + row) * D + c);
#pragma unroll
            for (int q = 0; q < 4; ++q) { acc[2 * q] = __uint_as_float(v[q] << 16); acc[2 * q + 1] = __uint_as_float(v[q] & 0xffff0000u); }
        }
#pragma unroll
        for (int j = 0; j < TOPK; ++j) {
            const int s = tokS[(size_t)row * 8 + j]; const float w = tokW[(size_t)row * 8 + j];
            const u32x4 v = *(const u32x4*)(OUTS + (size_t)s * D + c);
#pragma unroll
            for (int q = 0; q < 4; ++q) { acc[2 * q] += w * __uint_as_float(v[q] << 16); acc[2 * q + 1] += w * __uint_as_float(v[q] & 0xffff0000u); }
        }
        const f32x4 g0 = *(const f32x4*)(g2 + c), g1 = *(const f32x4*)(g2 + c + 4);
        f32x4 x0 = *(const f32x4*)(xr + c), x1 = *(const f32x4*)(xr + c + 4);
#pragma unroll
        for (int q = 0; q < 4; ++q) { x0[q] += g0[q] * acc[q]; x1[q] += g1[q] * acc[4 + q]; }
        *(f32x4*)(xr + c) = x0; *(f32x4*)(xr + c + 4) = x1;
    }
}

#define XB_TMO      128
#define XB_XCNT(j)  (256  + 64 * (j))
#define XB_XSUB(j)  (1280 + 64 * (j))
#define XB_XGEN(j)  (2304 + 64 * (j))
#define XB_TOP      3328
#define XB_TOPGEN   3392
#define XCD_BAR_WORDS 3456
#define XB_SPIN_CAP (1u << 18)
#define LAS __attribute__((address_space(3)))

__device__ __forceinline__ unsigned xb_ld(unsigned* p)              { return __hip_atomic_load(p, __ATOMIC_RELAXED, __HIP_MEMORY_SCOPE_AGENT); }
__device__ __forceinline__ unsigned xb_add(unsigned* p, unsigned v) { return __hip_atomic_fetch_add(p, v, __ATOMIC_RELAXED, __HIP_MEMORY_SCOPE_AGENT); }
__device__ __forceinline__ unsigned xb_xcc_id() { return (unsigned)__builtin_amdgcn_s_getreg((3 << 11) | 20) & 0xFu; }
#define XB_SPIN(cond, bar) do { unsigned _sp = 0; while (cond) { __builtin_amdgcn_s_sleep(1); \
    if ((++_sp & 255u) == 0u) { if (xb_ld(&(bar)[XB_TMO])) break; if (_sp > XB_SPIN_CAP) { atomicAdd(&(bar)[XB_TMO], 1u); break; } } } } while (0)

struct XcdBarrier {
    unsigned* bar; unsigned x;
    volatile LAS unsigned* st;
};
__device__ __forceinline__ XcdBarrier xcd_barrier_post(unsigned* bar, volatile LAS unsigned* st) {
    XcdBarrier b; b.bar = bar; b.x = xb_xcc_id(); b.st = st;
    if (threadIdx.x == 0) (void)xb_add(&bar[XB_XCNT(b.x)], 1u);
    return b;
}
__device__ __forceinline__ void xcd_barrier_complete(unsigned* bar, unsigned x, unsigned& nloc, unsigned& nx) {
    const unsigned G = gridDim.x * gridDim.y * gridDim.z;
    unsigned sum, cnt, mine, sp = 0u;
    for (;;) {
        sum = 0u; cnt = 0u; mine = 0u;
#pragma unroll
        for (unsigned j = 0; j < 16; ++j) { const unsigned c = xb_ld(&bar[XB_XCNT(j)]); sum += c; cnt += (c > 0u) ? 1u : 0u; mine = (j == x) ? c : mine; }
        if (sum == G) break;
        __builtin_amdgcn_s_sleep(1);
        if ((++sp & 255u) == 0u) { if (xb_ld(&bar[XB_TMO])) break; if (sp > XB_SPIN_CAP) { atomicAdd(&bar[XB_TMO], 1u); break; } }
    }
    nloc = mine > 0u ? mine : 1u; nx = cnt > 0u ? cnt : 1u;
}
__device__ __forceinline__ void xcd_barrier(const XcdBarrier& b) {
    asm volatile("s_waitcnt vmcnt(0)" ::: "memory");
    __syncthreads();
    if (threadIdx.x == 0) {
        unsigned* bar = b.bar;
        __builtin_amdgcn_s_waitcnt(0);
        unsigned nloc = b.st[0], nx = b.st[1];
        if (nloc == 0u) { xcd_barrier_complete(bar, b.x, nloc, nx); b.st[0] = nloc; b.st[1] = nx; }
        const unsigned old = xb_add(&bar[XB_XSUB(b.x)], 1u);
        const unsigned gen = old / nloc;
        if (old + 1u == (gen + 1u) * nloc) {
            __builtin_amdgcn_fence(__ATOMIC_RELEASE, "agent");
            asm volatile("s_waitcnt vmcnt(0)" ::: "memory");
            const unsigned og = xb_add(&bar[XB_TOP], 1u);
            const unsigned tg = og / nx;
            if (og + 1u == (tg + 1u) * nx) xb_add(&bar[XB_TOPGEN], 1u);
            else XB_SPIN(xb_ld(&bar[XB_TOPGEN]) == tg, bar);
            __builtin_amdgcn_fence(__ATOMIC_ACQUIRE, "agent");
            xb_add(&bar[XB_XGEN(b.x)], 1u);
            asm volatile("s_waitcnt vmcnt(0)" ::: "memory");
        } else {
            XB_SPIN(xb_ld(&bar[XB_XGEN(b.x)]) == gen, bar);
            __builtin_amdgcn_fence(__ATOMIC_ACQUIRE, "agent");
            asm volatile("s_waitcnt vmcnt(0)" ::: "memory");
        }
    }
    __syncthreads();
}

constexpr int FUSED_LDS = 16 + 2 * SC_TS * 384 * 4;
constexpr int SCAN_BLOCKS = 64;
__global__ void __launch_bounds__(256, 2) k_fused(Params p) {
    extern __shared__ __attribute__((aligned(16))) char dsm[];
    if (threadIdx.x == 0) *(uint4*)dsm = make_uint4(0u, 0u, 0u, 0u);
    __syncthreads();
    XcdBarrier bar = xcd_barrier_post((unsigned*)(p.ws + WS_BAR), (volatile LAS unsigned*)dsm);
    char* sm = dsm + 16;
    const int bid = blockIdx.x, nb = gridDim.x;
    phase_ada(p, bid, nb);
    phase_convert_layer(p, 0, bid, nb, (float*)sm);
    xcd_barrier(bar);
    phase_ada2(p, bid, nb);
    xcd_barrier(bar);
    for (int l = 0; l < DEPTH; ++l) {
        phase_norm1(p, l, bid, nb);
        xcd_barrier(bar);
        phase_inproj(p, l, bid, nb, sm);
        xcd_barrier(bar);
        phase_rwprep(p, l, bid, nb, sm);
        phase_atprep(p, l, bid, nb);
        xcd_barrier(bar);
        if (bid < SCAN_BLOCKS) phase_scan(p, bid, SCAN_BLOCKS, sm);
        else {
            phase_gmlp(p, l, bid - SCAN_BLOCKS, nb - SCAN_BLOCKS, sm);
            phase_attn(p, l, bid - SCAN_BLOCKS, nb - SCAN_BLOCKS, sm);
            if (l == 0) phase_convert_layer(p, 1, bid - SCAN_BLOCKS, nb - SCAN_BLOCKS, (float*)sm);
        }
        xcd_barrier(bar);
        phase_rwpost(p, l, bid, nb);
        xcd_barrier(bar);
        phase_oproj(p, l, bid, nb, sm);
        xcd_barrier(bar);
        phase_norm2_route(p, l, bid, nb, sm);
        xcd_barrier(bar);
        phase_slots(p, l, bid, nb, sm);
        xcd_barrier(bar);
        phase_moe1(p, l, bid, nb, sm);
        xcd_barrier(bar);
        phase_moe2(p, l, bid, nb, sm);
        xcd_barrier(bar);
        phase_combine(p, l, bid, nb, sm);
        xcd_barrier(bar);
    }
}

extern "C" void kernel_launch(void* const* d_in, const int* in_sizes, int n_in, void* d_out, int out_size, void* d_ws, size_t ws_size, hipStream_t stream) {
    if (n_in != 35 || out_size != SEQ * D || ws_size < WS_END) {
        fprintf(stderr, "kernel_launch: unexpected shapes: n_in %d out %d ws %zu (need %zu)\n", n_in, out_size, ws_size, (size_t)WS_END);
        return;
    }
    static int grid = 0;
    if (!grid) {
        int dev = 0, cus = 0, per_cu = 0;
        (void)hipGetDevice(&dev);
        (void)hipDeviceGetAttribute(&cus, hipDeviceAttributeMultiprocessorCount, dev);
        (void)hipFuncSetAttribute((const void*)k_fused, hipFuncAttributeMaxDynamicSharedMemorySize, FUSED_LDS);
        (void)hipOccupancyMaxActiveBlocksPerMultiprocessor(&per_cu, (const void*)k_fused, 256, FUSED_LDS);
        if (per_cu < 1) { fprintf(stderr, "kernel_launch: occupancy query says %d blocks per CU\n", per_cu); per_cu = 1; }
        grid = cus * (per_cu < 2 ? per_cu : 2);
        if (grid <= SCAN_BLOCKS) grid = 0;
    }
    if (!grid) { fprintf(stderr, "kernel_launch: bad grid\n"); return; }
    Params p{};
    const float** f = (const float**)&p;
    for (int i = 0; i < 35; ++i) f[i] = (const float*)d_in[i];
    p.out = (float*)d_out;
    p.ws = (char*)d_ws;
    (void)hipMemsetAsync(d_ws, 0, WS_ZERO_END, stream);
    hipLaunchKernelGGL(k_fused, dim3(grid), dim3(256), FUSED_LDS, stream, p);
}
```

```cpp
#include <hip/hip_runtime.h>
#include <stdint.h>
#include <stdio.h>

typedef unsigned short bf16_t;
typedef short bf16x8 __attribute__((ext_vector_type(8)));
typedef float f32x4 __attribute__((ext_vector_type(4)));
typedef unsigned u32x4 __attribute__((ext_vector_type(4)));
typedef unsigned u32x2 __attribute__((ext_vector_type(2)));

constexpr int D = 2048, SEQ = 8192, CTXL = 256, NTOK = SEQ + CTXL, DEPTH = 2;
constexpr int RW = 512, RWP = 1920, GMW = 512, INP = 4480;
constexpr int COL_GM = 1920, COL_AT = 2944, COL_K = 3968, COL_V = 4224;
constexpr int NE = 64, NEX = 65, EFF = 512, TOPK = 8;
constexpr int SLOT_CAP = 84224;
constexpr int MAX_TILES = SLOT_CAP / 128;

constexpr size_t al256(size_t x) { return (x + 255) & ~(size_t)255; }
constexpr size_t WS_BAR = 0;
constexpr size_t WS_CNT = 16384;
constexpr size_t WS_MOD = WS_CNT + 1024;
constexpr size_t WS_ZERO_END = al256(WS_MOD + (size_t)2 * 2 * 12288 * 4);
constexpr size_t WS_WINT = WS_ZERO_END;
constexpr size_t WS_WOT = WS_WINT + (size_t)2 * INP * D * 2;
constexpr size_t WS_W13T = WS_WOT + (size_t)2 * D * D * 2;
constexpr size_t WS_W2T = WS_W13T + (size_t)2 * NEX * 1024 * D * 2;
constexpr size_t WS_H = WS_W2T + (size_t)2 * NEX * D * EFF * 2;
constexpr size_t WS_P = WS_H + (size_t)NTOK * D * 2;
constexpr size_t WS_REC = WS_P + (size_t)NTOK * INP * 4;
constexpr size_t WS_YD = WS_REC + (size_t)2 * 8 * NTOK * 384 * 4;
constexpr size_t WS_G = WS_YD + (size_t)2 * NTOK * RW * 4;
constexpr size_t WS_BV = WS_G + (size_t)NTOK * RW * 4;
constexpr size_t WS_GMR = WS_BV + (size_t)NTOK * RW * 4;
constexpr size_t WS_YCAT = al256(WS_GMR + (size_t)NTOK * 4);
constexpr size_t WS_Q = WS_YCAT + (size_t)NTOK * D * 2;
constexpr size_t WS_K = WS_Q + (size_t)NTOK * 1024 * 4;
constexpr size_t WS_X1 = WS_K + (size_t)NTOK * 256 * 4;
constexpr size_t WS_X2C = WS_X1 + (size_t)NTOK * D * 4;
constexpr size_t WS_TOKE = WS_X2C + (size_t)CTXL * D * 4;
constexpr size_t WS_TOKP = WS_TOKE + (size_t)NTOK * 8 * 4;
constexpr size_t WS_TOKW = WS_TOKP + (size_t)NTOK * 8 * 4;
constexpr size_t WS_SLOTT = WS_TOKW + (size_t)NTOK * 8 * 4;
constexpr size_t WS_SLOTW = al256(WS_SLOTT + (size_t)SLOT_CAP * 4);
constexpr size_t WS_TILE = al256(WS_SLOTW + (size_t)SLOT_CAP * 4);
constexpr size_t WS_ACT = al256(WS_TILE + (size_t)(MAX_TILES + 64) * 4);
constexpr size_t WS_MODP = WS_ACT + (size_t)SLOT_CAP * EFF * 2;
constexpr size_t WS_TOKS = WS_MODP + (size_t)2 * 2 * 32 * 12288 * 4;
constexpr size_t WS_OUTS = WS_TOKS + (size_t)NTOK * 8 * 4;
constexpr size_t WS_END = WS_OUTS + (size_t)SLOT_CAP * D * 2;

struct Params {
    const float *x, *c, *ctx, *c_ctx, *w_ada, *b_ada, *norm1_g, *norm2_g, *w_in, *w_o;
    const float *rw_mu, *rw_w0, *rw_w2, *rw_a0, *rw_a2, *rw_g2, *rw_kk, *rw_ka, *rw_rk, *rw_ln_g, *rw_ln_b;
    const float *gm_norm_g, *gm_ws, *gm_b, *at_qn, *at_kn, *at_sink;
    const float *moe_router, *moe_bias, *moe_wg, *moe_wu, *moe_wd, *sh_wg, *sh_wu, *sh_wd;
    float* out;
    char* ws;
};

__device__ __forceinline__ bf16_t f2bf(float f) {
    unsigned u = __float_as_uint(f);
    u += 0x7fffu + ((u >> 16) & 1u);
    return (bf16_t)(u >> 16);
}
__device__ __forceinline__ float bf2f(bf16_t h) { return __uint_as_float(((unsigned)h) << 16); }
__device__ __forceinline__ unsigned pack_bf2(float lo, float hi) { return (unsigned)f2bf(lo) | ((unsigned)f2bf(hi) << 16); }
__device__ __forceinline__ float wave_sum(float v) {
#pragma unroll
    for (int o = 32; o >= 1; o >>= 1) v += __shfl_xor(v, o);
    return v;
}
__device__ __forceinline__ float wave_max(float v) {
#pragma unroll
    for (int o = 32; o >= 1; o >>= 1) v = fmaxf(v, __shfl_xor(v, o));
    return v;
}
__device__ __forceinline__ float sigmoidf_(float x) { return 1.f / (1.f + expf(-x)); }
__device__ __forceinline__ float siluf_(float x) { return x / (1.f + expf(-x)); }
__device__ __forceinline__ float gelu_tanh(float x) {
    const float u = 0.7978845608028654f * (x + 0.044715f * x * x * x);
    return 0.5f * x * (1.f + tanhf(u));
}
__device__ __forceinline__ float softplusf_(float x) { return fmaxf(x, 0.f) + log1pf(expf(-fabsf(x))); }

struct RowSrc { const float* a; const float* b; };
__device__ __forceinline__ const float* rowp(const RowSrc& r, int row) { return row < SEQ ? r.a + (size_t)row * D : r.b + (size_t)(row - SEQ) * D; }
struct RowDst { float* a; float* b; };
__device__ __forceinline__ float* rowp(const RowDst& r, int row) { return row < SEQ ? r.a + (size_t)row * D : r.b + (size_t)(row - SEQ) * D; }

__device__ __forceinline__ RowSrc layer_in(const Params& p, int l) {
    RowSrc r; if (l == 0) { r.a = p.x; r.b = p.ctx; } else { float* x1 = (float*)(p.ws + WS_X1); r.a = x1; r.b = x1 + (size_t)SEQ * D; } return r;
}
__device__ __forceinline__ RowDst layer_out(const Params& p, int l) {
    RowDst r; if (l == 0) { float* x1 = (float*)(p.ws + WS_X1); r.a = x1; r.b = x1 + (size_t)SEQ * D; } else { r.a = p.out; r.b = (float*)(p.ws + WS_X2C); } return r;
}
__device__ __forceinline__ const float* modp(const Params& p, int l, int row, int which) {
    return (const float*)(p.ws + WS_MOD) + ((size_t)(l * 2 + (row < SEQ ? 0 : 1)) * 6 + which) * D;
}

__device__ __forceinline__ int otid() { int t = threadIdx.x; asm volatile("" : "+v"(t)); return t; }

__device__ void phase_ada(const Params& p, int bid, int nb) {
    float* part = (float*)(p.ws + WS_MODP);
    const int tid = otid();
    for (int u = bid; u < 2 * 12 * 32; u += nb) {
        const int l = u / (12 * 32), r = u % (12 * 32), cg = r / 32, kc = r % 32;
        const int n = cg * 1024 + tid * 4;
        const float* w = p.w_ada + (size_t)l * D * 12288 + (size_t)(kc * 64) * 12288 + n;
        f32x4 a0 = {0, 0, 0, 0}, a1 = {0, 0, 0, 0};
#pragma unroll 8
        for (int k = 0; k < 64; ++k) {
            const f32x4 wv = *(const f32x4*)(w + (size_t)k * 12288);
            const float c0 = siluf_(p.c[kc * 64 + k]), c1 = siluf_(p.c_ctx[kc * 64 + k]);
            a0 += wv * c0; a1 += wv * c1;
        }
        *(f32x4*)(part + ((size_t)((l * 2 + 0) * 32 + kc)) * 12288 + n) = a0;
        *(f32x4*)(part + ((size_t)((l * 2 + 1) * 32 + kc)) * 12288 + n) = a1;
    }
}
__device__ void phase_ada2(const Params& p, int bid, int nb) {
    const float* part = (const float*)(p.ws + WS_MODP);
    float* mod = (float*)(p.ws + WS_MOD);
    for (int i = bid * 256 + otid(); i < 2 * 2 * 12288; i += nb * 256) {
        const int ls = i / 12288, n = i % 12288, l = ls >> 1;
        float acc = p.b_ada[(size_t)l * 12288 + n];
        for (int kc = 0; kc < 32; ++kc) acc += part[((size_t)(ls * 32 + kc)) * 12288 + n];
        mod[i] = acc;
    }
}

struct TJob { const float* src; bf16_t* dst; int K, N, batch; size_t sstride, dstride; int mode; };
__device__ __forceinline__ int tjob_tiles(const TJob& j) { return j.batch * (j.K / 64) * (j.N / 64); }
__device__ void tconv_tile(const TJob& j, int t, float* tile  ) {
    const int tid = otid();
    const int tk = j.K / 64, tn = j.N / 64;
    const int b = t / (tk * tn), r = t % (tk * tn), kt = r / tn, nt = r % tn;
    const float* src = j.src + (size_t)b * j.sstride + (size_t)(kt * 64) * j.N + nt * 64;
    __syncthreads();
#pragma unroll
    for (int i = 0; i < 4; ++i) {
        const int k = i * 16 + (tid >> 4), n = (tid & 15) * 4;
        const f32x4 v = *(const f32x4*)(src + (size_t)k * j.N + n);
        tile[k * 65 + n + 0] = v[0]; tile[k * 65 + n + 1] = v[1]; tile[k * 65 + n + 2] = v[2]; tile[k * 65 + n + 3] = v[3];
    }
    __syncthreads();
    const int n = tid >> 2, kq = (tid & 3) * 16;
    int ng = nt * 64 + n;
    if (j.mode == 1) ng = 32 * (ng >> 4) + (ng & 15);
    else if (j.mode == 2) ng = 32 * (ng >> 4) + 16 + (ng & 15);
    bf16_t* dst = j.dst + (size_t)b * j.dstride + (size_t)ng * j.K + kt * 64 + kq;
    unsigned w[8];
#pragma unroll
    for (int i = 0; i < 8; ++i) w[i] = pack_bf2(tile[(kq + 2 * i) * 65 + n], tile[(kq + 2 * i + 1) * 65 + n]);
    *(uint4*)(dst) = make_uint4(w[0], w[1], w[2], w[3]);
    *(uint4*)(dst + 8) = make_uint4(w[4], w[5], w[6], w[7]);
}
__device__ void phase_tconv(const TJob& j, int bid, int nb, float* tile) {
    const int nt = tjob_tiles(j);
    for (int t = bid; t < nt; t += nb) tconv_tile(j, t, tile);
}
__device__ void phase_convert_layer(const Params& p, int l, int bid, int nb, float* tile) {
    TJob j;
    j = {p.w_in + (size_t)l * D * INP, (bf16_t*)(p.ws + WS_WINT) + (size_t)l * INP * D, D, INP, 1, 0, 0, 0}; phase_tconv(j, bid, nb, tile);
    j = {p.w_o + (size_t)l * D * D, (bf16_t*)(p.ws + WS_WOT) + (size_t)l * D * D, D, D, 1, 0, 0, 0}; phase_tconv(j, bid, nb, tile);
    bf16_t* w13 = (bf16_t*)(p.ws + WS_W13T) + (size_t)l * NEX * 1024 * D;
    bf16_t* w2 = (bf16_t*)(p.ws + WS_W2T) + (size_t)l * NEX * D * EFF;
    j = {p.moe_wg + (size_t)l * NE * D * EFF, w13, D, EFF, NE, (size_t)D * EFF, (size_t)1024 * D, 1}; phase_tconv(j, bid, nb, tile);
    j = {p.moe_wu + (size_t)l * NE * D * EFF, w13, D, EFF, NE, (size_t)D * EFF, (size_t)1024 * D, 2}; phase_tconv(j, bid, nb, tile);
    j = {p.moe_wd + (size_t)l * NE * EFF * D, w2, EFF, D, NE, (size_t)EFF * D, (size_t)D * EFF, 0}; phase_tconv(j, bid, nb, tile);
    j = {p.sh_wg + (size_t)l * D * EFF, w13 + (size_t)NE * 1024 * D, D, EFF, 1, 0, 0, 1}; phase_tconv(j, bid, nb, tile);
    j = {p.sh_wu + (size_t)l * D * EFF, w13 + (size_t)NE * 1024 * D, D, EFF, 1, 0, 0, 2}; phase_tconv(j, bid, nb, tile);
    j = {p.sh_wd + (size_t)l * EFF * D, w2 + (size_t)NE * D * EFF, EFF, D, 1, 0, 0, 0}; phase_tconv(j, bid, nb, tile);
}

__device__ void phase_norm1(const Params& p, int l, int bid, int nb) {
    const RowSrc in = layer_in(p, l);
    bf16_t* H = (bf16_t*)(p.ws + WS_H);
    const float* g = p.norm1_g + (size_t)l * D;
    const int wid = otid() >> 6, lane = otid() & 63;
    for (int row = bid * 4 + wid; row < NTOK; row += nb * 4) {
        const float* xr = rowp(in, row);
        const float* sh = modp(p, l, row, 0);
        const float* sc = modp(p, l, row, 1);
        f32x4 v[8]; float ss = 0.f;
#pragma unroll
        for (int i = 0; i < 8; ++i) { v[i] = *(const f32x4*)(xr + i * 256 + lane * 4); ss += v[i][0] * v[i][0] + v[i][1] * v[i][1] + v[i][2] * v[i][2] + v[i][3] * v[i][3]; }
        ss = wave_sum(ss);
        const float rstd = rsqrtf(ss * (1.f / D) + 1e-6f);
#pragma unroll
        for (int i = 0; i < 8; ++i) {
            const int c = i * 256 + lane * 4;
            const f32x4 gv = *(const f32x4*)(g + c), shv = *(const f32x4*)(sh + c), scv = *(const f32x4*)(sc + c);
            float o[4];
#pragma unroll
            for (int j = 0; j < 4; ++j) o[j] = (v[i][j] * rstd * gv[j]) * (1.f + scv[j]) + shv[j];
            *(uint2*)(H + (size_t)row * D + c) = make_uint2(pack_bf2(o[0], o[1]), pack_bf2(o[2], o[3]));
        }
    }
}

constexpr int GT_LD = 72;
constexpr int GT_LDS_BYTES = 2 * 128 * GT_LD * 2;
template <class ARow>
__device__ __forceinline__ void gemm_tile(const bf16_t* __restrict__ A, ARow arow, const bf16_t* __restrict__ Bt, int K, int n0, f32x4 (&acc)[4][4], char* smem) {
    bf16_t* As = (bf16_t*)smem;
    bf16_t* Bs = As + 128 * GT_LD;
    const int tid = otid(), wid = tid >> 6, lane = tid & 63, wr = wid >> 1, wc = wid & 1, fr = lane & 15, fq = lane >> 4;
    const int lr = tid >> 3, lk = (tid & 7) * 8;
    size_t aoff[4]; const bf16_t* bp[4];
#pragma unroll
    for (int i = 0; i < 4; ++i) { aoff[i] = arow(lr + 32 * i) + lk; bp[i] = Bt + (size_t)(n0 + lr + 32 * i) * K + lk; }
#pragma unroll
    for (int i = 0; i < 4; ++i)
#pragma unroll
        for (int j = 0; j < 4; ++j) acc[i][j] = (f32x4){0.f, 0.f, 0.f, 0.f};
    u32x4 ra[4], rb[4];
#pragma unroll
    for (int i = 0; i < 4; ++i) { ra[i] = *(const u32x4*)(A + aoff[i]); rb[i] = *(const u32x4*)(bp[i]); }
    const int nk = K / 64;
    for (int kt = 0; kt < nk; ++kt) {
        __syncthreads();
#pragma unroll
        for (int i = 0; i < 4; ++i) {
            *(u32x4*)(As + (lr + 32 * i) * GT_LD + lk) = ra[i];
            *(u32x4*)(Bs + (lr + 32 * i) * GT_LD + lk) = rb[i];
        }
        __syncthreads();
        if (kt + 1 < nk) {
#pragma unroll
            for (int i = 0; i < 4; ++i) { ra[i] = *(const u32x4*)(A + aoff[i] + (kt + 1) * 64); rb[i] = *(const u32x4*)(bp[i] + (kt + 1) * 64); }
        }
#pragma unroll
        for (int ks = 0; ks < 2; ++ks) {
            bf16x8 af[4], bf[4];
#pragma unroll
            for (int i = 0; i < 4; ++i) af[i] = *(const bf16x8*)(As + (wr * 64 + i * 16 + fr) * GT_LD + ks * 32 + fq * 8);
#pragma unroll
            for (int j = 0; j < 4; ++j) bf[j] = *(const bf16x8*)(Bs + (wc * 64 + j * 16 + fr) * GT_LD + ks * 32 + fq * 8);
#pragma unroll
            for (int i = 0; i < 4; ++i)
#pragma unroll
                for (int j = 0; j < 4; ++j) acc[i][j] = __builtin_amdgcn_mfma_f32_16x16x32_bf16(bf[j], af[i], acc[i][j], 0, 0, 0);
        }
    }
}
#define GT_IDX const int _tid = otid(), _wid = _tid >> 6, _lane = _tid & 63, wr = _wid >> 1, wc = _wid & 1, fr = _lane & 15, fq = _lane >> 4

__device__ void phase_inproj(const Params& p, int l, int bid, int nb, char* smem) {
    const bf16_t* H = (const bf16_t*)(p.ws + WS_H);
    const bf16_t* Bt = (const bf16_t*)(p.ws + WS_WINT) + (size_t)l * INP * D;
    float* P = (float*)(p.ws + WS_P);
    constexpr int TM = NTOK / 128, TN = INP / 128;
    GT_IDX;
    for (int u = bid; u < TM * TN; u += nb) {
        const int tm = u / TN, tn = u % TN, m0 = tm * 128, n0 = tn * 128;
        f32x4 acc[4][4];
        gemm_tile(H, [&](int r) { return (size_t)(m0 + r) * D; }, Bt, D, n0, acc, smem);
#pragma unroll
        for (int i = 0; i < 4; ++i)
#pragma unroll
            for (int j = 0; j < 4; ++j) *(f32x4*)(P + (size_t)(m0 + wr * 64 + i * 16 + fr) * INP + n0 + wc * 64 + j * 16 + fq * 4) = acc[i][j];
    }
}

__device__ __forceinline__ int scan_pos(int d, int row) {
    if (row >= SEQ) { const int c = row - SEQ; return d == 0 ? c : (CTXL - 1 - c); }
    return CTXL + (d == 0 ? row : (SEQ - 1 - row));
}
__device__ __forceinline__ int scan_row(int d, int s) {
    if (s < CTXL) return SEQ + (d == 0 ? s : (CTXL - 1 - s));
    const int q = s - CTXL; return d == 0 ? q : (SEQ - 1 - q);
}
constexpr int RP_TB = 4;
__device__ __forceinline__ float shifted(const float* P, int row, int col, float mu0, float mu1) {
    const float cur = P[(size_t)row * INP + col];
    const bool first = (row == 0) || (row == SEQ), last = (row == SEQ - 1) || (row == NTOK - 1);
    const float prev = first ? 0.f : P[(size_t)(row - 1) * INP + col];
    const float nxt = last ? 0.f : P[(size_t)(row + 1) * INP + col];
    return cur + mu0 * (prev - cur) + mu1 * (nxt - cur);
}
__device__ void phase_rwprep(const Params& p, int l, int bid, int nb, char* smem) {
    const float* P = (const float*)(p.ws + WS_P);
    float* REC = (float*)(p.ws + WS_REC);
    float* G = (float*)(p.ws + WS_G);
    float* BV = (float*)(p.ws + WS_BV);
    float* GMR = (float*)(p.ws + WS_GMR);
    float* lin = (float*)smem;
    const float* mu = p.rw_mu + (size_t)l * 2 * RWP;
    const float* w0 = p.rw_w0 + (size_t)l * 2 * RW;
    const float* w2 = p.rw_w2 + (size_t)l * 2 * 64 * RW;
    const float* a0 = p.rw_a0 + (size_t)l * 2 * RW;
    const float* a2 = p.rw_a2 + (size_t)l * 2 * 64 * RW;
    const float* g2 = p.rw_g2 + (size_t)l * 128 * RW;
    const float* kkw = p.rw_kk + (size_t)l * RW;
    const float* kaw = p.rw_ka + (size_t)l * RW;
    const float* rkw = p.rw_rk + (size_t)l * RW;
    const int tid = otid(), wid = tid >> 6, lane = tid & 63;
    for (int blk = bid; blk < NTOK / RP_TB; blk += nb) {
        const int t0 = blk * RP_TB;
        __syncthreads();
        for (int i = tid; i < RP_TB * 384; i += 256) {
            const int tt = i / 384, j = i % 384, col = 1536 + j;
            const float v = shifted(P, t0 + tt, col, mu[col], mu[RWP + col]);
            lin[i] = j < 128 ? tanhf(v) : (j < 256 ? v : sigmoidf_(v));
        }
        __syncthreads();
        {
            const int row = t0 + wid; float ss = 0.f;
#pragma unroll
            for (int i = 0; i < 8; ++i) { const float gv = gelu_tanh(P[(size_t)row * INP + COL_GM + GMW + i * 64 + lane]); ss += gv * gv; }
            ss = wave_sum(ss);
            if (lane == 0) GMR[row] = rsqrtf(ss * (1.f / GMW) + 1e-6f);
        }
#pragma unroll
        for (int cc = 0; cc < 2; ++cc) {
            const int c = tid + cc * 256, h = c >> 6, ci = c & 63;
            float lw[2][RP_TB], la[2][RP_TB], lg[RP_TB];
#pragma unroll
            for (int tt = 0; tt < RP_TB; ++tt) { lw[0][tt] = lw[1][tt] = la[0][tt] = la[1][tt] = lg[tt] = 0.f; }
            for (int j = 0; j < 64; ++j) {
                const float wf = w2[(size_t)(0 * 64 + j) * RW + c], wb = w2[(size_t)(1 * 64 + j) * RW + c];
                const float af = a2[(size_t)(0 * 64 + j) * RW + c], ab = a2[(size_t)(1 * 64 + j) * RW + c];
                const float g0 = g2[(size_t)j * RW + c], g1 = g2[(size_t)(j + 64) * RW + c];
#pragma unroll
                for (int tt = 0; tt < RP_TB; ++tt) {
                    const float* li = lin + tt * 384;
                    lw[0][tt] += li[j] * wf; lw[1][tt] += li[64 + j] * wb;
                    la[0][tt] += li[128 + j] * af; la[1][tt] += li[192 + j] * ab;
                    lg[tt] += li[256 + j] * g0 + li[320 + j] * g1;
                }
            }
            const float kkc = kkw[c], kac = kaw[c], rkc = rkw[c];
#pragma unroll
            for (int tt = 0; tt < RP_TB; ++tt) {
                const int row = t0 + tt;
                const float r = shifted(P, row, c, mu[c], mu[RWP + c]);
                const float k = shifted(P, row, 512 + c, mu[512 + c], mu[RWP + 512 + c]);
                const float v = shifted(P, row, 1024 + c, mu[1024 + c], mu[RWP + 1024 + c]);
                float kk = k * kkc;
                const float nrm = sqrtf(wave_sum(kk * kk));
                kk = kk / fmaxf(nrm, 1e-12f);
                const float bon = wave_sum(r * k * rkc);
                G[(size_t)row * RW + c] = lg[tt];
                BV[(size_t)row * RW + c] = bon * v;
#pragma unroll
                for (int d = 0; d < 2; ++d) {
                    const float wlog = -softplusf_(-(w0[d * RW + c] + lw[d][tt])) - 0.5f;
                    const float decay = expf(-expf(wlog));
                    const float a = sigmoidf_(a0[d * RW + c] + la[d][tt]);
                    const float kd = k * (1.f + (a - 1.f) * kac);
                    float* rec = REC + ((size_t)(d * 8 + h) * NTOK + scan_pos(d, row)) * 384;
                    rec[ci] = decay; rec[64 + ci] = kk; rec[128 + ci] = kk * a; rec[192 + ci] = kd; rec[256 + ci] = r; rec[320 + ci] = v;
                }
            }
        }
    }
}

template <int CTRL> __device__ __forceinline__ float dppf(float v) {
    return __int_as_float(__builtin_amdgcn_update_dpp(0, __float_as_int(v), CTRL, 0xf, 0xf, true));
}
__device__ __forceinline__ float red16(float v) {
    v += dppf<0xB1>(v); v += dppf<0x4E>(v); v += dppf<0x124>(v); v += dppf<0x128>(v); return v;
}
constexpr int SC_TS = 16;
constexpr int SCAN_BLOCKS = 128;
__device__ __forceinline__ void red16x2(float& a, float& b) {
    a += dppf<0xB1>(a); b += dppf<0xB1>(b); a += dppf<0x4E>(a); b += dppf<0x4E>(b);
    a += dppf<0x124>(a); b += dppf<0x124>(b); a += dppf<0x128>(a); b += dppf<0x128>(b);
}
#define SC_LD(slot, s) { const float* b_ = buf + (s) * 384; qw[slot] = *(const f32x4*)(b_ + 4 * l16); qk[slot] = *(const f32x4*)(b_ + 64 + 4 * l16); \
    qb[slot] = *(const f32x4*)(b_ + 128 + 4 * l16); qd[slot] = *(const f32x4*)(b_ + 192 + 4 * l16); qr[slot] = *(const f32x4*)(b_ + 256 + 4 * l16); qv[slot] = b_[320 + i]; }
__device__ __forceinline__ void scan_chunk(const float* buf, int l16, int i, f32x4& S, float* ydst) {
    f32x4 qw[3], qk[3], qb[3], qd[3], qr[3]; float qv[3];
    SC_LD(0, 0); SC_LD(1, 1);
    f32x4 rp = {0.f, 0.f, 0.f, 0.f};
    float yv = 0.f;
#pragma unroll
    for (int s = 0; s < SC_TS; ++s) {
        const int sl = s % 3;
        if (s + 2 < SC_TS) SC_LD((s + 2) % 3, s + 2);
        const f32x4 pk = S * qk[sl];
        float a = (pk[0] + pk[1]) + (pk[2] + pk[3]);
        if (s > 0) {
            const f32x4 py = S * rp;
            float bsum = (py[0] + py[1]) + (py[2] + py[3]);
            red16x2(a, bsum);
            yv = (l16 == s - 1) ? bsum : yv;
        } else a = red16(a);
        const float sa = -a;
        S = (S * qw[sl] + qd[sl] * qv[sl]) + qb[sl] * sa;
        rp = qr[sl];
    }
    {
        const f32x4 py = S * rp;
        const float bsum = red16((py[0] + py[1]) + (py[2] + py[3]));
        yv = (l16 == SC_TS - 1) ? bsum : yv;
    }
    *ydst = yv;
}
#define SC_LOAD(R, ch) { const float* _g = rec + (size_t)(ch) * (SC_TS * 384) + lt * 4; _Pragma("unroll") for (int q = 0; q < 12; ++q) R[q] = *(const f32x4*)(_g + q * 512); }
#define SC_WRITE(R, B) { float* _l = (B) + lt * 4; _Pragma("unroll") for (int q = 0; q < 12; ++q) *(f32x4*)(_l + q * 512) = R[q]; }
__device__ void phase_scan(const Params& p, int bid, char* smem) {
    const float* REC = (const float*)(p.ws + WS_REC);
    float* YD = (float*)(p.ws + WS_YD);
    float* B0 = (float*)smem;
    float* B1 = B0 + SC_TS * 384;
    const int tid = otid(), wid = tid >> 6, lane = tid & 63, l16 = lane & 15;
    const int xcd = bid & 7, slot = bid >> 3, dh = xcd * 2 + (slot >> 3), rq = slot & 7;
    const int d = dh >> 3, h = dh & 7;
    const float* rec = REC + (size_t)dh * NTOK * 384;
    constexpr int NCH = NTOK / SC_TS;
    if (wid >= 2) {
        const int lt = tid - 128;
        f32x4 R0[12], R1[12];
        SC_LOAD(R0, 0); SC_WRITE(R0, B0);
        SC_LOAD(R1, 1); SC_LOAD(R0, 2);
        __syncthreads();
        for (int c = 0; c < NCH; c += 2) {
            if (c + 1 < NCH) SC_WRITE(R1, B1);
            if (c + 3 < NCH) SC_LOAD(R1, c + 3);
            __syncthreads();
            if (c + 2 < NCH) SC_WRITE(R0, B0);
            if (c + 4 < NCH) SC_LOAD(R0, c + 4);
            __syncthreads();
        }
    } else {
        const int i = rq * 8 + wid * 4 + (lane >> 4);
        f32x4 S = {0.f, 0.f, 0.f, 0.f};
        float* yout = YD + (size_t)d * NTOK * RW + h * 64 + i;
        const int dstep = d == 0 ? 1 : -1;
        __syncthreads();
        for (int c = 0; c < NCH; c += 2) {
            scan_chunk(B0, l16, i, S, yout + (size_t)(scan_row(d, c * SC_TS) + dstep * l16) * RW);
            __syncthreads();
            scan_chunk(B1, l16, i, S, yout + (size_t)(scan_row(d, (c + 1) * SC_TS) + dstep * l16) * RW);
            __syncthreads();
        }
    }
}

__device__ void phase_rwpost(const Params& p, int l, int bid, int nb) {
    const float* YD = (const float*)(p.ws + WS_YD);
    const float* G = (const float*)(p.ws + WS_G);
    const float* BV = (const float*)(p.ws + WS_BV);
    bf16_t* Y = (bf16_t*)(p.ws + WS_YCAT);
    const float* lng = p.rw_ln_g + (size_t)l * RW;
    const float* lnb = p.rw_ln_b + (size_t)l * RW;
    const int wid = otid() >> 6, lane = otid() & 63;
    for (int u = bid * 4 + wid; u < NTOK * 8; u += nb * 4) {
        const int row = u >> 3, h = u & 7, c = h * 64 + lane;
        const float y = YD[(size_t)row * RW + c] + YD[((size_t)NTOK + row) * RW + c];
        const float mean = wave_sum(y) * (1.f / 64);
        const float dv = y - mean;
        const float var = wave_sum(dv * dv) * (1.f / 64);
        const float yn = dv * rsqrtf(var + 64e-5f) * lng[c] + lnb[c];
        Y[(size_t)row * D + c] = f2bf((yn + BV[(size_t)row * RW + c]) * G[(size_t)row * RW + c]);
    }
}

__device__ void phase_gmlp(const Params& p, int l, int bid, int nb, char* smem) {
    const float* P = (const float*)(p.ws + WS_P);
    const float* GMR = (const float*)(p.ws + WS_GMR);
    bf16_t* Y = (bf16_t*)(p.ws + WS_YCAT);
    float* vt = (float*)smem;
    const float* ng = p.gm_norm_g + (size_t)l * GMW;
    const int tid = otid(), c = tid & 63, pq = tid >> 6;
    for (int u = bid; u < (NTOK / 128) * 8; u += nb) {
        const int n = u >> 3, g = u & 7, t0 = n * 128;
        const float* ws = p.gm_ws + ((size_t)l * 8 + g) * 128 * 128;
        const float* bs = p.gm_b + ((size_t)l * 8 + g) * 128;
        __syncthreads();
        for (int i = tid; i < 128 * 64; i += 256) {
            const int q = i >> 6, cc = i & 63;
            vt[i] = gelu_tanh(P[(size_t)(t0 + q) * INP + COL_GM + GMW + g * 64 + cc]) * GMR[t0 + q] * ng[g * 64 + cc];
        }
        __syncthreads();
        for (int pi = 0; pi < 32; ++pi) {
            const int pp = __builtin_amdgcn_readfirstlane(pq * 32 + pi);
            const float* wrow = ws + (size_t)pp * 128;
            float acc = 0.f;
#pragma unroll 16
            for (int q = 0; q < 128; ++q) acc += wrow[q] * vt[q * 64 + c];
            const float uu = gelu_tanh(P[(size_t)(t0 + pp) * INP + COL_GM + g * 64 + c]);
            Y[(size_t)(t0 + pp) * D + 512 + g * 64 + c] = f2bf(uu * (acc + bs[pp]));
        }
    }
}

__device__ void phase_atprep(const Params& p, int l, int bid, int nb) {
    const float* P = (const float*)(p.ws + WS_P);
    float* Q = (float*)(p.ws + WS_Q);
    float* Kf = (float*)(p.ws + WS_K);
    const float* qn = p.at_qn + (size_t)l * 64;
    const float* kn = p.at_kn + (size_t)l * 64;
    const int wid = otid() >> 6, lane = otid() & 63;
    const int sec = lane >> 5, dd = lane & 31, f = dd & 15, hf = dd >> 4;
    const float inv_freq = powf(10000.f, -(float)f / 16.f);
    for (int u = bid * 4 + wid; u < NTOK * 20; u += nb * 4) {
        const int row = u / 20, hv = u % 20;
        const bool isq = hv < 16;
        const float xv = P[(size_t)row * INP + (isq ? COL_AT + hv * 64 : COL_K + (hv - 16) * 64) + lane];
        const float ss = wave_sum(xv * xv);
        float y = xv * rsqrtf(ss * (1.f / 64) + 1e-6f) * (isq ? qn[lane] : kn[lane]);
        if (row < SEQ) {
            const float pos = (float)(sec == 0 ? (row >> 6) : (row & 63));
            const float ang = pos * inv_freq;
            const float cs = cosf(ang), sn = sinf(ang);
            const float other = __shfl_xor(y, 16);
            y = hf == 0 ? (y * cs - other * sn) : (y * cs + other * sn);
        }
        if (isq) Q[(size_t)row * 1024 + hv * 64 + lane] = y * 0.125f;
        else Kf[(size_t)row * 256 + (hv - 16) * 64 + lane] = y;
    }
}

__device__ void phase_attn(const Params& p, int l, int bid, int nb, char* smem) {
    const float* P = (const float*)(p.ws + WS_P);
    const float* Q = (const float*)(p.ws + WS_Q);
    const float* Kf = (const float*)(p.ws + WS_K);
    bf16_t* Y = (bf16_t*)(p.ws + WS_YCAT);
    float* Ks = (float*)smem;
    float* Vs = Ks + 64 * 64;
    const int tid = otid(), g = tid >> 6, qi = tid & 63;
    for (int u = bid; u < (NTOK / 64) * 4; u += nb) {
        const int qt = u >> 2, kvh = u & 3, t0 = qt * 64, row = t0 + qi, head = kvh * 4 + g;
        const bool isx = t0 < SEQ;
        float q[64], o[64];
#pragma unroll
        for (int d4 = 0; d4 < 16; ++d4) { const f32x4 v = *(const f32x4*)(Q + (size_t)row * 1024 + head * 64 + d4 * 4); q[d4 * 4] = v[0]; q[d4 * 4 + 1] = v[1]; q[d4 * 4 + 2] = v[2]; q[d4 * 4 + 3] = v[3]; }
#pragma unroll
        for (int d = 0; d < 64; ++d) o[d] = 0.f;
        float m = p.at_sink[(size_t)l * 16 + head], lsum = 1.f;
        for (int ci = (isx ? 0 : 5); ci < 9; ++ci) {
            int k0; bool local;
            if (ci < 5) { k0 = t0 - 128 + ci * 64; local = true; if (k0 < 0 || k0 >= SEQ) continue; }
            else { k0 = SEQ + (ci - 5) * 64; local = false; }
            __syncthreads();
            for (int i = tid; i < 64 * 16; i += 256) {
                const int kr = i >> 4, d4 = (i & 15) * 4;
                *(f32x4*)(Ks + kr * 64 + d4) = *(const f32x4*)(Kf + (size_t)(k0 + kr) * 256 + kvh * 64 + d4);
                *(f32x4*)(Vs + kr * 64 + d4) = *(const f32x4*)(P + (size_t)(k0 + kr) * INP + COL_V + kvh * 64 + d4);
            }
            __syncthreads();
            for (int j = 0; j < 64; ++j) {
                if (local) { const int dist = (k0 + j) - row; if (dist > 128 || dist < -128) continue; }
                float s = 0.f;
#pragma unroll
                for (int d4 = 0; d4 < 16; ++d4) { const f32x4 kv = *(const f32x4*)(Ks + j * 64 + d4 * 4); s += q[d4 * 4] * kv[0] + q[d4 * 4 + 1] * kv[1] + q[d4 * 4 + 2] * kv[2] + q[d4 * 4 + 3] * kv[3]; }
                if (s > m) {
                    const float al = expf(m - s); lsum *= al;
#pragma unroll
                    for (int d = 0; d < 64; ++d) o[d] *= al;
                    m = s;
                }
                const float pr = expf(s - m); lsum += pr;
#pragma unroll
                for (int d4 = 0; d4 < 16; ++d4) { const f32x4 vv = *(const f32x4*)(Vs + j * 64 + d4 * 4); o[d4 * 4] += pr * vv[0]; o[d4 * 4 + 1] += pr * vv[1]; o[d4 * 4 + 2] += pr * vv[2]; o[d4 * 4 + 3] += pr * vv[3]; }
            }
        }
        const float inv = 1.f / lsum;
        bf16_t* yo = Y + (size_t)row * D + 1024 + head * 64;
#pragma unroll
        for (int d8 = 0; d8 < 8; ++d8) {
            *(uint4*)(yo + d8 * 8) = make_uint4(pack_bf2(o[d8 * 8] * inv, o[d8 * 8 + 1] * inv), pack_bf2(o[d8 * 8 + 2] * inv, o[d8 * 8 + 3] * inv),
                                                pack_bf2(o[d8 * 8 + 4] * inv, o[d8 * 8 + 5] * inv), pack_bf2(o[d8 * 8 + 6] * inv, o[d8 * 8 + 7] * inv));
        }
    }
}

__device__ void phase_oproj(const Params& p, int l, int bid, int nb, char* smem) {
    const bf16_t* Y = (const bf16_t*)(p.ws + WS_YCAT);
    const bf16_t* Bt = (const bf16_t*)(p.ws + WS_WOT) + (size_t)l * D * D;
    const RowSrc in = layer_in(p, l);
    const RowDst out = layer_out(p, l);
    constexpr int TM = NTOK / 128, TN = D / 128;
    GT_IDX;
    for (int u = bid; u < TM * TN; u += nb) {
        const int tm = u / TN, tn = u % TN, m0 = tm * 128, n0 = tn * 128;
        f32x4 acc[4][4];
        gemm_tile(Y, [&](int r) { return (size_t)(m0 + r) * D; }, Bt, D, n0, acc, smem);
#pragma unroll
        for (int i = 0; i < 4; ++i)
#pragma unroll
            for (int j = 0; j < 4; ++j) {
                const int row = m0 + wr * 64 + i * 16 + fr, col = n0 + wc * 64 + j * 16 + fq * 4;
                const f32x4 xin = *(const f32x4*)(rowp(in, row) + col);
                const f32x4 g1 = *(const f32x4*)(modp(p, l, row, 2) + col);
                *(f32x4*)(rowp(out, row) + col) = xin + g1 * acc[i][j];
            }
    }
}

__device__ void phase_norm2_route(const Params& p, int l, int bid, int nb, char* smem) {
    const RowDst xs = layer_out(p, l);
    bf16_t* H = (bf16_t*)(p.ws + WS_H);
    int* cnt = (int*)(p.ws + WS_CNT) + l * 64;
    int* tokE = (int*)(p.ws + WS_TOKE);
    int* tokP = (int*)(p.ws + WS_TOKP);
    float* tokW = (float*)(p.ws + WS_TOKW);
    const float* g = p.norm2_g + (size_t)l * D;
    const float* router = p.moe_router + (size_t)l * D * NE;
    const float* rbias = p.moe_bias + (size_t)l * NE;
    float* hs = (float*)smem;
    float* part = hs + 4 * D;
    const int tid = otid(), wid = tid >> 6, lane = tid & 63;
    for (int blk = bid; blk < NTOK / 4; blk += nb) {
        const int t0 = blk * 4;
        __syncthreads();
        {
            const int rr = wid, row = t0 + rr;
            const float* xr = rowp(xs, row);
            const float* sh = modp(p, l, row, 3);
            const float* sc = modp(p, l, row, 4);
            f32x4 v[8]; float ss = 0.f;
#pragma unroll
            for (int i = 0; i < 8; ++i) { v[i] = *(const f32x4*)(xr + i * 256 + lane * 4); ss += v[i][0] * v[i][0] + v[i][1] * v[i][1] + v[i][2] * v[i][2] + v[i][3] * v[i][3]; }
            ss = wave_sum(ss);
            const float rstd = rsqrtf(ss * (1.f / D) + 1e-6f);
#pragma unroll
            for (int i = 0; i < 8; ++i) {
                const int c = i * 256 + lane * 4;
                const f32x4 gv = *(const f32x4*)(g + c), shv = *(const f32x4*)(sh + c), scv = *(const f32x4*)(sc + c);
                f32x4 o;
#pragma unroll
                for (int j = 0; j < 4; ++j) o[j] = (v[i][j] * rstd * gv[j]) * (1.f + scv[j]) + shv[j];
                *(f32x4*)(hs + rr * D + c) = o;
                *(uint2*)(H + (size_t)row * D + c) = make_uint2(pack_bf2(o[0], o[1]), pack_bf2(o[2], o[3]));
            }
        }
        __syncthreads();
        {
            float acc[4] = {0.f, 0.f, 0.f, 0.f};
            const float* rp = router + (size_t)(wid * 512) * NE + lane;
            const float* hp = hs + wid * 512;
#pragma unroll 4
            for (int k = 0; k < 512; ++k) {
                const float rv = rp[(size_t)k * NE];
#pragma unroll
                for (int r = 0; r < 4; ++r) acc[r] += hp[r * D + k] * rv;
            }
#pragma unroll
            for (int r = 0; r < 4; ++r) part[(wid * 4 + r) * 64 + lane] = acc[r];
        }
        __syncthreads();
        {
            const int rr = wid, row = t0 + rr;
            const float logit = part[(0 * 4 + rr) * 64 + lane] + part[(1 * 4 + rr) * 64 + lane] + part[(2 * 4 + rr) * 64 + lane] + part[(3 * 4 + rr) * 64 + lane];
            const float score = sigmoidf_(logit);
            const float biased = score + rbias[lane];
            float m1 = biased;
            m1 = fmaxf(m1, __shfl_xor(m1, 1)); m1 = fmaxf(m1, __shfl_xor(m1, 2)); m1 = fmaxf(m1, __shfl_xor(m1, 4));
            const unsigned long long eq = __ballot(biased == m1);
            const int gbase = lane & ~7;
            const unsigned geq = (unsigned)((eq >> gbase) & 0xffull);
            const int first = gbase + (__ffs(geq) - 1);
            float m2 = (lane == first) ? -INFINITY : biased;
            m2 = fmaxf(m2, __shfl_xor(m2, 1)); m2 = fmaxf(m2, __shfl_xor(m2, 2)); m2 = fmaxf(m2, __shfl_xor(m2, 4));
            const float gs = m1 + m2;
            const int mygrp = lane >> 3;
            int rank = 0;
#pragma unroll
            for (int k = 0; k < 8; ++k) { const float o = __shfl(gs, k * 8); rank += (o > gs || (o == gs && k < mygrp)) ? 1 : 0; }
            float val = rank < 4 ? biased : -INFINITY;
            int sel = -1;
#pragma unroll
            for (int j = 0; j < TOPK; ++j) {
                const float mx = wave_max(val);
                const unsigned long long bm = __ballot(val == mx);
                const int win = __ffsll((long long)bm) - 1;
                if (lane == win) { sel = j; val = -INFINITY; }
            }
            const float ssum = wave_sum(sel >= 0 ? score : 0.f);
            if (sel >= 0) {
                const int pos = atomicAdd(cnt + lane, 1);
                tokE[(size_t)row * 8 + sel] = lane; tokP[(size_t)row * 8 + sel] = pos; tokW[(size_t)row * 8 + sel] = score / ssum * 2.5f;
            }
        }
    }
}

__device__ void phase_slots(const Params& p, int l, int bid, int nb, char* smem) {
    const int* cnt = (const int*)(p.ws + WS_CNT) + l * 64;
    const int* tokE = (const int*)(p.ws + WS_TOKE);
    const int* tokP = (const int*)(p.ws + WS_TOKP);
    const float* tokW = (const float*)(p.ws + WS_TOKW);
    int* slotT = (int*)(p.ws + WS_SLOTT);
    float* slotW = (float*)(p.ws + WS_SLOTW);
    int* tile = (int*)(p.ws + WS_TILE);
    int* tokS = (int*)(p.ws + WS_TOKS);
    int* off = (int*)smem;
    const int tid = otid();
    __syncthreads();
    if (tid == 0) {
        int o = 0;
        for (int e = 0; e < NE; ++e) { off[e] = o; o += (cnt[e] + 127) / 128 * 128; }
        off[NE] = o; off[NE + 1] = o + NTOK;
    }
    __syncthreads();
    const int gt = bid * 256 + tid, gs = nb * 256;
    for (int i = gt; i < NTOK * 8; i += gs) { const int e = tokE[i]; const int s = off[e] + tokP[i]; slotT[s] = i >> 3; slotW[s] = tokW[i]; tokS[i] = s; }
    for (int i = gt; i < NTOK; i += gs) { slotT[off[NE] + i] = i; slotW[off[NE] + i] = 1.f; }
    for (int i = gt; i < NE * 128; i += gs) { const int e = i >> 7, j = i & 127; const int s = off[e] + cnt[e] + j; if (s < off[e + 1]) { slotT[s] = -1; slotW[s] = 0.f; } }
    if (bid == 0) {
        const int nt = off[NE + 1] / 128;
        if (tid == 0) tile[0] = nt;
        for (int i = tid; i < nt; i += 256) {
            const int s = i * 128; int e = 0;
            for (int k = 1; k <= NE; ++k) if (s >= off[k]) e = k;
            tile[1 + i] = e;
        }
    }
}

__device__ void phase_moe1(const Params& p, int l, int bid, int nb, char* smem) {
    const bf16_t* H = (const bf16_t*)(p.ws + WS_H);
    const bf16_t* W13 = (const bf16_t*)(p.ws + WS_W13T) + (size_t)l * NEX * 1024 * D;
    const int* slotT = (const int*)(p.ws + WS_SLOTT);
    const int* tile = (const int*)(p.ws + WS_TILE);
    bf16_t* ACT = (bf16_t*)(p.ws + WS_ACT);
    const int nt = tile[0];
    GT_IDX;
    for (int u = bid; u < nt * 8; u += nb) {
        const int ti = u >> 3, ct = u & 7, e = tile[1 + ti], s0 = ti * 128, n0 = ct * 128;
        const bf16_t* Bt = W13 + (size_t)e * 1024 * D;
        f32x4 acc[4][4];
        gemm_tile(H, [&](int r) { const int t = slotT[s0 + r]; return (size_t)(t < 0 ? 0 : t) * D; }, Bt, D, n0, acc, smem);
#pragma unroll
        for (int i = 0; i < 4; ++i)
#pragma unroll
            for (int jp = 0; jp < 2; ++jp) {
                const int slot = s0 + wr * 64 + i * 16 + fr, ch = (n0 + wc * 64 + jp * 32) / 2 + fq * 4;
                float a[4];
#pragma unroll
                for (int r = 0; r < 4; ++r) a[r] = siluf_(acc[i][2 * jp][r]) * acc[i][2 * jp + 1][r];
                *(uint2*)(ACT + (size_t)slot * EFF + ch) = make_uint2(pack_bf2(a[0], a[1]), pack_bf2(a[2], a[3]));
            }
    }
}

__device__ void phase_moe2(const Params& p, int l, int bid, int nb, char* smem) {
    const bf16_t* ACT = (const bf16_t*)(p.ws + WS_ACT);
    const bf16_t* W2 = (const bf16_t*)(p.ws + WS_W2T) + (size_t)l * NEX * D * EFF;
    const int* tile = (const int*)(p.ws + WS_TILE);
    bf16_t* OUTS = (bf16_t*)(p.ws + WS_OUTS);
    const int nt = tile[0];
    GT_IDX;
    for (int u = bid; u < nt * 16; u += nb) {
        const int ti = u >> 4, ct = u & 15, e = tile[1 + ti], s0 = ti * 128, n0 = ct * 128;
        const bf16_t* Bt = W2 + (size_t)e * D * EFF;
        f32x4 acc[4][4];
        gemm_tile(ACT, [&](int r) { return (size_t)(s0 + r) * EFF; }, Bt, EFF, n0, acc, smem);
#pragma unroll
        for (int i = 0; i < 4; ++i) {
            const int slot = s0 + wr * 64 + i * 16 + fr;
#pragma unroll
            for (int j = 0; j < 4; ++j) {
                const int col = n0 + wc * 64 + j * 16 + fq * 4;
                *(uint2*)(OUTS + (size_t)slot * D + col) = make_uint2(pack_bf2(acc[i][j][0], acc[i][j][1]), pack_bf2(acc[i][j][2], acc[i][j][3]));
            }
        }
    }
}

__device__ void phase_combine(const Params& p, int l, int bid, int nb, char* smem) {
    const bf16_t* OUTS = (const bf16_t*)(p.ws + WS_OUTS);
    const int* tokS = (const int*)(p.ws + WS_TOKS);
    const float* tokW = (const float*)(p.ws + WS_TOKW);
    const int* cnt = (const int*)(p.ws + WS_CNT) + l * 64;
    const RowDst out = layer_out(p, l);
    int* sh0 = (int*)smem;
    __syncthreads();
    if (otid() == 0) { int o = 0; for (int e = 0; e < NE; ++e) o += (cnt[e] + 127) / 128 * 128; sh0[0] = o; }
    __syncthreads();
    const int shared0 = sh0[0];
    const int tid = otid();
    for (int row = bid; row < NTOK; row += nb) {
        float* xr = rowp(out, row);
        const float* g2 = modp(p, l, row, 5);
        const int c = tid * 8;
        float acc[8];
        {
            const u32x4 v = *(const u32x4*)(OUTS + (size_t)(shared0 + row) * D + c);
#pragma unroll
            for (int q = 0; q < 4; ++q) { acc[2 * q] = __uint_as_float(v[q] << 16); acc[2 * q + 1] = __uint_as_float(v[q] & 0xffff0000u); }
        }
#pragma unroll
        for (int j = 0; j < TOPK; ++j) {
            const int s = tokS[(size_t)row * 8 + j]; const float w = tokW[(size_t)row * 8 + j];
            const u32x4 v = *(const u32x4*)(OUTS + (size_t)s * D + c);
#pragma unroll
            for (int q = 0; q < 4; ++q) { acc[2 * q] += w * __uint_as_float(v[q] << 16); acc[2 * q + 1] += w * __uint_as_float(v[q] & 0xffff0000u); }
        }
        const f32x4 g0 = *(const f32x4*)(g2 + c), g1 = *(const f32x4*)(g2 + c + 4);
        f32x4 x0 = *(const f32x4*)(xr + c), x1 = *(const f32x4*)(xr + c + 4);
#pragma unroll
        for (int q = 0; q < 4; ++q) { x0[q] += g0[q] * acc[q]; x1[q] += g1[q] * acc[4 + q]; }
        *(f32x4*)(xr + c) = x0; *(f32x4*)(xr + c + 4) = x1;
    }
}

#define XB_TMO      128
#define XB_XCNT(j)  (256  + 64 * (j))
#define XB_XSUB(j)  (1280 + 64 * (j))
#define XB_XGEN(j)  (2304 + 64 * (j))
#define XB_TOP      3328
#define XB_TOPGEN   3392
#define XCD_BAR_WORDS 3456
#define XB_SPIN_CAP (1u << 18)
#define LAS __attribute__((address_space(3)))

__device__ __forceinline__ unsigned xb_ld(unsigned* p)              { return __hip_atomic_load(p, __ATOMIC_RELAXED, __HIP_MEMORY_SCOPE_AGENT); }
__device__ __forceinline__ unsigned xb_add(unsigned* p, unsigned v) { return __hip_atomic_fetch_add(p, v, __ATOMIC_RELAXED, __HIP_MEMORY_SCOPE_AGENT); }
__device__ __forceinline__ unsigned xb_xcc_id() { return (unsigned)__builtin_amdgcn_s_getreg((3 << 11) | 20) & 0xFu; }
#define XB_SPIN(cond, bar) do { unsigned _sp = 0; while (cond) { __builtin_amdgcn_s_sleep(1); \
    if ((++_sp & 255u) == 0u) { if (xb_ld(&(bar)[XB_TMO])) break; if (_sp > XB_SPIN_CAP) { atomicAdd(&(bar)[XB_TMO], 1u); break; } } } } while (0)

struct XcdBarrier {
    unsigned* bar; unsigned x;
    volatile LAS unsigned* st;
};
__device__ __forceinline__ XcdBarrier xcd_barrier_post(unsigned* bar, volatile LAS unsigned* st) {
    XcdBarrier b; b.bar = bar; b.x = xb_xcc_id(); b.st = st;
    if (threadIdx.x == 0) (void)xb_add(&bar[XB_XCNT(b.x)], 1u);
    return b;
}
__device__ __forceinline__ void xcd_barrier_complete(unsigned* bar, unsigned x, unsigned& nloc, unsigned& nx) {
    const unsigned G = gridDim.x * gridDim.y * gridDim.z;
    unsigned sum, cnt, mine, sp = 0u;
    for (;;) {
        sum = 0u; cnt = 0u; mine = 0u;
#pragma unroll
        for (unsigned j = 0; j < 16; ++j) { const unsigned c = xb_ld(&bar[XB_XCNT(j)]); sum += c; cnt += (c > 0u) ? 1u : 0u; mine = (j == x) ? c : mine; }
        if (sum == G) break;
        __builtin_amdgcn_s_sleep(1);
        if ((++sp & 255u) == 0u) { if (xb_ld(&bar[XB_TMO])) break; if (sp > XB_SPIN_CAP) { atomicAdd(&bar[XB_TMO], 1u); break; } }
    }
    nloc = mine > 0u ? mine : 1u; nx = cnt > 0u ? cnt : 1u;
}
__device__ __forceinline__ void xcd_barrier(const XcdBarrier& b) {
    asm volatile("s_waitcnt vmcnt(0)" ::: "memory");
    __syncthreads();
    if (threadIdx.x == 0) {
        unsigned* bar = b.bar;
        __builtin_amdgcn_s_waitcnt(0);
        unsigned nloc = b.st[0], nx = b.st[1];
        if (nloc == 0u) { xcd_barrier_complete(bar, b.x, nloc, nx); b.st[0] = nloc; b.st[1] = nx; }
        const unsigned old = xb_add(&bar[XB_XSUB(b.x)], 1u);
        const unsigned gen = old / nloc;
        if (old + 1u == (gen + 1u) * nloc) {
            __builtin_amdgcn_fence(__ATOMIC_RELEASE, "agent");
            asm volatile("s_waitcnt vmcnt(0)" ::: "memory");
            const unsigned og = xb_add(&bar[XB_TOP], 1u);
            const unsigned tg = og / nx;
            if (og + 1u == (tg + 1u) * nx) xb_add(&bar[XB_TOPGEN], 1u);
            else XB_SPIN(xb_ld(&bar[XB_TOPGEN]) == tg, bar);
            __builtin_amdgcn_fence(__ATOMIC_ACQUIRE, "agent");
            xb_add(&bar[XB_XGEN(b.x)], 1u);
            asm volatile("s_waitcnt vmcnt(0)" ::: "memory");
        } else {
            XB_SPIN(xb_ld(&bar[XB_XGEN(b.x)]) == gen, bar);
            __builtin_amdgcn_fence(__ATOMIC_ACQUIRE, "agent");
            asm volatile("s_waitcnt vmcnt(0)" ::: "memory");
        }
    }
    __syncthreads();
}

constexpr int FUSED_LDS = 16 + 2 * SC_TS * 384 * 4;
__global__ void __launch_bounds__(256, 2) k_fused(Params p) {
    extern __shared__ __attribute__((aligned(16))) char dsm[];
    if (threadIdx.x == 0) *(uint4*)dsm = make_uint4(0u, 0u, 0u, 0u);
    __syncthreads();
    XcdBarrier bar = xcd_barrier_post((unsigned*)(p.ws + WS_BAR), (volatile LAS unsigned*)dsm);
    char* sm = dsm + 16;
    const int bid = blockIdx.x, nb = gridDim.x;
    phase_ada(p, bid, nb);
    phase_convert_layer(p, 0, bid, nb, (float*)sm);
    xcd_barrier(bar);
    phase_ada2(p, bid, nb);
    xcd_barrier(bar);
    for (int l = 0; l < DEPTH; ++l) {
        phase_norm1(p, l, bid, nb);
        xcd_barrier(bar);
        phase_inproj(p, l, bid, nb, sm);
        xcd_barrier(bar);
        phase_rwprep(p, l, bid, nb, sm);
        phase_atprep(p, l, bid, nb);
        xcd_barrier(bar);
        if (bid < SCAN_BLOCKS) phase_scan(p, bid, sm);
        else {
            phase_gmlp(p, l, bid - SCAN_BLOCKS, nb - SCAN_BLOCKS, sm);
            phase_attn(p, l, bid - SCAN_BLOCKS, nb - SCAN_BLOCKS, sm);
            if (l == 0) phase_convert_layer(p, 1, bid - SCAN_BLOCKS, nb - SCAN_BLOCKS, (float*)sm);
        }
        xcd_barrier(bar);
        phase_rwpost(p, l, bid, nb);
        xcd_barrier(bar);
        phase_oproj(p, l, bid, nb, sm);
        xcd_barrier(bar);
        phase_norm2_route(p, l, bid, nb, sm);
        xcd_barrier(bar);
        phase_slots(p, l, bid, nb, sm);
        xcd_barrier(bar);
        phase_moe1(p, l, bid, nb, sm);
        xcd_barrier(bar);
        phase_moe2(p, l, bid, nb, sm);
        xcd_barrier(bar);
        phase_combine(p, l, bid, nb, sm);
        xcd_barrier(bar);
    }
}

extern "C" void kernel_launch(void* const* d_in, const int* in_sizes, int n_in, void* d_out, int out_size, void* d_ws, size_t ws_size, hipStream_t stream) {
    if (n_in != 35 || out_size != SEQ * D || ws_size < WS_END) {
        fprintf(stderr, "kernel_launch: unexpected shapes: n_in %d out %d ws %zu (need %zu)\n", n_in, out_size, ws_size, (size_t)WS_END);
        return;
    }
    static int grid = 0;
    if (!grid) {
        int dev = 0, cus = 0, per_cu = 0;
        (void)hipGetDevice(&dev);
        (void)hipDeviceGetAttribute(&cus, hipDeviceAttributeMultiprocessorCount, dev);
        (void)hipFuncSetAttribute((const void*)k_fused, hipFuncAttributeMaxDynamicSharedMemorySize, FUSED_LDS);
        (void)hipOccupancyMaxActiveBlocksPerMultiprocessor(&per_cu, (const void*)k_fused, 256, FUSED_LDS);
        if (per_cu < 1) { fprintf(stderr, "kernel_launch: occupancy query says %d blocks per CU\n", per_cu); per_cu = 1; }
        grid = cus * (per_cu < 2 ? per_cu : 2);
        if (grid <= SCAN_BLOCKS) grid = 0;
    }
    if (!grid) { fprintf(stderr, "kernel_launch: bad grid\n"); return; }
    Params p{};
    const float** f = (const float**)&p;
    for (int i = 0; i < 35; ++i) f[i] = (const float*)d_in[i];
    p.out = (float*)d_out;
    p.ws = (char*)d_ws;
    (void)hipMemsetAsync(d_ws, 0, WS_ZERO_END, stream);
    hipLaunchKernelGGL(k_fused, dim3(grid), dim3(256), FUSED_LDS, stream, p);
}
```

```cpp
#include <hip/hip_runtime.h>
#include <stdint.h>
#include <stdio.h>

typedef unsigned short bf16_t;
typedef short bf16x8 __attribute__((ext_vector_type(8)));
typedef float f32x4 __attribute__((ext_vector_type(4)));
typedef unsigned u32x4 __attribute__((ext_vector_type(4)));
typedef unsigned u32x2 __attribute__((ext_vector_type(2)));
typedef float f32x16 __attribute__((ext_vector_type(16)));

constexpr int D = 2048, SEQ = 8192, CTXL = 256, NTOK = SEQ + CTXL, DEPTH = 2;
constexpr int RW = 512, RWP = 1920, GMW = 512, INP = 4480;
constexpr int COL_GM = 1920, COL_AT = 2944, COL_K = 3968, COL_V = 4224;
constexpr int NE = 64, NEX = 65, EFF = 512, TOPK = 8;
constexpr int SLOT_CAP = 92416;
constexpr int MAX_TILES = SLOT_CAP / 256;
constexpr int INP_PAD = 4608;
constexpr int NT = 512;

constexpr size_t al256(size_t x) { return (x + 255) & ~(size_t)255; }
constexpr size_t WS_BAR = 0;
constexpr size_t WS_CNT = 16384;
constexpr size_t WS_MOD = WS_CNT + 1024;
constexpr size_t WS_ZERO_END = al256(WS_MOD + (size_t)2 * 2 * 12288 * 4);
constexpr size_t WS_WINT = WS_ZERO_END;
constexpr size_t WS_WOT = WS_WINT + (size_t)2 * INP_PAD * D * 2;
constexpr size_t WS_W13T = WS_WOT + (size_t)2 * D * D * 2;
constexpr size_t WS_W2T = WS_W13T + (size_t)2 * NEX * 1024 * D * 2;
constexpr size_t WS_H = WS_W2T + (size_t)2 * NEX * D * EFF * 2;
constexpr size_t WS_P = WS_H + (size_t)NTOK * D * 2;
constexpr size_t WS_REC = WS_P + (size_t)NTOK * INP * 4;
constexpr size_t WS_YD = WS_REC + (size_t)2 * 8 * NTOK * 384 * 4;
constexpr size_t WS_G = WS_YD + (size_t)2 * NTOK * RW * 4;
constexpr size_t WS_BV = WS_G + (size_t)NTOK * RW * 4;
constexpr size_t WS_GMR = WS_BV + (size_t)NTOK * RW * 4;
constexpr size_t WS_YCAT = al256(WS_GMR + (size_t)NTOK * 4);
constexpr size_t WS_Q = WS_YCAT + (size_t)NTOK * D * 2;
constexpr size_t WS_K = WS_Q + (size_t)NTOK * 1024 * 4;
constexpr size_t WS_X1 = WS_K + (size_t)NTOK * 256 * 4;
constexpr size_t WS_X2C = WS_X1 + (size_t)NTOK * D * 4;
constexpr size_t WS_TOKE = WS_X2C + (size_t)CTXL * D * 4;
constexpr size_t WS_TOKP = WS_TOKE + (size_t)NTOK * 8 * 4;
constexpr size_t WS_TOKW = WS_TOKP + (size_t)NTOK * 8 * 4;
constexpr size_t WS_SLOTT = WS_TOKW + (size_t)NTOK * 8 * 4;
constexpr size_t WS_SLOTW = al256(WS_SLOTT + (size_t)SLOT_CAP * 4);
constexpr size_t WS_TILE = al256(WS_SLOTW + (size_t)SLOT_CAP * 4);
constexpr size_t WS_ACT = al256(WS_TILE + (size_t)(MAX_TILES + 64) * 4);
constexpr size_t WS_MODP = WS_ACT + (size_t)SLOT_CAP * EFF * 2;
constexpr size_t WS_TOKS = WS_MODP + (size_t)2 * 2 * 32 * 12288 * 4;
constexpr size_t WS_OUTS = WS_TOKS + (size_t)NTOK * 8 * 4;
constexpr size_t WS_WLT = WS_OUTS + (size_t)SLOT_CAP * D * 2;
constexpr size_t WS_ROPE = WS_WLT + (size_t)2 * RW * 384 * 2;
constexpr size_t WS_RT = WS_ROPE + (size_t)192 * 16 * 2 * 4;
constexpr size_t WS_END = WS_RT + (size_t)2 * 2 * NE * D * 2;

struct Params {
    const float *x, *c, *ctx, *c_ctx, *w_ada, *b_ada, *norm1_g, *norm2_g, *w_in, *w_o;
    const float *rw_mu, *rw_w0, *rw_w2, *rw_a0, *rw_a2, *rw_g2, *rw_kk, *rw_ka, *rw_rk, *rw_ln_g, *rw_ln_b;
    const float *gm_norm_g, *gm_ws, *gm_b, *at_qn, *at_kn, *at_sink;
    const float *moe_router, *moe_bias, *moe_wg, *moe_wu, *moe_wd, *sh_wg, *sh_wu, *sh_wd;
    float* out;
    char* ws;
};

__device__ __forceinline__ bf16_t f2bf(float f) {
    unsigned u = __float_as_uint(f);
    u += 0x7fffu + ((u >> 16) & 1u);
    return (bf16_t)(u >> 16);
}
__device__ __forceinline__ unsigned pack_bf2(float lo, float hi) { return (unsigned)f2bf(lo) | ((unsigned)f2bf(hi) << 16); }
__device__ __forceinline__ int olane() { int t; asm volatile("v_mbcnt_lo_u32_b32 %0, -1, 0\n\tv_mbcnt_hi_u32_b32 %0, -1, %0" : "=v"(t)); return t; }
__device__ __forceinline__ float bperm(float v, int src_lane) { return __int_as_float(__builtin_amdgcn_ds_bpermute(src_lane << 2, __float_as_int(v))); }
template <int CTRL> __device__ __forceinline__ float dppf(float v) {
    return __int_as_float(__builtin_amdgcn_update_dpp(0, __float_as_int(v), CTRL, 0xf, 0xf, true));
}
__device__ __forceinline__ float red16(float v) {
    v += dppf<0xB1>(v); v += dppf<0x4E>(v); v += dppf<0x124>(v); v += dppf<0x128>(v); return v;
}
__device__ __forceinline__ float wave_sum(float v) {
    const int lane = olane();
    v = red16(v);
    v += bperm(v, lane ^ 16); v += bperm(v, lane ^ 32);
    return v;
}
__device__ __forceinline__ float wave_max(float v) {
    const int lane = olane();
    v = fmaxf(v, dppf<0xB1>(v)); v = fmaxf(v, dppf<0x4E>(v)); v = fmaxf(v, dppf<0x124>(v)); v = fmaxf(v, dppf<0x128>(v));
    v = fmaxf(v, bperm(v, lane ^ 16)); v = fmaxf(v, bperm(v, lane ^ 32));
    return v;
}
__device__ __forceinline__ float max8(float v) {
    const int lane = olane();
    v = fmaxf(v, dppf<0xB1>(v)); v = fmaxf(v, dppf<0x4E>(v)); v = fmaxf(v, bperm(v, lane ^ 4));
    return v;
}
__device__ __forceinline__ float fexp(float x) { return __builtin_amdgcn_exp2f(x * 1.4426950408889634f); }
__device__ __forceinline__ float flog(float x) { return __builtin_amdgcn_logf(x) * 0.6931471805599453f; }
__device__ __forceinline__ float frcp(float x) { return __builtin_amdgcn_rcpf(x); }
__device__ __forceinline__ float sigmoidf_(float x) { return frcp(1.f + fexp(-x)); }
__device__ __forceinline__ float siluf_(float x) { return x * frcp(1.f + fexp(-x)); }
__device__ __forceinline__ float ftanh(float u) { const float e = fexp(-2.f * fabsf(u)); const float t = (1.f - e) * frcp(1.f + e); return u < 0.f ? -t : t; }
__device__ __forceinline__ float gelu_tanh(float x) {
    const float u = 0.7978845608028654f * (x + 0.044715f * x * x * x);
    const float hx = 0.5f * x;
    return fmaf(hx, ftanh(u), hx);
}
__device__ __forceinline__ float softplusf_(float x) { return fmaxf(x, 0.f) + flog(1.f + fexp(-fabsf(x))); }

struct RowSrc { const float* a; const float* b; };
__device__ __forceinline__ const float* rowp(const RowSrc& r, int row) { return row < SEQ ? r.a + (size_t)row * D : r.b + (size_t)(row - SEQ) * D; }
struct RowDst { float* a; float* b; };
__device__ __forceinline__ float* rowp(const RowDst& r, int row) { return row < SEQ ? r.a + (size_t)row * D : r.b + (size_t)(row - SEQ) * D; }

__device__ __forceinline__ RowSrc layer_in(const Params& p, int l) {
    RowSrc r; if (l == 0) { r.a = p.x; r.b = p.ctx; } else { float* x1 = (float*)(p.ws + WS_X1); r.a = x1; r.b = x1 + (size_t)SEQ * D; } return r;
}
__device__ __forceinline__ RowDst layer_out(const Params& p, int l) {
    RowDst r; if (l == 0) { float* x1 = (float*)(p.ws + WS_X1); r.a = x1; r.b = x1 + (size_t)SEQ * D; } else { r.a = p.out; r.b = (float*)(p.ws + WS_X2C); } return r;
}
__device__ __forceinline__ const float* modp(const Params& p, int l, int row, int which) {
    return (const float*)(p.ws + WS_MOD) + ((size_t)(l * 2 + (row < SEQ ? 0 : 1)) * 6 + which) * D;
}
__device__ __forceinline__ int ntok_of(int l) { return l == DEPTH - 1 ? SEQ : NTOK; }
struct KP : Params { int wb; };
__device__ __forceinline__ int otid(int wb) {
    int t; asm volatile("v_mbcnt_lo_u32_b32 %0, -1, 0\n\tv_mbcnt_hi_u32_b32 %0, -1, %0" : "=v"(t));
    return t | wb;
}

__device__ void phase_ada(const KP& p, int bid, int nb) {
    float* part = (float*)(p.ws + WS_MODP);
    const int tid = otid(p.wb);
    for (int u = bid; u < 2 * 6 * 32; u += nb) {
        const int l = u / (6 * 32), r = u % (6 * 32), cg = r / 32, kc = r % 32;
        const int n = cg * 2048 + tid * 4;
        const float* w = p.w_ada + (size_t)l * D * 12288 + (size_t)(kc * 64) * 12288 + n;
        f32x4 a0 = {0, 0, 0, 0}, a1 = {0, 0, 0, 0};
#pragma unroll 8
        for (int k = 0; k < 64; ++k) {
            const f32x4 wv = *(const f32x4*)(w + (size_t)k * 12288);
            const float c0 = siluf_(p.c[kc * 64 + k]), c1 = siluf_(p.c_ctx[kc * 64 + k]);
            a0 += wv * c0; a1 += wv * c1;
        }
        *(f32x4*)(part + ((size_t)((l * 2 + 0) * 32 + kc)) * 12288 + n) = a0;
        *(f32x4*)(part + ((size_t)((l * 2 + 1) * 32 + kc)) * 12288 + n) = a1;
    }
}
__device__ void phase_ada2(const KP& p, int bid, int nb) {
    const float* part = (const float*)(p.ws + WS_MODP);
    float* mod = (float*)(p.ws + WS_MOD);
    for (int i = bid * NT + otid(p.wb); i < 2 * 2 * 12288; i += nb * NT) {
        const int ls = i / 12288, n = i % 12288, l = ls >> 1;
        float acc = p.b_ada[(size_t)l * 12288 + n];
        for (int kc = 0; kc < 32; ++kc) acc += part[((size_t)(ls * 32 + kc)) * 12288 + n];
        mod[i] = acc;
    }
}

struct TJob { const float* src; bf16_t* dst; int K, N, batch; size_t sstride, dstride; int mode; };
__device__ __forceinline__ void tconv_pair(const TJob& j, int t0, float* tiles  , int tid) {
    const int half = tid >> 8, ht = tid & 255;
    float* tile = tiles + half * (64 * 65);
    const int tk = j.K / 64, tn = j.N / 64, ntl = j.batch * tk * tn;
    const int t = t0 + half;
    const bool on = t < ntl;
    const int b = t / (tk * tn), r = t % (tk * tn), kt = r / tn, nt = r % tn;
    __syncthreads();
    if (on) {
        const float* src = j.src + (size_t)b * j.sstride + (size_t)(kt * 64) * j.N + nt * 64;
#pragma unroll
        for (int i = 0; i < 4; ++i) {
            const int k = i * 16 + (ht >> 4), n = (ht & 15) * 4;
            const f32x4 v = *(const f32x4*)(src + (size_t)k * j.N + n);
            tile[k * 65 + n + 0] = v[0]; tile[k * 65 + n + 1] = v[1]; tile[k * 65 + n + 2] = v[2]; tile[k * 65 + n + 3] = v[3];
        }
    }
    __syncthreads();
    if (on) {
        const int n = ht >> 2, kq = (ht & 3) * 16;
        int ng = nt * 64 + n;
        if (j.mode == 1) ng = 32 * (ng >> 4) + (ng & 15);
        else if (j.mode == 2) ng = 32 * (ng >> 4) + 16 + (ng & 15);
        bf16_t* dst = j.dst + (size_t)b * j.dstride + (size_t)ng * j.K + kt * 64 + kq;
        u32x4 w0, w1;
#pragma unroll
        for (int i = 0; i < 4; ++i) { w0[i] = pack_bf2(tile[(kq + 2 * i) * 65 + n], tile[(kq + 2 * i + 1) * 65 + n]); w1[i] = pack_bf2(tile[(kq + 8 + 2 * i) * 65 + n], tile[(kq + 8 + 2 * i + 1) * 65 + n]); }
        *(u32x4*)(dst) = w0;
        *(u32x4*)(dst + 8) = w1;
    }
}
__device__ void phase_tconv(const TJob& j, int bid, int nb, float* tiles  , int wb) {
    const int tid = otid(wb);
    const int ntl = j.batch * (j.K / 64) * (j.N / 64);
    for (int t0 = bid * 2; t0 < ntl; t0 += nb * 2) tconv_pair(j, t0, tiles, tid);
}
__device__ void phase_convert_dense(const KP& p, int l, int bid, int nb, float* tile) {
    TJob j;
    j = {p.w_in + (size_t)l * D * INP, (bf16_t*)(p.ws + WS_WINT) + (size_t)l * INP_PAD * D, D, INP, 1, 0, 0, 0}; phase_tconv(j, bid, nb, tile, p.wb);
    j = {p.w_o + (size_t)l * D * D, (bf16_t*)(p.ws + WS_WOT) + (size_t)l * D * D, D, D, 1, 0, 0, 0}; phase_tconv(j, bid, nb, tile, p.wb);
}
constexpr int CQ_ITEM = 16;
constexpr int CQ_T_BIG = NE * (D / 64) * (EFF / 64);
constexpr int CQ_T_SH = (D / 64) * (EFF / 64);
constexpr int CQ_ITEMS = (3 * CQ_T_BIG + 3 * CQ_T_SH) / CQ_ITEM;
__device__ void phase_convert_moe_queue(const KP& p, int l, char* smem) {
    bf16_t* w13 = (bf16_t*)(p.ws + WS_W13T) + (size_t)l * NEX * 1024 * D;
    bf16_t* w2 = (bf16_t*)(p.ws + WS_W2T) + (size_t)l * NEX * D * EFF;
    int* qctr = (int*)(p.ws + WS_CNT) + 200 + l;
    float* tiles = (float*)smem;
    int* sh = (int*)(smem + 2 * 64 * 65 * 4);
    const int tid = otid(p.wb);
    for (;;) {
        __syncthreads();
        if (tid == 0) sh[0] = atomicAdd(qctr, 1);
        __syncthreads();
        const int item = sh[0];
        if (item >= CQ_ITEMS) break;
        int t = item * CQ_ITEM;
        TJob j;
        if (t < CQ_T_BIG) j = {p.moe_wg + (size_t)l * NE * D * EFF, w13, D, EFF, NE, (size_t)D * EFF, (size_t)1024 * D, 1};
        else if (t < 2 * CQ_T_BIG) { t -= CQ_T_BIG; j = {p.moe_wu + (size_t)l * NE * D * EFF, w13, D, EFF, NE, (size_t)D * EFF, (size_t)1024 * D, 2}; }
        else if (t < 3 * CQ_T_BIG) { t -= 2 * CQ_T_BIG; j = {p.moe_wd + (size_t)l * NE * EFF * D, w2, EFF, D, NE, (size_t)EFF * D, (size_t)D * EFF, 0}; }
        else if (t < 3 * CQ_T_BIG + CQ_T_SH) { t -= 3 * CQ_T_BIG; j = {p.sh_wg + (size_t)l * D * EFF, w13 + (size_t)NE * 1024 * D, D, EFF, 1, 0, 0, 1}; }
        else if (t < 3 * CQ_T_BIG + 2 * CQ_T_SH) { t -= 3 * CQ_T_BIG + CQ_T_SH; j = {p.sh_wu + (size_t)l * D * EFF, w13 + (size_t)NE * 1024 * D, D, EFF, 1, 0, 0, 2}; }
        else { t -= 3 * CQ_T_BIG + 2 * CQ_T_SH; j = {p.sh_wd + (size_t)l * EFF * D, w2 + (size_t)NE * D * EFF, EFF, D, 1, 0, 0, 0}; }
#pragma unroll 1
        for (int i = 0; i < CQ_ITEM; i += 2) tconv_pair(j, t + i, tiles, tid);
    }
}

__device__ void phase_convert_lora(const KP& p, int bid, int nb) {
    bf16_t* WLT = (bf16_t*)(p.ws + WS_WLT);
    const int tid = otid(p.wb);
    for (int i = bid * NT + tid; i < 2 * D * NE; i += nb * NT) {
        const int l = i / (D * NE), r = i % (D * NE), k = r / NE, e = r % NE;
        const float x = p.moe_router[i];
        const bf16_t hi = f2bf(x); const bf16_t lo = f2bf(x - __uint_as_float((unsigned)hi << 16));
        bf16_t* rt = (bf16_t*)(p.ws + WS_RT) + (size_t)l * 2 * NE * D;
        rt[(size_t)e * D + k] = hi; rt[(size_t)NE * D + (size_t)e * D + k] = lo;
    }
    for (int i = bid * NT + tid; i < 192 * 16; i += nb * NT) {
        const int pos = i >> 4, f = i & 15;
        const float ang = (float)(pos < 128 ? pos : pos - 128) * powf(10000.f, -(float)f / 16.f);
        float* rt = (float*)(p.ws + WS_ROPE) + (size_t)i * 2;
        rt[0] = cosf(ang); rt[1] = sinf(ang);
    }
    for (int i = bid * NT + tid; i < 2 * RW * 384; i += nb * NT) {
        const int l = i / (RW * 384), r = i % (RW * 384), k = r / RW, c = r % RW;
        float v;
        if (k < 128) v = p.rw_w2[((size_t)l * 2 * 64 + k) * RW + c];
        else if (k < 256) v = p.rw_a2[((size_t)l * 2 * 64 + (k - 128)) * RW + c];
        else v = p.rw_g2[((size_t)l * 128 + (k - 256)) * RW + c];
        WLT[((size_t)l * RW + c) * 384 + k] = f2bf(v);
    }
}

__device__ void phase_norm1(const KP& p, int l, int bid, int nb) {
    const RowSrc in = layer_in(p, l);
    bf16_t* H = (bf16_t*)(p.ws + WS_H);
    const float* g = p.norm1_g + (size_t)l * D;
    const int tid = otid(p.wb), wid = tid >> 6, lane = tid & 63;
    for (int row = bid * 8 + wid; row < NTOK; row += nb * 8) {
        const float* xr = rowp(in, row);
        const float* sh = modp(p, l, row, 0);
        const float* sc = modp(p, l, row, 1);
        f32x4 v[8]; float ss = 0.f;
#pragma unroll
        for (int i = 0; i < 8; ++i) { v[i] = *(const f32x4*)(xr + i * 256 + lane * 4); ss += v[i][0] * v[i][0] + v[i][1] * v[i][1] + v[i][2] * v[i][2] + v[i][3] * v[i][3]; }
        ss = wave_sum(ss);
        const float rstd = rsqrtf(ss * (1.f / D) + 1e-6f);
#pragma unroll
        for (int i = 0; i < 8; ++i) {
            const int c = i * 256 + lane * 4;
            const f32x4 gv = *(const f32x4*)(g + c), shv = *(const f32x4*)(sh + c), scv = *(const f32x4*)(sc + c);
            float o[4];
#pragma unroll
            for (int j = 0; j < 4; ++j) { const float t = v[i][j] * rstd * gv[j]; o[j] = fmaf(t, scv[j], t) + shv[j]; }
            u32x2 w; w[0] = pack_bf2(o[0], o[1]); w[1] = pack_bf2(o[2], o[3]);
            *(u32x2*)(H + (size_t)row * D + c) = w;
        }
    }
}

constexpr int G_HT = 128 * 64;
constexpr int G_LDS = 8 * G_HT * 2;
__device__ __forceinline__ int g_lds_byte(int r, int c) {
    const int st = (r >> 4) * 2 + (c >> 5), rr = r & 15, cc = c & 31, ob = rr * 64 + cc * 2;
    return st * 1024 + (ob ^ (((ob >> 9) & 1) << 5));
}
__device__ __forceinline__ void g_stage_rc(int b, int& R, int& C) {
    const int st = b / 1024, sb = b % 1024, swz = sb ^ (((sb >> 9) & 1) << 5);
    R = (st >> 1) * 16 + swz / 64; C = (st & 1) * 32 + (swz % 64) / 2;
}
struct GOff { unsigned ao[2][2], bo; };
#define SA(b, h) (shm + ((b) * 2 + (h)) * G_HT)
#define SB(b, h) (shm + (4 + (b) * 2 + (h)) * G_HT)
#define STG_A(P, h, kt) do { _Pragma("unroll") for (int _i = 0; _i < 2; ++_i) \
    __builtin_amdgcn_global_load_lds((const unsigned*)((const char*)(A + (kt) * 64) + o.ao[h][_i]), (unsigned*)((char*)(P) + tz * 16 + _i * 8192), 16, 0, 0); } while (0)
#define STG_B(P, h, kt) do { _Pragma("unroll") for (int _i = 0; _i < 2; ++_i) \
    __builtin_amdgcn_global_load_lds((const unsigned*)((const char*)(Bt + ((h) * 128 + _i * 64) * K + (kt) * 64) + o.bo), (unsigned*)((char*)(P) + tz * 16 + _i * 8192), 16, 0, 0); } while (0)
template <bool PERM, class ARow>
__device__ __forceinline__ void gemm_offsets(ARow arow, const int K, const int wb, GOff& o) {
    const int tz = otid(wb);
    int r, c; g_stage_rc(tz * 16, r, c);
    const int rb = PERM ? ((r & ~31) + 8 * ((r & 15) >> 2) + 4 * ((r >> 4) & 1) + (r & 3)) : r;
    o.bo = (unsigned)((rb * K + c) * 2);
#pragma unroll
    for (int h = 0; h < 2; ++h)
#pragma unroll
        for (int i = 0; i < 2; ++i) o.ao[h][i] = (unsigned)((arow(h * 128 + i * 64 + r) + c) * 2);
}
__device__ __forceinline__ void gemm_issue(const bf16_t* __restrict__ A, const bf16_t* __restrict__ Bt, const int K, const GOff& o, bf16_t* shm, const int wb) {
    const int tz = otid(wb);
    STG_B(SB(0, 0), 0, 0); STG_A(SA(0, 0), 0, 0);
    STG_B(SB(0, 1), 1, 0); STG_A(SA(0, 1), 1, 0);
    STG_B(SB(1, 0), 0, 1); STG_A(SA(1, 0), 0, 1); STG_B(SB(1, 1), 1, 1);
}
__device__ __forceinline__ void gemm_main(const bf16_t* __restrict__ A, const bf16_t* __restrict__ Bt, const int K, const GOff& o, f32x4 (&acc)[2][2][4][2], bf16_t* shm, const int wb) {
#define LDA(dst, b, h) _Pragma("unroll") for (int m = 0; m < 4; ++m) _Pragma("unroll") for (int k = 0; k < 2; ++k) \
    dst[m][k] = *reinterpret_cast<const bf16x8*>((const char*)SA(b, h) + g_lds_byte(wr * 64 + m * 16 + fr, k * 32 + fq * 8))
#define LDB(dst, b, h) _Pragma("unroll") for (int n = 0; n < 2; ++n) _Pragma("unroll") for (int k = 0; k < 2; ++k) \
    dst[n][k] = *reinterpret_cast<const bf16x8*>((const char*)SB(b, h) + g_lds_byte(wc * 32 + n * 16 + fr, k * 32 + fq * 8))
#define MMA(ai, bj, Af, Bf) do { __builtin_amdgcn_s_setprio(1); \
    _Pragma("unroll") for (int m = 0; m < 4; ++m) _Pragma("unroll") for (int n = 0; n < 2; ++n) _Pragma("unroll") for (int k = 0; k < 2; ++k) \
        acc[ai][bj][m][n] = __builtin_amdgcn_mfma_f32_16x16x32_bf16(Bf[n][k], Af[m][k], acc[ai][bj][m][n], 0, 0, 0); \
    __builtin_amdgcn_s_setprio(0); } while (0)
#define WAIT_V(n) asm volatile("s_waitcnt vmcnt(" #n ")" ::: "memory")
#define WAIT_L(n) asm volatile("s_waitcnt lgkmcnt(" #n ")" ::: "memory")
#define BAR __builtin_amdgcn_s_barrier()
#define SCHED __builtin_amdgcn_sched_barrier(0)
    int tz = otid(wb);
    int wid = tz >> 6, lane = tz & 63, wr = wid >> 2, wc = wid & 3, fr = lane & 15, fq = lane >> 4;
#pragma unroll
    for (int a = 0; a < 2; ++a)
#pragma unroll
        for (int b = 0; b < 2; ++b)
#pragma unroll
            for (int m = 0; m < 4; ++m)
#pragma unroll
                for (int n = 0; n < 2; ++n) acc[a][b][m][n] = (f32x4){0.f, 0.f, 0.f, 0.f};
    bf16x8 At[4][2], B0[2][2], B1[2][2];
    const int nt = K / 64;
    WAIT_V(0); BAR;
    if (wr == 1) BAR;
    for (int t = 0; t < nt - 2; t += 2) {
        LDB(B0, 0, 0); SCHED; LDA(At, 0, 0); STG_A(SA(1, 1), 1, t + 1);
        WAIT_L(8); BAR; WAIT_L(0); MMA(0, 0, At, B0); BAR; SCHED;
        LDB(B1, 0, 1); STG_B(SB(0, 0), 0, t + 2);
        BAR; WAIT_L(0); MMA(0, 1, At, B1); BAR;
        LDA(At, 0, 1); STG_A(SA(0, 0), 0, t + 2);
        BAR; WAIT_L(0); MMA(1, 0, At, B0); BAR; SCHED;
        STG_B(SB(0, 1), 1, t + 2);
        WAIT_V(6); BAR; MMA(1, 1, At, B1); BAR;
        LDB(B0, 1, 0); SCHED; LDA(At, 1, 0); STG_A(SA(0, 1), 1, t + 2);
        WAIT_L(8); BAR; WAIT_L(0); MMA(0, 0, At, B0); BAR; SCHED;
        LDB(B1, 1, 1); STG_B(SB(1, 0), 0, t + 3);
        BAR; WAIT_L(0); MMA(0, 1, At, B1); BAR;
        LDA(At, 1, 1); STG_A(SA(1, 0), 0, t + 3);
        BAR; WAIT_L(0); MMA(1, 0, At, B0); BAR; SCHED;
        STG_B(SB(1, 1), 1, t + 3);
        WAIT_V(6); BAR; MMA(1, 1, At, B1); BAR;
    }
    { LDB(B0, 0, 0); WAIT_V(0); LDA(At, 0, 0); STG_A(SA(1, 1), 1, nt - 1);
      BAR; WAIT_L(0); MMA(0, 0, At, B0); BAR;
      LDB(B1, 0, 1); BAR; WAIT_L(0); MMA(0, 1, At, B1); BAR;
      LDA(At, 0, 1); WAIT_V(4); BAR; WAIT_L(0); MMA(1, 0, At, B0); MMA(1, 1, At, B1); BAR; }
    { LDB(B0, 1, 0); LDA(At, 1, 0); WAIT_V(2); BAR; WAIT_L(0); MMA(0, 0, At, B0); BAR;
      LDB(B1, 1, 1); WAIT_V(0); BAR; WAIT_L(0); MMA(0, 1, At, B1); BAR;
      LDA(At, 1, 1); BAR; WAIT_L(0); MMA(1, 0, At, B0); MMA(1, 1, At, B1); BAR; }
    if (wr == 0) BAR;
#undef LDA
#undef LDB
#undef MMA
#undef WAIT_V
#undef WAIT_L
#undef BAR
#undef SCHED
}
#undef SA
#undef SB
#undef STG_A
#undef STG_B
struct GU { const bf16_t* A; const bf16_t* Bt; int i0, i1, i2, i3; };
template <bool PERM, class Mk, class Row, class Epi>
__device__ __forceinline__ void gemm_phase(const int nwg, const int bid, const int nb, const int K, bf16_t* shm, const int wb, Mk mk, Row row, Epi epi) {
    int L = bid;
    if (L >= nwg) return;
    GU cur = mk(L);
    GOff oc;
    gemm_offsets<PERM>([&](int r) { return row(cur, r); }, K, wb, oc);
    gemm_issue(cur.A, cur.Bt, K, oc, shm, wb);
    for (;;) {
        f32x4 acc[2][2][4][2];
        gemm_main(cur.A, cur.Bt, K, oc, acc, shm, wb);
        const int Ln = L + nb;
        const bool more = Ln < nwg;
        GU nxt = cur; GOff on = oc;
        if (more) {
            nxt = mk(Ln);
            gemm_offsets<PERM>([&](int r) { return row(nxt, r); }, K, wb, on);
            gemm_issue(nxt.A, nxt.Bt, K, on, shm, wb);
        }
        epi(cur, acc);
        if (!more) break;
        cur = nxt; oc = on; L = Ln;
    }
}
#define G_IDX int _tz = otid(p.wb); const int _wid = _tz >> 6, _lane = _tz & 63, wr = _wid >> 2, wc = _wid & 3, fr = _lane & 15, fq = _lane >> 4
__device__ __forceinline__ int xcd_remap(int L, int nwg) {
    const int q = nwg / 8, r = nwg % 8, xcd = L % 8, off = L / 8;
    return (xcd < r ? xcd * (q + 1) : r * (q + 1) + (xcd - r) * q) + off;
}
__device__ __forceinline__ void dense_tile(int wgid, int nM, int nN, int& pm, int& pn) {
    const int nig = 8 * nN, gid = wgid / nig, fm = gid * 8, gsz = (nM - fm) < 8 ? (nM - fm) : 8;
    pm = fm + ((wgid % nig) % gsz); pn = (wgid % nig) / gsz;
}

__device__ void phase_inproj(const KP& p, int l, int bid, int nb, bf16_t* shm) {
    const bf16_t* H = (const bf16_t*)(p.ws + WS_H);
    const bf16_t* Bt = (const bf16_t*)(p.ws + WS_WINT) + (size_t)l * INP_PAD * D;
    float* P = (float*)(p.ws + WS_P);
    constexpr int nM = NTOK / 256, nN = INP_PAD / 256, nwg = nM * nN;
    gemm_phase<false>(nwg, bid, nb, D, shm, p.wb,
        [&](int L) { int pm, pn; dense_tile(xcd_remap(L, nwg), nM, nN, pm, pn); GU u; u.A = H; u.Bt = Bt + (size_t)(pn * 256) * D; u.i0 = pm * 256; u.i1 = pn * 256; u.i2 = 0; u.i3 = 0; return u; },
        [&](const GU& u, int r) { return (u.i0 + r) * D; },
        [&](const GU& u, f32x4 (&acc)[2][2][4][2]) {
            const int m0 = u.i0, n0 = u.i1;
            G_IDX;
#pragma unroll
            for (int ai = 0; ai < 2; ++ai)
#pragma unroll
                for (int m = 0; m < 4; ++m) {
                    float* prow = P + (size_t)(m0 + ai * 128 + wr * 64 + m * 16 + fr) * INP + n0 + wc * 32 + fq * 4;
#pragma unroll
                    for (int bj = 0; bj < 2; ++bj)
#pragma unroll
                        for (int n = 0; n < 2; ++n)
                            if (n0 + bj * 128 + wc * 32 + n * 16 + fq * 4 < INP) *(f32x4*)(prow + bj * 128 + n * 16) = acc[ai][bj][m][n];
                }
        });
}

__device__ __forceinline__ int scan_pos(int d, int row) {
    if (row >= SEQ) { const int c = row - SEQ; return d == 0 ? c : (CTXL - 1 - c); }
    return CTXL + (d == 0 ? row : (SEQ - 1 - row));
}
__device__ __forceinline__ int scan_row(int d, int s) {
    if (s < CTXL) return SEQ + (d == 0 ? s : (CTXL - 1 - s));
    const int q = s - CTXL; return d == 0 ? q : (SEQ - 1 - q);
}
constexpr int RP_TB = 11;
constexpr int RP_LD = 392;
__device__ __forceinline__ f32x4 shifted4(const float* P, int row, int col, const float* mu) {
    const f32x4 cur = *(const f32x4*)(P + (size_t)row * INP + col);
    const bool first = (row == 0) || (row == SEQ), last = (row == SEQ - 1) || (row == NTOK - 1);
    f32x4 prev = {0.f, 0.f, 0.f, 0.f}, nxt = {0.f, 0.f, 0.f, 0.f};
    if (!first) prev = *(const f32x4*)(P + (size_t)(row - 1) * INP + col);
    if (!last) nxt = *(const f32x4*)(P + (size_t)(row + 1) * INP + col);
    const f32x4 m0 = *(const f32x4*)(mu + col), m1 = *(const f32x4*)(mu + RWP + col);
    return cur + m0 * (prev - cur) + m1 * (nxt - cur);
}
__device__ __forceinline__ float shifted(const float* P, int row, int col, float mu0, float mu1) {
    const float cur = P[(size_t)row * INP + col];
    const bool first = (row == 0) || (row == SEQ), last = (row == SEQ - 1) || (row == NTOK - 1);
    const float prev = first ? 0.f : P[(size_t)(row - 1) * INP + col];
    const float nxt = last ? 0.f : P[(size_t)(row + 1) * INP + col];
    return cur + mu0 * (prev - cur) + mu1 * (nxt - cur);
}
__device__ void phase_rwprep(const KP& p, int l, int bid, int nb, char* smem) {
    const float* P = (const float*)(p.ws + WS_P);
    float* REC = (float*)(p.ws + WS_REC);
    float* G = (float*)(p.ws + WS_G);
    float* BV = (float*)(p.ws + WS_BV);
    float* GMR = (float*)(p.ws + WS_GMR);
    const bf16_t* WLT = (const bf16_t*)(p.ws + WS_WLT) + (size_t)l * RW * 384;
    bf16_t* lin = (bf16_t*)smem;
    const float* mu = p.rw_mu + (size_t)l * 2 * RWP;
    const float* w0 = p.rw_w0 + (size_t)l * 2 * RW;
    const float* a0 = p.rw_a0 + (size_t)l * 2 * RW;
    const float* kkw = p.rw_kk + (size_t)l * RW;
    const float* kaw = p.rw_ka + (size_t)l * RW;
    const float* rkw = p.rw_rk + (size_t)l * RW;
    const int tid = otid(p.wb), wid = tid >> 6, lane = tid & 63, t16 = lane & 15, g = lane >> 4;
    for (int blk = bid; blk < NTOK / RP_TB; blk += nb) {
        const int t0 = blk * RP_TB;
        __syncthreads();
        for (int i = tid; i < RP_TB * 384; i += NT) {
            const int tt = i / 384, j = i % 384, col = 1536 + j;
            const float v = shifted(P, t0 + tt, col, mu[col], mu[RWP + col]);
            lin[tt * RP_LD + j] = f2bf(j < 128 ? ftanh(v) : (j < 256 ? v : sigmoidf_(v)));
        }
        __syncthreads();
        for (int q = wid; q < RP_TB; q += 8) {
            const int row = t0 + q; float ss = 0.f;
#pragma unroll
            for (int i = 0; i < 8; ++i) { const float gv = gelu_tanh(P[(size_t)row * INP + COL_GM + GMW + i * 64 + lane]); ss += gv * gv; }
            ss = wave_sum(ss);
            if (lane == 0) GMR[row] = rsqrtf(ss * (1.f / GMW) + 1e-6f);
        }
        const bool live = t16 < RP_TB;
        const int row = t0 + (live ? t16 : RP_TB - 1);
        float nrm2 = 0.f, bon = 0.f;
#pragma unroll
        for (int tl = 0; tl < 4; ++tl) {
            const int c = wid * 64 + tl * 16 + g * 4;
            const f32x4 r4 = shifted4(P, row, c, mu), k4 = shifted4(P, row, 512 + c, mu);
            const f32x4 kq = k4 * *(const f32x4*)(kkw + c), rk = *(const f32x4*)(rkw + c);
#pragma unroll
            for (int e = 0; e < 4; ++e) { nrm2 += kq[e] * kq[e]; bon += r4[e] * k4[e] * rk[e]; }
        }
        nrm2 += bperm(nrm2, lane ^ 16); nrm2 += bperm(nrm2, lane ^ 32);
        bon += bperm(bon, lane ^ 16); bon += bperm(bon, lane ^ 32);
        const float inrm = 1.f / fmaxf(sqrtf(nrm2), 1e-12f);
        const bf16_t* lrow = lin + (live ? t16 : RP_TB - 1) * RP_LD + g * 8;
#pragma unroll 2
        for (int tl = 0; tl < 4; ++tl) {
            f32x4 acc[5];
#pragma unroll
            for (int m = 0; m < 5; ++m) acc[m] = (f32x4){0.f, 0.f, 0.f, 0.f};
            const bf16_t* wrow = WLT + (size_t)(wid * 64 + tl * 16 + t16) * 384 + g * 8;
#pragma unroll
            for (int ks = 0; ks < 12; ++ks) {
                const int m = ks < 8 ? (ks >> 1) : 4;
                acc[m] = __builtin_amdgcn_mfma_f32_16x16x32_bf16(*(const bf16x8*)(wrow + ks * 32), *(const bf16x8*)(lrow + ks * 32), acc[m], 0, 0, 0);
            }
            const int c = wid * 64 + tl * 16 + g * 4, ci = tl * 16 + g * 4;
            const f32x4 r4 = shifted4(P, row, c, mu), k4 = shifted4(P, row, 512 + c, mu), v4 = shifted4(P, row, 1024 + c, mu);
            const f32x4 kq = k4 * *(const f32x4*)(kkw + c) * inrm;
            if (live) {
                *(f32x4*)(G + (size_t)row * RW + c) = acc[4];
                *(f32x4*)(BV + (size_t)row * RW + c) = v4 * bon;
            }
            const f32x4 ka = *(const f32x4*)(kaw + c);
#pragma unroll
            for (int d = 0; d < 2; ++d) {
                const f32x4 w0v = *(const f32x4*)(w0 + d * RW + c), a0v = *(const f32x4*)(a0 + d * RW + c);
                f32x4 decay, av, kd;
#pragma unroll
                for (int e = 0; e < 4; ++e) {
                    const float wlog = -softplusf_(-(w0v[e] + acc[d][e])) - 0.5f;
                    decay[e] = fexp(-fexp(wlog));
                    av[e] = sigmoidf_(a0v[e] + acc[2 + d][e]);
                    kd[e] = k4[e] * (1.f + (av[e] - 1.f) * ka[e]);
                }
                if (live) {
                    float* rec = REC + ((size_t)(d * 8 + wid) * NTOK + scan_pos(d, row)) * 384 + ci;
                    *(f32x4*)(rec) = decay; *(f32x4*)(rec + 64) = kq; *(f32x4*)(rec + 128) = kq * av;
                    *(f32x4*)(rec + 192) = kd; *(f32x4*)(rec + 256) = r4; *(f32x4*)(rec + 320) = v4;
                }
            }
        }
    }
}

constexpr int SC_TS = 16;
constexpr int SCAN_BLOCKS = 128;
constexpr int SC_OPB = SC_TS * 384;
constexpr int SC_SBW = SC_TS * 64 * 4;
constexpr int SC_LDS = (2 * SC_OPB + 2 * 2 * SC_SBW) * 4;
#define SC_LD(slot, s) { const float* b_ = buf + (s) * 384 + 4 * l16; qw[slot] = *(const f32x4*)(b_); qk[slot] = *(const f32x4*)(b_ + 64); \
    qb[slot] = *(const f32x4*)(b_ + 128); qd[slot] = *(const f32x4*)(b_ + 192); qv[slot] = buf[(s) * 384 + 320 + i]; }
__device__ __forceinline__ void scan_chunk(const float* buf, float* sb, int l16, int lane, int i, f32x4& S) {
    f32x4 qw[3], qk[3], qb[3], qd[3]; float qv[3];
    SC_LD(0, 0); SC_LD(1, 1);
#pragma unroll
    for (int s = 0; s < SC_TS; ++s) {
        const int sl = s % 3;
        if (s + 2 < SC_TS) SC_LD((s + 2) % 3, s + 2);
        const f32x4 pk = S * qk[sl];
        const float sa = -red16((pk[0] + pk[1]) + (pk[2] + pk[3]));
        S = (S * qw[sl] + qd[sl] * qv[sl]) + qb[sl] * sa;
        *(f32x4*)(sb + (s * 64 + lane) * 4) = S;
    }
}
#define SC_LOAD(R, ch) { const float* _g = rec + (size_t)(ch) * SC_OPB + lt * 4; _Pragma("unroll") for (int q = 0; q < 12; ++q) R[q] = *(const f32x4*)(_g + q * 512); }
#define SC_WRITE(R, B) { float* _l = (B) + lt * 4; _Pragma("unroll") for (int q = 0; q < 12; ++q) *(f32x4*)(_l + q * 512) = R[q]; }
__device__ void phase_scan(const KP& p, int bid, char* smem) {
    const float* REC = (const float*)(p.ws + WS_REC);
    float* YD = (float*)(p.ws + WS_YD);
    float* B0 = (float*)smem;
    float* B1 = B0 + SC_OPB;
    float* SB0 = B1 + SC_OPB;
    float* SB1 = SB0 + 2 * SC_SBW;
    const int tid = otid(p.wb), wid = tid >> 6, lane = tid & 63, l16 = lane & 15;
    const int xcd = bid & 7, slot = bid >> 3, dh = xcd * 2 + (slot >> 3), rq = slot & 7;
    const int d = dh >> 3, h = dh & 7;
    const float* rec = REC + (size_t)dh * NTOK * 384;
    constexpr int NCH = NTOK / SC_TS;
    if (wid >= 6) {
        __syncthreads();
        for (int c = 0; c <= NCH; ++c) __syncthreads();
    } else if (wid >= 4) {
        const int lt = tid - 256;
        f32x4 R0[12], R1[12];
        SC_LOAD(R0, 0); SC_WRITE(R0, B0);
        SC_LOAD(R1, 1); SC_LOAD(R0, 2);
        __syncthreads();
        for (int c = 0; c < NCH; c += 2) {
            if (c + 1 < NCH) SC_WRITE(R1, B1);
            if (c + 3 < NCH) SC_LOAD(R1, c + 3);
            __syncthreads();
            if (c + 2 < NCH) SC_WRITE(R0, B0);
            if (c + 4 < NCH) SC_LOAD(R0, c + 4);
            __syncthreads();
        }
        __syncthreads();
    } else if (wid >= 2) {
        const int cw = wid - 2, dstep = d == 0 ? 1 : -1;
        float* yout = YD + (size_t)d * NTOK * RW + h * 64 + rq * 8 + cw * 4 + (lane >> 4);
        f32x4 rr[SC_TS];
#define SC_RLOAD(B) { _Pragma("unroll") for (int s = 0; s < SC_TS; ++s) rr[s] = *(const f32x4*)((B) + s * 384 + 256 + 4 * l16); }
#define SC_READOUT(SB, ch) { float yv = 0.f; \
            _Pragma("unroll") for (int s = 0; s < SC_TS; ++s) { const f32x4 sv = *(const f32x4*)((SB) + cw * SC_SBW + (s * 64 + lane) * 4); const f32x4 py = sv * rr[s]; \
                const float y = red16((py[0] + py[1]) + (py[2] + py[3])); yv = (l16 == s) ? y : yv; } \
            yout[(size_t)(scan_row(d, (ch) * SC_TS) + dstep * l16) * RW] = yv; }
        __syncthreads();
        SC_RLOAD(B0);
        __syncthreads();
        for (int c = 1; c < NCH; c += 2) {
            SC_READOUT(SB0, c - 1); SC_RLOAD(B1);
            __syncthreads();
            SC_READOUT(SB1, c);
            if (c + 1 < NCH) SC_RLOAD(B0);
            __syncthreads();
        }
    } else {
        const int i = rq * 8 + wid * 4 + (lane >> 4);
        f32x4 S = {0.f, 0.f, 0.f, 0.f};
        __syncthreads();
        for (int c = 0; c < NCH; c += 2) {
            scan_chunk(B0, SB0 + wid * SC_SBW, l16, lane, i, S);
            __syncthreads();
            scan_chunk(B1, SB1 + wid * SC_SBW, l16, lane, i, S);
            __syncthreads();
        }
        __syncthreads();
    }
}

__device__ void phase_rwpost(const KP& p, int l, int bid, int nb) {
    const float* YD = (const float*)(p.ws + WS_YD);
    const float* G = (const float*)(p.ws + WS_G);
    const float* BV = (const float*)(p.ws + WS_BV);
    bf16_t* Y = (bf16_t*)(p.ws + WS_YCAT);
    const float* lng = p.rw_ln_g + (size_t)l * RW;
    const float* lnb = p.rw_ln_b + (size_t)l * RW;
    const int tid = otid(p.wb), wid = tid >> 6, lane = tid & 63;
    for (int u = bid * 8 + wid; u < NTOK * 8; u += nb * 8) {
        const int row = u >> 3, h = u & 7, c = h * 64 + lane;
        const float y = YD[(size_t)row * RW + c] + YD[((size_t)NTOK + row) * RW + c];
        const float mean = wave_sum(y) * (1.f / 64);
        const float dv = y - mean;
        const float var = wave_sum(dv * dv) * (1.f / 64);
        const float yn = dv * rsqrtf(var + 64e-5f) * lng[c] + lnb[c];
        Y[(size_t)row * D + c] = f2bf((yn + BV[(size_t)row * RW + c]) * G[(size_t)row * RW + c]);
    }
}

constexpr int GM_LD = 136;
__device__ void phase_gmlp(const KP& p, int l, int bid, int nb, char* smem) {
    const float* P = (const float*)(p.ws + WS_P);
    const float* GMR = (const float*)(p.ws + WS_GMR);
    bf16_t* Y = (bf16_t*)(p.ws + WS_YCAT);
    bf16_t* vt = (bf16_t*)smem;
    const float* ng = p.gm_norm_g + (size_t)l * GMW;
    const int tid = otid(p.wb), wid = tid >> 6, lane = tid & 63, r = lane & 31, h = lane >> 5, mt = wid >> 1, nt = wid & 1;
    for (int u = bid; u < (NTOK / 128) * 8; u += nb) {
        const int n = u >> 3, g = u & 7, t0 = n * 128;
        const float* ws = p.gm_ws + ((size_t)l * 8 + g) * 128 * 128;
        const float* bs = p.gm_b + ((size_t)l * 8 + g) * 128;
        __syncthreads();
        {
            const int c = tid & 63, qp0 = tid >> 6;
            const float gn = ng[g * 64 + c];
#pragma unroll
            for (int i = 0; i < 8; ++i) {
                const int q = (qp0 + 8 * i) * 2;
                const float v0 = gelu_tanh(P[(size_t)(t0 + q) * INP + COL_GM + GMW + g * 64 + c]) * GMR[t0 + q] * gn;
                const float v1 = gelu_tanh(P[(size_t)(t0 + q + 1) * INP + COL_GM + GMW + g * 64 + c]) * GMR[t0 + q + 1] * gn;
                *(unsigned*)(vt + c * GM_LD + q) = pack_bf2(v0, v1);
            }
        }
        __syncthreads();
        f32x16 acc;
#pragma unroll
        for (int i = 0; i < 16; ++i) acc[i] = 0.f;
        const float* arow = ws + (size_t)(mt * 32 + r) * 128 + h * 8;
#pragma unroll
        for (int ks = 0; ks < 8; ++ks) {
            const f32x4 a0 = *(const f32x4*)(arow + ks * 16), a1 = *(const f32x4*)(arow + ks * 16 + 4);
            u32x4 aw; aw[0] = pack_bf2(a0[0], a0[1]); aw[1] = pack_bf2(a0[2], a0[3]); aw[2] = pack_bf2(a1[0], a1[1]); aw[3] = pack_bf2(a1[2], a1[3]);
            const bf16x8 bfr = *(const bf16x8*)(vt + (nt * 32 + r) * GM_LD + ks * 16 + h * 8);
            acc = __builtin_amdgcn_mfma_f32_32x32x16_bf16(__builtin_bit_cast(bf16x8, aw), bfr, acc, 0, 0, 0);
        }
        const int c = nt * 32 + r;
#pragma unroll
        for (int i = 0; i < 16; ++i) {
            const int pp = mt * 32 + (i & 3) + 8 * (i >> 2) + 4 * h;
            const float uu = gelu_tanh(P[(size_t)(t0 + pp) * INP + COL_GM + g * 64 + c]);
            Y[(size_t)(t0 + pp) * D + 512 + g * 64 + c] = f2bf(uu * (acc[i] + bs[pp]));
        }
    }
}

__device__ void phase_atprep(const KP& p, int l, int bid, int nb, char* smem) {
    const float* P = (const float*)(p.ws + WS_P);
    bf16_t* Qb = (bf16_t*)(p.ws + WS_Q);
    bf16_t* Kb = (bf16_t*)(p.ws + WS_K);
    bf16_t* VT = Kb + (size_t)NTOK * 256;
    const float* qn = p.at_qn + (size_t)l * 64;
    const float* kn = p.at_kn + (size_t)l * 64;
    const int tid = otid(p.wb);
    const float* rope = (const float*)(p.ws + WS_ROPE);
    for (int i = bid * NT + tid; i < NTOK * 20; i += nb * NT) {
        const int row = i / 20, hv = i % 20;
        const bool isq = hv < 16;
        const float* src = P + (size_t)row * INP + (isq ? COL_AT + hv * 64 : COL_K + (hv - 16) * 64);
        const float* gn = isq ? qn : kn;
        f32x4 x[16]; float ss = 0.f;
#pragma unroll
        for (int k = 0; k < 16; ++k) { x[k] = *(const f32x4*)(src + 4 * k); ss += x[k][0] * x[k][0] + x[k][1] * x[k][1] + x[k][2] * x[k][2] + x[k][3] * x[k][3]; }
        const float sc = rsqrtf(ss * (1.f / 64) + 1e-6f) * (isq ? 0.125f : 1.f);
#pragma unroll
        for (int k = 0; k < 16; ++k) x[k] = x[k] * *(const f32x4*)(gn + 4 * k) * sc;
        if (row < SEQ) {
#pragma unroll
            for (int sec = 0; sec < 2; ++sec) {
                const float* rt = rope + (size_t)((sec == 0 ? (row >> 6) : (128 + (row & 63))) * 16) * 2;
#pragma unroll
                for (int k = 0; k < 4; ++k) {
                    const f32x4 c0 = *(const f32x4*)(rt + 8 * k), c1 = *(const f32x4*)(rt + 8 * k + 4);
                    f32x4& a = x[8 * sec + k]; f32x4& b2 = x[8 * sec + 4 + k];
                    const float cs[4] = {c0[0], c0[2], c1[0], c1[2]}, sn[4] = {c0[1], c0[3], c1[1], c1[3]};
#pragma unroll
                    for (int e = 0; e < 4; ++e) { const float x1 = a[e], x2 = b2[e]; a[e] = x1 * cs[e] - x2 * sn[e]; b2[e] = x2 * cs[e] + x1 * sn[e]; }
                }
            }
        }
        bf16_t* dst = isq ? (Qb + (size_t)row * 1024 + hv * 64) : (Kb + (size_t)row * 256 + (hv - 16) * 64);
#pragma unroll
        for (int k = 0; k < 8; ++k) {
            u32x4 w; w[0] = pack_bf2(x[2 * k][0], x[2 * k][1]); w[1] = pack_bf2(x[2 * k][2], x[2 * k][3]); w[2] = pack_bf2(x[2 * k + 1][0], x[2 * k + 1][1]); w[3] = pack_bf2(x[2 * k + 1][2], x[2 * k + 1][3]);
            *(u32x4*)(dst + 8 * k) = w;
        }
    }
    float* tile = (float*)smem;
    for (int u = bid; u < (NTOK / 64) * 4; u += nb) {
        const int t0 = (u >> 2) * 64, kvh = u & 3;
        __syncthreads();
        {
            const int tok = tid >> 3, d8 = (tid & 7) * 8;
            const float* src = P + (size_t)(t0 + tok) * INP + COL_V + kvh * 64 + d8;
            const f32x4 a = *(const f32x4*)src, b2 = *(const f32x4*)(src + 4);
#pragma unroll
            for (int i = 0; i < 4; ++i) { tile[tok * 65 + d8 + i] = a[i]; tile[tok * 65 + d8 + 4 + i] = b2[i]; }
        }
        __syncthreads();
        {
            const int d = tid >> 3, tk = (tid & 7) * 8;
            u32x4 w;
#pragma unroll
            for (int i = 0; i < 4; ++i) w[i] = pack_bf2(tile[(tk + 2 * i) * 65 + d], tile[(tk + 2 * i + 1) * 65 + d]);
            *(u32x4*)(VT + (size_t)(kvh * 64 + d) * NTOK + t0 + tk) = w;
        }
    }
}

constexpr int AT_LD = 72;
constexpr int AT_TILE = 64 * AT_LD;
__device__ void phase_attn(const KP& p, int l, int bid, int nb, char* smem) {
    const bf16_t* Qb = (const bf16_t*)(p.ws + WS_Q);
    const bf16_t* Kb = (const bf16_t*)(p.ws + WS_K);
    const bf16_t* VT = Kb + (size_t)NTOK * 256;
    bf16_t* Y = (bf16_t*)(p.ws + WS_YCAT);
    bf16_t* Kc = (bf16_t*)smem;
    bf16_t* Vc = Kc + AT_TILE;
    const int tid = otid(p.wb), wid = tid >> 6, lane = tid & 63, q = lane & 31, h = lane >> 5, g = wid >> 1, qh = wid & 1;
    const int srow = tid >> 3, sseg = tid & 7;
    const int voff = srow * AT_LD + (sseg >> 2) * 32 + ((sseg >> 1) & 1) * 16 + (sseg & 1) * 4;
    for (int u = bid; u < (NTOK / 64) * 4; u += nb) {
        const int qt = u >> 2, kvh = u & 3, t0 = qt * 64, head = kvh * 4 + g, qrow = t0 + qh * 32 + q;
        int c_lo = 0, n_local = 0;
        if (t0 < SEQ) { c_lo = 2 - (t0 >> 6); if (c_lo < 0) c_lo = 0; int c_hi = (SEQ + 64 - t0) >> 6; if (c_hi > 4) c_hi = 4; n_local = c_hi - c_lo + 1; }
        const int nch = n_local + 4;
        bf16x8 qf[4];
#pragma unroll
        for (int ks = 0; ks < 4; ++ks) qf[ks] = *(const bf16x8*)(Qb + (size_t)qrow * 1024 + head * 64 + ks * 16 + h * 8);
        f32x16 O0, O1;
#pragma unroll
        for (int r = 0; r < 16; ++r) { O0[r] = 0.f; O1[r] = 0.f; }
        float m = p.at_sink[(size_t)l * 16 + head], lsum = h == 0 ? 1.f : 0.f;
        u32x4 rk, rv;
        {
            const int k0 = n_local > 0 ? (t0 - 128 + 64 * c_lo) : SEQ;
            rk = *(const u32x4*)(Kb + (size_t)(k0 + srow) * 256 + kvh * 64 + sseg * 8);
            rv = *(const u32x4*)(VT + (size_t)(kvh * 64 + srow) * NTOK + k0 + sseg * 8);
        }
        for (int ci = 0; ci < nch; ++ci) {
            const bool local = ci < n_local;
            const int k0 = local ? (t0 - 128 + 64 * (c_lo + ci)) : (SEQ + 64 * (ci - n_local));
            __syncthreads();
            *(u32x4*)(Kc + srow * AT_LD + sseg * 8) = rk;
            { u32x2 lo, hi; lo[0] = rv[0]; lo[1] = rv[1]; hi[0] = rv[2]; hi[1] = rv[3]; *(u32x2*)(Vc + voff) = lo; *(u32x2*)(Vc + voff + 8) = hi; }
            __syncthreads();
            if (ci + 1 < nch) {
                const int kn = (ci + 1 < n_local) ? (t0 - 128 + 64 * (c_lo + ci + 1)) : (SEQ + 64 * (ci + 1 - n_local));
                rk = *(const u32x4*)(Kb + (size_t)(kn + srow) * 256 + kvh * 64 + sseg * 8);
                rv = *(const u32x4*)(VT + (size_t)(kvh * 64 + srow) * NTOK + kn + sseg * 8);
            }
            f32x16 s0, s1;
#pragma unroll
            for (int r = 0; r < 16; ++r) { s0[r] = 0.f; s1[r] = 0.f; }
#pragma unroll
            for (int ks = 0; ks < 4; ++ks) {
                const bf16x8 k0f = *(const bf16x8*)(Kc + q * AT_LD + ks * 16 + h * 8);
                const bf16x8 k1f = *(const bf16x8*)(Kc + (32 + q) * AT_LD + ks * 16 + h * 8);
                s0 = __builtin_amdgcn_mfma_f32_32x32x16_bf16(k0f, qf[ks], s0, 0, 0, 0);
                s1 = __builtin_amdgcn_mfma_f32_32x32x16_bf16(k1f, qf[ks], s1, 0, 0, 0);
            }
            if (local) {
                const int base = k0 + 4 * h - qrow;
#pragma unroll
                for (int r = 0; r < 16; ++r) {
                    const int d0 = base + (r & 3) + 8 * (r >> 2), d1 = d0 + 32;
                    if (d0 > 128 || d0 < -128) s0[r] = -INFINITY;
                    if (d1 > 128 || d1 < -128) s1[r] = -INFINITY;
                }
            }
            float mx = fmaxf(s0[0], s1[0]);
#pragma unroll
            for (int r = 1; r < 16; ++r) mx = fmaxf(mx, fmaxf(s0[r], s1[r]));
            mx = fmaxf(mx, bperm(mx, lane ^ 32));
            const float mnew = fmaxf(m, mx);
            const float alpha = __expf(m - mnew);
            m = mnew; lsum *= alpha;
#pragma unroll
            for (int r = 0; r < 16; ++r) { O0[r] *= alpha; O1[r] *= alpha; }
            float ps = 0.f;
#pragma unroll
            for (int r = 0; r < 16; ++r) { s0[r] = __expf(s0[r] - m); s1[r] = __expf(s1[r] - m); ps += s0[r] + s1[r]; }
            lsum += ps;
            bf16x8 pf[2][2];
#pragma unroll
            for (int s = 0; s < 2; ++s) {
                u32x4 w0, w1;
#pragma unroll
                for (int i = 0; i < 4; ++i) { w0[i] = pack_bf2(s0[8 * s + 2 * i], s0[8 * s + 2 * i + 1]); w1[i] = pack_bf2(s1[8 * s + 2 * i], s1[8 * s + 2 * i + 1]); }
                pf[0][s] = __builtin_bit_cast(bf16x8, w0); pf[1][s] = __builtin_bit_cast(bf16x8, w1);
            }
#pragma unroll
            for (int kb = 0; kb < 2; ++kb)
#pragma unroll
                for (int s = 0; s < 2; ++s) {
                    const bf16x8 v0f = *(const bf16x8*)(Vc + q * AT_LD + kb * 32 + s * 16 + h * 8);
                    const bf16x8 v1f = *(const bf16x8*)(Vc + (32 + q) * AT_LD + kb * 32 + s * 16 + h * 8);
                    O0 = __builtin_amdgcn_mfma_f32_32x32x16_bf16(v0f, pf[kb][s], O0, 0, 0, 0);
                    O1 = __builtin_amdgcn_mfma_f32_32x32x16_bf16(v1f, pf[kb][s], O1, 0, 0, 0);
                }
        }
        lsum += bperm(lsum, lane ^ 32);
        const float inv = 1.f / lsum;
        bf16_t* yo = Y + (size_t)qrow * D + 1024 + head * 64 + 4 * h;
#pragma unroll
        for (int rg = 0; rg < 4; ++rg) {
            u32x2 w0, w1;
            w0[0] = pack_bf2(O0[4 * rg] * inv, O0[4 * rg + 1] * inv); w0[1] = pack_bf2(O0[4 * rg + 2] * inv, O0[4 * rg + 3] * inv);
            w1[0] = pack_bf2(O1[4 * rg] * inv, O1[4 * rg + 1] * inv); w1[1] = pack_bf2(O1[4 * rg + 2] * inv, O1[4 * rg + 3] * inv);
            *(u32x2*)(yo + 8 * rg) = w0;
            *(u32x2*)(yo + 32 + 8 * rg) = w1;
        }
    }
}

__device__ void phase_oproj(const KP& p, int l, int bid, int nb, bf16_t* shm) {
    const bf16_t* Y = (const bf16_t*)(p.ws + WS_YCAT);
    const bf16_t* Bt = (const bf16_t*)(p.ws + WS_WOT) + (size_t)l * D * D;
    const RowSrc in = layer_in(p, l);
    const RowDst out = layer_out(p, l);
    const int nM = ntok_of(l) / 256, nN = D / 256, nwg = nM * nN;
    gemm_phase<false>(nwg, bid, nb, D, shm, p.wb,
        [&](int L) { int pm, pn; dense_tile(xcd_remap(L, nwg), nM, nN, pm, pn); GU u; u.A = Y; u.Bt = Bt + (size_t)(pn * 256) * D; u.i0 = pm * 256; u.i1 = pn * 256; u.i2 = 0; u.i3 = 0; return u; },
        [&](const GU& u, int r) { return (u.i0 + r) * D; },
        [&](const GU& u, f32x4 (&acc)[2][2][4][2]) {
            const int m0 = u.i0, n0 = u.i1;
            G_IDX;
#pragma unroll
            for (int ai = 0; ai < 2; ++ai)
#pragma unroll
                for (int m = 0; m < 4; ++m) {
                    const int row = m0 + ai * 128 + wr * 64 + m * 16 + fr;
                    const float* xi = rowp(in, row);
                    float* xo = rowp(out, row);
                    const float* g1 = modp(p, l, row, 2);
#pragma unroll
                    for (int bj = 0; bj < 2; ++bj)
#pragma unroll
                        for (int n = 0; n < 2; ++n) {
                            const int col = n0 + bj * 128 + wc * 32 + n * 16 + fq * 4;
                            *(f32x4*)(xo + col) = *(const f32x4*)(xi + col) + *(const f32x4*)(g1 + col) * acc[ai][bj][m][n];
                        }
                }
        });
}

constexpr int RT_R = 11;
constexpr int RT_LD = D + 8;
__device__ void phase_norm2_route(const KP& p, int l, int bid, int nb, char* smem, const bool dummy = false) {
    const RowDst xs = layer_out(p, l);
    bf16_t* H = (bf16_t*)(p.ws + WS_H);
    int* cnt = (int*)(p.ws + WS_CNT) + l * 64 + (dummy ? 128 : 0);
    int* tokE = (int*)(p.ws + WS_TOKE);
    int* tokP = (int*)(p.ws + WS_TOKP);
    float* tokW = (float*)(p.ws + WS_TOKW);
    const float* g = p.norm2_g + (size_t)l * D;
    const bf16_t* RTH = (const bf16_t*)(p.ws + WS_RT) + (size_t)l * 2 * NE * D;
    const bf16_t* RTL = RTH + (size_t)NE * D;
    const float* rbias = p.moe_bias + (size_t)l * NE;
    bf16_t* hh = (bf16_t*)smem;
    bf16_t* hl = hh + RT_R * RT_LD;
    float* part = (float*)(hl + RT_R * RT_LD);
    int* lcnt = (int*)(part + 8 * 64 * 16);
    int* lbase = lcnt + 64;
    int* lsel = lbase + 64;
    const int tid = otid(p.wb), wid = tid >> 6, lane = tid & 63, c16 = lane & 15, g4 = lane >> 4;
    const int ntok = ntok_of(l), nsteps = (ntok + RT_R - 1) / RT_R;
    __syncthreads();
    if (tid < 64) lcnt[tid] = 0;
    for (int i = tid; i < 4 * RT_R * 8; i += NT) lsel[i] = -1;
    int step = 0;
    for (int blk = bid; blk < nsteps; blk += nb, ++step) {
        const int t0 = blk * RT_R;
        __syncthreads();
        {
            int rrq[2], rowq[2]; bool liveq[2]; const float* xrq[2]; const float* shq[2]; const float* scq[2];
            f32x4 v[2][8]; float ss[2];
#pragma unroll
            for (int q = 0; q < 2; ++q) {
                rrq[q] = wid + 8 * q; liveq[q] = rrq[q] < RT_R && t0 + rrq[q] < ntok;
                rowq[q] = liveq[q] ? t0 + rrq[q] : ntok - 1;
                xrq[q] = rowp(xs, rowq[q]); shq[q] = modp(p, l, rowq[q], 3); scq[q] = modp(p, l, rowq[q], 4); ss[q] = 0.f;
            }
#pragma unroll
            for (int i = 0; i < 8; ++i)
#pragma unroll
                for (int q = 0; q < 2; ++q) { v[q][i] = *(const f32x4*)(xrq[q] + i * 256 + lane * 4); ss[q] += v[q][i][0] * v[q][i][0] + v[q][i][1] * v[q][i][1] + v[q][i][2] * v[q][i][2] + v[q][i][3] * v[q][i][3]; }
            float rstd[2];
#pragma unroll
            for (int q = 0; q < 2; ++q) rstd[q] = rsqrtf(wave_sum(ss[q]) * (1.f / D) + 1e-6f);
#pragma unroll
            for (int i = 0; i < 8; ++i) {
                const int c = i * 256 + lane * 4;
                const f32x4 gv = *(const f32x4*)(g + c);
#pragma unroll
                for (int q = 0; q < 2; ++q) {
                    const f32x4 shv = *(const f32x4*)(shq[q] + c), scv = *(const f32x4*)(scq[q] + c);
                    float o[4]; unsigned hi[4]; float lo[4];
#pragma unroll
                    for (int j = 0; j < 4; ++j) { const float t = v[q][i][j] * rstd[q] * gv[j]; o[j] = fmaf(t, scv[j], t) + shv[j]; hi[j] = f2bf(o[j]); lo[j] = o[j] - __uint_as_float(hi[j] << 16); }
                    u32x2 wh, wl; wh[0] = hi[0] | (hi[1] << 16); wh[1] = hi[2] | (hi[3] << 16); wl[0] = pack_bf2(lo[0], lo[1]); wl[1] = pack_bf2(lo[2], lo[3]);
                    if (rrq[q] < RT_R) { *(u32x2*)(hh + rrq[q] * RT_LD + c) = wh; *(u32x2*)(hl + rrq[q] * RT_LD + c) = wl; }
                    if (liveq[q]) *(u32x2*)(H + (size_t)rowq[q] * D + c) = wh;
                }
            }
        }
        __syncthreads();
        {
            f32x4 acc[4];
#pragma unroll
            for (int et = 0; et < 4; ++et) acc[et] = (f32x4){0.f, 0.f, 0.f, 0.f};
            const int hr = c16 < RT_R ? c16 : RT_R - 1;
            const bf16_t* bh = hh + hr * RT_LD + wid * 256 + g4 * 8;
            const bf16_t* bl = hl + hr * RT_LD + wid * 256 + g4 * 8;
            const bf16_t* ah = RTH + (size_t)c16 * D + wid * 256 + g4 * 8;
            const bf16_t* al = RTL + (size_t)c16 * D + wid * 256 + g4 * 8;
#pragma unroll 2
            for (int ks = 0; ks < 8; ++ks) {
                const bf16x8 bhf = *(const bf16x8*)(bh + ks * 32), blf = *(const bf16x8*)(bl + ks * 32);
#pragma unroll
                for (int et = 0; et < 4; ++et) {
                    const bf16x8 ahf = *(const bf16x8*)(ah + (size_t)et * 16 * D + ks * 32), alf = *(const bf16x8*)(al + (size_t)et * 16 * D + ks * 32);
                    acc[et] = __builtin_amdgcn_mfma_f32_16x16x32_bf16(ahf, bhf, acc[et], 0, 0, 0);
                    acc[et] = __builtin_amdgcn_mfma_f32_16x16x32_bf16(ahf, blf, acc[et], 0, 0, 0);
                    acc[et] = __builtin_amdgcn_mfma_f32_16x16x32_bf16(alf, bhf, acc[et], 0, 0, 0);
                }
            }
#pragma unroll
            for (int et = 0; et < 4; ++et)
#pragma unroll
                for (int r = 0; r < 4; ++r) part[(wid * 64 + et * 16 + g4 * 4 + r) * 16 + c16] = acc[et][r];
        }
        __syncthreads();
        {
            bool liveq[2]; int rowq[2]; float score[2], biased[2], val[2]; int sel[2];
#pragma unroll
            for (int q = 0; q < 2; ++q) {
                const int rr = wid + 8 * q;
                liveq[q] = rr < RT_R && t0 + rr < ntok; rowq[q] = t0 + rr;
                const int rc = rr < RT_R ? rr : RT_R - 1;
                float logit = 0.f;
#pragma unroll
                for (int kq = 0; kq < 8; ++kq) logit += part[(kq * 64 + lane) * 16 + rc];
                score[q] = sigmoidf_(logit); biased[q] = score[q] + rbias[lane]; sel[q] = -1;
            }
            const int gbase = lane & ~7, mygrp = lane >> 3;
#pragma unroll
            for (int q = 0; q < 2; ++q) {
                const float m1 = max8(biased[q]);
                const unsigned long long eq = __ballot(biased[q] == m1);
                const unsigned geq = (unsigned)((eq >> gbase) & 0xffull);
                const int first = gbase + (__ffs(geq) - 1);
                const float m2 = max8((lane == first) ? -INFINITY : biased[q]);
                const float gs = m1 + m2;
                int rank = 0;
#pragma unroll
                for (int k = 0; k < 8; ++k) { const float o = bperm(gs, k * 8); rank += (o > gs || (o == gs && k < mygrp)) ? 1 : 0; }
                val[q] = rank < 4 ? biased[q] : -INFINITY;
            }
#pragma unroll
            for (int j = 0; j < TOPK; ++j)
#pragma unroll
                for (int q = 0; q < 2; ++q) {
                    const float mx = wave_max(val[q]);
                    const unsigned long long bm = __ballot(val[q] == mx);
                    const int win = __ffsll((long long)bm) - 1;
                    if (lane == win) { sel[q] = j; val[q] = -INFINITY; }
                }
#pragma unroll
            for (int q = 0; q < 2; ++q) {
                const float ssum = wave_sum(sel[q] >= 0 ? score[q] : 0.f);
                if (liveq[q] && sel[q] >= 0) {
                    const int lr = atomicAdd(lcnt + lane, 1);
                    lsel[((step * RT_R) + (wid + 8 * q)) * 8 + sel[q]] = (lane << 16) | lr;
                    if (!dummy) { tokE[(size_t)rowq[q] * 8 + sel[q]] = lane; tokW[(size_t)rowq[q] * 8 + sel[q]] = score[q] * frcp(ssum) * 2.5f; }
                }
            }
        }
    }
    __syncthreads();
    if (tid < 64) lbase[tid] = atomicAdd(cnt + tid, lcnt[tid]);
    __syncthreads();
    if (!dummy)
        for (int i = tid; i < step * RT_R * 8; i += NT) {
            const int v = lsel[i];
            if (v < 0) continue;
            const int st = i / (RT_R * 8), rr = (i / 8) % RT_R, j = i & 7;
            const int row = (bid + st * nb) * RT_R + rr;
            tokP[(size_t)row * 8 + j] = lbase[v >> 16] + (v & 0xffff);
        }
}

__device__ void phase_slots(const KP& p, int l, int bid, int nb, char* smem) {
    const int* cnt = (const int*)(p.ws + WS_CNT) + l * 64;
    const int* tokE = (const int*)(p.ws + WS_TOKE);
    const int* tokP = (const int*)(p.ws + WS_TOKP);
    int* slotT = (int*)(p.ws + WS_SLOTT);
    int* tile = (int*)(p.ws + WS_TILE);
    int* tokS = (int*)(p.ws + WS_TOKS);
    int* off = (int*)smem;
    const int tid = otid(p.wb);
    const int ntok = ntok_of(l);
    __syncthreads();
    if (tid == 0) {
        int o = 0;
        for (int e = 0; e < NE; ++e) { off[e] = o; o += (cnt[e] + 255) / 256 * 256; }
        off[NE] = o; off[NE + 1] = o + ntok;
    }
    __syncthreads();
    int nbo = nb; asm volatile("" : "+s"(nbo));
    const int gt = bid * NT + tid, gs = nbo * NT;
    for (int i = gt; i < ntok * 8; i += gs) { const int e = tokE[i]; const int s = off[e] + tokP[i]; slotT[s] = i >> 3; tokS[i] = s; }
    for (int i = gt; i < ntok; i += gs) slotT[off[NE] + i] = i;
    for (int i = gt; i < NE * 256; i += gs) { const int e = i >> 8, j = i & 255; const int s = off[e] + cnt[e] + j; if (s < off[e + 1]) slotT[s] = -1; }
    if (bid == 0) {
        const int nt = off[NE + 1] / 256;
        if (tid == 0) tile[0] = nt;
        for (int i = tid; i < nt; i += NT) {
            const int s = i * 256; int e = 0;
            for (int k = 1; k <= NE; ++k) if (s >= off[k]) e = k;
            tile[1 + i] = e;
        }
    }
}

__device__ void phase_moe1(const KP& p, int l, int bid, int nb, bf16_t* shm) {
    const bf16_t* H = (const bf16_t*)(p.ws + WS_H);
    const bf16_t* W13 = (const bf16_t*)(p.ws + WS_W13T) + (size_t)l * NEX * 1024 * D;
    const int* slotT = (const int*)(p.ws + WS_SLOTT);
    const int* tile = (const int*)(p.ws + WS_TILE);
    bf16_t* ACT = (bf16_t*)(p.ws + WS_ACT);
    const int nt = tile[0], nwg = nt * 4;
    gemm_phase<false>(nwg, bid, nb, D, shm, p.wb,
        [&](int L) { const int wg = xcd_remap(L, nwg), ti = wg >> 2, ct = wg & 3, e = tile[1 + ti]; GU u; u.A = H; u.Bt = W13 + ((size_t)e * 1024 + ct * 256) * D; u.i0 = ti * 256; u.i1 = ct * 256; u.i2 = 0; u.i3 = 0; return u; },
        [&](const GU& u, int r) { const int t = slotT[u.i0 + r]; return (t < 0 ? 0 : t) * D; },
        [&](const GU& u, f32x4 (&acc)[2][2][4][2]) {
            const int s0 = u.i0, n0 = u.i1;
            G_IDX;
#pragma unroll
            for (int ai = 0; ai < 2; ++ai)
#pragma unroll
                for (int m = 0; m < 4; ++m) {
                    const int slot = s0 + ai * 128 + wr * 64 + m * 16 + fr;
#pragma unroll
                    for (int bj = 0; bj < 2; ++bj) {
                        const int ch = (n0 + bj * 128 + wc * 32) / 2 + fq * 4;
                        float a[4];
#pragma unroll
                        for (int r = 0; r < 4; ++r) a[r] = siluf_(acc[ai][bj][m][0][r]) * acc[ai][bj][m][1][r];
                        u32x2 w; w[0] = pack_bf2(a[0], a[1]); w[1] = pack_bf2(a[2], a[3]);
                        *(u32x2*)(ACT + (size_t)slot * EFF + ch) = w;
                    }
                }
        });
}

__device__ void phase_moe2(const KP& p, int l, int bid, int nb, bf16_t* shm) {
    const bf16_t* ACT = (const bf16_t*)(p.ws + WS_ACT);
    const bf16_t* W2 = (const bf16_t*)(p.ws + WS_W2T) + (size_t)l * NEX * D * EFF;
    const int* tile = (const int*)(p.ws + WS_TILE);
    const int* slotT = (const int*)(p.ws + WS_SLOTT);
    bf16_t* OUTS = (bf16_t*)(p.ws + WS_OUTS);
    const int nt = tile[0], nwg = nt * 8;
    for (int k = (bid >> 3) & 3; k > 0; --k) __builtin_amdgcn_s_sleep(127);
    gemm_phase<true>(nwg, bid, nb, EFF, shm, p.wb,
        [&](int L) { const int wg = xcd_remap(L, nwg), ti = wg >> 3, ct = wg & 7, e = tile[1 + ti]; GU u; u.A = ACT; u.Bt = W2 + ((size_t)e * D + ct * 256) * EFF; u.i0 = ti * 256; u.i1 = ct * 256; u.i2 = 0; u.i3 = 0; return u; },
        [&](const GU& u, int r) { return (u.i0 + r) * EFF; },
        [&](const GU& u, f32x4 (&acc)[2][2][4][2]) {
            const int s0 = u.i0, n0 = u.i1;
            G_IDX;
#pragma unroll
            for (int ai = 0; ai < 2; ++ai)
#pragma unroll
                for (int m = 0; m < 4; ++m) {
                    const int slot = s0 + ai * 128 + wr * 64 + m * 16 + fr;
                    if (slotT[slot] < 0) continue;
                    bf16_t* orow = OUTS + (size_t)slot * D + n0 + wc * 32 + fq * 8;
#pragma unroll
                    for (int bj = 0; bj < 2; ++bj) {
                        u32x4 w;
                        w[0] = pack_bf2(acc[ai][bj][m][0][0], acc[ai][bj][m][0][1]); w[1] = pack_bf2(acc[ai][bj][m][0][2], acc[ai][bj][m][0][3]);
                        w[2] = pack_bf2(acc[ai][bj][m][1][0], acc[ai][bj][m][1][1]); w[3] = pack_bf2(acc[ai][bj][m][1][2], acc[ai][bj][m][1][3]);
                        *(u32x4*)(orow + bj * 128) = w;
                    }
                }
        });
}

__device__ void phase_combine(const KP& p, int l, int bid, int nb, char* smem, const bool dummy = false) {
    const bf16_t* OUTS = (const bf16_t*)(p.ws + WS_OUTS);
    const int* tokS = (const int*)(p.ws + WS_TOKS);
    const float* tokW = (const float*)(p.ws + WS_TOKW);
    const int* cnt = (const int*)(p.ws + WS_CNT) + l * 64;
    const RowDst out = layer_out(p, l);
    int* sh0 = (int*)smem;
    const int tid = otid(p.wb), half = tid >> 8, ht = tid & 255;
    __syncthreads();
    if (tid == 0) { int o = 0; for (int e = 0; e < NE; ++e) o += (cnt[e] + 255) / 256 * 256; sh0[0] = o; }
    __syncthreads();
    const int shared0 = sh0[0];
    const int ntok = ntok_of(l);
    for (int row = bid * 2 + half; row < ntok; row += nb * 2) {
        float* xr = rowp(out, row);
        const float* g2 = modp(p, l, row, 5);
        const int c = ht * 8;
        float acc[8];
        {
            const u32x4 v = *(const u32x4*)(OUTS + (size_t)(shared0 + row) * D + c);
#pragma unroll
            for (int q = 0; q < 4; ++q) { acc[2 * q] = __uint_as_float(v[q] << 16); acc[2 * q + 1] = __uint_as_float(v[q] & 0xffff0000u); }
        }
#pragma unroll
        for (int j = 0; j < TOPK; ++j) {
            const int s = tokS[(size_t)row * 8 + j]; const float w = tokW[(size_t)row * 8 + j];
            const u32x4 v = *(const u32x4*)(OUTS + (size_t)s * D + c);
#pragma unroll
            for (int q = 0; q < 4; ++q) { acc[2 * q] += w * __uint_as_float(v[q] << 16); acc[2 * q + 1] += w * __uint_as_float(v[q] & 0xffff0000u); }
        }
        const f32x4 g0 = *(const f32x4*)(g2 + c), g1 = *(const f32x4*)(g2 + c + 4);
        f32x4 x0 = *(const f32x4*)(xr + c), x1 = *(const f32x4*)(xr + c + 4);
#pragma unroll
        for (int q = 0; q < 4; ++q) { x0[q] += g0[q] * acc[q]; x1[q] += g1[q] * acc[4 + q]; }
        if (!dummy || x0[0] == 1234.5f) { *(f32x4*)(xr + c) = x0; *(f32x4*)(xr + c + 4) = x1; }
    }
}

#define XB_TMO      128
#define XB_XCNT(j)  (256  + 64 * (j))
#define XB_XSUB(j)  (1280 + 64 * (j))
#define XB_XGEN(j)  (2304 + 64 * (j))
#define XB_TOP      3328
#define XB_TOPGEN   3392
#define XCD_BAR_WORDS 3456
#define XB_SPIN_CAP (1u << 18)
#define LAS __attribute__((address_space(3)))

__device__ __forceinline__ unsigned xb_ld(unsigned* p)              { return __hip_atomic_load(p, __ATOMIC_RELAXED, __HIP_MEMORY_SCOPE_AGENT); }
__device__ __forceinline__ unsigned xb_add(unsigned* p, unsigned v) { return __hip_atomic_fetch_add(p, v, __ATOMIC_RELAXED, __HIP_MEMORY_SCOPE_AGENT); }
__device__ __forceinline__ unsigned xb_xcc_id() { return (unsigned)__builtin_amdgcn_s_getreg((3 << 11) | 20) & 0xFu; }
#define XB_SPIN(cond, bar) do { unsigned _sp = 0; while (cond) { __builtin_amdgcn_s_sleep(1); \
    if ((++_sp & 255u) == 0u) { if (xb_ld(&(bar)[XB_TMO])) break; if (_sp > XB_SPIN_CAP) { atomicAdd(&(bar)[XB_TMO], 1u); break; } } } } while (0)

struct XcdBarrier {
    unsigned* bar; unsigned x;
    volatile LAS unsigned* st;
};
__device__ __forceinline__ XcdBarrier xcd_barrier_post(unsigned* bar, volatile LAS unsigned* st) {
    XcdBarrier b; b.bar = bar; b.x = (unsigned)__builtin_amdgcn_readfirstlane((int)xb_xcc_id()); b.st = st;
    if (threadIdx.x == 0) (void)xb_add(&bar[XB_XCNT(b.x)], 1u);
    return b;
}
__device__ __forceinline__ void xcd_barrier_complete(unsigned* bar, unsigned x, unsigned& nloc, unsigned& nx) {
    const unsigned G = gridDim.x * gridDim.y * gridDim.z;
    unsigned sum, cnt, mine, sp = 0u;
    for (;;) {
        sum = 0u; cnt = 0u; mine = 0u;
#pragma unroll
        for (unsigned j = 0; j < 16; ++j) { const unsigned c = xb_ld(&bar[XB_XCNT(j)]); sum += c; cnt += (c > 0u) ? 1u : 0u; mine = (j == x) ? c : mine; }
        if (sum == G) break;
        __builtin_amdgcn_s_sleep(1);
        if ((++sp & 255u) == 0u) { if (xb_ld(&bar[XB_TMO])) break; if (sp > XB_SPIN_CAP) { atomicAdd(&bar[XB_TMO], 1u); break; } }
    }
    nloc = mine > 0u ? mine : 1u; nx = cnt > 0u ? cnt : 1u;
}
__device__ __forceinline__ void xcd_barrier(const XcdBarrier& b) {
    asm volatile("s_waitcnt vmcnt(0)" ::: "memory");
    __syncthreads();
    unsigned bx = b.x; asm volatile("" : "+s"(bx));
    if (threadIdx.x == 0) {
        unsigned* bar = b.bar;
        __builtin_amdgcn_s_waitcnt(0);
        unsigned nloc = b.st[0], nx = b.st[1];
        if (nloc == 0u) { xcd_barrier_complete(bar, bx, nloc, nx); b.st[0] = nloc; b.st[1] = nx; }
        const unsigned old = xb_add(&bar[XB_XSUB(bx)], 1u);
        const unsigned gen = old / nloc;
        if (old + 1u == (gen + 1u) * nloc) {
            __builtin_amdgcn_fence(__ATOMIC_RELEASE, "agent");
            asm volatile("s_waitcnt vmcnt(0)" ::: "memory");
            const unsigned og = xb_add(&bar[XB_TOP], 1u);
            const unsigned tg = og / nx;
            if (og + 1u == (tg + 1u) * nx) xb_add(&bar[XB_TOPGEN], 1u);
            else XB_SPIN(xb_ld(&bar[XB_TOPGEN]) == tg, bar);
            __builtin_amdgcn_fence(__ATOMIC_ACQUIRE, "agent");
            xb_add(&bar[XB_XGEN(bx)], 1u);
            asm volatile("s_waitcnt vmcnt(0)" ::: "memory");
        } else {
            XB_SPIN(xb_ld(&bar[XB_XGEN(bx)]) == gen, bar);
            __builtin_amdgcn_fence(__ATOMIC_ACQUIRE, "agent");
            asm volatile("s_waitcnt vmcnt(0)" ::: "memory");
        }
    }
    __syncthreads();
}

#ifndef PROBE_MASK
#define PROBE_MASK 0u
#endif
#ifndef REP2_SKIP
#define REP2_SKIP 0
#endif
#ifndef REP2_SKIP
#define REP2_SKIP 0
#endif
#ifndef REP2_SKIP
#define REP2_SKIP 0
#endif
#ifndef REP2_SKIP
#define REP2_SKIP 0
#endif
#ifndef REP2_SKIP
#define REP2_SKIP 0
#endif
#ifndef REP2_SKIP
#define REP2_SKIP 0
#endif
#ifndef REP3_SKIP
#define REP3_SKIP 0
#endif
#ifndef REP_PHASE
#define REP_PHASE (-1)
#define REP_L 1
#define REP_N 1
#endif
constexpr int FUSED_LDS = G_LDS + 16;
__global__ void __launch_bounds__(512, 2) k_fused(Params p0) {
    extern __shared__ __attribute__((aligned(16))) char dsm[];
    KP p; (Params&)p = p0; p.wb = __builtin_amdgcn_readfirstlane((int)threadIdx.x) & ~63;
    if (threadIdx.x == 0) *(uint4*)(dsm + G_LDS) = make_uint4(0u, 0u, 0u, 0u);
    __syncthreads();
    XcdBarrier bar = xcd_barrier_post((unsigned*)(p.ws + WS_BAR), (volatile LAS unsigned*)(dsm + G_LDS));
    char* sm = dsm;
    bf16_t* shm = (bf16_t*)dsm;
    const int bid = blockIdx.x, nb = gridDim.x;
#if PROBE_MASK
    unsigned long long* stamps = (unsigned long long*)(p.ws + WS_BAR + 14336);
    int nstamp = 0;
#define STAMP() do { if (bid == 0 && threadIdx.x == 0) stamps[nstamp] = wall_clock64(); ++nstamp; } while (0)
    STAMP();
#else
#define STAMP() do { } while (0)
#endif
    for (int _r = 0; _r < (REP_PHASE == 20 ? REP_N : 1); ++_r) {
        phase_ada(p, bid, nb);
        phase_convert_dense(p, 0, bid, nb, (float*)sm);
        phase_convert_dense(p, 1, bid, nb, (float*)sm);
        phase_convert_lora(p, bid, nb);
        xcd_barrier(bar); STAMP();
    }
    phase_ada2(p, bid, nb);
    xcd_barrier(bar); STAMP();
#define RUN(k, body) { const int _n = (REP_PHASE == (k) && l == REP_L) ? REP_N : 1; for (int _r = 0; _r < _n; ++_r) { body; xcd_barrier(bar); STAMP(); } }
    for (int l = 0; l < DEPTH; ++l) {
        RUN(0, phase_norm1(p, l, bid, nb));
        RUN(1, phase_inproj(p, l, bid, nb, shm));
        RUN(2, { if (!(REP2_SKIP & 1) || _r == 0) phase_rwprep(p, l, bid, nb, sm); if (!(REP2_SKIP & 2) || _r == 0) phase_atprep(p, l, bid, nb, sm); });
        RUN(3, {
            if (bid < SCAN_BLOCKS) { if (!(REP3_SKIP & 1) || _r == 0) phase_scan(p, bid, sm); }
            else {
                if (!(REP3_SKIP & 4) || _r == 0) phase_attn(p, l, bid - SCAN_BLOCKS, nb - SCAN_BLOCKS, sm);
                if (!(REP3_SKIP & 2) || _r == 0) phase_gmlp(p, l, bid - SCAN_BLOCKS, nb - SCAN_BLOCKS, sm);
            }
            phase_convert_moe_queue(p, l, sm);
            });
        RUN(4, phase_rwpost(p, l, bid, nb));
        RUN(5, phase_oproj(p, l, bid, nb, shm));
        RUN(6, phase_norm2_route(p, l, bid, nb, sm, _r > 0));
        RUN(7, phase_slots(p, l, bid, nb, sm));
        RUN(8, phase_moe1(p, l, bid, nb, shm));
        RUN(9, phase_moe2(p, l, bid, nb, shm));
        RUN(10, phase_combine(p, l, bid, nb, sm, _r + 1 < _n));
    }
#if PROBE_MASK
    if (bid == 0 && threadIdx.x == 0) {
        unsigned long long ticks = 0;
        for (int i = 0; i + 1 < nstamp; ++i) if ((PROBE_MASK >> i) & 1u) ticks += stamps[i + 1] - stamps[i];
        float v = (float)ticks * 10.0f;
        if (PROBE_MASK == 0x40000000u) v = 1.0e5f;
        p.out[0] = v;
    }
#endif
}

extern "C" void kernel_launch(void* const* d_in, const int* in_sizes, int n_in, void* d_out, int out_size, void* d_ws, size_t ws_size, hipStream_t stream) {
    if (n_in != 35 || out_size != SEQ * D || ws_size < WS_END) {
        fprintf(stderr, "kernel_launch: unexpected shapes: n_in %d out %d ws %zu (need %zu)\n", n_in, out_size, ws_size, (size_t)WS_END);
        return;
    }
    static int grid = 0;
    if (!grid) {
        int dev = 0, cus = 0, per_cu = 0;
        (void)hipGetDevice(&dev);
        (void)hipDeviceGetAttribute(&cus, hipDeviceAttributeMultiprocessorCount, dev);
        (void)hipFuncSetAttribute((const void*)k_fused, hipFuncAttributeMaxDynamicSharedMemorySize, FUSED_LDS);
        (void)hipOccupancyMaxActiveBlocksPerMultiprocessor(&per_cu, (const void*)k_fused, NT, FUSED_LDS);
        if (per_cu < 1) fprintf(stderr, "kernel_launch: occupancy query says %d workgroups per CU; launching one per CU anyway\n", per_cu);
        grid = cus;
        if (grid <= SCAN_BLOCKS) grid = 0;
    }
    if (!grid) { fprintf(stderr, "kernel_launch: bad grid\n"); return; }
    Params p{};
    const float** f = (const float**)&p;
    for (int i = 0; i < 35; ++i) f[i] = (const float*)d_in[i];
    p.out = (float*)d_out;
    p.ws = (char*)d_ws;
    (void)hipMemsetAsync(d_ws, 0, WS_ZERO_END, stream);
    hipLaunchKernelGGL(k_fused, dim3(grid), dim3(NT), FUSED_LDS, stream, p);
}
```

```cpp
#include <hip/hip_runtime.h>
#include <stdint.h>
#include <stdio.h>

typedef unsigned short bf16_t;
typedef short bf16x8 __attribute__((ext_vector_type(8)));
typedef float f32x4 __attribute__((ext_vector_type(4)));
typedef unsigned u32x4 __attribute__((ext_vector_type(4)));
typedef unsigned u32x2 __attribute__((ext_vector_type(2)));
typedef float f32x16 __attribute__((ext_vector_type(16)));

constexpr int D = 2048, SEQ = 8192, CTXL = 256, NTOK = SEQ + CTXL, DEPTH = 2;
constexpr int RW = 512, RWP = 1920, GMW = 512, INP = 4480;
constexpr int COL_GM = 1920, COL_AT = 2944, COL_K = 3968, COL_V = 4224;
constexpr int NE = 64, NEX = 65, EFF = 512, TOPK = 8;
constexpr int SLOT_CAP = 92416;
constexpr int MAX_TILES = SLOT_CAP / 256;
constexpr int INP_PAD = 4608;
constexpr int NT = 512;

constexpr size_t al256(size_t x) { return (x + 255) & ~(size_t)255; }
constexpr size_t WS_BAR = 0;
constexpr size_t WS_CNT = 16384;
constexpr size_t WS_MOD = WS_CNT + 1024;
constexpr size_t WS_ZERO_END = al256(WS_MOD + (size_t)2 * 2 * 12288 * 4);
constexpr size_t WS_WINT = WS_ZERO_END;
constexpr size_t WS_WOT = WS_WINT + (size_t)2 * INP_PAD * D * 2;
constexpr size_t WS_W13T = WS_WOT + (size_t)2 * D * D * 2;
constexpr size_t WS_W2T = WS_W13T + (size_t)2 * NEX * 1024 * D * 2;
constexpr size_t WS_H = WS_W2T + (size_t)2 * NEX * D * EFF * 2;
constexpr size_t WS_P = WS_H + (size_t)NTOK * D * 2;
constexpr size_t WS_REC = WS_P + (size_t)NTOK * INP * 4;
constexpr size_t WS_YD = WS_REC + (size_t)2 * 8 * NTOK * 384 * 4;
constexpr size_t WS_G = WS_YD + (size_t)2 * NTOK * RW * 4;
constexpr size_t WS_BV = WS_G + (size_t)NTOK * RW * 4;
constexpr size_t WS_GMR = WS_BV + (size_t)NTOK * RW * 4;
constexpr size_t WS_YCAT = al256(WS_GMR + (size_t)NTOK * 4);
constexpr size_t WS_Q = WS_YCAT + (size_t)NTOK * D * 2;
constexpr size_t WS_K = WS_Q + (size_t)NTOK * 1024 * 4;
constexpr size_t WS_X1 = WS_K + (size_t)NTOK * 256 * 4;
constexpr size_t WS_X2C = WS_X1 + (size_t)NTOK * D * 4;
constexpr size_t WS_TOKE = WS_X2C + (size_t)CTXL * D * 4;
constexpr size_t WS_TOKP = WS_TOKE + (size_t)NTOK * 8 * 4;
constexpr size_t WS_TOKW = WS_TOKP + (size_t)NTOK * 8 * 4;
constexpr size_t WS_SLOTT = WS_TOKW + (size_t)NTOK * 8 * 4;
constexpr size_t WS_SLOTW = al256(WS_SLOTT + (size_t)SLOT_CAP * 4);
constexpr size_t WS_TILE = al256(WS_SLOTW + (size_t)SLOT_CAP * 4);
constexpr size_t WS_ACT = al256(WS_TILE + (size_t)(MAX_TILES + 64) * 4);
constexpr size_t WS_MODP = WS_ACT + (size_t)SLOT_CAP * EFF * 2;
constexpr size_t WS_TOKS = WS_MODP + (size_t)2 * 2 * 32 * 12288 * 4;
constexpr size_t WS_OUTS = WS_TOKS + (size_t)NTOK * 8 * 4;
constexpr size_t WS_WLT = WS_OUTS + (size_t)SLOT_CAP * D * 2;
constexpr size_t WS_ROPE = WS_WLT + (size_t)2 * RW * 384 * 2;
constexpr size_t WS_RT = WS_ROPE + (size_t)192 * 16 * 2 * 4;
constexpr size_t WS_FR = WS_RT + (size_t)2 * 2 * NE * D * 2;
constexpr size_t WS_END = WS_FR + (size_t)16 * (NTOK / 16) * 12800;

struct Params {
    const float *x, *c, *ctx, *c_ctx, *w_ada, *b_ada, *norm1_g, *norm2_g, *w_in, *w_o;
    const float *rw_mu, *rw_w0, *rw_w2, *rw_a0, *rw_a2, *rw_g2, *rw_kk, *rw_ka, *rw_rk, *rw_ln_g, *rw_ln_b;
    const float *gm_norm_g, *gm_ws, *gm_b, *at_qn, *at_kn, *at_sink;
    const float *moe_router, *moe_bias, *moe_wg, *moe_wu, *moe_wd, *sh_wg, *sh_wu, *sh_wd;
    float* out;
    char* ws;
};

__device__ __forceinline__ bf16_t f2bf(float f) {
    unsigned u = __float_as_uint(f);
    u += 0x7fffu + ((u >> 16) & 1u);
    return (bf16_t)(u >> 16);
}
__device__ __forceinline__ unsigned pack_bf2(float lo, float hi) { return (unsigned)f2bf(lo) | ((unsigned)f2bf(hi) << 16); }
__device__ __forceinline__ int olane() { int t; asm volatile("v_mbcnt_lo_u32_b32 %0, -1, 0\n\tv_mbcnt_hi_u32_b32 %0, -1, %0" : "=v"(t)); return t; }
__device__ __forceinline__ float bperm(float v, int src_lane) { return __int_as_float(__builtin_amdgcn_ds_bpermute(src_lane << 2, __float_as_int(v))); }
template <int CTRL> __device__ __forceinline__ float dppf(float v) {
    return __int_as_float(__builtin_amdgcn_update_dpp(0, __float_as_int(v), CTRL, 0xf, 0xf, true));
}
__device__ __forceinline__ float red16(float v) {
    v += dppf<0xB1>(v); v += dppf<0x4E>(v); v += dppf<0x124>(v); v += dppf<0x128>(v); return v;
}
__device__ __forceinline__ float wave_sum(float v) {
    const int lane = olane();
    v = red16(v);
    v += bperm(v, lane ^ 16); v += bperm(v, lane ^ 32);
    return v;
}
__device__ __forceinline__ float wave_max(float v) {
    const int lane = olane();
    v = fmaxf(v, dppf<0xB1>(v)); v = fmaxf(v, dppf<0x4E>(v)); v = fmaxf(v, dppf<0x124>(v)); v = fmaxf(v, dppf<0x128>(v));
    v = fmaxf(v, bperm(v, lane ^ 16)); v = fmaxf(v, bperm(v, lane ^ 32));
    return v;
}
__device__ __forceinline__ float max8(float v) {
    const int lane = olane();
    v = fmaxf(v, dppf<0xB1>(v)); v = fmaxf(v, dppf<0x4E>(v)); v = fmaxf(v, bperm(v, lane ^ 4));
    return v;
}
__device__ __forceinline__ float fexp(float x) { return __builtin_amdgcn_exp2f(x * 1.4426950408889634f); }
__device__ __forceinline__ float flog(float x) { return __builtin_amdgcn_logf(x) * 0.6931471805599453f; }
__device__ __forceinline__ float frcp(float x) { return __builtin_amdgcn_rcpf(x); }
__device__ __forceinline__ float sigmoidf_(float x) { return frcp(1.f + fexp(-x)); }
__device__ __forceinline__ float siluf_(float x) { return x * frcp(1.f + fexp(-x)); }
__device__ __forceinline__ float ftanh(float u) { const float e = fexp(-2.f * fabsf(u)); const float t = (1.f - e) * frcp(1.f + e); return u < 0.f ? -t : t; }
__device__ __forceinline__ float gelu_tanh(float x) {
    const float u = 0.7978845608028654f * (x + 0.044715f * x * x * x);
    const float hx = 0.5f * x;
    return fmaf(hx, ftanh(u), hx);
}
__device__ __forceinline__ float softplusf_(float x) { return fmaxf(x, 0.f) + flog(1.f + fexp(-fabsf(x))); }

struct RowSrc { const float* a; const float* b; };
__device__ __forceinline__ const float* rowp(const RowSrc& r, int row) { return row < SEQ ? r.a + (size_t)row * D : r.b + (size_t)(row - SEQ) * D; }
struct RowDst { float* a; float* b; };
__device__ __forceinline__ float* rowp(const RowDst& r, int row) { return row < SEQ ? r.a + (size_t)row * D : r.b + (size_t)(row - SEQ) * D; }

__device__ __forceinline__ RowSrc layer_in(const Params& p, int l) {
    RowSrc r; if (l == 0) { r.a = p.x; r.b = p.ctx; } else { float* x1 = (float*)(p.ws + WS_X1); r.a = x1; r.b = x1 + (size_t)SEQ * D; } return r;
}
__device__ __forceinline__ RowDst layer_out(const Params& p, int l) {
    RowDst r; if (l == 0) { float* x1 = (float*)(p.ws + WS_X1); r.a = x1; r.b = x1 + (size_t)SEQ * D; } else { r.a = p.out; r.b = (float*)(p.ws + WS_X2C); } return r;
}
__device__ __forceinline__ const float* modp(const Params& p, int l, int row, int which) {
    return (const float*)(p.ws + WS_MOD) + ((size_t)(l * 2 + (row < SEQ ? 0 : 1)) * 6 + which) * D;
}
__device__ __forceinline__ int ntok_of(int l) { return l == DEPTH - 1 ? SEQ : NTOK; }
struct KP : Params { int wb; };
__device__ __forceinline__ int otid(int wb) {
    int t; asm volatile("v_mbcnt_lo_u32_b32 %0, -1, 0\n\tv_mbcnt_hi_u32_b32 %0, -1, %0" : "=v"(t));
    return t | wb;
}

__device__ void phase_ada(const KP& p, int bid, int nb) {
    float* part = (float*)(p.ws + WS_MODP);
    const int tid = otid(p.wb);
    for (int u = bid; u < 2 * 6 * 32; u += nb) {
        const int l = u / (6 * 32), r = u % (6 * 32), cg = r / 32, kc = r % 32;
        const int n = cg * 2048 + tid * 4;
        const float* w = p.w_ada + (size_t)l * D * 12288 + (size_t)(kc * 64) * 12288 + n;
        f32x4 a0 = {0, 0, 0, 0}, a1 = {0, 0, 0, 0};
#pragma unroll 8
        for (int k = 0; k < 64; ++k) {
            const f32x4 wv = *(const f32x4*)(w + (size_t)k * 12288);
            const float c0 = siluf_(p.c[kc * 64 + k]), c1 = siluf_(p.c_ctx[kc * 64 + k]);
            a0 += wv * c0; a1 += wv * c1;
        }
        *(f32x4*)(part + ((size_t)((l * 2 + 0) * 32 + kc)) * 12288 + n) = a0;
        *(f32x4*)(part + ((size_t)((l * 2 + 1) * 32 + kc)) * 12288 + n) = a1;
    }
}
__device__ void phase_ada2(const KP& p, int bid, int nb) {
    const float* part = (const float*)(p.ws + WS_MODP);
    float* mod = (float*)(p.ws + WS_MOD);
    for (int i = bid * NT + otid(p.wb); i < 2 * 2 * 12288; i += nb * NT) {
        const int ls = i / 12288, n = i % 12288, l = ls >> 1;
        float acc = p.b_ada[(size_t)l * 12288 + n];
        for (int kc = 0; kc < 32; ++kc) acc += part[((size_t)(ls * 32 + kc)) * 12288 + n];
        mod[i] = acc;
    }
}

struct TJob { const float* src; bf16_t* dst; int K, N, batch; size_t sstride, dstride; int mode; };
__device__ __forceinline__ void tconv_pair(const TJob& j, int t0, float* tiles  , int tid) {
    const int half = tid >> 8, ht = tid & 255;
    float* tile = tiles + half * (64 * 65);
    const int tk = j.K / 64, tn = j.N / 64, ntl = j.batch * tk * tn;
    const int t = t0 + half;
    const bool on = t < ntl;
    const int b = t / (tk * tn), r = t % (tk * tn), kt = r / tn, nt = r % tn;
    __syncthreads();
    if (on) {
        const float* src = j.src + (size_t)b * j.sstride + (size_t)(kt * 64) * j.N + nt * 64;
#pragma unroll
        for (int i = 0; i < 4; ++i) {
            const int k = i * 16 + (ht >> 4), n = (ht & 15) * 4;
            const f32x4 v = *(const f32x4*)(src + (size_t)k * j.N + n);
            tile[k * 65 + n + 0] = v[0]; tile[k * 65 + n + 1] = v[1]; tile[k * 65 + n + 2] = v[2]; tile[k * 65 + n + 3] = v[3];
        }
    }
    __syncthreads();
    if (on) {
        const int n = ht >> 2, kq = (ht & 3) * 16;
        int ng = nt * 64 + n;
        if (j.mode == 1) ng = 32 * (ng >> 4) + (ng & 15);
        else if (j.mode == 2) ng = 32 * (ng >> 4) + 16 + (ng & 15);
        bf16_t* dst = j.dst + (size_t)b * j.dstride + (size_t)ng * j.K + kt * 64 + kq;
        u32x4 w0, w1;
#pragma unroll
        for (int i = 0; i < 4; ++i) { w0[i] = pack_bf2(tile[(kq + 2 * i) * 65 + n], tile[(kq + 2 * i + 1) * 65 + n]); w1[i] = pack_bf2(tile[(kq + 8 + 2 * i) * 65 + n], tile[(kq + 8 + 2 * i + 1) * 65 + n]); }
        *(u32x4*)(dst) = w0;
        *(u32x4*)(dst + 8) = w1;
    }
}
__device__ void phase_tconv(const TJob& j, int bid, int nb, float* tiles  , int wb) {
    const int tid = otid(wb);
    const int ntl = j.batch * (j.K / 64) * (j.N / 64);
    for (int t0 = bid * 2; t0 < ntl; t0 += nb * 2) tconv_pair(j, t0, tiles, tid);
}
__device__ void phase_convert_dense(const KP& p, int l, int bid, int nb, float* tile) {
    TJob j;
    j = {p.w_in + (size_t)l * D * INP, (bf16_t*)(p.ws + WS_WINT) + (size_t)l * INP_PAD * D, D, INP, 1, 0, 0, 0}; phase_tconv(j, bid, nb, tile, p.wb);
    j = {p.w_o + (size_t)l * D * D, (bf16_t*)(p.ws + WS_WOT) + (size_t)l * D * D, D, D, 1, 0, 0, 0}; phase_tconv(j, bid, nb, tile, p.wb);
}
constexpr int CQ_ITEM = 16;
constexpr int CQ_T_BIG = NE * (D / 64) * (EFF / 64);
constexpr int CQ_T_SH = (D / 64) * (EFF / 64);
constexpr int CQ_ITEMS = (3 * CQ_T_BIG + 3 * CQ_T_SH) / CQ_ITEM;
__device__ void phase_convert_moe_queue(const KP& p, int l, char* smem) {
    bf16_t* w13 = (bf16_t*)(p.ws + WS_W13T) + (size_t)l * NEX * 1024 * D;
    bf16_t* w2 = (bf16_t*)(p.ws + WS_W2T) + (size_t)l * NEX * D * EFF;
    int* qctr = (int*)(p.ws + WS_CNT) + 200 + l;
    float* tiles = (float*)smem;
    int* sh = (int*)(smem + 2 * 64 * 65 * 4);
    const int tid = otid(p.wb);
    for (;;) {
        __syncthreads();
        if (tid == 0) sh[0] = atomicAdd(qctr, 1);
        __syncthreads();
        const int item = sh[0];
        if (item >= CQ_ITEMS) break;
        int t = item * CQ_ITEM;
        TJob j;
        if (t < CQ_T_BIG) j = {p.moe_wg + (size_t)l * NE * D * EFF, w13, D, EFF, NE, (size_t)D * EFF, (size_t)1024 * D, 1};
        else if (t < 2 * CQ_T_BIG) { t -= CQ_T_BIG; j = {p.moe_wu + (size_t)l * NE * D * EFF, w13, D, EFF, NE, (size_t)D * EFF, (size_t)1024 * D, 2}; }
        else if (t < 3 * CQ_T_BIG) { t -= 2 * CQ_T_BIG; j = {p.moe_wd + (size_t)l * NE * EFF * D, w2, EFF, D, NE, (size_t)EFF * D, (size_t)D * EFF, 0}; }
        else if (t < 3 * CQ_T_BIG + CQ_T_SH) { t -= 3 * CQ_T_BIG; j = {p.sh_wg + (size_t)l * D * EFF, w13 + (size_t)NE * 1024 * D, D, EFF, 1, 0, 0, 1}; }
        else if (t < 3 * CQ_T_BIG + 2 * CQ_T_SH) { t -= 3 * CQ_T_BIG + CQ_T_SH; j = {p.sh_wu + (size_t)l * D * EFF, w13 + (size_t)NE * 1024 * D, D, EFF, 1, 0, 0, 2}; }
        else { t -= 3 * CQ_T_BIG + 2 * CQ_T_SH; j = {p.sh_wd + (size_t)l * EFF * D, w2 + (size_t)NE * D * EFF, EFF, D, 1, 0, 0, 0}; }
#pragma unroll 1
        for (int i = 0; i < CQ_ITEM; i += 2) tconv_pair(j, t + i, tiles, tid);
    }
}

__device__ void phase_convert_lora(const KP& p, int bid, int nb) {
    bf16_t* WLT = (bf16_t*)(p.ws + WS_WLT);
    const int tid = otid(p.wb);
    for (int i = bid * NT + tid; i < 2 * D * NE; i += nb * NT) {
        const int l = i / (D * NE), r = i % (D * NE), k = r / NE, e = r % NE;
        const float x = p.moe_router[i];
        const bf16_t hi = f2bf(x); const bf16_t lo = f2bf(x - __uint_as_float((unsigned)hi << 16));
        bf16_t* rt = (bf16_t*)(p.ws + WS_RT) + (size_t)l * 2 * NE * D;
        rt[(size_t)e * D + k] = hi; rt[(size_t)NE * D + (size_t)e * D + k] = lo;
    }
    for (int i = bid * NT + tid; i < 192 * 16; i += nb * NT) {
        const int pos = i >> 4, f = i & 15;
        const float ang = (float)(pos < 128 ? pos : pos - 128) * powf(10000.f, -(float)f / 16.f);
        float* rt = (float*)(p.ws + WS_ROPE) + (size_t)i * 2;
        rt[0] = cosf(ang); rt[1] = sinf(ang);
    }
    for (int i = bid * NT + tid; i < 2 * RW * 384; i += nb * NT) {
        const int l = i / (RW * 384), r = i % (RW * 384), k = r / RW, c = r % RW;
        float v;
        if (k < 128) v = p.rw_w2[((size_t)l * 2 * 64 + k) * RW + c];
        else if (k < 256) v = p.rw_a2[((size_t)l * 2 * 64 + (k - 128)) * RW + c];
        else v = p.rw_g2[((size_t)l * 128 + (k - 256)) * RW + c];
        WLT[((size_t)l * RW + c) * 384 + k] = f2bf(v);
    }
}

__device__ void phase_norm1(const KP& p, int l, int bid, int nb) {
    const RowSrc in = layer_in(p, l);
    bf16_t* H = (bf16_t*)(p.ws + WS_H);
    const float* g = p.norm1_g + (size_t)l * D;
    const int tid = otid(p.wb), wid = tid >> 6, lane = tid & 63;
    for (int row = bid * 8 + wid; row < NTOK; row += nb * 8) {
        const float* xr = rowp(in, row);
        const float* sh = modp(p, l, row, 0);
        const float* sc = modp(p, l, row, 1);
        f32x4 v[8]; float ss = 0.f;
#pragma unroll
        for (int i = 0; i < 8; ++i) { v[i] = *(const f32x4*)(xr + i * 256 + lane * 4); ss += v[i][0] * v[i][0] + v[i][1] * v[i][1] + v[i][2] * v[i][2] + v[i][3] * v[i][3]; }
        ss = wave_sum(ss);
        const float rstd = rsqrtf(ss * (1.f / D) + 1e-6f);
#pragma unroll
        for (int i = 0; i < 8; ++i) {
            const int c = i * 256 + lane * 4;
            const f32x4 gv = *(const f32x4*)(g + c), shv = *(const f32x4*)(sh + c), scv = *(const f32x4*)(sc + c);
            float o[4];
#pragma unroll
            for (int j = 0; j < 4; ++j) { const float t = v[i][j] * rstd * gv[j]; o[j] = fmaf(t, scv[j], t) + shv[j]; }
            u32x2 w; w[0] = pack_bf2(o[0], o[1]); w[1] = pack_bf2(o[2], o[3]);
            *(u32x2*)(H + (size_t)row * D + c) = w;
        }
    }
}

constexpr int G_HT = 128 * 64;
constexpr int G_LDS = 8 * G_HT * 2;
__device__ __forceinline__ int g_lds_byte(int r, int c) {
    const int st = (r >> 4) * 2 + (c >> 5), rr = r & 15, cc = c & 31, ob = rr * 64 + cc * 2;
    return st * 1024 + (ob ^ (((ob >> 9) & 1) << 5));
}
__device__ __forceinline__ void g_stage_rc(int b, int& R, int& C) {
    const int st = b / 1024, sb = b % 1024, swz = sb ^ (((sb >> 9) & 1) << 5);
    R = (st >> 1) * 16 + swz / 64; C = (st & 1) * 32 + (swz % 64) / 2;
}
struct GOff { unsigned ao[2][2], bo; };
#define SA(b, h) (shm + ((b) * 2 + (h)) * G_HT)
#define SB(b, h) (shm + (4 + (b) * 2 + (h)) * G_HT)
#define STG_A(P, h, kt) do { _Pragma("unroll") for (int _i = 0; _i < 2; ++_i) \
    __builtin_amdgcn_global_load_lds((const unsigned*)((const char*)(A + (kt) * 64) + o.ao[h][_i]), (unsigned*)((char*)(P) + tz * 16 + _i * 8192), 16, 0, 0); } while (0)
#define STG_B(P, h, kt) do { _Pragma("unroll") for (int _i = 0; _i < 2; ++_i) \
    __builtin_amdgcn_global_load_lds((const unsigned*)((const char*)(Bt + ((h) * 128 + _i * 64) * K + (kt) * 64) + o.bo), (unsigned*)((char*)(P) + tz * 16 + _i * 8192), 16, 0, 0); } while (0)
template <bool PERM, class ARow>
__device__ __forceinline__ void gemm_offsets(ARow arow, const int K, const int wb, GOff& o) {
    const int tz = otid(wb);
    int r, c; g_stage_rc(tz * 16, r, c);
    const int rb = PERM ? ((r & ~31) + 8 * ((r & 15) >> 2) + 4 * ((r >> 4) & 1) + (r & 3)) : r;
    o.bo = (unsigned)((rb * K + c) * 2);
#pragma unroll
    for (int h = 0; h < 2; ++h)
#pragma unroll
        for (int i = 0; i < 2; ++i) o.ao[h][i] = (unsigned)((arow(h * 128 + i * 64 + r) + c) * 2);
}
__device__ __forceinline__ void gemm_issue(const bf16_t* __restrict__ A, const bf16_t* __restrict__ Bt, const int K, const GOff& o, bf16_t* shm, const int wb) {
    const int tz = otid(wb);
    STG_B(SB(0, 0), 0, 0); STG_A(SA(0, 0), 0, 0);
    STG_B(SB(0, 1), 1, 0); STG_A(SA(0, 1), 1, 0);
    STG_B(SB(1, 0), 0, 1); STG_A(SA(1, 0), 0, 1); STG_B(SB(1, 1), 1, 1);
}
__device__ __forceinline__ void gemm_main(const bf16_t* __restrict__ A, const bf16_t* __restrict__ Bt, const int K, const GOff& o, f32x4 (&acc)[2][2][4][2], bf16_t* shm, const int wb) {
#define LDA(dst, b, h) _Pragma("unroll") for (int m = 0; m < 4; ++m) _Pragma("unroll") for (int k = 0; k < 2; ++k) \
    dst[m][k] = *reinterpret_cast<const bf16x8*>((const char*)SA(b, h) + g_lds_byte(wr * 64 + m * 16 + fr, k * 32 + fq * 8))
#define LDB(dst, b, h) _Pragma("unroll") for (int n = 0; n < 2; ++n) _Pragma("unroll") for (int k = 0; k < 2; ++k) \
    dst[n][k] = *reinterpret_cast<const bf16x8*>((const char*)SB(b, h) + g_lds_byte(wc * 32 + n * 16 + fr, k * 32 + fq * 8))
#define MMA(ai, bj, Af, Bf) do { __builtin_amdgcn_s_setprio(1); \
    _Pragma("unroll") for (int m = 0; m < 4; ++m) _Pragma("unroll") for (int n = 0; n < 2; ++n) _Pragma("unroll") for (int k = 0; k < 2; ++k) \
        acc[ai][bj][m][n] = __builtin_amdgcn_mfma_f32_16x16x32_bf16(Bf[n][k], Af[m][k], acc[ai][bj][m][n], 0, 0, 0); \
    __builtin_amdgcn_s_setprio(0); } while (0)
#define WAIT_V(n) asm volatile("s_waitcnt vmcnt(" #n ")" ::: "memory")
#define WAIT_L(n) asm volatile("s_waitcnt lgkmcnt(" #n ")" ::: "memory")
#define BAR __builtin_amdgcn_s_barrier()
#define SCHED __builtin_amdgcn_sched_barrier(0)
    int tz = otid(wb);
    int wid = tz >> 6, lane = tz & 63, wr = wid >> 2, wc = wid & 3, fr = lane & 15, fq = lane >> 4;
#pragma unroll
    for (int a = 0; a < 2; ++a)
#pragma unroll
        for (int b = 0; b < 2; ++b)
#pragma unroll
            for (int m = 0; m < 4; ++m)
#pragma unroll
                for (int n = 0; n < 2; ++n) acc[a][b][m][n] = (f32x4){0.f, 0.f, 0.f, 0.f};
    bf16x8 At[4][2], B0[2][2], B1[2][2];
    const int nt = K / 64;
    WAIT_V(0); BAR;
    if (wr == 1) BAR;
    for (int t = 0; t < nt - 2; t += 2) {
        LDB(B0, 0, 0); SCHED; LDA(At, 0, 0); STG_A(SA(1, 1), 1, t + 1);
        WAIT_L(8); BAR; WAIT_L(0); MMA(0, 0, At, B0); BAR; SCHED;
        LDB(B1, 0, 1); STG_B(SB(0, 0), 0, t + 2);
        BAR; WAIT_L(0); MMA(0, 1, At, B1); BAR;
        LDA(At, 0, 1); STG_A(SA(0, 0), 0, t + 2);
        BAR; WAIT_L(0); MMA(1, 0, At, B0); BAR; SCHED;
        STG_B(SB(0, 1), 1, t + 2);
        WAIT_V(6); BAR; MMA(1, 1, At, B1); BAR;
        LDB(B0, 1, 0); SCHED; LDA(At, 1, 0); STG_A(SA(0, 1), 1, t + 2);
        WAIT_L(8); BAR; WAIT_L(0); MMA(0, 0, At, B0); BAR; SCHED;
        LDB(B1, 1, 1); STG_B(SB(1, 0), 0, t + 3);
        BAR; WAIT_L(0); MMA(0, 1, At, B1); BAR;
        LDA(At, 1, 1); STG_A(SA(1, 0), 0, t + 3);
        BAR; WAIT_L(0); MMA(1, 0, At, B0); BAR; SCHED;
        STG_B(SB(1, 1), 1, t + 3);
        WAIT_V(6); BAR; MMA(1, 1, At, B1); BAR;
    }
    { LDB(B0, 0, 0); WAIT_V(0); LDA(At, 0, 0); STG_A(SA(1, 1), 1, nt - 1);
      BAR; WAIT_L(0); MMA(0, 0, At, B0); BAR;
      LDB(B1, 0, 1); BAR; WAIT_L(0); MMA(0, 1, At, B1); BAR;
      LDA(At, 0, 1); WAIT_V(4); BAR; WAIT_L(0); MMA(1, 0, At, B0); MMA(1, 1, At, B1); BAR; }
    { LDB(B0, 1, 0); LDA(At, 1, 0); WAIT_V(2); BAR; WAIT_L(0); MMA(0, 0, At, B0); BAR;
      LDB(B1, 1, 1); WAIT_V(0); BAR; WAIT_L(0); MMA(0, 1, At, B1); BAR;
      LDA(At, 1, 1); BAR; WAIT_L(0); MMA(1, 0, At, B0); MMA(1, 1, At, B1); BAR; }
    if (wr == 0) BAR;
#undef LDA
#undef LDB
#undef MMA
#undef WAIT_V
#undef WAIT_L
#undef BAR
#undef SCHED
}
#undef SA
#undef SB
#undef STG_A
#undef STG_B
struct GU { const bf16_t* A; const bf16_t* Bt; int i0, i1, i2, i3; };
template <bool PERM, class Mk, class Row, class Epi>
__device__ __forceinline__ void gemm_phase(const int nwg, const int bid, const int nb, const int K, bf16_t* shm, const int wb, Mk mk, Row row, Epi epi) {
    int L = bid;
    if (L >= nwg) return;
    GU cur = mk(L);
    GOff oc;
    gemm_offsets<PERM>([&](int r) { return row(cur, r); }, K, wb, oc);
    gemm_issue(cur.A, cur.Bt, K, oc, shm, wb);
    for (;;) {
        f32x4 acc[2][2][4][2];
        gemm_main(cur.A, cur.Bt, K, oc, acc, shm, wb);
        const int Ln = L + nb;
        const bool more = Ln < nwg;
        GU nxt = cur; GOff on = oc;
        if (more) {
            nxt = mk(Ln);
            gemm_offsets<PERM>([&](int r) { return row(nxt, r); }, K, wb, on);
            gemm_issue(nxt.A, nxt.Bt, K, on, shm, wb);
        }
        epi(cur, acc);
        if (!more) break;
        cur = nxt; oc = on; L = Ln;
    }
}
#define G_IDX int _tz = otid(p.wb); const int _wid = _tz >> 6, _lane = _tz & 63, wr = _wid >> 2, wc = _wid & 3, fr = _lane & 15, fq = _lane >> 4
__device__ __forceinline__ int xcd_remap(int L, int nwg) {
    const int q = nwg / 8, r = nwg % 8, xcd = L % 8, off = L / 8;
    return (xcd < r ? xcd * (q + 1) : r * (q + 1) + (xcd - r) * q) + off;
}
__device__ __forceinline__ void dense_tile(int wgid, int nM, int nN, int& pm, int& pn) {
    const int nig = 8 * nN, gid = wgid / nig, fm = gid * 8, gsz = (nM - fm) < 8 ? (nM - fm) : 8;
    pm = fm + ((wgid % nig) % gsz); pn = (wgid % nig) / gsz;
}

__device__ void phase_inproj(const KP& p, int l, int bid, int nb, bf16_t* shm) {
    const bf16_t* H = (const bf16_t*)(p.ws + WS_H);
    const bf16_t* Bt = (const bf16_t*)(p.ws + WS_WINT) + (size_t)l * INP_PAD * D;
    float* P = (float*)(p.ws + WS_P);
    constexpr int nM = NTOK / 256, nN = INP_PAD / 256, nwg = nM * nN;
    gemm_phase<false>(nwg, bid, nb, D, shm, p.wb,
        [&](int L) { int pm, pn; dense_tile(xcd_remap(L, nwg), nM, nN, pm, pn); GU u; u.A = H; u.Bt = Bt + (size_t)(pn * 256) * D; u.i0 = pm * 256; u.i1 = pn * 256; u.i2 = 0; u.i3 = 0; return u; },
        [&](const GU& u, int r) { return (u.i0 + r) * D; },
        [&](const GU& u, f32x4 (&acc)[2][2][4][2]) {
            const int m0 = u.i0, n0 = u.i1;
            G_IDX;
#pragma unroll
            for (int ai = 0; ai < 2; ++ai)
#pragma unroll
                for (int m = 0; m < 4; ++m) {
                    float* prow = P + (size_t)(m0 + ai * 128 + wr * 64 + m * 16 + fr) * INP + n0 + wc * 32 + fq * 4;
#pragma unroll
                    for (int bj = 0; bj < 2; ++bj)
#pragma unroll
                        for (int n = 0; n < 2; ++n)
                            if (n0 + bj * 128 + wc * 32 + n * 16 + fq * 4 < INP) *(f32x4*)(prow + bj * 128 + n * 16) = acc[ai][bj][m][n];
                }
        });
}

__device__ __forceinline__ int scan_pos(int d, int row) {
    if (row >= SEQ) { const int c = row - SEQ; return d == 0 ? c : (CTXL - 1 - c); }
    return CTXL + (d == 0 ? row : (SEQ - 1 - row));
}
__device__ __forceinline__ int scan_row(int d, int s) {
    if (s < CTXL) return SEQ + (d == 0 ? s : (CTXL - 1 - s));
    const int q = s - CTXL; return d == 0 ? q : (SEQ - 1 - q);
}
constexpr int RP_TB = 11;
constexpr int RP_LD = 392;
__device__ __forceinline__ f32x4 shifted4(const float* P, int row, int col, const float* mu) {
    const f32x4 cur = *(const f32x4*)(P + (size_t)row * INP + col);
    const bool first = (row == 0) || (row == SEQ), last = (row == SEQ - 1) || (row == NTOK - 1);
    f32x4 prev = {0.f, 0.f, 0.f, 0.f}, nxt = {0.f, 0.f, 0.f, 0.f};
    if (!first) prev = *(const f32x4*)(P + (size_t)(row - 1) * INP + col);
    if (!last) nxt = *(const f32x4*)(P + (size_t)(row + 1) * INP + col);
    const f32x4 m0 = *(const f32x4*)(mu + col), m1 = *(const f32x4*)(mu + RWP + col);
    return cur + m0 * (prev - cur) + m1 * (nxt - cur);
}
__device__ __forceinline__ float shifted(const float* P, int row, int col, float mu0, float mu1) {
    const float cur = P[(size_t)row * INP + col];
    const bool first = (row == 0) || (row == SEQ), last = (row == SEQ - 1) || (row == NTOK - 1);
    const float prev = first ? 0.f : P[(size_t)(row - 1) * INP + col];
    const float nxt = last ? 0.f : P[(size_t)(row + 1) * INP + col];
    return cur + mu0 * (prev - cur) + mu1 * (nxt - cur);
}
__device__ void phase_rwprep(const KP& p, int l, int bid, int nb, char* smem) {
    const float* P = (const float*)(p.ws + WS_P);
    float* REC = (float*)(p.ws + WS_REC);
    float* G = (float*)(p.ws + WS_G);
    float* BV = (float*)(p.ws + WS_BV);
    float* GMR = (float*)(p.ws + WS_GMR);
    const bf16_t* WLT = (const bf16_t*)(p.ws + WS_WLT) + (size_t)l * RW * 384;
    bf16_t* lin = (bf16_t*)smem;
    const float* mu = p.rw_mu + (size_t)l * 2 * RWP;
    const float* w0 = p.rw_w0 + (size_t)l * 2 * RW;
    const float* a0 = p.rw_a0 + (size_t)l * 2 * RW;
    const float* kkw = p.rw_kk + (size_t)l * RW;
    const float* kaw = p.rw_ka + (size_t)l * RW;
    const float* rkw = p.rw_rk + (size_t)l * RW;
    const int tid = otid(p.wb), wid = tid >> 6, lane = tid & 63, t16 = lane & 15, g = lane >> 4;
    for (int blk = bid; blk < NTOK / RP_TB; blk += nb) {
        const int t0 = blk * RP_TB;
        __syncthreads();
        for (int i = tid; i < RP_TB * 384; i += NT) {
            const int tt = i / 384, j = i % 384, col = 1536 + j;
            const float v = shifted(P, t0 + tt, col, mu[col], mu[RWP + col]);
            lin[tt * RP_LD + j] = f2bf(j < 128 ? ftanh(v) : (j < 256 ? v : sigmoidf_(v)));
        }
        __syncthreads();
        for (int q = wid; q < RP_TB; q += 8) {
            const int row = t0 + q; float ss = 0.f;
#pragma unroll
            for (int i = 0; i < 8; ++i) { const float gv = gelu_tanh(P[(size_t)row * INP + COL_GM + GMW + i * 64 + lane]); ss += gv * gv; }
            ss = wave_sum(ss);
            if (lane == 0) GMR[row] = rsqrtf(ss * (1.f / GMW) + 1e-6f);
        }
        const bool live = t16 < RP_TB;
        const int row = t0 + (live ? t16 : RP_TB - 1);
        float nrm2 = 0.f, bon = 0.f;
#pragma unroll
        for (int tl = 0; tl < 4; ++tl) {
            const int c = wid * 64 + tl * 16 + g * 4;
            const f32x4 r4 = shifted4(P, row, c, mu), k4 = shifted4(P, row, 512 + c, mu);
            const f32x4 kq = k4 * *(const f32x4*)(kkw + c), rk = *(const f32x4*)(rkw + c);
#pragma unroll
            for (int e = 0; e < 4; ++e) { nrm2 += kq[e] * kq[e]; bon += r4[e] * k4[e] * rk[e]; }
        }
        nrm2 += bperm(nrm2, lane ^ 16); nrm2 += bperm(nrm2, lane ^ 32);
        bon += bperm(bon, lane ^ 16); bon += bperm(bon, lane ^ 32);
        const float inrm = 1.f / fmaxf(sqrtf(nrm2), 1e-12f);
        const bf16_t* lrow = lin + (live ? t16 : RP_TB - 1) * RP_LD + g * 8;
#pragma unroll 2
        for (int tl = 0; tl < 4; ++tl) {
            f32x4 acc[5];
#pragma unroll
            for (int m = 0; m < 5; ++m) acc[m] = (f32x4){0.f, 0.f, 0.f, 0.f};
            const bf16_t* wrow = WLT + (size_t)(wid * 64 + tl * 16 + t16) * 384 + g * 8;
#pragma unroll
            for (int ks = 0; ks < 12; ++ks) {
                const int m = ks < 8 ? (ks >> 1) : 4;
                acc[m] = __builtin_amdgcn_mfma_f32_16x16x32_bf16(*(const bf16x8*)(wrow + ks * 32), *(const bf16x8*)(lrow + ks * 32), acc[m], 0, 0, 0);
            }
            const int c = wid * 64 + tl * 16 + g * 4, ci = tl * 16 + g * 4;
            const f32x4 r4 = shifted4(P, row, c, mu), k4 = shifted4(P, row, 512 + c, mu), v4 = shifted4(P, row, 1024 + c, mu);
            const f32x4 kq = k4 * *(const f32x4*)(kkw + c) * inrm;
            if (live) {
                *(f32x4*)(G + (size_t)row * RW + c) = acc[4];
                *(f32x4*)(BV + (size_t)row * RW + c) = v4 * bon;
            }
            const f32x4 ka = *(const f32x4*)(kaw + c);
#pragma unroll
            for (int d = 0; d < 2; ++d) {
                const f32x4 w0v = *(const f32x4*)(w0 + d * RW + c), a0v = *(const f32x4*)(a0 + d * RW + c);
                f32x4 decay, av, kd;
#pragma unroll
                for (int e = 0; e < 4; ++e) {
                    const float wlog = -softplusf_(-(w0v[e] + acc[d][e])) - 0.5f;
                    decay[e] = fexp(-fexp(wlog));
                    av[e] = sigmoidf_(a0v[e] + acc[2 + d][e]);
                    kd[e] = k4[e] * (1.f + (av[e] - 1.f) * ka[e]);
                }
                if (live) {
                    float* rec = REC + ((size_t)(d * 8 + wid) * NTOK + scan_pos(d, row)) * 384 + ci;
                    *(f32x4*)(rec) = decay; *(f32x4*)(rec + 64) = kq; *(f32x4*)(rec + 128) = kq * av;
                    *(f32x4*)(rec + 192) = kd; *(f32x4*)(rec + 256) = r4; *(f32x4*)(rec + 320) = v4;
                }
            }
        }
    }
}

constexpr int SC_TS = 16;
constexpr int SCAN_BLOCKS = 128;
constexpr int SC_OPB = SC_TS * 384;
constexpr int SC_SBW = SC_TS * 64 * 4;
constexpr int SC_LDS = (2 * SC_OPB + 2 * 2 * SC_SBW) * 4;
#define SC_LD(slot, s) { const float* b_ = buf + (s) * 384 + 4 * l16; qw[slot] = *(const f32x4*)(b_); qk[slot] = *(const f32x4*)(b_ + 64); \
    qb[slot] = *(const f32x4*)(b_ + 128); qd[slot] = *(const f32x4*)(b_ + 192); qv[slot] = buf[(s) * 384 + 320 + i]; }
__device__ __forceinline__ void scan_chunk(const float* buf, float* sb, int l16, int lane, int i, f32x4& S) {
    f32x4 qw[3], qk[3], qb[3], qd[3]; float qv[3];
    SC_LD(0, 0); SC_LD(1, 1);
#pragma unroll
    for (int s = 0; s < SC_TS; ++s) {
        const int sl = s % 3;
        if (s + 2 < SC_TS) SC_LD((s + 2) % 3, s + 2);
        const f32x4 pk = S * qk[sl];
        const float sa = -red16((pk[0] + pk[1]) + (pk[2] + pk[3]));
        S = (S * qw[sl] + qd[sl] * qv[sl]) + qb[sl] * sa;
        *(f32x4*)(sb + (s * 64 + lane) * 4) = S;
    }
}
#define SC_LOAD(R, ch) { const float* _g = rec + (size_t)(ch) * SC_OPB + lt * 4; _Pragma("unroll") for (int q = 0; q < 12; ++q) R[q] = *(const f32x4*)(_g + q * 512); }
#define SC_WRITE(R, B) { float* _l = (B) + lt * 4; _Pragma("unroll") for (int q = 0; q < 12; ++q) *(f32x4*)(_l + q * 512) = R[q]; }
__device__ void phase_scan(const KP& p, int bid, char* smem) {
    const float* REC = (const float*)(p.ws + WS_REC);
    float* YD = (float*)(p.ws + WS_YD);
    float* B0 = (float*)smem;
    float* B1 = B0 + SC_OPB;
    float* SB0 = B1 + SC_OPB;
    float* SB1 = SB0 + 2 * SC_SBW;
    const int tid = otid(p.wb), wid = tid >> 6, lane = tid & 63, l16 = lane & 15;
    const int xcd = bid & 7, slot = bid >> 3, dh = xcd * 2 + (slot >> 3), rq = slot & 7;
    const int d = dh >> 3, h = dh & 7;
    const float* rec = REC + (size_t)dh * NTOK * 384;
    constexpr int NCH = NTOK / SC_TS;
    if (wid >= 6) {
        __syncthreads();
        for (int c = 0; c <= NCH; ++c) __syncthreads();
    } else if (wid >= 4) {
        const int lt = tid - 256;
        f32x4 R0[12], R1[12];
        SC_LOAD(R0, 0); SC_WRITE(R0, B0);
        SC_LOAD(R1, 1); SC_LOAD(R0, 2);
        __syncthreads();
        for (int c = 0; c < NCH; c += 2) {
            if (c + 1 < NCH) SC_WRITE(R1, B1);
            if (c + 3 < NCH) SC_LOAD(R1, c + 3);
            __syncthreads();
            if (c + 2 < NCH) SC_WRITE(R0, B0);
            if (c + 4 < NCH) SC_LOAD(R0, c + 4);
            __syncthreads();
        }
        __syncthreads();
    } else if (wid >= 2) {
        const int cw = wid - 2, dstep = d == 0 ? 1 : -1;
        float* yout = YD + (size_t)d * NTOK * RW + h * 64 + rq * 8 + cw * 4 + (lane >> 4);
        f32x4 rr[SC_TS];
#define SC_RLOAD(B) { _Pragma("unroll") for (int s = 0; s < SC_TS; ++s) rr[s] = *(const f32x4*)((B) + s * 384 + 256 + 4 * l16); }
#define SC_READOUT(SB, ch) { float yv = 0.f; \
            _Pragma("unroll") for (int s = 0; s < SC_TS; ++s) { const f32x4 sv = *(const f32x4*)((SB) + cw * SC_SBW + (s * 64 + lane) * 4); const f32x4 py = sv * rr[s]; \
                const float y = red16((py[0] + py[1]) + (py[2] + py[3])); yv = (l16 == s) ? y : yv; } \
            yout[(size_t)(scan_row(d, (ch) * SC_TS) + dstep * l16) * RW] = yv; }
        __syncthreads();
        SC_RLOAD(B0);
        __syncthreads();
        for (int c = 1; c < NCH; c += 2) {
            SC_READOUT(SB0, c - 1); SC_RLOAD(B1);
            __syncthreads();
            SC_READOUT(SB1, c);
            if (c + 1 < NCH) SC_RLOAD(B0);
            __syncthreads();
        }
    } else {
        const int i = rq * 8 + wid * 4 + (lane >> 4);
        f32x4 S = {0.f, 0.f, 0.f, 0.f};
        __syncthreads();
        for (int c = 0; c < NCH; c += 2) {
            scan_chunk(B0, SB0 + wid * SC_SBW, l16, lane, i, S);
            __syncthreads();
            scan_chunk(B1, SB1 + wid * SC_SBW, l16, lane, i, S);
            __syncthreads();
        }
        __syncthreads();
    }
}

constexpr int CK = 16, NCHK = NTOK / CK;
constexpr int FR_B = 12800;
constexpr int FR_AT = 0, FR_RT = 2048, FR_SM = 4096, FR_BT = 6144, FR_KT = 8192, FR_VF = 10240, FR_GC = 12288;
template <int SH> __device__ __forceinline__ float row_shr1(float v) {
    return __int_as_float(__builtin_amdgcn_update_dpp(0x3f800000, __float_as_int(v), 0x110 + SH, 0xf, 0xf, false));
}
__device__ __forceinline__ bf16x8 frag8(const float (&v)[16], int q) {
    u32x4 w; w[0] = pack_bf2(v[4 * q], v[4 * q + 1]); w[1] = pack_bf2(v[4 * q + 2], v[4 * q + 3]); w[2] = pack_bf2(v[4 * q + 4], v[4 * q + 5]); w[3] = pack_bf2(v[4 * q + 6], v[4 * q + 7]);
    return __builtin_bit_cast(bf16x8, w);
}
__device__ __forceinline__ bf16x8 frag4(const f32x4 a) {
    u32x4 w; w[0] = pack_bf2(a[0], a[1]); w[1] = pack_bf2(a[2], a[3]); w[2] = 0u; w[3] = 0u;
    return __builtin_bit_cast(bf16x8, w);
}
__device__ __forceinline__ bf16x8 frag4u(unsigned lo, unsigned hi) { u32x4 w; w[0] = lo; w[1] = hi; w[2] = 0u; w[3] = 0u; return __builtin_bit_cast(bf16x8, w); }
#define MM(a, b, c) __builtin_amdgcn_mfma_f32_16x16x32_bf16(a, b, c, 0, 0, 0)
__device__ void phase_cprep(const KP& p, int bid, int nb, char* smem) {
    const float* REC = (const float*)(p.ws + WS_REC);
    char* FR = p.ws + WS_FR;
    const int tid = otid(p.wb), wid = tid >> 6, lane = tid & 63, t = lane & 15, g = lane >> 4;
    bf16_t* zt = (bf16_t*)smem + wid * 2048;
    const f32x4 Z4 = {0.f, 0.f, 0.f, 0.f};
    for (int u = bid * 8 + wid; u < 16 * NCHK; u += nb * 8) {
        const int dh = u / NCHK, c = u % NCHK;
        const float* rrow = REC + ((size_t)dh * NTOK + c * CK + t) * 384;
        float w_[16], kk[16], bb[16], kd[16], rr[16];
#pragma unroll
        for (int q = 0; q < 4; ++q) {
            const int jo = 32 * (q >> 1) + 16 * (q & 1) + 4 * g;
            const f32x4 a0 = *(const f32x4*)(rrow + jo), a1 = *(const f32x4*)(rrow + 64 + jo), a2 = *(const f32x4*)(rrow + 128 + jo), a3 = *(const f32x4*)(rrow + 192 + jo), a4 = *(const f32x4*)(rrow + 256 + jo);
#pragma unroll
            for (int e = 0; e < 4; ++e) { w_[4 * q + e] = a0[e]; kk[4 * q + e] = a1[e]; bb[4 * q + e] = a2[e]; kd[4 * q + e] = a3[e]; rr[4 * q + e] = a4[e]; }
        }
        float gam[16], At[16], Bh[16], Kh[16], Rt[16], Bt[16], Kt[16];
#pragma unroll
        for (int k = 0; k < 16; ++k) {
            float x = w_[k];
            x *= row_shr1<1>(x); x *= row_shr1<2>(x); x *= row_shr1<4>(x); x *= row_shr1<8>(x);
            gam[k] = x;
        }
#pragma unroll
        for (int k = 0; k < 16; ++k) {
            const float gp = row_shr1<1>(gam[k]), gc = bperm(gam[k], (lane & 48) | 15), ig = frcp(gam[k]);
            At[k] = kk[k] * gp; Bh[k] = bb[k] * ig; Kh[k] = kd[k] * ig; Rt[k] = rr[k] * gam[k];
            Bt[k] = -Bh[k] * gc; Kt[k] = Kh[k] * gc;
        }
        const bf16x8 fA0 = frag8(At, 0), fA1 = frag8(At, 2), fB0 = frag8(Bh, 0), fB1 = frag8(Bh, 2), fK0 = frag8(Kh, 0), fK1 = frag8(Kh, 2), fR0 = frag8(Rt, 0), fR1 = frag8(Rt, 2);
        f32x4 X = MM(fA1, fB1, MM(fA0, fB0, Z4));
        f32x4 XT = MM(fB1, fA1, MM(fB0, fA0, Z4));
        f32x4 LakT = MM(fK1, fA1, MM(fK0, fA0, Z4));
        f32x4 LrbT = MM(fB1, fR1, MM(fB0, fR0, Z4));
        f32x4 LrkT = MM(fK1, fR1, MM(fK0, fR0, Z4));
        f32x4 T, TT;
#pragma unroll
        for (int r = 0; r < 4; ++r) {
            const int row = 4 * g + r;
            X[r] = t < row ? -X[r] : 0.f;
            XT[r] = row < t ? -XT[r] : 0.f;
            LakT[r] = row < t ? LakT[r] : 0.f;
            LrbT[r] = row <= t ? -LrbT[r] : 0.f;
            LrkT[r] = row <= t ? LrkT[r] : 0.f;
            const float id = row == t ? 1.f : 0.f;
            T[r] = id + X[r]; TT[r] = id + XT[r];
        }
#pragma unroll
        for (int it = 0; it < 3; ++it) {
            const f32x4 X2 = MM(frag4(XT), frag4(X), Z4), X2T = MM(frag4(X), frag4(XT), Z4);
            const f32x4 Tn = MM(frag4(TT), frag4(X2), T), TTn = MM(frag4(X2), frag4(TT), TT);
            X = X2; XT = X2T; T = Tn; TT = TTn;
        }
#pragma unroll
        for (int q = 0; q < 4; ++q)
#pragma unroll
            for (int e = 0; e < 4; ++e) {
                const int j = 32 * (q >> 1) + 16 * (q & 1) + 4 * g + e;
                zt[j * 16 + t] = f2bf(Bt[4 * q + e]); zt[1024 + j * 16 + t] = f2bf(Kt[4 * q + e]);
            }
        char* fb = FR + ((size_t)dh * NCHK + c) * FR_B;
        *(bf16x8*)(fb + FR_AT + lane * 16) = fA0; *(bf16x8*)(fb + FR_AT + 1024 + lane * 16) = fA1;
        *(bf16x8*)(fb + FR_RT + lane * 16) = fR0; *(bf16x8*)(fb + FR_RT + 1024 + lane * 16) = fR1;
        {
            u32x4 s0, s1;
            s0[0] = pack_bf2(TT[0], TT[1]); s0[1] = pack_bf2(TT[2], TT[3]); s0[2] = pack_bf2(LakT[0], LakT[1]); s0[3] = pack_bf2(LakT[2], LakT[3]);
            s1[0] = pack_bf2(LrbT[0], LrbT[1]); s1[1] = pack_bf2(LrbT[2], LrbT[3]); s1[2] = pack_bf2(LrkT[0], LrkT[1]); s1[3] = pack_bf2(LrkT[2], LrkT[3]);
            *(u32x4*)(fb + FR_SM + lane * 32) = s0; *(u32x4*)(fb + FR_SM + lane * 32 + 16) = s1;
        }
#pragma unroll
        for (int jt = 0; jt < 4; ++jt) {
            *(u32x2*)(fb + FR_BT + jt * 512 + lane * 8) = *(const u32x2*)(zt + (16 * jt + t) * 16 + 4 * g);
            *(u32x2*)(fb + FR_KT + jt * 512 + lane * 8) = *(const u32x2*)(zt + 1024 + (16 * jt + t) * 16 + 4 * g);
            const float* vp = REC + ((size_t)dh * NTOK + c * CK + 4 * g) * 384 + 320 + 16 * jt + t;
            u32x2 vw; vw[0] = pack_bf2(vp[0], vp[384]); vw[1] = pack_bf2(vp[768], vp[1152]);
            *(u32x2*)(fb + FR_VF + jt * 512 + lane * 8) = vw;
        }
        if (t == 15) {
#pragma unroll
            for (int q = 0; q < 4; ++q) { f32x4 gv = {gam[4 * q], gam[4 * q + 1], gam[4 * q + 2], gam[4 * q + 3]}; *(f32x4*)(fb + FR_GC + (32 * (q >> 1) + 16 * (q & 1) + 4 * g) * 4) = gv; }
        }
    }
}

constexpr int CS_BLOCKS = 16, CS_D = 7, CS_R = 9;
__device__ void phase_cscan(const KP& p, int bid, char* smem) {
    const char* FRs = p.ws + WS_FR + (size_t)bid * NCHK * FR_B;
    float* YD = (float*)(p.ws + WS_YD);
    const int tid = otid(p.wb), wid = tid >> 6, lane = tid & 63, c16 = lane & 15, g = lane >> 4;
    const int d = bid >> 3, h = bid & 7;
    if (wid >= 4) {
        const int lw = wid - 4;
#define CS_ISSUE(ch) { const char* _s = FRs + (size_t)(ch) * FR_B; char* _d = smem + ((ch) % CS_R) * FR_B; \
            _Pragma("unroll") for (int _k = 0; _k < 3; ++_k) __builtin_amdgcn_global_load_lds((const unsigned*)(_s + (lw + 4 * _k) * 1024 + lane * 16), (unsigned*)(_d + (lw + 4 * _k) * 1024 + lane * 16), 16, 0, 0); \
            if (lw == 0 && lane < 16) __builtin_amdgcn_global_load_lds((const unsigned*)(_s + 12288 + lane * 16), (unsigned*)(_d + 12288 + lane * 16), 16, 0, 0); }
#define CS_WAIT() { if (lw == 0) asm volatile("s_waitcnt vmcnt(24)" ::: "memory"); else asm volatile("s_waitcnt vmcnt(18)" ::: "memory"); }
        for (int ch = 0; ch < CS_D; ++ch) CS_ISSUE(ch);
        CS_WAIT();
        asm volatile("" ::: "memory"); __builtin_amdgcn_s_barrier(); asm volatile("" ::: "memory");
        for (int pch = 0; pch < NCHK; ++pch) {
            if (pch + CS_D < NCHK) { CS_ISSUE(pch + CS_D); CS_WAIT(); }
            else asm volatile("s_waitcnt vmcnt(0)" ::: "memory");
            asm volatile("" ::: "memory"); __builtin_amdgcn_s_barrier(); asm volatile("" ::: "memory");
        }
    } else {
        const int it = wid, dstep = d == 0 ? 1 : -1;
        float* yout = YD + (size_t)d * NTOK * RW + h * 64 + it * 16 + c16;
        const f32x4 Z4 = {0.f, 0.f, 0.f, 0.f};
        f32x4 ST[4] = {Z4, Z4, Z4, Z4};
        asm volatile("" ::: "memory"); __builtin_amdgcn_s_barrier(); asm volatile("" ::: "memory");
        for (int pch = 0; pch < NCHK; ++pch) {
            const char* sb = smem + (pch % CS_R) * FR_B;
            const bf16x8 A0 = *(const bf16x8*)(sb + FR_AT + lane * 16), A1 = *(const bf16x8*)(sb + FR_AT + 1024 + lane * 16);
            const bf16x8 R0 = *(const bf16x8*)(sb + FR_RT + lane * 16), R1 = *(const bf16x8*)(sb + FR_RT + 1024 + lane * 16);
            const u32x4 s0 = *(const u32x4*)(sb + FR_SM + lane * 32), s1 = *(const u32x4*)(sb + FR_SM + lane * 32 + 16);
            const u32x2 vf = *(const u32x2*)(sb + FR_VF + it * 512 + lane * 8);
            const bf16x8 TA = frag4u(s0[0], s0[1]), LakA = frag4u(s0[2], s0[3]), LrbA = frag4u(s1[0], s1[1]), LrkA = frag4u(s1[2], s1[3]), VF = frag4u(vf[0], vf[1]);
            u32x4 b0, b1;
            b0[0] = pack_bf2(ST[0][0], ST[0][1]); b0[1] = pack_bf2(ST[0][2], ST[0][3]); b0[2] = pack_bf2(ST[1][0], ST[1][1]); b0[3] = pack_bf2(ST[1][2], ST[1][3]);
            b1[0] = pack_bf2(ST[2][0], ST[2][1]); b1[1] = pack_bf2(ST[2][2], ST[2][3]); b1[2] = pack_bf2(ST[3][0], ST[3][1]); b1[3] = pack_bf2(ST[3][2], ST[3][3]);
            const bf16x8 Bs0 = __builtin_bit_cast(bf16x8, b0), Bs1 = __builtin_bit_cast(bf16x8, b1);
            const f32x4 Q = MM(LakA, VF, MM(A1, Bs1, MM(A0, Bs0, Z4)));
            const f32x4 P = MM(TA, frag4(Q), Z4);
            const bf16x8 PB = frag4(P);
            const f32x4 Y = MM(LrkA, VF, MM(LrbA, PB, MM(R1, Bs1, MM(R0, Bs0, Z4))));
#pragma unroll
            for (int jt = 0; jt < 4; ++jt) {
                const f32x4 gc = *(const f32x4*)(sb + FR_GC + (16 * jt + 4 * g) * 4);
                const u32x2 bt = *(const u32x2*)(sb + FR_BT + jt * 512 + lane * 8), kt = *(const u32x2*)(sb + FR_KT + jt * 512 + lane * 8);
                ST[jt] = MM(frag4u(bt[0], bt[1]), PB, MM(frag4u(kt[0], kt[1]), VF, ST[jt] * gc));
            }
            const int row0 = scan_row(d, pch * CK) + dstep * 4 * g;
#pragma unroll
            for (int r = 0; r < 4; ++r) yout[(size_t)(row0 + dstep * r) * RW] = Y[r];
            asm volatile("" ::: "memory"); __builtin_amdgcn_s_barrier(); asm volatile("" ::: "memory");
        }
    }
}
#undef MM

__device__ void phase_rwpost(const KP& p, int l, int bid, int nb) {
    const float* YD = (const float*)(p.ws + WS_YD);
    const float* G = (const float*)(p.ws + WS_G);
    const float* BV = (const float*)(p.ws + WS_BV);
    bf16_t* Y = (bf16_t*)(p.ws + WS_YCAT);
    const float* lng = p.rw_ln_g + (size_t)l * RW;
    const float* lnb = p.rw_ln_b + (size_t)l * RW;
    const int tid = otid(p.wb), wid = tid >> 6, lane = tid & 63;
    for (int u = bid * 8 + wid; u < NTOK * 8; u += nb * 8) {
        const int row = u >> 3, h = u & 7, c = h * 64 + lane;
        const float y = YD[(size_t)row * RW + c] + YD[((size_t)NTOK + row) * RW + c];
        const float mean = wave_sum(y) * (1.f / 64);
        const float dv = y - mean;
        const float var = wave_sum(dv * dv) * (1.f / 64);
        const float yn = dv * rsqrtf(var + 64e-5f) * lng[c] + lnb[c];
        Y[(size_t)row * D + c] = f2bf((yn + BV[(size_t)row * RW + c]) * G[(size_t)row * RW + c]);
    }
}

constexpr int GM_LD = 136;
__device__ void phase_gmlp(const KP& p, int l, int bid, int nb, char* smem) {
    const float* P = (const float*)(p.ws + WS_P);
    const float* GMR = (const float*)(p.ws + WS_GMR);
    bf16_t* Y = (bf16_t*)(p.ws + WS_YCAT);
    bf16_t* vt = (bf16_t*)smem;
    const float* ng = p.gm_norm_g + (size_t)l * GMW;
    const int tid = otid(p.wb), wid = tid >> 6, lane = tid & 63, r = lane & 31, h = lane >> 5, mt = wid >> 1, nt = wid & 1;
    for (int u = bid; u < (NTOK / 128) * 8; u += nb) {
        const int n = u >> 3, g = u & 7, t0 = n * 128;
        const float* ws = p.gm_ws + ((size_t)l * 8 + g) * 128 * 128;
        const float* bs = p.gm_b + ((size_t)l * 8 + g) * 128;
        __syncthreads();
        {
            const int c = tid & 63, qp0 = tid >> 6;
            const float gn = ng[g * 64 + c];
#pragma unroll
            for (int i = 0; i < 8; ++i) {
                const int q = (qp0 + 8 * i) * 2;
                const float v0 = gelu_tanh(P[(size_t)(t0 + q) * INP + COL_GM + GMW + g * 64 + c]) * GMR[t0 + q] * gn;
                const float v1 = gelu_tanh(P[(size_t)(t0 + q + 1) * INP + COL_GM + GMW + g * 64 + c]) * GMR[t0 + q + 1] * gn;
                *(unsigned*)(vt + c * GM_LD + q) = pack_bf2(v0, v1);
            }
        }
        __syncthreads();
        f32x16 acc;
#pragma unroll
        for (int i = 0; i < 16; ++i) acc[i] = 0.f;
        const float* arow = ws + (size_t)(mt * 32 + r) * 128 + h * 8;
#pragma unroll
        for (int ks = 0; ks < 8; ++ks) {
            const f32x4 a0 = *(const f32x4*)(arow + ks * 16), a1 = *(const f32x4*)(arow + ks * 16 + 4);
            u32x4 aw; aw[0] = pack_bf2(a0[0], a0[1]); aw[1] = pack_bf2(a0[2], a0[3]); aw[2] = pack_bf2(a1[0], a1[1]); aw[3] = pack_bf2(a1[2], a1[3]);
            const bf16x8 bfr = *(const bf16x8*)(vt + (nt * 32 + r) * GM_LD + ks * 16 + h * 8);
            acc = __builtin_amdgcn_mfma_f32_32x32x16_bf16(__builtin_bit_cast(bf16x8, aw), bfr, acc, 0, 0, 0);
        }
        const int c = nt * 32 + r;
#pragma unroll
        for (int i = 0; i < 16; ++i) {
            const int pp = mt * 32 + (i & 3) + 8 * (i >> 2) + 4 * h;
            const float uu = gelu_tanh(P[(size_t)(t0 + pp) * INP + COL_GM + g * 64 + c]);
            Y[(size_t)(t0 + pp) * D + 512 + g * 64 + c] = f2bf(uu * (acc[i] + bs[pp]));
        }
    }
}

__device__ void phase_atprep(const KP& p, int l, int bid, int nb, char* smem) {
    const float* P = (const float*)(p.ws + WS_P);
    bf16_t* Qb = (bf16_t*)(p.ws + WS_Q);
    bf16_t* Kb = (bf16_t*)(p.ws + WS_K);
    bf16_t* VT = Kb + (size_t)NTOK * 256;
    const float* qn = p.at_qn + (size_t)l * 64;
    const float* kn = p.at_kn + (size_t)l * 64;
    const int tid = otid(p.wb);
    const float* rope = (const float*)(p.ws + WS_ROPE);
    for (int i = bid * NT + tid; i < NTOK * 20; i += nb * NT) {
        const int row = i / 20, hv = i % 20;
        const bool isq = hv < 16;
        const float* src = P + (size_t)row * INP + (isq ? COL_AT + hv * 64 : COL_K + (hv - 16) * 64);
        const float* gn = isq ? qn : kn;
        f32x4 x[16]; float ss = 0.f;
#pragma unroll
        for (int k = 0; k < 16; ++k) { x[k] = *(const f32x4*)(src + 4 * k); ss += x[k][0] * x[k][0] + x[k][1] * x[k][1] + x[k][2] * x[k][2] + x[k][3] * x[k][3]; }
        const float sc = rsqrtf(ss * (1.f / 64) + 1e-6f) * (isq ? 0.125f : 1.f);
#pragma unroll
        for (int k = 0; k < 16; ++k) x[k] = x[k] * *(const f32x4*)(gn + 4 * k) * sc;
        if (row < SEQ) {
#pragma unroll
            for (int sec = 0; sec < 2; ++sec) {
                const float* rt = rope + (size_t)((sec == 0 ? (row >> 6) : (128 + (row & 63))) * 16) * 2;
#pragma unroll
                for (int k = 0; k < 4; ++k) {
                    const f32x4 c0 = *(const f32x4*)(rt + 8 * k), c1 = *(const f32x4*)(rt + 8 * k + 4);
                    f32x4& a = x[8 * sec + k]; f32x4& b2 = x[8 * sec + 4 + k];
                    const float cs[4] = {c0[0], c0[2], c1[0], c1[2]}, sn[4] = {c0[1], c0[3], c1[1], c1[3]};
#pragma unroll
                    for (int e = 0; e < 4; ++e) { const float x1 = a[e], x2 = b2[e]; a[e] = x1 * cs[e] - x2 * sn[e]; b2[e] = x2 * cs[e] + x1 * sn[e]; }
                }
            }
        }
        bf16_t* dst = isq ? (Qb + (size_t)row * 1024 + hv * 64) : (Kb + (size_t)row * 256 + (hv - 16) * 64);
#pragma unroll
        for (int k = 0; k < 8; ++k) {
            u32x4 w; w[0] = pack_bf2(x[2 * k][0], x[2 * k][1]); w[1] = pack_bf2(x[2 * k][2], x[2 * k][3]); w[2] = pack_bf2(x[2 * k + 1][0], x[2 * k + 1][1]); w[3] = pack_bf2(x[2 * k + 1][2], x[2 * k + 1][3]);
            *(u32x4*)(dst + 8 * k) = w;
        }
    }
    float* tile = (float*)smem;
    for (int u = bid; u < (NTOK / 64) * 4; u += nb) {
        const int t0 = (u >> 2) * 64, kvh = u & 3;
        __syncthreads();
        {
            const int tok = tid >> 3, d8 = (tid & 7) * 8;
            const float* src = P + (size_t)(t0 + tok) * INP + COL_V + kvh * 64 + d8;
            const f32x4 a = *(const f32x4*)src, b2 = *(const f32x4*)(src + 4);
#pragma unroll
            for (int i = 0; i < 4; ++i) { tile[tok * 65 + d8 + i] = a[i]; tile[tok * 65 + d8 + 4 + i] = b2[i]; }
        }
        __syncthreads();
        {
            const int d = tid >> 3, tk = (tid & 7) * 8;
            u32x4 w;
#pragma unroll
            for (int i = 0; i < 4; ++i) w[i] = pack_bf2(tile[(tk + 2 * i) * 65 + d], tile[(tk + 2 * i + 1) * 65 + d]);
            *(u32x4*)(VT + (size_t)(kvh * 64 + d) * NTOK + t0 + tk) = w;
        }
    }
}

constexpr int AT_LD = 72;
constexpr int AT_TILE = 64 * AT_LD;
__device__ void phase_attn(const KP& p, int l, int bid, int nb, char* smem) {
    const bf16_t* Qb = (const bf16_t*)(p.ws + WS_Q);
    const bf16_t* Kb = (const bf16_t*)(p.ws + WS_K);
    const bf16_t* VT = Kb + (size_t)NTOK * 256;
    bf16_t* Y = (bf16_t*)(p.ws + WS_YCAT);
    bf16_t* Kc = (bf16_t*)smem;
    bf16_t* Vc = Kc + AT_TILE;
    const int tid = otid(p.wb), wid = tid >> 6, lane = tid & 63, q = lane & 31, h = lane >> 5, g = wid >> 1, qh = wid & 1;
    const int srow = tid >> 3, sseg = tid & 7;
    const int voff = srow * AT_LD + (sseg >> 2) * 32 + ((sseg >> 1) & 1) * 16 + (sseg & 1) * 4;
    for (int u = bid; u < (NTOK / 64) * 4; u += nb) {
        const int qt = u >> 2, kvh = u & 3, t0 = qt * 64, head = kvh * 4 + g, qrow = t0 + qh * 32 + q;
        int c_lo = 0, n_local = 0;
        if (t0 < SEQ) { c_lo = 2 - (t0 >> 6); if (c_lo < 0) c_lo = 0; int c_hi = (SEQ + 64 - t0) >> 6; if (c_hi > 4) c_hi = 4; n_local = c_hi - c_lo + 1; }
        const int nch = n_local + 4;
        bf16x8 qf[4];
#pragma unroll
        for (int ks = 0; ks < 4; ++ks) qf[ks] = *(const bf16x8*)(Qb + (size_t)qrow * 1024 + head * 64 + ks * 16 + h * 8);
        f32x16 O0, O1;
#pragma unroll
        for (int r = 0; r < 16; ++r) { O0[r] = 0.f; O1[r] = 0.f; }
        float m = p.at_sink[(size_t)l * 16 + head], lsum = h == 0 ? 1.f : 0.f;
        u32x4 rk, rv;
        {
            const int k0 = n_local > 0 ? (t0 - 128 + 64 * c_lo) : SEQ;
            rk = *(const u32x4*)(Kb + (size_t)(k0 + srow) * 256 + kvh * 64 + sseg * 8);
            rv = *(const u32x4*)(VT + (size_t)(kvh * 64 + srow) * NTOK + k0 + sseg * 8);
        }
        for (int ci = 0; ci < nch; ++ci) {
            const bool local = ci < n_local;
            const int k0 = local ? (t0 - 128 + 64 * (c_lo + ci)) : (SEQ + 64 * (ci - n_local));
            __syncthreads();
            *(u32x4*)(Kc + srow * AT_LD + sseg * 8) = rk;
            { u32x2 lo, hi; lo[0] = rv[0]; lo[1] = rv[1]; hi[0] = rv[2]; hi[1] = rv[3]; *(u32x2*)(Vc + voff) = lo; *(u32x2*)(Vc + voff + 8) = hi; }
            __syncthreads();
            if (ci + 1 < nch) {
                const int kn = (ci + 1 < n_local) ? (t0 - 128 + 64 * (c_lo + ci + 1)) : (SEQ + 64 * (ci + 1 - n_local));
                rk = *(const u32x4*)(Kb + (size_t)(kn + srow) * 256 + kvh * 64 + sseg * 8);
                rv = *(const u32x4*)(VT + (size_t)(kvh * 64 + srow) * NTOK + kn + sseg * 8);
            }
            f32x16 s0, s1;
#pragma unroll
            for (int r = 0; r < 16; ++r) { s0[r] = 0.f; s1[r] = 0.f; }
#pragma unroll
            for (int ks = 0; ks < 4; ++ks) {
                const bf16x8 k0f = *(const bf16x8*)(Kc + q * AT_LD + ks * 16 + h * 8);
                const bf16x8 k1f = *(const bf16x8*)(Kc + (32 + q) * AT_LD + ks * 16 + h * 8);
                s0 = __builtin_amdgcn_mfma_f32_32x32x16_bf16(k0f, qf[ks], s0, 0, 0, 0);
                s1 = __builtin_amdgcn_mfma_f32_32x32x16_bf16(k1f, qf[ks], s1, 0, 0, 0);
            }
            if (local) {
                const int base = k0 + 4 * h - qrow;
#pragma unroll
                for (int r = 0; r < 16; ++r) {
                    const int d0 = base + (r & 3) + 8 * (r >> 2), d1 = d0 + 32;
                    if (d0 > 128 || d0 < -128) s0[r] = -INFINITY;
                    if (d1 > 128 || d1 < -128) s1[r] = -INFINITY;
                }
            }
            float mx = fmaxf(s0[0], s1[0]);
#pragma unroll
            for (int r = 1; r < 16; ++r) mx = fmaxf(mx, fmaxf(s0[r], s1[r]));
            mx = fmaxf(mx, bperm(mx, lane ^ 32));
            const float mnew = fmaxf(m, mx);
            const float alpha = __expf(m - mnew);
            m = mnew; lsum *= alpha;
#pragma unroll
            for (int r = 0; r < 16; ++r) { O0[r] *= alpha; O1[r] *= alpha; }
            float ps = 0.f;
#pragma unroll
            for (int r = 0; r < 16; ++r) { s0[r] = __expf(s0[r] - m); s1[r] = __expf(s1[r] - m); ps += s0[r] + s1[r]; }
            lsum += ps;
            bf16x8 pf[2][2];
#pragma unroll
            for (int s = 0; s < 2; ++s) {
                u32x4 w0, w1;
#pragma unroll
                for (int i = 0; i < 4; ++i) { w0[i] = pack_bf2(s0[8 * s + 2 * i], s0[8 * s + 2 * i + 1]); w1[i] = pack_bf2(s1[8 * s + 2 * i], s1[8 * s + 2 * i + 1]); }
                pf[0][s] = __builtin_bit_cast(bf16x8, w0); pf[1][s] = __builtin_bit_cast(bf16x8, w1);
            }
#pragma unroll
            for (int kb = 0; kb < 2; ++kb)
#pragma unroll
                for (int s = 0; s < 2; ++s) {
                    const bf16x8 v0f = *(const bf16x8*)(Vc + q * AT_LD + kb * 32 + s * 16 + h * 8);
                    const bf16x8 v1f = *(const bf16x8*)(Vc + (32 + q) * AT_LD + kb * 32 + s * 16 + h * 8);
                    O0 = __builtin_amdgcn_mfma_f32_32x32x16_bf16(v0f, pf[kb][s], O0, 0, 0, 0);
                    O1 = __builtin_amdgcn_mfma_f32_32x32x16_bf16(v1f, pf[kb][s], O1, 0, 0, 0);
                }
        }
        lsum += bperm(lsum, lane ^ 32);
        const float inv = 1.f / lsum;
        bf16_t* yo = Y + (size_t)qrow * D + 1024 + head * 64 + 4 * h;
#pragma unroll
        for (int rg = 0; rg < 4; ++rg) {
            u32x2 w0, w1;
            w0[0] = pack_bf2(O0[4 * rg] * inv, O0[4 * rg + 1] * inv); w0[1] = pack_bf2(O0[4 * rg + 2] * inv, O0[4 * rg + 3] * inv);
            w1[0] = pack_bf2(O1[4 * rg] * inv, O1[4 * rg + 1] * inv); w1[1] = pack_bf2(O1[4 * rg + 2] * inv, O1[4 * rg + 3] * inv);
            *(u32x2*)(yo + 8 * rg) = w0;
            *(u32x2*)(yo + 32 + 8 * rg) = w1;
        }
    }
}

__device__ void phase_oproj(const KP& p, int l, int bid, int nb, bf16_t* shm) {
    const bf16_t* Y = (const bf16_t*)(p.ws + WS_YCAT);
    const bf16_t* Bt = (const bf16_t*)(p.ws + WS_WOT) + (size_t)l * D * D;
    const RowSrc in = layer_in(p, l);
    const RowDst out = layer_out(p, l);
    const int nM = ntok_of(l) / 256, nN = D / 256, nwg = nM * nN;
    gemm_phase<false>(nwg, bid, nb, D, shm, p.wb,
        [&](int L) { int pm, pn; dense_tile(xcd_remap(L, nwg), nM, nN, pm, pn); GU u; u.A = Y; u.Bt = Bt + (size_t)(pn * 256) * D; u.i0 = pm * 256; u.i1 = pn * 256; u.i2 = 0; u.i3 = 0; return u; },
        [&](const GU& u, int r) { return (u.i0 + r) * D; },
        [&](const GU& u, f32x4 (&acc)[2][2][4][2]) {
            const int m0 = u.i0, n0 = u.i1;
            G_IDX;
#pragma unroll
            for (int ai = 0; ai < 2; ++ai)
#pragma unroll
                for (int m = 0; m < 4; ++m) {
                    const int row = m0 + ai * 128 + wr * 64 + m * 16 + fr;
                    const float* xi = rowp(in, row);
                    float* xo = rowp(out, row);
                    const float* g1 = modp(p, l, row, 2);
#pragma unroll
                    for (int bj = 0; bj < 2; ++bj)
#pragma unroll
                        for (int n = 0; n < 2; ++n) {
                            const int col = n0 + bj * 128 + wc * 32 + n * 16 + fq * 4;
                            *(f32x4*)(xo + col) = *(const f32x4*)(xi + col) + *(const f32x4*)(g1 + col) * acc[ai][bj][m][n];
                        }
                }
        });
}

constexpr int RT_R = 11;
constexpr int RT_LD = D + 8;
__device__ void phase_norm2_route(const KP& p, int l, int bid, int nb, char* smem, const bool dummy = false) {
    const RowDst xs = layer_out(p, l);
    bf16_t* H = (bf16_t*)(p.ws + WS_H);
    int* cnt = (int*)(p.ws + WS_CNT) + l * 64 + (dummy ? 128 : 0);
    int* tokE = (int*)(p.ws + WS_TOKE);
    int* tokP = (int*)(p.ws + WS_TOKP);
    float* tokW = (float*)(p.ws + WS_TOKW);
    const float* g = p.norm2_g + (size_t)l * D;
    const bf16_t* RTH = (const bf16_t*)(p.ws + WS_RT) + (size_t)l * 2 * NE * D;
    const bf16_t* RTL = RTH + (size_t)NE * D;
    const float* rbias = p.moe_bias + (size_t)l * NE;
    bf16_t* hh = (bf16_t*)smem;
    bf16_t* hl = hh + RT_R * RT_LD;
    float* part = (float*)(hl + RT_R * RT_LD);
    int* lcnt = (int*)(part + 8 * 64 * 16);
    int* lbase = lcnt + 64;
    int* lsel = lbase + 64;
    const int tid = otid(p.wb), wid = tid >> 6, lane = tid & 63, c16 = lane & 15, g4 = lane >> 4;
    const int ntok = ntok_of(l), nsteps = (ntok + RT_R - 1) / RT_R;
    __syncthreads();
    if (tid < 64) lcnt[tid] = 0;
    for (int i = tid; i < 4 * RT_R * 8; i += NT) lsel[i] = -1;
    int step = 0;
    for (int blk = bid; blk < nsteps; blk += nb, ++step) {
        const int t0 = blk * RT_R;
        __syncthreads();
        {
            int rrq[2], rowq[2]; bool liveq[2]; const float* xrq[2]; const float* shq[2]; const float* scq[2];
            f32x4 v[2][8]; float ss[2];
#pragma unroll
            for (int q = 0; q < 2; ++q) {
                rrq[q] = wid + 8 * q; liveq[q] = rrq[q] < RT_R && t0 + rrq[q] < ntok;
                rowq[q] = liveq[q] ? t0 + rrq[q] : ntok - 1;
                xrq[q] = rowp(xs, rowq[q]); shq[q] = modp(p, l, rowq[q], 3); scq[q] = modp(p, l, rowq[q], 4); ss[q] = 0.f;
            }
#pragma unroll
            for (int i = 0; i < 8; ++i)
#pragma unroll
                for (int q = 0; q < 2; ++q) { v[q][i] = *(const f32x4*)(xrq[q] + i * 256 + lane * 4); ss[q] += v[q][i][0] * v[q][i][0] + v[q][i][1] * v[q][i][1] + v[q][i][2] * v[q][i][2] + v[q][i][3] * v[q][i][3]; }
            float rstd[2];
#pragma unroll
            for (int q = 0; q < 2; ++q) rstd[q] = rsqrtf(wave_sum(ss[q]) * (1.f / D) + 1e-6f);
#pragma unroll
            for (int i = 0; i < 8; ++i) {
                const int c = i * 256 + lane * 4;
                const f32x4 gv = *(const f32x4*)(g + c);
#pragma unroll
                for (int q = 0; q < 2; ++q) {
                    const f32x4 shv = *(const f32x4*)(shq[q] + c), scv = *(const f32x4*)(scq[q] + c);
                    float o[4]; unsigned hi[4]; float lo[4];
#pragma unroll
                    for (int j = 0; j < 4; ++j) { const float t = v[q][i][j] * rstd[q] * gv[j]; o[j] = fmaf(t, scv[j], t) + shv[j]; hi[j] = f2bf(o[j]); lo[j] = o[j] - __uint_as_float(hi[j] << 16); }
                    u32x2 wh, wl; wh[0] = hi[0] | (hi[1] << 16); wh[1] = hi[2] | (hi[3] << 16); wl[0] = pack_bf2(lo[0], lo[1]); wl[1] = pack_bf2(lo[2], lo[3]);
                    if (rrq[q] < RT_R) { *(u32x2*)(hh + rrq[q] * RT_LD + c) = wh; *(u32x2*)(hl + rrq[q] * RT_LD + c) = wl; }
                    if (liveq[q]) *(u32x2*)(H + (size_t)rowq[q] * D + c) = wh;
                }
            }
        }
        __syncthreads();
        {
            f32x4 acc[4];
#pragma unroll
            for (int et = 0; et < 4; ++et) acc[et] = (f32x4){0.f, 0.f, 0.f, 0.f};
            const int hr = c16 < RT_R ? c16 : RT_R - 1;
            const bf16_t* bh = hh + hr * RT_LD + wid * 256 + g4 * 8;
            const bf16_t* bl = hl + hr * RT_LD + wid * 256 + g4 * 8;
            const bf16_t* ah = RTH + (size_t)c16 * D + wid * 256 + g4 * 8;
            const bf16_t* al = RTL + (size_t)c16 * D + wid * 256 + g4 * 8;
#pragma unroll 2
            for (int ks = 0; ks < 8; ++ks) {
                const bf16x8 bhf = *(const bf16x8*)(bh + ks * 32), blf = *(const bf16x8*)(bl + ks * 32);
#pragma unroll
                for (int et = 0; et < 4; ++et) {
                    const bf16x8 ahf = *(const bf16x8*)(ah + (size_t)et * 16 * D + ks * 32), alf = *(const bf16x8*)(al + (size_t)et * 16 * D + ks * 32);
                    acc[et] = __builtin_amdgcn_mfma_f32_16x16x32_bf16(ahf, bhf, acc[et], 0, 0, 0);
                    acc[et] = __builtin_amdgcn_mfma_f32_16x16x32_bf16(ahf, blf, acc[et], 0, 0, 0);
                    acc[et] = __builtin_amdgcn_mfma_f32_16x16x32_bf16(alf, bhf, acc[et], 0, 0, 0);
                }
            }
#pragma unroll
            for (int et = 0; et < 4; ++et)
#pragma unroll
                for (int r = 0; r < 4; ++r) part[(wid * 64 + et * 16 + g4 * 4 + r) * 16 + c16] = acc[et][r];
        }
        __syncthreads();
        {
            bool liveq[2]; int rowq[2]; float score[2], biased[2], val[2]; int sel[2];
#pragma unroll
            for (int q = 0; q < 2; ++q) {
                const int rr = wid + 8 * q;
                liveq[q] = rr < RT_R && t0 + rr < ntok; rowq[q] = t0 + rr;
                const int rc = rr < RT_R ? rr : RT_R - 1;
                float logit = 0.f;
#pragma unroll
                for (int kq = 0; kq < 8; ++kq) logit += part[(kq * 64 + lane) * 16 + rc];
                score[q] = sigmoidf_(logit); biased[q] = score[q] + rbias[lane]; sel[q] = -1;
            }
            const int gbase = lane & ~7, mygrp = lane >> 3;
#pragma unroll
            for (int q = 0; q < 2; ++q) {
                const float m1 = max8(biased[q]);
                const unsigned long long eq = __ballot(biased[q] == m1);
                const unsigned geq = (unsigned)((eq >> gbase) & 0xffull);
                const int first = gbase + (__ffs(geq) - 1);
                const float m2 = max8((lane == first) ? -INFINITY : biased[q]);
                const float gs = m1 + m2;
                int rank = 0;
#pragma unroll
                for (int k = 0; k < 8; ++k) { const float o = bperm(gs, k * 8); rank += (o > gs || (o == gs && k < mygrp)) ? 1 : 0; }
                val[q] = rank < 4 ? biased[q] : -INFINITY;
            }
#pragma unroll
            for (int j = 0; j < TOPK; ++j)
#pragma unroll
                for (int q = 0; q < 2; ++q) {
                    const float mx = wave_max(val[q]);
                    const unsigned long long bm = __ballot(val[q] == mx);
                    const int win = __ffsll((long long)bm) - 1;
                    if (lane == win) { sel[q] = j; val[q] = -INFINITY; }
                }
#pragma unroll
            for (int q = 0; q < 2; ++q) {
                const float ssum = wave_sum(sel[q] >= 0 ? score[q] : 0.f);
                if (liveq[q] && sel[q] >= 0) {
                    const int lr = atomicAdd(lcnt + lane, 1);
                    lsel[((step * RT_R) + (wid + 8 * q)) * 8 + sel[q]] = (lane << 16) | lr;
                    if (!dummy) { tokE[(size_t)rowq[q] * 8 + sel[q]] = lane; tokW[(size_t)rowq[q] * 8 + sel[q]] = score[q] * frcp(ssum) * 2.5f; }
                }
            }
        }
    }
    __syncthreads();
    if (tid < 64) lbase[tid] = atomicAdd(cnt + tid, lcnt[tid]);
    __syncthreads();
    if (!dummy)
        for (int i = tid; i < step * RT_R * 8; i += NT) {
            const int v = lsel[i];
            if (v < 0) continue;
            const int st = i / (RT_R * 8), rr = (i / 8) % RT_R, j = i & 7;
            const int row = (bid + st * nb) * RT_R + rr;
            tokP[(size_t)row * 8 + j] = lbase[v >> 16] + (v & 0xffff);
        }
}

__device__ void phase_slots(const KP& p, int l, int bid, int nb, char* smem) {
    const int* cnt = (const int*)(p.ws + WS_CNT) + l * 64;
    const int* tokE = (const int*)(p.ws + WS_TOKE);
    const int* tokP = (const int*)(p.ws + WS_TOKP);
    int* slotT = (int*)(p.ws + WS_SLOTT);
    int* tile = (int*)(p.ws + WS_TILE);
    int* tokS = (int*)(p.ws + WS_TOKS);
    int* off = (int*)smem;
    const int tid = otid(p.wb);
    const int ntok = ntok_of(l);
    __syncthreads();
    if (tid == 0) {
        int o = 0;
        for (int e = 0; e < NE; ++e) { off[e] = o; o += (cnt[e] + 255) / 256 * 256; }
        off[NE] = o; off[NE + 1] = o + ntok;
    }
    __syncthreads();
    int nbo = nb; asm volatile("" : "+s"(nbo));
    const int gt = bid * NT + tid, gs = nbo * NT;
    for (int i = gt; i < ntok * 8; i += gs) { const int e = tokE[i]; const int s = off[e] + tokP[i]; slotT[s] = i >> 3; tokS[i] = s; }
    for (int i = gt; i < ntok; i += gs) slotT[off[NE] + i] = i;
    for (int i = gt; i < NE * 256; i += gs) { const int e = i >> 8, j = i & 255; const int s = off[e] + cnt[e] + j; if (s < off[e + 1]) slotT[s] = -1; }
    if (bid == 0) {
        const int nt = off[NE + 1] / 256;
        if (tid == 0) tile[0] = nt;
        for (int i = tid; i < nt; i += NT) {
            const int s = i * 256; int e = 0;
            for (int k = 1; k <= NE; ++k) if (s >= off[k]) e = k;
            tile[1 + i] = e;
        }
    }
}

__device__ void phase_moe1(const KP& p, int l, int bid, int nb, bf16_t* shm) {
    const bf16_t* H = (const bf16_t*)(p.ws + WS_H);
    const bf16_t* W13 = (const bf16_t*)(p.ws + WS_W13T) + (size_t)l * NEX * 1024 * D;
    const int* slotT = (const int*)(p.ws + WS_SLOTT);
    const int* tile = (const int*)(p.ws + WS_TILE);
    bf16_t* ACT = (bf16_t*)(p.ws + WS_ACT);
    const int nt = tile[0], nwg = nt * 4;
    gemm_phase<false>(nwg, bid, nb, D, shm, p.wb,
        [&](int L) { const int wg = xcd_remap(L, nwg), ti = wg >> 2, ct = wg & 3, e = tile[1 + ti]; GU u; u.A = H; u.Bt = W13 + ((size_t)e * 1024 + ct * 256) * D; u.i0 = ti * 256; u.i1 = ct * 256; u.i2 = 0; u.i3 = 0; return u; },
        [&](const GU& u, int r) { const int t = slotT[u.i0 + r]; return (t < 0 ? 0 : t) * D; },
        [&](const GU& u, f32x4 (&acc)[2][2][4][2]) {
            const int s0 = u.i0, n0 = u.i1;
            G_IDX;
#pragma unroll
            for (int ai = 0; ai < 2; ++ai)
#pragma unroll
                for (int m = 0; m < 4; ++m) {
                    const int slot = s0 + ai * 128 + wr * 64 + m * 16 + fr;
#pragma unroll
                    for (int bj = 0; bj < 2; ++bj) {
                        const int ch = (n0 + bj * 128 + wc * 32) / 2 + fq * 4;
                        float a[4];
#pragma unroll
                        for (int r = 0; r < 4; ++r) a[r] = siluf_(acc[ai][bj][m][0][r]) * acc[ai][bj][m][1][r];
                        u32x2 w; w[0] = pack_bf2(a[0], a[1]); w[1] = pack_bf2(a[2], a[3]);
                        *(u32x2*)(ACT + (size_t)slot * EFF + ch) = w;
                    }
                }
        });
}

__device__ void phase_moe2(const KP& p, int l, int bid, int nb, bf16_t* shm) {
    const bf16_t* ACT = (const bf16_t*)(p.ws + WS_ACT);
    const bf16_t* W2 = (const bf16_t*)(p.ws + WS_W2T) + (size_t)l * NEX * D * EFF;
    const int* tile = (const int*)(p.ws + WS_TILE);
    const int* slotT = (const int*)(p.ws + WS_SLOTT);
    bf16_t* OUTS = (bf16_t*)(p.ws + WS_OUTS);
    const int nt = tile[0], nwg = nt * 8;
    for (int k = (bid >> 3) & 3; k > 0; --k) __builtin_amdgcn_s_sleep(127);
    gemm_phase<true>(nwg, bid, nb, EFF, shm, p.wb,
        [&](int L) { const int wg = xcd_remap(L, nwg), ti = wg >> 3, ct = wg & 7, e = tile[1 + ti]; GU u; u.A = ACT; u.Bt = W2 + ((size_t)e * D + ct * 256) * EFF; u.i0 = ti * 256; u.i1 = ct * 256; u.i2 = 0; u.i3 = 0; return u; },
        [&](const GU& u, int r) { return (u.i0 + r) * EFF; },
        [&](const GU& u, f32x4 (&acc)[2][2][4][2]) {
            const int s0 = u.i0, n0 = u.i1;
            G_IDX;
#pragma unroll
            for (int ai = 0; ai < 2; ++ai)
#pragma unroll
                for (int m = 0; m < 4; ++m) {
                    const int slot = s0 + ai * 128 + wr * 64 + m * 16 + fr;
                    if (slotT[slot] < 0) continue;
                    bf16_t* orow = OUTS + (size_t)slot * D + n0 + wc * 32 + fq * 8;
#pragma unroll
                    for (int bj = 0; bj < 2; ++bj) {
                        u32x4 w;
                        w[0] = pack_bf2(acc[ai][bj][m][0][0], acc[ai][bj][m][0][1]); w[1] = pack_bf2(acc[ai][bj][m][0][2], acc[ai][bj][m][0][3]);
                        w[2] = pack_bf2(acc[ai][bj][m][1][0], acc[ai][bj][m][1][1]); w[3] = pack_bf2(acc[ai][bj][m][1][2], acc[ai][bj][m][1][3]);
                        *(u32x4*)(orow + bj * 128) = w;
                    }
                }
        });
}

__device__ void phase_combine(const KP& p, int l, int bid, int nb, char* smem, const bool dummy = false) {
    const bf16_t* OUTS = (const bf16_t*)(p.ws + WS_OUTS);
    const int* tokS = (const int*)(p.ws + WS_TOKS);
    const float* tokW = (const float*)(p.ws + WS_TOKW);
    const int* cnt = (const int*)(p.ws + WS_CNT) + l * 64;
    const RowDst out = layer_out(p, l);
    int* sh0 = (int*)smem;
    const int tid = otid(p.wb), half = tid >> 8, ht = tid & 255;
    __syncthreads();
    if (tid == 0) { int o = 0; for (int e = 0; e < NE; ++e) o += (cnt[e] + 255) / 256 * 256; sh0[0] = o; }
    __syncthreads();
    const int shared0 = sh0[0];
    const int ntok = ntok_of(l);
    for (int row = bid * 2 + half; row < ntok; row += nb * 2) {
        float* xr = rowp(out, row);
        const float* g2 = modp(p, l, row, 5);
        const int c = ht * 8;
        float acc[8];
        {
            const u32x4 v = *(const u32x4*)(OUTS + (size_t)(shared0 + row) * D + c);
#pragma unroll
            for (int q = 0; q < 4; ++q) { acc[2 * q] = __uint_as_float(v[q] << 16); acc[2 * q + 1] = __uint_as_float(v[q] & 0xffff0000u); }
        }
#pragma unroll
        for (int j = 0; j < TOPK; ++j) {
            const int s = tokS[(size_t)row * 8 + j]; const float w = tokW[(size_t)row * 8 + j];
            const u32x4 v = *(const u32x4*)(OUTS + (size_t)s * D + c);
#pragma unroll
            for (int q = 0; q < 4; ++q) { acc[2 * q] += w * __uint_as_float(v[q] << 16); acc[2 * q + 1] += w * __uint_as_float(v[q] & 0xffff0000u); }
        }
        const f32x4 g0 = *(const f32x4*)(g2 + c), g1 = *(const f32x4*)(g2 + c + 4);
        f32x4 x0 = *(const f32x4*)(xr + c), x1 = *(const f32x4*)(xr + c + 4);
#pragma unroll
        for (int q = 0; q < 4; ++q) { x0[q] += g0[q] * acc[q]; x1[q] += g1[q] * acc[4 + q]; }
        if (!dummy || x0[0] == 1234.5f) { *(f32x4*)(xr + c) = x0; *(f32x4*)(xr + c + 4) = x1; }
    }
}

#define XB_TMO      128
#define XB_XCNT(j)  (256  + 64 * (j))
#define XB_XSUB(j)  (1280 + 64 * (j))
#define XB_XGEN(j)  (2304 + 64 * (j))
#define XB_TOP      3328
#define XB_TOPGEN   3392
#define XCD_BAR_WORDS 3456
#define XB_SPIN_CAP (1u << 18)
#define LAS __attribute__((address_space(3)))

__device__ __forceinline__ unsigned xb_ld(unsigned* p)              { return __hip_atomic_load(p, __ATOMIC_RELAXED, __HIP_MEMORY_SCOPE_AGENT); }
__device__ __forceinline__ unsigned xb_add(unsigned* p, unsigned v) { return __hip_atomic_fetch_add(p, v, __ATOMIC_RELAXED, __HIP_MEMORY_SCOPE_AGENT); }
__device__ __forceinline__ unsigned xb_xcc_id() { return (unsigned)__builtin_amdgcn_s_getreg((3 << 11) | 20) & 0xFu; }
#define XB_SPIN(cond, bar) do { unsigned _sp = 0; while (cond) { __builtin_amdgcn_s_sleep(1); \
    if ((++_sp & 255u) == 0u) { if (xb_ld(&(bar)[XB_TMO])) break; if (_sp > XB_SPIN_CAP) { atomicAdd(&(bar)[XB_TMO], 1u); break; } } } } while (0)

struct XcdBarrier {
    unsigned* bar; unsigned x;
    volatile LAS unsigned* st;
};
__device__ __forceinline__ XcdBarrier xcd_barrier_post(unsigned* bar, volatile LAS unsigned* st) {
    XcdBarrier b; b.bar = bar; b.x = (unsigned)__builtin_amdgcn_readfirstlane((int)xb_xcc_id()); b.st = st;
    if (threadIdx.x == 0) (void)xb_add(&bar[XB_XCNT(b.x)], 1u);
    return b;
}
__device__ __forceinline__ void xcd_barrier_complete(unsigned* bar, unsigned x, unsigned& nloc, unsigned& nx) {
    const unsigned G = gridDim.x * gridDim.y * gridDim.z;
    unsigned sum, cnt, mine, sp = 0u;
    for (;;) {
        sum = 0u; cnt = 0u; mine = 0u;
#pragma unroll
        for (unsigned j = 0; j < 16; ++j) { const unsigned c = xb_ld(&bar[XB_XCNT(j)]); sum += c; cnt += (c > 0u) ? 1u : 0u; mine = (j == x) ? c : mine; }
        if (sum == G) break;
        __builtin_amdgcn_s_sleep(1);
        if ((++sp & 255u) == 0u) { if (xb_ld(&bar[XB_TMO])) break; if (sp > XB_SPIN_CAP) { atomicAdd(&bar[XB_TMO], 1u); break; } }
    }
    nloc = mine > 0u ? mine : 1u; nx = cnt > 0u ? cnt : 1u;
}
__device__ __forceinline__ void xcd_barrier(const XcdBarrier& b) {
    asm volatile("s_waitcnt vmcnt(0)" ::: "memory");
    __syncthreads();
    unsigned bx = b.x; asm volatile("" : "+s"(bx));
    if (threadIdx.x == 0) {
        unsigned* bar = b.bar;
        __builtin_amdgcn_s_waitcnt(0);
        unsigned nloc = b.st[0], nx = b.st[1];
        if (nloc == 0u) { xcd_barrier_complete(bar, bx, nloc, nx); b.st[0] = nloc; b.st[1] = nx; }
        const unsigned old = xb_add(&bar[XB_XSUB(bx)], 1u);
        const unsigned gen = old / nloc;
        if (old + 1u == (gen + 1u) * nloc) {
            __builtin_amdgcn_fence(__ATOMIC_RELEASE, "agent");
            asm volatile("s_waitcnt vmcnt(0)" ::: "memory");
            const unsigned og = xb_add(&bar[XB_TOP], 1u);
            const unsigned tg = og / nx;
            if (og + 1u == (tg + 1u) * nx) xb_add(&bar[XB_TOPGEN], 1u);
            else XB_SPIN(xb_ld(&bar[XB_TOPGEN]) == tg, bar);
            __builtin_amdgcn_fence(__ATOMIC_ACQUIRE, "agent");
            xb_add(&bar[XB_XGEN(bx)], 1u);
            asm volatile("s_waitcnt vmcnt(0)" ::: "memory");
        } else {
            XB_SPIN(xb_ld(&bar[XB_XGEN(bx)]) == gen, bar);
            __builtin_amdgcn_fence(__ATOMIC_ACQUIRE, "agent");
            asm volatile("s_waitcnt vmcnt(0)" ::: "memory");
        }
    }
    __syncthreads();
}

#ifndef PROBE_MASK
#define PROBE_MASK 0u
#endif
#ifndef REP2_SKIP
#define REP2_SKIP 0
#endif
#ifndef REP2_SKIP
#define REP2_SKIP 0
#endif
#ifndef REP2_SKIP
#define REP2_SKIP 0
#endif
#ifndef REP2_SKIP
#define REP2_SKIP 0
#endif
#ifndef REP2_SKIP
#define REP2_SKIP 0
#endif
#ifndef REP2_SKIP
#define REP2_SKIP 0
#endif
#ifndef REP3_SKIP
#define REP3_SKIP 0
#endif
#ifndef REP_PHASE
#define REP_PHASE (-1)
#define REP_L 1
#define REP_N 1
#endif
constexpr int FUSED_LDS = G_LDS + 16;
__global__ void __launch_bounds__(512, 2) k_fused(Params p0) {
    extern __shared__ __attribute__((aligned(16))) char dsm[];
    KP p; (Params&)p = p0; p.wb = __builtin_amdgcn_readfirstlane((int)threadIdx.x) & ~63;
    if (threadIdx.x == 0) *(uint4*)(dsm + G_LDS) = make_uint4(0u, 0u, 0u, 0u);
    __syncthreads();
    XcdBarrier bar = xcd_barrier_post((unsigned*)(p.ws + WS_BAR), (volatile LAS unsigned*)(dsm + G_LDS));
    char* sm = dsm;
    bf16_t* shm = (bf16_t*)dsm;
    const int bid = blockIdx.x, nb = gridDim.x;
#if PROBE_MASK
    unsigned long long* stamps = (unsigned long long*)(p.ws + WS_BAR + 14336);
    int nstamp = 0;
#define STAMP() do { if (bid == 0 && threadIdx.x == 0) stamps[nstamp] = wall_clock64(); ++nstamp; } while (0)
    STAMP();
#else
#define STAMP() do { } while (0)
#endif
    for (int _r = 0; _r < (REP_PHASE == 20 ? REP_N : 1); ++_r) {
        phase_ada(p, bid, nb);
        phase_convert_dense(p, 0, bid, nb, (float*)sm);
        phase_convert_dense(p, 1, bid, nb, (float*)sm);
        phase_convert_lora(p, bid, nb);
        xcd_barrier(bar); STAMP();
    }
    phase_ada2(p, bid, nb);
    xcd_barrier(bar); STAMP();
#define RUN(k, body) { const int _n = (REP_PHASE == (k) && l == REP_L) ? REP_N : 1; for (int _r = 0; _r < _n; ++_r) { body; xcd_barrier(bar); STAMP(); } }
    for (int l = 0; l < DEPTH; ++l) {
        RUN(0, phase_norm1(p, l, bid, nb));
        RUN(1, phase_inproj(p, l, bid, nb, shm));
        RUN(2, { if (!(REP2_SKIP & 1) || _r == 0) phase_rwprep(p, l, bid, nb, sm); if (!(REP2_SKIP & 2) || _r == 0) phase_atprep(p, l, bid, nb, sm); });
        RUN(11, phase_cprep(p, bid, nb, sm));
        RUN(3, {
            if (bid < CS_BLOCKS) { if (!(REP3_SKIP & 1) || _r == 0) phase_cscan(p, bid, sm); }
            else {
                if (!(REP3_SKIP & 4) || _r == 0) phase_attn(p, l, bid - CS_BLOCKS, nb - CS_BLOCKS, sm);
                if (!(REP3_SKIP & 2) || _r == 0) phase_gmlp(p, l, bid - CS_BLOCKS, nb - CS_BLOCKS, sm);
            }
            phase_convert_moe_queue(p, l, sm);
            });
        RUN(4, phase_rwpost(p, l, bid, nb));
        RUN(5, phase_oproj(p, l, bid, nb, shm));
        RUN(6, phase_norm2_route(p, l, bid, nb, sm, _r > 0));
        RUN(7, phase_slots(p, l, bid, nb, sm));
        RUN(8, phase_moe1(p, l, bid, nb, shm));
        RUN(9, phase_moe2(p, l, bid, nb, shm));
        RUN(10, phase_combine(p, l, bid, nb, sm, _r + 1 < _n));
    }
#if PROBE_MASK
    if (bid == 0 && threadIdx.x == 0) {
        unsigned long long ticks = 0;
        for (int i = 0; i + 1 < nstamp; ++i) if ((PROBE_MASK >> i) & 1u) ticks += stamps[i + 1] - stamps[i];
        float v = (float)ticks * 10.0f;
        if (PROBE_MASK == 0x40000000u) v = 1.0e5f;
        p.out[0] = v;
    }
#endif
}

extern "C" void kernel_launch(void* const* d_in, const int* in_sizes, int n_in, void* d_out, int out_size, void* d_ws, size_t ws_size, hipStream_t stream) {
    if (n_in != 35 || out_size != SEQ * D || ws_size < WS_END) {
        fprintf(stderr, "kernel_launch: unexpected shapes: n_in %d out %d ws %zu (need %zu)\n", n_in, out_size, ws_size, (size_t)WS_END);
        return;
    }
    static int grid = 0;
    if (!grid) {
        int dev = 0, cus = 0, per_cu = 0;
        (void)hipGetDevice(&dev);
        (void)hipDeviceGetAttribute(&cus, hipDeviceAttributeMultiprocessorCount, dev);
        (void)hipFuncSetAttribute((const void*)k_fused, hipFuncAttributeMaxDynamicSharedMemorySize, FUSED_LDS);
        (void)hipOccupancyMaxActiveBlocksPerMultiprocessor(&per_cu, (const void*)k_fused, NT, FUSED_LDS);
        if (per_cu < 1) fprintf(stderr, "kernel_launch: occupancy query says %d workgroups per CU; launching one per CU anyway\n", per_cu);
        grid = cus;
        if (grid <= CS_BLOCKS) grid = 0;
    }
    if (!grid) { fprintf(stderr, "kernel_launch: bad grid\n"); return; }
    Params p{};
    const float** f = (const float**)&p;
    for (int i = 0; i < 35; ++i) f[i] = (const float*)d_in[i];
    p.out = (float*)d_out;
    p.ws = (char*)d_ws;
    (void)hipMemsetAsync(d_ws, 0, WS_ZERO_END, stream);
    hipLaunchKernelGGL(k_fused, dim3(grid), dim3(NT), FUSED_LDS, stream, p);
}
```

```cpp
#include <hip/hip_runtime.h>
#include <stdint.h>
#include <stdio.h>

typedef unsigned short bf16_t;
typedef short bf16x8 __attribute__((ext_vector_type(8)));
typedef float f32x4 __attribute__((ext_vector_type(4)));
typedef unsigned u32x4 __attribute__((ext_vector_type(4)));
typedef unsigned u32x2 __attribute__((ext_vector_type(2)));
typedef float f32x16 __attribute__((ext_vector_type(16)));

constexpr int D = 2048, SEQ = 8192, CTXL = 256, NTOK = SEQ + CTXL, DEPTH = 2;
constexpr int RW = 512, RWP = 1920, GMW = 512, INP = 4480;
constexpr int COL_GM = 1920, COL_AT = 2944, COL_K = 3968, COL_V = 4224;
constexpr int NE = 64, NEX = 65, EFF = 512, TOPK = 8;
constexpr int SLOT_CAP = 92416;
constexpr int MAX_TILES = SLOT_CAP / 256;
constexpr int INP_PAD = 4608;
constexpr int NT = 512;

constexpr size_t al256(size_t x) { return (x + 255) & ~(size_t)255; }
constexpr size_t WS_BAR = 0;
constexpr size_t WS_CNT = 16384;
constexpr size_t WS_MOD = WS_CNT + 1024;
constexpr size_t WS_ZERO_END = al256(WS_MOD + (size_t)2 * 2 * 12288 * 4);
constexpr size_t WS_WINT = WS_ZERO_END;
constexpr size_t WS_WOT = WS_WINT + (size_t)2 * INP_PAD * D * 2;
constexpr size_t WS_W13T = WS_WOT + (size_t)2 * D * D * 2;
constexpr size_t WS_W2T = WS_W13T + (size_t)2 * NEX * 1024 * D * 2;
constexpr size_t WS_H = WS_W2T + (size_t)2 * NEX * D * EFF * 2;
constexpr size_t WS_P = WS_H + (size_t)NTOK * D * 2;
constexpr size_t WS_REC = WS_P + (size_t)NTOK * INP * 4;
constexpr size_t WS_YD = WS_REC + (size_t)2 * 8 * NTOK * 384 * 4;
constexpr size_t WS_G = WS_YD + (size_t)2 * NTOK * RW * 4;
constexpr size_t WS_BV = WS_G + (size_t)NTOK * RW * 4;
constexpr size_t WS_GMR = WS_BV + (size_t)NTOK * RW * 4;
constexpr size_t WS_YCAT = al256(WS_GMR + (size_t)NTOK * 4);
constexpr size_t WS_Q = WS_YCAT + (size_t)NTOK * D * 2;
constexpr size_t WS_K = WS_Q + (size_t)NTOK * 1024 * 4;
constexpr size_t WS_X1 = WS_K + (size_t)NTOK * 256 * 4;
constexpr size_t WS_X2C = WS_X1 + (size_t)NTOK * D * 4;
constexpr size_t WS_TOKE = WS_X2C + (size_t)CTXL * D * 4;
constexpr size_t WS_TOKP = WS_TOKE + (size_t)NTOK * 8 * 4;
constexpr size_t WS_TOKW = WS_TOKP + (size_t)NTOK * 8 * 4;
constexpr size_t WS_SLOTT = WS_TOKW + (size_t)NTOK * 8 * 4;
constexpr size_t WS_SLOTW = al256(WS_SLOTT + (size_t)SLOT_CAP * 4);
constexpr size_t WS_TILE = al256(WS_SLOTW + (size_t)SLOT_CAP * 4);
constexpr size_t WS_ACT = al256(WS_TILE + (size_t)(MAX_TILES + 64) * 4);
constexpr size_t WS_MODP = WS_ACT + (size_t)SLOT_CAP * EFF * 2;
constexpr size_t WS_TOKS = WS_MODP + (size_t)2 * 2 * 32 * 12288 * 4;
constexpr size_t WS_OUTS = WS_TOKS + (size_t)NTOK * 8 * 4;
constexpr size_t WS_WLT = WS_OUTS + (size_t)SLOT_CAP * D * 2;
constexpr size_t WS_ROPE = WS_WLT + (size_t)2 * RW * 384 * 2;
constexpr size_t WS_RT = WS_ROPE + (size_t)192 * 16 * 2 * 4;
constexpr size_t WS_FR = WS_RT + (size_t)2 * 2 * NE * D * 2;
constexpr size_t WS_END = WS_FR + (size_t)16 * (NTOK / 16) * 12800;

struct Params {
    const float *x, *c, *ctx, *c_ctx, *w_ada, *b_ada, *norm1_g, *norm2_g, *w_in, *w_o;
    const float *rw_mu, *rw_w0, *rw_w2, *rw_a0, *rw_a2, *rw_g2, *rw_kk, *rw_ka, *rw_rk, *rw_ln_g, *rw_ln_b;
    const float *gm_norm_g, *gm_ws, *gm_b, *at_qn, *at_kn, *at_sink;
    const float *moe_router, *moe_bias, *moe_wg, *moe_wu, *moe_wd, *sh_wg, *sh_wu, *sh_wd;
    float* out;
    char* ws;
};

__device__ __forceinline__ bf16_t f2bf(float f) {
    unsigned u = __float_as_uint(f);
    u += 0x7fffu + ((u >> 16) & 1u);
    return (bf16_t)(u >> 16);
}
typedef __bf16 bf16x2n __attribute__((ext_vector_type(2)));
typedef float f32x2n __attribute__((ext_vector_type(2)));
__device__ __forceinline__ unsigned pack_bf2(float lo, float hi) { const f32x2n v = {lo, hi}; const bf16x2n b2 = __builtin_convertvector(v, bf16x2n); return __builtin_bit_cast(unsigned, b2); }
__device__ __forceinline__ int olane() { int t; asm volatile("v_mbcnt_lo_u32_b32 %0, -1, 0\n\tv_mbcnt_hi_u32_b32 %0, -1, %0" : "=v"(t)); return t; }
__device__ __forceinline__ float bperm(float v, int src_lane) { return __int_as_float(__builtin_amdgcn_ds_bpermute(src_lane << 2, __float_as_int(v))); }
template <int CTRL> __device__ __forceinline__ float dppf(float v) {
    return __int_as_float(__builtin_amdgcn_update_dpp(0, __float_as_int(v), CTRL, 0xf, 0xf, true));
}
__device__ __forceinline__ float red16(float v) {
    v += dppf<0xB1>(v); v += dppf<0x4E>(v); v += dppf<0x124>(v); v += dppf<0x128>(v); return v;
}
__device__ __forceinline__ float wave_sum(float v) {
    const int lane = olane();
    v = red16(v);
    v += bperm(v, lane ^ 16); v += bperm(v, lane ^ 32);
    return v;
}
__device__ __forceinline__ float wave_max(float v) {
    const int lane = olane();
    v = fmaxf(v, dppf<0xB1>(v)); v = fmaxf(v, dppf<0x4E>(v)); v = fmaxf(v, dppf<0x124>(v)); v = fmaxf(v, dppf<0x128>(v));
    v = fmaxf(v, bperm(v, lane ^ 16)); v = fmaxf(v, bperm(v, lane ^ 32));
    return v;
}
__device__ __forceinline__ float max8(float v) {
    const int lane = olane();
    v = fmaxf(v, dppf<0xB1>(v)); v = fmaxf(v, dppf<0x4E>(v)); v = fmaxf(v, bperm(v, lane ^ 4));
    return v;
}
__device__ __forceinline__ float fexp(float x) { return __builtin_amdgcn_exp2f(x * 1.4426950408889634f); }
__device__ __forceinline__ float flog(float x) { return __builtin_amdgcn_logf(x) * 0.6931471805599453f; }
__device__ __forceinline__ float frcp(float x) { return __builtin_amdgcn_rcpf(x); }
__device__ __forceinline__ float sigmoidf_(float x) { return frcp(1.f + fexp(-x)); }
__device__ __forceinline__ float siluf_(float x) { return x * frcp(1.f + fexp(-x)); }
__device__ __forceinline__ float ftanh(float u) { const float e = fexp(-2.f * fabsf(u)); const float t = (1.f - e) * frcp(1.f + e); return u < 0.f ? -t : t; }
__device__ __forceinline__ float gelu_tanh(float x) {
    const float u = 0.7978845608028654f * (x + 0.044715f * x * x * x);
    const float hx = 0.5f * x;
    return fmaf(hx, ftanh(u), hx);
}
__device__ __forceinline__ float softplusf_(float x) { return fmaxf(x, 0.f) + flog(1.f + fexp(-fabsf(x))); }

struct RowSrc { const float* a; const float* b; };
__device__ __forceinline__ const float* rowp(const RowSrc& r, int row) { return row < SEQ ? r.a + (size_t)row * D : r.b + (size_t)(row - SEQ) * D; }
struct RowDst { float* a; float* b; };
__device__ __forceinline__ float* rowp(const RowDst& r, int row) { return row < SEQ ? r.a + (size_t)row * D : r.b + (size_t)(row - SEQ) * D; }

__device__ __forceinline__ RowSrc layer_in(const Params& p, int l) {
    RowSrc r; if (l == 0) { r.a = p.x; r.b = p.ctx; } else { float* x1 = (float*)(p.ws + WS_X1); r.a = x1; r.b = x1 + (size_t)SEQ * D; } return r;
}
__device__ __forceinline__ RowDst layer_out(const Params& p, int l) {
    RowDst r; if (l == 0) { float* x1 = (float*)(p.ws + WS_X1); r.a = x1; r.b = x1 + (size_t)SEQ * D; } else { r.a = p.out; r.b = (float*)(p.ws + WS_X2C); } return r;
}
__device__ __forceinline__ const float* modp(const Params& p, int l, int row, int which) {
    return (const float*)(p.ws + WS_MOD) + ((size_t)(l * 2 + (row < SEQ ? 0 : 1)) * 6 + which) * D;
}
__device__ __forceinline__ int ntok_of(int l) { return l == DEPTH - 1 ? SEQ : NTOK; }
struct KP : Params { int wb; };
__device__ __forceinline__ int otid(int wb) {
    int t; asm volatile("v_mbcnt_lo_u32_b32 %0, -1, 0\n\tv_mbcnt_hi_u32_b32 %0, -1, %0" : "=v"(t));
    return t | wb;
}

__device__ void phase_ada(const KP& p, int bid, int nb) {
    float* part = (float*)(p.ws + WS_MODP);
    const int tid = otid(p.wb);
    for (int u = bid; u < 2 * 6 * 32; u += nb) {
        const int l = u / (6 * 32), r = u % (6 * 32), cg = r / 32, kc = r % 32;
        const int n = cg * 2048 + tid * 4;
        const float* w = p.w_ada + (size_t)l * D * 12288 + (size_t)(kc * 64) * 12288 + n;
        f32x4 a0 = {0, 0, 0, 0}, a1 = {0, 0, 0, 0};
#pragma unroll 8
        for (int k = 0; k < 64; ++k) {
            const f32x4 wv = *(const f32x4*)(w + (size_t)k * 12288);
            const float c0 = siluf_(p.c[kc * 64 + k]), c1 = siluf_(p.c_ctx[kc * 64 + k]);
            a0 += wv * c0; a1 += wv * c1;
        }
        *(f32x4*)(part + ((size_t)((l * 2 + 0) * 32 + kc)) * 12288 + n) = a0;
        *(f32x4*)(part + ((size_t)((l * 2 + 1) * 32 + kc)) * 12288 + n) = a1;
    }
}
__device__ void phase_ada2(const KP& p, int bid, int nb) {
    const float* part = (const float*)(p.ws + WS_MODP);
    float* mod = (float*)(p.ws + WS_MOD);
    for (int i = bid * NT + otid(p.wb); i < 2 * 2 * 12288; i += nb * NT) {
        const int ls = i / 12288, n = i % 12288, l = ls >> 1;
        float acc = p.b_ada[(size_t)l * 12288 + n];
        for (int kc = 0; kc < 32; ++kc) acc += part[((size_t)(ls * 32 + kc)) * 12288 + n];
        mod[i] = acc;
    }
}

struct TJob { const float* src; bf16_t* dst; int K, N, batch; size_t sstride, dstride; int mode; };
__device__ __forceinline__ void tconv_pair(const TJob& j, int t0, float* tiles  , int tid) {
    const int half = tid >> 8, ht = tid & 255;
    float* tile = tiles + half * (64 * 65);
    const int tk = j.K / 64, tn = j.N / 64, ntl = j.batch * tk * tn;
    const int t = t0 + half;
    const bool on = t < ntl;
    const int b = t / (tk * tn), r = t % (tk * tn), kt = r / tn, nt = r % tn;
    __syncthreads();
    if (on) {
        const float* src = j.src + (size_t)b * j.sstride + (size_t)(kt * 64) * j.N + nt * 64;
#pragma unroll
        for (int i = 0; i < 4; ++i) {
            const int k = i * 16 + (ht >> 4), n = (ht & 15) * 4;
            const f32x4 v = *(const f32x4*)(src + (size_t)k * j.N + n);
            tile[k * 65 + n + 0] = v[0]; tile[k * 65 + n + 1] = v[1]; tile[k * 65 + n + 2] = v[2]; tile[k * 65 + n + 3] = v[3];
        }
    }
    __syncthreads();
    if (on) {
        const int n = ht >> 2, kq = (ht & 3) * 16;
        int ng = nt * 64 + n;
        if (j.mode == 1) ng = 32 * (ng >> 4) + (ng & 15);
        else if (j.mode == 2) ng = 32 * (ng >> 4) + 16 + (ng & 15);
        bf16_t* dst = j.dst + (size_t)b * j.dstride + (size_t)ng * j.K + kt * 64 + kq;
        u32x4 w0, w1;
#pragma unroll
        for (int i = 0; i < 4; ++i) { w0[i] = pack_bf2(tile[(kq + 2 * i) * 65 + n], tile[(kq + 2 * i + 1) * 65 + n]); w1[i] = pack_bf2(tile[(kq + 8 + 2 * i) * 65 + n], tile[(kq + 8 + 2 * i + 1) * 65 + n]); }
        *(u32x4*)(dst) = w0;
        *(u32x4*)(dst + 8) = w1;
    }
}
__device__ void phase_tconv(const TJob& j, int bid, int nb, float* tiles  , int wb) {
    const int tid = otid(wb);
    const int ntl = j.batch * (j.K / 64) * (j.N / 64);
    for (int t0 = bid * 2; t0 < ntl; t0 += nb * 2) tconv_pair(j, t0, tiles, tid);
}
__device__ void phase_convert_dense(const KP& p, int l, int bid, int nb, float* tile) {
    TJob j;
    j = {p.w_in + (size_t)l * D * INP, (bf16_t*)(p.ws + WS_WINT) + (size_t)l * INP_PAD * D, D, INP, 1, 0, 0, 0}; phase_tconv(j, bid, nb, tile, p.wb);
    j = {p.w_o + (size_t)l * D * D, (bf16_t*)(p.ws + WS_WOT) + (size_t)l * D * D, D, D, 1, 0, 0, 0}; phase_tconv(j, bid, nb, tile, p.wb);
}
constexpr int CQ_ITEM = 16;
constexpr int CQ_T_BIG = NE * (D / 64) * (EFF / 64);
constexpr int CQ_T_SH = (D / 64) * (EFF / 64);
constexpr int CQ_IPL = (3 * CQ_T_BIG + 3 * CQ_T_SH) / CQ_ITEM;
__device__ __forceinline__ void conv_item(const KP& p, int l, int item, float* tiles, int tid) {
    int t = item * CQ_ITEM;
    bf16_t* w13 = (bf16_t*)(p.ws + WS_W13T) + (size_t)l * NEX * 1024 * D;
    bf16_t* w2 = (bf16_t*)(p.ws + WS_W2T) + (size_t)l * NEX * D * EFF;
    TJob j;
    if (t < CQ_T_BIG) j = {p.moe_wg + (size_t)l * NE * D * EFF, w13, D, EFF, NE, (size_t)D * EFF, (size_t)1024 * D, 1};
    else if (t < 2 * CQ_T_BIG) { t -= CQ_T_BIG; j = {p.moe_wu + (size_t)l * NE * D * EFF, w13, D, EFF, NE, (size_t)D * EFF, (size_t)1024 * D, 2}; }
    else if (t < 3 * CQ_T_BIG) { t -= 2 * CQ_T_BIG; j = {p.moe_wd + (size_t)l * NE * EFF * D, w2, EFF, D, NE, (size_t)EFF * D, (size_t)D * EFF, 0}; }
    else if (t < 3 * CQ_T_BIG + CQ_T_SH) { t -= 3 * CQ_T_BIG; j = {p.sh_wg + (size_t)l * D * EFF, w13 + (size_t)NE * 1024 * D, D, EFF, 1, 0, 0, 1}; }
    else if (t < 3 * CQ_T_BIG + 2 * CQ_T_SH) { t -= 3 * CQ_T_BIG + CQ_T_SH; j = {p.sh_wu + (size_t)l * D * EFF, w13 + (size_t)NE * 1024 * D, D, EFF, 1, 0, 0, 2}; }
    else { t -= 3 * CQ_T_BIG + 2 * CQ_T_SH; j = {p.sh_wd + (size_t)l * EFF * D, w2 + (size_t)NE * D * EFF, EFF, D, 1, 0, 0, 0}; }
#pragma unroll 1
    for (int i = 0; i < CQ_ITEM; i += 2) tconv_pair(j, t + i, tiles, tid);
}
__device__ void conv_pull(const KP& p, int l, char* smem) {
    int* qhead = (int*)(p.ws + WS_CNT) + 200 + l;
    float* tiles = (float*)smem;
    int* sh = (int*)(smem + 2 * 64 * 65 * 4);
    const int tid = otid(p.wb);
    __syncthreads();
    if (tid == 0) sh[0] = __hip_atomic_fetch_add(qhead, 1, __ATOMIC_RELAXED, __HIP_MEMORY_SCOPE_AGENT);
    __syncthreads();
    int item = sh[0];
    while (item < CQ_IPL) {
        int nxt = 0;
        if (tid == 0) nxt = __hip_atomic_fetch_add(qhead, 1, __ATOMIC_RELAXED, __HIP_MEMORY_SCOPE_AGENT);
        conv_item(p, l, item, tiles, tid);
        __syncthreads();
        if (tid == 0) sh[0] = nxt;
        __syncthreads();
        item = sh[0];
    }
}

__device__ void phase_convert_lora(const KP& p, int bid, int nb) {
    bf16_t* WLT = (bf16_t*)(p.ws + WS_WLT);
    const int tid = otid(p.wb);
    for (int i = bid * NT + tid; i < 2 * D * NE; i += nb * NT) {
        const int l = i / (D * NE), r = i % (D * NE), k = r / NE, e = r % NE;
        const float x = p.moe_router[i];
        const bf16_t hi = f2bf(x); const bf16_t lo = f2bf(x - __uint_as_float((unsigned)hi << 16));
        bf16_t* rt = (bf16_t*)(p.ws + WS_RT) + (size_t)l * 2 * NE * D;
        rt[(size_t)e * D + k] = hi; rt[(size_t)NE * D + (size_t)e * D + k] = lo;
    }
    for (int i = bid * NT + tid; i < 192 * 16; i += nb * NT) {
        const int pos = i >> 4, f = i & 15;
        const float ang = (float)(pos < 128 ? pos : pos - 128) * powf(10000.f, -(float)f / 16.f);
        float* rt = (float*)(p.ws + WS_ROPE) + (size_t)i * 2;
        rt[0] = cosf(ang); rt[1] = sinf(ang);
    }
    for (int i = bid * NT + tid; i < 2 * RW * 384; i += nb * NT) {
        const int l = i / (RW * 384), r = i % (RW * 384), k = r / RW, c = r % RW;
        float v;
        if (k < 128) v = p.rw_w2[((size_t)l * 2 * 64 + k) * RW + c];
        else if (k < 256) v = p.rw_a2[((size_t)l * 2 * 64 + (k - 128)) * RW + c];
        else v = p.rw_g2[((size_t)l * 128 + (k - 256)) * RW + c];
        WLT[((size_t)l * RW + c) * 384 + k] = f2bf(v);
    }
}

__device__ void phase_norm1(const KP& p, int l, int bid, int nb) {
    const RowSrc in = layer_in(p, l);
    bf16_t* H = (bf16_t*)(p.ws + WS_H);
    const float* g = p.norm1_g + (size_t)l * D;
    const int tid = otid(p.wb), wid = tid >> 6, lane = tid & 63;
    for (int row = bid * 8 + wid; row < NTOK; row += nb * 8) {
        const float* xr = rowp(in, row);
        const float* sh = modp(p, l, row, 0);
        const float* sc = modp(p, l, row, 1);
        f32x4 v[8]; float ss = 0.f;
#pragma unroll
        for (int i = 0; i < 8; ++i) { v[i] = *(const f32x4*)(xr + i * 256 + lane * 4); ss += v[i][0] * v[i][0] + v[i][1] * v[i][1] + v[i][2] * v[i][2] + v[i][3] * v[i][3]; }
        ss = wave_sum(ss);
        const float rstd = rsqrtf(ss * (1.f / D) + 1e-6f);
#pragma unroll
        for (int i = 0; i < 8; ++i) {
            const int c = i * 256 + lane * 4;
            const f32x4 gv = *(const f32x4*)(g + c), shv = *(const f32x4*)(sh + c), scv = *(const f32x4*)(sc + c);
            float o[4];
#pragma unroll
            for (int j = 0; j < 4; ++j) { const float t = v[i][j] * rstd * gv[j]; o[j] = fmaf(t, scv[j], t) + shv[j]; }
            u32x2 w; w[0] = pack_bf2(o[0], o[1]); w[1] = pack_bf2(o[2], o[3]);
            *(u32x2*)(H + (size_t)row * D + c) = w;
        }
    }
}

constexpr int G_HT = 128 * 64;
constexpr int G_LDS = 8 * G_HT * 2;
__device__ __forceinline__ int g_lds_byte(int r, int c) {
    const int st = (r >> 4) * 2 + (c >> 5), rr = r & 15, cc = c & 31, ob = rr * 64 + cc * 2;
    return st * 1024 + (ob ^ (((ob >> 9) & 1) << 5));
}
__device__ __forceinline__ void g_stage_rc(int b, int& R, int& C) {
    const int st = b / 1024, sb = b % 1024, swz = sb ^ (((sb >> 9) & 1) << 5);
    R = (st >> 1) * 16 + swz / 64; C = (st & 1) * 32 + (swz % 64) / 2;
}
struct GOff { unsigned ao[2][2], bo; };
#define SA(b, h) (shm + ((b) * 2 + (h)) * G_HT)
#define SB(b, h) (shm + (4 + (b) * 2 + (h)) * G_HT)
#define STG_A(P, h, kt) do { _Pragma("unroll") for (int _i = 0; _i < 2; ++_i) \
    __builtin_amdgcn_global_load_lds((const unsigned*)((const char*)(A + (kt) * 64) + o.ao[h][_i]), (unsigned*)((char*)(P) + tz * 16 + _i * 8192), 16, 0, 0); } while (0)
#define STG_B(P, h, kt) do { _Pragma("unroll") for (int _i = 0; _i < 2; ++_i) \
    __builtin_amdgcn_global_load_lds((const unsigned*)((const char*)(Bt + ((h) * 128 + _i * 64) * K + (kt) * 64) + o.bo), (unsigned*)((char*)(P) + tz * 16 + _i * 8192), 16, 0, 0); } while (0)
template <bool PERM, class ARow>
__device__ __forceinline__ void gemm_offsets(ARow arow, const int K, const int wb, GOff& o) {
    const int tz = otid(wb);
    int r, c; g_stage_rc(tz * 16, r, c);
    const int rb = PERM ? ((r & ~31) + 8 * ((r & 15) >> 2) + 4 * ((r >> 4) & 1) + (r & 3)) : r;
    o.bo = (unsigned)((rb * K + c) * 2);
#pragma unroll
    for (int h = 0; h < 2; ++h)
#pragma unroll
        for (int i = 0; i < 2; ++i) o.ao[h][i] = (unsigned)((arow(h * 128 + i * 64 + r) + c) * 2);
}
__device__ __forceinline__ void gemm_issue(const bf16_t* __restrict__ A, const bf16_t* __restrict__ Bt, const int K, const GOff& o, bf16_t* shm, const int wb) {
    const int tz = otid(wb);
    STG_B(SB(0, 0), 0, 0); STG_A(SA(0, 0), 0, 0);
    STG_B(SB(0, 1), 1, 0); STG_A(SA(0, 1), 1, 0);
    STG_B(SB(1, 0), 0, 1); STG_A(SA(1, 0), 0, 1); STG_B(SB(1, 1), 1, 1);
}
__device__ __forceinline__ void gemm_main(const bf16_t* __restrict__ A, const bf16_t* __restrict__ Bt, const int K, const GOff& o, f32x4 (&acc)[2][2][4][2], bf16_t* shm, const int wb) {
#define LDA(dst, b, h) _Pragma("unroll") for (int m = 0; m < 4; ++m) _Pragma("unroll") for (int k = 0; k < 2; ++k) \
    dst[m][k] = *reinterpret_cast<const bf16x8*>((const char*)SA(b, h) + g_lds_byte(wr * 64 + m * 16 + fr, k * 32 + fq * 8))
#define LDB(dst, b, h) _Pragma("unroll") for (int n = 0; n < 2; ++n) _Pragma("unroll") for (int k = 0; k < 2; ++k) \
    dst[n][k] = *reinterpret_cast<const bf16x8*>((const char*)SB(b, h) + g_lds_byte(wc * 32 + n * 16 + fr, k * 32 + fq * 8))
#define MMA(ai, bj, Af, Bf) do { __builtin_amdgcn_s_setprio(1); \
    _Pragma("unroll") for (int m = 0; m < 4; ++m) _Pragma("unroll") for (int n = 0; n < 2; ++n) _Pragma("unroll") for (int k = 0; k < 2; ++k) \
        acc[ai][bj][m][n] = __builtin_amdgcn_mfma_f32_16x16x32_bf16(Bf[n][k], Af[m][k], acc[ai][bj][m][n], 0, 0, 0); \
    __builtin_amdgcn_s_setprio(0); } while (0)
#define WAIT_V(n) asm volatile("s_waitcnt vmcnt(" #n ")" ::: "memory")
#define WAIT_L(n) asm volatile("s_waitcnt lgkmcnt(" #n ")" ::: "memory")
#define BAR __builtin_amdgcn_s_barrier()
#define SCHED __builtin_amdgcn_sched_barrier(0)
    int tz = otid(wb);
    int wid = tz >> 6, lane = tz & 63, wr = wid >> 2, wc = wid & 3, fr = lane & 15, fq = lane >> 4;
#pragma unroll
    for (int a = 0; a < 2; ++a)
#pragma unroll
        for (int b = 0; b < 2; ++b)
#pragma unroll
            for (int m = 0; m < 4; ++m)
#pragma unroll
                for (int n = 0; n < 2; ++n) acc[a][b][m][n] = (f32x4){0.f, 0.f, 0.f, 0.f};
    bf16x8 At[4][2], B0[2][2], B1[2][2];
    const int nt = K / 64;
    WAIT_V(0); BAR;
    if (wr == 1) BAR;
    for (int t = 0; t < nt - 2; t += 2) {
        LDB(B0, 0, 0); SCHED; LDA(At, 0, 0); STG_A(SA(1, 1), 1, t + 1);
        WAIT_L(8); BAR; WAIT_L(0); MMA(0, 0, At, B0); BAR; SCHED;
        LDB(B1, 0, 1); STG_B(SB(0, 0), 0, t + 2);
        BAR; WAIT_L(0); MMA(0, 1, At, B1); BAR;
        LDA(At, 0, 1); STG_A(SA(0, 0), 0, t + 2);
        BAR; WAIT_L(0); MMA(1, 0, At, B0); BAR; SCHED;
        STG_B(SB(0, 1), 1, t + 2);
        WAIT_V(6); BAR; MMA(1, 1, At, B1); BAR;
        LDB(B0, 1, 0); SCHED; LDA(At, 1, 0); STG_A(SA(0, 1), 1, t + 2);
        WAIT_L(8); BAR; WAIT_L(0); MMA(0, 0, At, B0); BAR; SCHED;
        LDB(B1, 1, 1); STG_B(SB(1, 0), 0, t + 3);
        BAR; WAIT_L(0); MMA(0, 1, At, B1); BAR;
        LDA(At, 1, 1); STG_A(SA(1, 0), 0, t + 3);
        BAR; WAIT_L(0); MMA(1, 0, At, B0); BAR; SCHED;
        STG_B(SB(1, 1), 1, t + 3);
        WAIT_V(6); BAR; MMA(1, 1, At, B1); BAR;
    }
    { LDB(B0, 0, 0); WAIT_V(0); LDA(At, 0, 0); STG_A(SA(1, 1), 1, nt - 1);
      BAR; WAIT_L(0); MMA(0, 0, At, B0); BAR;
      LDB(B1, 0, 1); BAR; WAIT_L(0); MMA(0, 1, At, B1); BAR;
      LDA(At, 0, 1); WAIT_V(4); BAR; WAIT_L(0); MMA(1, 0, At, B0); MMA(1, 1, At, B1); BAR; }
    { LDB(B0, 1, 0); LDA(At, 1, 0); WAIT_V(2); BAR; WAIT_L(0); MMA(0, 0, At, B0); BAR;
      LDB(B1, 1, 1); WAIT_V(0); BAR; WAIT_L(0); MMA(0, 1, At, B1); BAR;
      LDA(At, 1, 1); BAR; WAIT_L(0); MMA(1, 0, At, B0); MMA(1, 1, At, B1); BAR; }
    if (wr == 0) BAR;
#undef LDA
#undef LDB
#undef MMA
#undef WAIT_V
#undef WAIT_L
#undef BAR
#undef SCHED
}
#undef SA
#undef SB
#undef STG_A
#undef STG_B
struct GU { const bf16_t* A; const bf16_t* Bt; int i0, i1, i2, i3; };
template <bool PERM, class Mk, class Row, class Epi>
__device__ __forceinline__ void gemm_phase(const int nwg, const int bid, const int nb, const int K, bf16_t* shm, const int wb, Mk mk, Row row, Epi epi) {
    int L = bid;
    if (L >= nwg) return;
    GU cur = mk(L);
    GOff oc;
    gemm_offsets<PERM>([&](int r) { return row(cur, r); }, K, wb, oc);
    gemm_issue(cur.A, cur.Bt, K, oc, shm, wb);
    for (;;) {
        f32x4 acc[2][2][4][2];
        gemm_main(cur.A, cur.Bt, K, oc, acc, shm, wb);
        const int Ln = L + nb;
        const bool more = Ln < nwg;
        GU nxt = cur; GOff on = oc;
        if (more) {
            nxt = mk(Ln);
            gemm_offsets<PERM>([&](int r) { return row(nxt, r); }, K, wb, on);
            gemm_issue(nxt.A, nxt.Bt, K, on, shm, wb);
        }
        epi(cur, acc);
        if (!more) break;
        cur = nxt; oc = on; L = Ln;
    }
}
#define G_IDX int _tz = otid(p.wb); const int _wid = _tz >> 6, _lane = _tz & 63, wr = _wid >> 2, wc = _wid & 3, fr = _lane & 15, fq = _lane >> 4
__device__ __forceinline__ int xcd_remap(int L, int nwg) {
    const int q = nwg / 8, r = nwg % 8, xcd = L % 8, off = L / 8;
    return (xcd < r ? xcd * (q + 1) : r * (q + 1) + (xcd - r) * q) + off;
}
__device__ __forceinline__ void dense_tile(int wgid, int nM, int nN, int& pm, int& pn) {
    const int nig = 8 * nN, gid = wgid / nig, fm = gid * 8, gsz = (nM - fm) < 8 ? (nM - fm) : 8;
    pm = fm + ((wgid % nig) % gsz); pn = (wgid % nig) / gsz;
}

__device__ void phase_inproj(const KP& p, int l, int bid, int nb, bf16_t* shm) {
    const bf16_t* H = (const bf16_t*)(p.ws + WS_H);
    const bf16_t* Bt = (const bf16_t*)(p.ws + WS_WINT) + (size_t)l * INP_PAD * D;
    float* P = (float*)(p.ws + WS_P);
    constexpr int nM = NTOK / 256, nN = INP_PAD / 256, nwg = nM * nN;
    gemm_phase<false>(nwg, bid, nb, D, shm, p.wb,
        [&](int L) { int pm, pn; dense_tile(xcd_remap(L, nwg), nM, nN, pm, pn); GU u; u.A = H; u.Bt = Bt + (size_t)(pn * 256) * D; u.i0 = pm * 256; u.i1 = pn * 256; u.i2 = 0; u.i3 = 0; return u; },
        [&](const GU& u, int r) { return (u.i0 + r) * D; },
        [&](const GU& u, f32x4 (&acc)[2][2][4][2]) {
            const int m0 = u.i0, n0 = u.i1;
            G_IDX;
#pragma unroll
            for (int ai = 0; ai < 2; ++ai)
#pragma unroll
                for (int m = 0; m < 4; ++m) {
                    float* prow = P + (size_t)(m0 + ai * 128 + wr * 64 + m * 16 + fr) * INP + n0 + wc * 32 + fq * 4;
#pragma unroll
                    for (int bj = 0; bj < 2; ++bj)
#pragma unroll
                        for (int n = 0; n < 2; ++n)
                            if (n0 + bj * 128 + wc * 32 + n * 16 + fq * 4 < INP) *(f32x4*)(prow + bj * 128 + n * 16) = acc[ai][bj][m][n];
                }
        });
}

__device__ __forceinline__ int scan_pos(int d, int row) {
    if (row >= SEQ) { const int c = row - SEQ; return d == 0 ? c : (CTXL - 1 - c); }
    return CTXL + (d == 0 ? row : (SEQ - 1 - row));
}
__device__ __forceinline__ int scan_row(int d, int s) {
    if (s < CTXL) return SEQ + (d == 0 ? s : (CTXL - 1 - s));
    const int q = s - CTXL; return d == 0 ? q : (SEQ - 1 - q);
}
constexpr int RP_TB = 11;
constexpr int RP_LD = 392;
__device__ __forceinline__ f32x4 shifted4(const float* P, int row, int col, const float* mu) {
    const f32x4 cur = *(const f32x4*)(P + (size_t)row * INP + col);
    const bool first = (row == 0) || (row == SEQ), last = (row == SEQ - 1) || (row == NTOK - 1);
    f32x4 prev = {0.f, 0.f, 0.f, 0.f}, nxt = {0.f, 0.f, 0.f, 0.f};
    if (!first) prev = *(const f32x4*)(P + (size_t)(row - 1) * INP + col);
    if (!last) nxt = *(const f32x4*)(P + (size_t)(row + 1) * INP + col);
    const f32x4 m0 = *(const f32x4*)(mu + col), m1 = *(const f32x4*)(mu + RWP + col);
    return cur + m0 * (prev - cur) + m1 * (nxt - cur);
}
__device__ __forceinline__ float shifted(const float* P, int row, int col, float mu0, float mu1) {
    const float cur = P[(size_t)row * INP + col];
    const bool first = (row == 0) || (row == SEQ), last = (row == SEQ - 1) || (row == NTOK - 1);
    const float prev = first ? 0.f : P[(size_t)(row - 1) * INP + col];
    const float nxt = last ? 0.f : P[(size_t)(row + 1) * INP + col];
    return cur + mu0 * (prev - cur) + mu1 * (nxt - cur);
}
__device__ void phase_rwprep(const KP& p, int l, int bid, int nb, char* smem) {
    const float* P = (const float*)(p.ws + WS_P);
    float* REC = (float*)(p.ws + WS_REC);
    float* G = (float*)(p.ws + WS_G);
    float* BV = (float*)(p.ws + WS_BV);
    float* GMR = (float*)(p.ws + WS_GMR);
    const bf16_t* WLT = (const bf16_t*)(p.ws + WS_WLT) + (size_t)l * RW * 384;
    bf16_t* lin = (bf16_t*)smem;
    const float* mu = p.rw_mu + (size_t)l * 2 * RWP;
    const float* w0 = p.rw_w0 + (size_t)l * 2 * RW;
    const float* a0 = p.rw_a0 + (size_t)l * 2 * RW;
    const float* kkw = p.rw_kk + (size_t)l * RW;
    const float* kaw = p.rw_ka + (size_t)l * RW;
    const float* rkw = p.rw_rk + (size_t)l * RW;
    const int tid = otid(p.wb), wid = tid >> 6, lane = tid & 63, t16 = lane & 15, g = lane >> 4;
    for (int blk = bid; blk < NTOK / RP_TB; blk += nb) {
        const int t0 = blk * RP_TB;
        __syncthreads();
        for (int i = tid; i < RP_TB * 384; i += NT) {
            const int tt = i / 384, j = i % 384, col = 1536 + j;
            const float v = shifted(P, t0 + tt, col, mu[col], mu[RWP + col]);
            lin[tt * RP_LD + j] = f2bf(j < 128 ? ftanh(v) : (j < 256 ? v : sigmoidf_(v)));
        }
        __syncthreads();
        for (int q = wid; q < RP_TB; q += 8) {
            const int row = t0 + q; float ss = 0.f;
#pragma unroll
            for (int i = 0; i < 8; ++i) { const float gv = gelu_tanh(P[(size_t)row * INP + COL_GM + GMW + i * 64 + lane]); ss += gv * gv; }
            ss = wave_sum(ss);
            if (lane == 0) GMR[row] = rsqrtf(ss * (1.f / GMW) + 1e-6f);
        }
        const bool live = t16 < RP_TB;
        const int row = t0 + (live ? t16 : RP_TB - 1);
        float nrm2 = 0.f, bon = 0.f;
#pragma unroll
        for (int tl = 0; tl < 4; ++tl) {
            const int c = wid * 64 + tl * 16 + g * 4;
            const f32x4 r4 = shifted4(P, row, c, mu), k4 = shifted4(P, row, 512 + c, mu);
            const f32x4 kq = k4 * *(const f32x4*)(kkw + c), rk = *(const f32x4*)(rkw + c);
#pragma unroll
            for (int e = 0; e < 4; ++e) { nrm2 += kq[e] * kq[e]; bon += r4[e] * k4[e] * rk[e]; }
        }
        nrm2 += bperm(nrm2, lane ^ 16); nrm2 += bperm(nrm2, lane ^ 32);
        bon += bperm(bon, lane ^ 16); bon += bperm(bon, lane ^ 32);
        const float inrm = 1.f / fmaxf(sqrtf(nrm2), 1e-12f);
        const bf16_t* lrow = lin + (live ? t16 : RP_TB - 1) * RP_LD + g * 8;
#pragma unroll 2
        for (int tl = 0; tl < 4; ++tl) {
            f32x4 acc[5];
#pragma unroll
            for (int m = 0; m < 5; ++m) acc[m] = (f32x4){0.f, 0.f, 0.f, 0.f};
            const bf16_t* wrow = WLT + (size_t)(wid * 64 + tl * 16 + t16) * 384 + g * 8;
#pragma unroll
            for (int ks = 0; ks < 12; ++ks) {
                const int m = ks < 8 ? (ks >> 1) : 4;
                acc[m] = __builtin_amdgcn_mfma_f32_16x16x32_bf16(*(const bf16x8*)(wrow + ks * 32), *(const bf16x8*)(lrow + ks * 32), acc[m], 0, 0, 0);
            }
            const int c = wid * 64 + tl * 16 + g * 4, ci = tl * 16 + g * 4;
            const f32x4 r4 = shifted4(P, row, c, mu), k4 = shifted4(P, row, 512 + c, mu), v4 = shifted4(P, row, 1024 + c, mu);
            const f32x4 kq = k4 * *(const f32x4*)(kkw + c) * inrm;
            if (live) {
                *(f32x4*)(G + (size_t)row * RW + c) = acc[4];
                *(f32x4*)(BV + (size_t)row * RW + c) = v4 * bon;
            }
            const f32x4 ka = *(const f32x4*)(kaw + c);
#pragma unroll
            for (int d = 0; d < 2; ++d) {
                const f32x4 w0v = *(const f32x4*)(w0 + d * RW + c), a0v = *(const f32x4*)(a0 + d * RW + c);
                f32x4 decay, av, kd;
#pragma unroll
                for (int e = 0; e < 4; ++e) {
                    const float wlog = -softplusf_(-(w0v[e] + acc[d][e])) - 0.5f;
                    decay[e] = fexp(-fexp(wlog));
                    av[e] = sigmoidf_(a0v[e] + acc[2 + d][e]);
                    kd[e] = k4[e] * (1.f + (av[e] - 1.f) * ka[e]);
                }
                if (live) {
                    float* rec = REC + ((size_t)(d * 8 + wid) * NTOK + scan_pos(d, row)) * 384 + ci;
                    *(f32x4*)(rec) = decay; *(f32x4*)(rec + 64) = kq; *(f32x4*)(rec + 128) = kq * av;
                    *(f32x4*)(rec + 192) = kd; *(f32x4*)(rec + 256) = r4; *(f32x4*)(rec + 320) = v4;
                }
            }
        }
    }
}

constexpr int SC_TS = 16;
constexpr int SCAN_BLOCKS = 128;
constexpr int SC_OPB = SC_TS * 384;
constexpr int SC_SBW = SC_TS * 64 * 4;
constexpr int SC_LDS = (2 * SC_OPB + 2 * 2 * SC_SBW) * 4;
#define SC_LD(slot, s) { const float* b_ = buf + (s) * 384 + 4 * l16; qw[slot] = *(const f32x4*)(b_); qk[slot] = *(const f32x4*)(b_ + 64); \
    qb[slot] = *(const f32x4*)(b_ + 128); qd[slot] = *(const f32x4*)(b_ + 192); qv[slot] = buf[(s) * 384 + 320 + i]; }
__device__ __forceinline__ void scan_chunk(const float* buf, float* sb, int l16, int lane, int i, f32x4& S) {
    f32x4 qw[3], qk[3], qb[3], qd[3]; float qv[3];
    SC_LD(0, 0); SC_LD(1, 1);
#pragma unroll
    for (int s = 0; s < SC_TS; ++s) {
        const int sl = s % 3;
        if (s + 2 < SC_TS) SC_LD((s + 2) % 3, s + 2);
        const f32x4 pk = S * qk[sl];
        const float sa = -red16((pk[0] + pk[1]) + (pk[2] + pk[3]));
        S = (S * qw[sl] + qd[sl] * qv[sl]) + qb[sl] * sa;
        *(f32x4*)(sb + (s * 64 + lane) * 4) = S;
    }
}
#define SC_LOAD(R, ch) { const float* _g = rec + (size_t)(ch) * SC_OPB + lt * 4; _Pragma("unroll") for (int q = 0; q < 12; ++q) R[q] = *(const f32x4*)(_g + q * 512); }
#define SC_WRITE(R, B) { float* _l = (B) + lt * 4; _Pragma("unroll") for (int q = 0; q < 12; ++q) *(f32x4*)(_l + q * 512) = R[q]; }
__device__ void phase_scan(const KP& p, int bid, char* smem) {
    const float* REC = (const float*)(p.ws + WS_REC);
    float* YD = (float*)(p.ws + WS_YD);
    float* B0 = (float*)smem;
    float* B1 = B0 + SC_OPB;
    float* SB0 = B1 + SC_OPB;
    float* SB1 = SB0 + 2 * SC_SBW;
    const int tid = otid(p.wb), wid = tid >> 6, lane = tid & 63, l16 = lane & 15;
    const int xcd = bid & 7, slot = bid >> 3, dh = xcd * 2 + (slot >> 3), rq = slot & 7;
    const int d = dh >> 3, h = dh & 7;
    const float* rec = REC + (size_t)dh * NTOK * 384;
    constexpr int NCH = NTOK / SC_TS;
    if (wid >= 6) {
        __syncthreads();
        for (int c = 0; c <= NCH; ++c) __syncthreads();
    } else if (wid >= 4) {
        const int lt = tid - 256;
        f32x4 R0[12], R1[12];
        SC_LOAD(R0, 0); SC_WRITE(R0, B0);
        SC_LOAD(R1, 1); SC_LOAD(R0, 2);
        __syncthreads();
        for (int c = 0; c < NCH; c += 2) {
            if (c + 1 < NCH) SC_WRITE(R1, B1);
            if (c + 3 < NCH) SC_LOAD(R1, c + 3);
            __syncthreads();
            if (c + 2 < NCH) SC_WRITE(R0, B0);
            if (c + 4 < NCH) SC_LOAD(R0, c + 4);
            __syncthreads();
        }
        __syncthreads();
    } else if (wid >= 2) {
        const int cw = wid - 2, dstep = d == 0 ? 1 : -1;
        float* yout = YD + (size_t)d * NTOK * RW + h * 64 + rq * 8 + cw * 4 + (lane >> 4);
        f32x4 rr[SC_TS];
#define SC_RLOAD(B) { _Pragma("unroll") for (int s = 0; s < SC_TS; ++s) rr[s] = *(const f32x4*)((B) + s * 384 + 256 + 4 * l16); }
#define SC_READOUT(SB, ch) { float yv = 0.f; \
            _Pragma("unroll") for (int s = 0; s < SC_TS; ++s) { const f32x4 sv = *(const f32x4*)((SB) + cw * SC_SBW + (s * 64 + lane) * 4); const f32x4 py = sv * rr[s]; \
                const float y = red16((py[0] + py[1]) + (py[2] + py[3])); yv = (l16 == s) ? y : yv; } \
            yout[(size_t)(scan_row(d, (ch) * SC_TS) + dstep * l16) * RW] = yv; }
        __syncthreads();
        SC_RLOAD(B0);
        __syncthreads();
        for (int c = 1; c < NCH; c += 2) {
            SC_READOUT(SB0, c - 1); SC_RLOAD(B1);
            __syncthreads();
            SC_READOUT(SB1, c);
            if (c + 1 < NCH) SC_RLOAD(B0);
            __syncthreads();
        }
    } else {
        const int i = rq * 8 + wid * 4 + (lane >> 4);
        f32x4 S = {0.f, 0.f, 0.f, 0.f};
        __syncthreads();
        for (int c = 0; c < NCH; c += 2) {
            scan_chunk(B0, SB0 + wid * SC_SBW, l16, lane, i, S);
            __syncthreads();
            scan_chunk(B1, SB1 + wid * SC_SBW, l16, lane, i, S);
            __syncthreads();
        }
        __syncthreads();
    }
}

constexpr int CK = 16, NCHK = NTOK / CK;
constexpr int FR_B = 12800;
constexpr int FR_AT = 0, FR_RT = 2048, FR_SM = 4096, FR_BT = 6144  , FR_VF = 10240, FR_GC = 12288;
template <int SH> __device__ __forceinline__ float row_shr1(float v) {
    return __int_as_float(__builtin_amdgcn_update_dpp(0x3f800000, __float_as_int(v), 0x110 + SH, 0xf, 0xf, false));
}
__device__ __forceinline__ bf16x8 frag8(const float (&v)[16], int q) {
    u32x4 w; w[0] = pack_bf2(v[4 * q], v[4 * q + 1]); w[1] = pack_bf2(v[4 * q + 2], v[4 * q + 3]); w[2] = pack_bf2(v[4 * q + 4], v[4 * q + 5]); w[3] = pack_bf2(v[4 * q + 6], v[4 * q + 7]);
    return __builtin_bit_cast(bf16x8, w);
}
__device__ __forceinline__ bf16x8 frag4(const f32x4 a) {
    u32x4 w; w[0] = pack_bf2(a[0], a[1]); w[1] = pack_bf2(a[2], a[3]); w[2] = 0u; w[3] = 0u;
    return __builtin_bit_cast(bf16x8, w);
}
__device__ __forceinline__ bf16x8 frag4u(unsigned lo, unsigned hi) { u32x4 w; w[0] = lo; w[1] = hi; w[2] = 0u; w[3] = 0u; return __builtin_bit_cast(bf16x8, w); }
#define MM(a, b, c) __builtin_amdgcn_mfma_f32_16x16x32_bf16(a, b, c, 0, 0, 0)
__device__ void phase_cprep(const KP& p, int bid, int nb, char* smem) {
    const float* REC = (const float*)(p.ws + WS_REC);
    char* FR = p.ws + WS_FR;
    const int tid = otid(p.wb), wid = tid >> 6, lane = tid & 63, t = lane & 15, g = lane >> 4;
    bf16_t* zt = (bf16_t*)smem + wid * 2048;
    const f32x4 Z4 = {0.f, 0.f, 0.f, 0.f};
    for (int u = bid * 8 + wid; u < 16 * NCHK; u += nb * 8) {
        const int dh = u / NCHK, c = u % NCHK;
        const float* rrow = REC + ((size_t)dh * NTOK + c * CK + t) * 384;
        float w_[16], kk[16], bb[16], kd[16], rr[16];
#pragma unroll
        for (int q = 0; q < 4; ++q) {
            const int jo = 32 * (q >> 1) + 16 * (q & 1) + 4 * g;
            const f32x4 a0 = *(const f32x4*)(rrow + jo), a1 = *(const f32x4*)(rrow + 64 + jo), a2 = *(const f32x4*)(rrow + 128 + jo), a3 = *(const f32x4*)(rrow + 192 + jo), a4 = *(const f32x4*)(rrow + 256 + jo);
#pragma unroll
            for (int e = 0; e < 4; ++e) { w_[4 * q + e] = a0[e]; kk[4 * q + e] = a1[e]; bb[4 * q + e] = a2[e]; kd[4 * q + e] = a3[e]; rr[4 * q + e] = a4[e]; }
        }
        float gam[16], At[16], Bh[16], Kh[16], Rt[16], Bt[16], Kt[16];
#pragma unroll
        for (int k = 0; k < 16; ++k) {
            float x = w_[k];
            x *= row_shr1<1>(x); x *= row_shr1<2>(x); x *= row_shr1<4>(x); x *= row_shr1<8>(x);
            gam[k] = x;
        }
#pragma unroll
        for (int k = 0; k < 16; ++k) {
            const float gp = row_shr1<1>(gam[k]), gc = bperm(gam[k], (lane & 48) | 15), ig = frcp(gam[k]);
            At[k] = kk[k] * gp; Bh[k] = bb[k] * ig; Kh[k] = kd[k] * ig; Rt[k] = rr[k] * gam[k];
            Bt[k] = -Bh[k] * gc; Kt[k] = Kh[k] * gc;
        }
        const bf16x8 fA0 = frag8(At, 0), fA1 = frag8(At, 2), fB0 = frag8(Bh, 0), fB1 = frag8(Bh, 2), fK0 = frag8(Kh, 0), fK1 = frag8(Kh, 2), fR0 = frag8(Rt, 0), fR1 = frag8(Rt, 2);
        f32x4 X = MM(fA1, fB1, MM(fA0, fB0, Z4));
        f32x4 XT = MM(fB1, fA1, MM(fB0, fA0, Z4));
        f32x4 Lak = MM(fA1, fK1, MM(fA0, fK0, Z4));
        f32x4 LrbT = MM(fB1, fR1, MM(fB0, fR0, Z4));
        f32x4 LrkT = MM(fK1, fR1, MM(fK0, fR0, Z4));
        f32x4 T, TT;
#pragma unroll
        for (int r = 0; r < 4; ++r) {
            const int row = 4 * g + r;
            X[r] = t < row ? -X[r] : 0.f;
            XT[r] = row < t ? -XT[r] : 0.f;
            Lak[r] = t < row ? Lak[r] : 0.f;
            LrbT[r] = row <= t ? -LrbT[r] : 0.f;
            LrkT[r] = row <= t ? LrkT[r] : 0.f;
            const float id = row == t ? 1.f : 0.f;
            T[r] = id + X[r]; TT[r] = id + XT[r];
        }
#pragma unroll
        for (int it = 0; it < 3; ++it) {
            const f32x4 X2 = MM(frag4(XT), frag4(X), Z4), X2T = MM(frag4(X), frag4(XT), Z4);
            const f32x4 Tn = MM(frag4(TT), frag4(X2), T), TTn = MM(frag4(X2), frag4(TT), TT);
            X = X2; XT = X2T; T = Tn; TT = TTn;
        }
        const f32x4 TLT = MM(frag4(Lak), frag4(TT), Z4);
#pragma unroll
        for (int q = 0; q < 4; ++q)
#pragma unroll
            for (int e = 0; e < 4; ++e) {
                const int j = 32 * (q >> 1) + 16 * (q & 1) + 4 * g + e;
                zt[j * 16 + t] = f2bf(Bt[4 * q + e]); zt[1024 + j * 16 + t] = f2bf(Kt[4 * q + e]);
            }
        char* fb = FR + ((size_t)dh * NCHK + c) * FR_B;
        *(bf16x8*)(fb + FR_AT + lane * 16) = fA0; *(bf16x8*)(fb + FR_AT + 1024 + lane * 16) = fA1;
        *(bf16x8*)(fb + FR_RT + lane * 16) = fR0; *(bf16x8*)(fb + FR_RT + 1024 + lane * 16) = fR1;
        {
            u32x4 s0, s1;
            s0[0] = pack_bf2(TT[0], TT[1]); s0[1] = pack_bf2(TT[2], TT[3]); s0[2] = pack_bf2(TLT[0], TLT[1]); s0[3] = pack_bf2(TLT[2], TLT[3]);
            s1[0] = pack_bf2(LrbT[0], LrbT[1]); s1[1] = pack_bf2(LrbT[2], LrbT[3]); s1[2] = pack_bf2(LrkT[0], LrkT[1]); s1[3] = pack_bf2(LrkT[2], LrkT[3]);
            *(u32x4*)(fb + FR_SM + lane * 32) = s0; *(u32x4*)(fb + FR_SM + lane * 32 + 16) = s1;
        }
#pragma unroll
        for (int jt = 0; jt < 4; ++jt) {
            {
                const u32x2 b2 = *(const u32x2*)(zt + (16 * jt + t) * 16 + 4 * g), k2 = *(const u32x2*)(zt + 1024 + (16 * jt + t) * 16 + 4 * g);
                u32x4 bk; bk[0] = b2[0]; bk[1] = b2[1]; bk[2] = k2[0]; bk[3] = k2[1];
                *(u32x4*)(fb + FR_BT + jt * 1024 + lane * 16) = bk;
            }
            const float* vp = REC + ((size_t)dh * NTOK + c * CK + 4 * g) * 384 + 320 + 16 * jt + t;
            u32x2 vw; vw[0] = pack_bf2(vp[0], vp[384]); vw[1] = pack_bf2(vp[768], vp[1152]);
            *(u32x2*)(fb + FR_VF + jt * 512 + lane * 8) = vw;
        }
        if (t == 15) {
#pragma unroll
            for (int q = 0; q < 4; ++q) { f32x4 gv = {gam[4 * q], gam[4 * q + 1], gam[4 * q + 2], gam[4 * q + 3]}; *(f32x4*)(fb + FR_GC + (32 * (q >> 1) + 16 * (q & 1) + 4 * g) * 4) = gv; }
        }
    }
}

constexpr int CS_BLOCKS = 16, CS_R = 3;
__device__ void phase_cscan(const KP& p, int bid, char* smem) {
    const char* FRs = p.ws + WS_FR + (size_t)bid * NCHK * FR_B;
    float* YD = (float*)(p.ws + WS_YD);
    const int tid = otid(p.wb), wid = tid >> 6, lane = tid & 63, c16 = lane & 15, g = lane >> 4;
    const int d = bid >> 3, h = bid & 7;
    if (wid >= 4) {
        const int lw = wid - 4;
        const bool tail = lw == 0 && lane < 16;
        u32x4 fifo[8][4];
#define CS_LD(k, ch) { const char* _s = FRs + (size_t)(ch) * FR_B + lane * 16; \
            _Pragma("unroll") for (int _q = 0; _q < 3; ++_q) fifo[k][_q] = *(const u32x4*)(_s + (lw + 4 * _q) * 1024); \
            if (tail) fifo[k][3] = *(const u32x4*)(_s + 12288); }
#define CS_WR(k, ch) { char* _d = smem + ((ch) % CS_R) * FR_B + lane * 16; \
            _Pragma("unroll") for (int _q = 0; _q < 3; ++_q) *(u32x4*)(_d + (lw + 4 * _q) * 1024) = fifo[k][_q]; \
            if (tail) *(u32x4*)(_d + 12288) = fifo[k][3]; }
#define CS_BAR() { asm volatile("" ::: "memory"); __builtin_amdgcn_s_barrier(); asm volatile("" ::: "memory"); }
#define CS_PERIOD(r) { if (pch + (r) + 1 < NCHK) CS_WR(((r) + 1) & 7, pch + (r) + 1); if (pch + (r) + 9 < NCHK) CS_LD(((r) + 1) & 7, pch + (r) + 9); CS_BAR(); }
        CS_LD(0, 0); CS_LD(1, 1); CS_LD(2, 2); CS_LD(3, 3); CS_LD(4, 4); CS_LD(5, 5); CS_LD(6, 6); CS_LD(7, 7);
        CS_WR(0, 0); CS_LD(0, 8);
        CS_BAR();
        for (int pch = 0; pch < NCHK; pch += 8) {
            CS_PERIOD(0); CS_PERIOD(1); CS_PERIOD(2); CS_PERIOD(3); CS_PERIOD(4); CS_PERIOD(5); CS_PERIOD(6); CS_PERIOD(7);
        }
    } else {
        const int it = wid, dstep = d == 0 ? 1 : -1;
        float* yout = YD + (size_t)d * NTOK * RW + h * 64 + it * 16 + c16;
        const f32x4 Z4 = {0.f, 0.f, 0.f, 0.f};
        f32x4 ST[4] = {Z4, Z4, Z4, Z4};
        asm volatile("" ::: "memory"); __builtin_amdgcn_s_barrier(); asm volatile("" ::: "memory");
        for (int pch = 0; pch < NCHK; ++pch) {
            const char* sb = smem + (pch % CS_R) * FR_B;
            const bf16x8 A0 = *(const bf16x8*)(sb + FR_AT + lane * 16), A1 = *(const bf16x8*)(sb + FR_AT + 1024 + lane * 16);
            const bf16x8 R0 = *(const bf16x8*)(sb + FR_RT + lane * 16), R1 = *(const bf16x8*)(sb + FR_RT + 1024 + lane * 16);
            const bf16x8 TTL = *(const bf16x8*)(sb + FR_SM + lane * 32), LRR = *(const bf16x8*)(sb + FR_SM + lane * 32 + 16);
            const u32x2 vf = *(const u32x2*)(sb + FR_VF + it * 512 + lane * 8);
            u32x4 b0, b1;
            b0[0] = pack_bf2(ST[0][0], ST[0][1]); b0[1] = pack_bf2(ST[0][2], ST[0][3]); b0[2] = pack_bf2(ST[1][0], ST[1][1]); b0[3] = pack_bf2(ST[1][2], ST[1][3]);
            b1[0] = pack_bf2(ST[2][0], ST[2][1]); b1[1] = pack_bf2(ST[2][2], ST[2][3]); b1[2] = pack_bf2(ST[3][0], ST[3][1]); b1[3] = pack_bf2(ST[3][2], ST[3][3]);
            const bf16x8 Bs0 = __builtin_bit_cast(bf16x8, b0), Bs1 = __builtin_bit_cast(bf16x8, b1);
            const f32x4 Q = MM(A1, Bs1, MM(A0, Bs0, Z4));
            u32x4 qv; qv[0] = pack_bf2(Q[0], Q[1]); qv[1] = pack_bf2(Q[2], Q[3]); qv[2] = vf[0]; qv[3] = vf[1];
            const f32x4 P = MM(TTL, __builtin_bit_cast(bf16x8, qv), Z4);
            u32x4 pv; pv[0] = pack_bf2(P[0], P[1]); pv[1] = pack_bf2(P[2], P[3]); pv[2] = vf[0]; pv[3] = vf[1];
            const bf16x8 PV = __builtin_bit_cast(bf16x8, pv);
            const f32x4 Y = MM(LRR, PV, MM(R1, Bs1, MM(R0, Bs0, Z4)));
#pragma unroll
            for (int jt = 0; jt < 4; ++jt) {
                const f32x4 gc = *(const f32x4*)(sb + FR_GC + (16 * jt + 4 * g) * 4);
                const bf16x8 bk = *(const bf16x8*)(sb + FR_BT + jt * 1024 + lane * 16);
                ST[jt] = MM(bk, PV, ST[jt] * gc);
            }
            const int row0 = scan_row(d, pch * CK) + dstep * 4 * g;
#pragma unroll
            for (int r = 0; r < 4; ++r) yout[(size_t)(row0 + dstep * r) * RW] = Y[r];
            asm volatile("" ::: "memory"); __builtin_amdgcn_s_barrier(); asm volatile("" ::: "memory");
        }
    }
}
#undef MM

__device__ void phase_rwpost(const KP& p, int l, int bid, int nb) {
    const float* YD = (const float*)(p.ws + WS_YD);
    const float* G = (const float*)(p.ws + WS_G);
    const float* BV = (const float*)(p.ws + WS_BV);
    bf16_t* Y = (bf16_t*)(p.ws + WS_YCAT);
    const float* lng = p.rw_ln_g + (size_t)l * RW;
    const float* lnb = p.rw_ln_b + (size_t)l * RW;
    const int tid = otid(p.wb), wid = tid >> 6, lane = tid & 63;
    for (int u = bid * 8 + wid; u < NTOK * 8; u += nb * 8) {
        const int row = u >> 3, h = u & 7, c = h * 64 + lane;
        const float y = YD[(size_t)row * RW + c] + YD[((size_t)NTOK + row) * RW + c];
        const float mean = wave_sum(y) * (1.f / 64);
        const float dv = y - mean;
        const float var = wave_sum(dv * dv) * (1.f / 64);
        const float yn = dv * rsqrtf(var + 64e-5f) * lng[c] + lnb[c];
        Y[(size_t)row * D + c] = f2bf((yn + BV[(size_t)row * RW + c]) * G[(size_t)row * RW + c]);
    }
}

constexpr int GM_LD = 136;
__device__ void phase_gmlp(const KP& p, int l, int bid, int nb, char* smem) {
    const float* P = (const float*)(p.ws + WS_P);
    const float* GMR = (const float*)(p.ws + WS_GMR);
    bf16_t* Y = (bf16_t*)(p.ws + WS_YCAT);
    bf16_t* vt = (bf16_t*)smem;
    const float* ng = p.gm_norm_g + (size_t)l * GMW;
    const int tid = otid(p.wb), wid = tid >> 6, lane = tid & 63, r = lane & 31, h = lane >> 5, mt = wid >> 1, nt = wid & 1;
    for (int u = bid; u < (NTOK / 128) * 8; u += nb) {
        const int n = u >> 3, g = u & 7, t0 = n * 128;
        const float* ws = p.gm_ws + ((size_t)l * 8 + g) * 128 * 128;
        const float* bs = p.gm_b + ((size_t)l * 8 + g) * 128;
        __syncthreads();
        {
            const int c = tid & 63, qp0 = tid >> 6;
            const float gn = ng[g * 64 + c];
#pragma unroll
            for (int i = 0; i < 8; ++i) {
                const int q = (qp0 + 8 * i) * 2;
                const float v0 = gelu_tanh(P[(size_t)(t0 + q) * INP + COL_GM + GMW + g * 64 + c]) * GMR[t0 + q] * gn;
                const float v1 = gelu_tanh(P[(size_t)(t0 + q + 1) * INP + COL_GM + GMW + g * 64 + c]) * GMR[t0 + q + 1] * gn;
                *(unsigned*)(vt + c * GM_LD + q) = pack_bf2(v0, v1);
            }
        }
        __syncthreads();
        f32x16 acc;
#pragma unroll
        for (int i = 0; i < 16; ++i) acc[i] = 0.f;
        const float* arow = ws + (size_t)(mt * 32 + r) * 128 + h * 8;
#pragma unroll
        for (int ks = 0; ks < 8; ++ks) {
            const f32x4 a0 = *(const f32x4*)(arow + ks * 16), a1 = *(const f32x4*)(arow + ks * 16 + 4);
            u32x4 aw; aw[0] = pack_bf2(a0[0], a0[1]); aw[1] = pack_bf2(a0[2], a0[3]); aw[2] = pack_bf2(a1[0], a1[1]); aw[3] = pack_bf2(a1[2], a1[3]);
            const bf16x8 bfr = *(const bf16x8*)(vt + (nt * 32 + r) * GM_LD + ks * 16 + h * 8);
            acc = __builtin_amdgcn_mfma_f32_32x32x16_bf16(__builtin_bit_cast(bf16x8, aw), bfr, acc, 0, 0, 0);
        }
        const int c = nt * 32 + r;
#pragma unroll
        for (int i = 0; i < 16; ++i) {
            const int pp = mt * 32 + (i & 3) + 8 * (i >> 2) + 4 * h;
            const float uu = gelu_tanh(P[(size_t)(t0 + pp) * INP + COL_GM + g * 64 + c]);
            Y[(size_t)(t0 + pp) * D + 512 + g * 64 + c] = f2bf(uu * (acc[i] + bs[pp]));
        }
    }
}

__device__ void phase_atprep(const KP& p, int l, int bid, int nb, char* smem) {
    const float* P = (const float*)(p.ws + WS_P);
    bf16_t* Qb = (bf16_t*)(p.ws + WS_Q);
    bf16_t* Kb = (bf16_t*)(p.ws + WS_K);
    bf16_t* VT = Kb + (size_t)NTOK * 256;
    const float* qn = p.at_qn + (size_t)l * 64;
    const float* kn = p.at_kn + (size_t)l * 64;
    const int tid = otid(p.wb);
    const float* rope = (const float*)(p.ws + WS_ROPE);
    for (int i = bid * NT + tid; i < NTOK * 20; i += nb * NT) {
        const int row = i / 20, hv = i % 20;
        const bool isq = hv < 16;
        const float* src = P + (size_t)row * INP + (isq ? COL_AT + hv * 64 : COL_K + (hv - 16) * 64);
        const float* gn = isq ? qn : kn;
        f32x4 x[16]; float ss = 0.f;
#pragma unroll
        for (int k = 0; k < 16; ++k) { x[k] = *(const f32x4*)(src + 4 * k); ss += x[k][0] * x[k][0] + x[k][1] * x[k][1] + x[k][2] * x[k][2] + x[k][3] * x[k][3]; }
        const float sc = rsqrtf(ss * (1.f / 64) + 1e-6f) * (isq ? 0.125f : 1.f);
#pragma unroll
        for (int k = 0; k < 16; ++k) x[k] = x[k] * *(const f32x4*)(gn + 4 * k) * sc;
        if (row < SEQ) {
#pragma unroll
            for (int sec = 0; sec < 2; ++sec) {
                const float* rt = rope + (size_t)((sec == 0 ? (row >> 6) : (128 + (row & 63))) * 16) * 2;
#pragma unroll
                for (int k = 0; k < 4; ++k) {
                    const f32x4 c0 = *(const f32x4*)(rt + 8 * k), c1 = *(const f32x4*)(rt + 8 * k + 4);
                    f32x4& a = x[8 * sec + k]; f32x4& b2 = x[8 * sec + 4 + k];
                    const float cs[4] = {c0[0], c0[2], c1[0], c1[2]}, sn[4] = {c0[1], c0[3], c1[1], c1[3]};
#pragma unroll
                    for (int e = 0; e < 4; ++e) { const float x1 = a[e], x2 = b2[e]; a[e] = x1 * cs[e] - x2 * sn[e]; b2[e] = x2 * cs[e] + x1 * sn[e]; }
                }
            }
        }
        bf16_t* dst = isq ? (Qb + (size_t)row * 1024 + hv * 64) : (Kb + (size_t)row * 256 + (hv - 16) * 64);
#pragma unroll
        for (int k = 0; k < 8; ++k) {
            u32x4 w; w[0] = pack_bf2(x[2 * k][0], x[2 * k][1]); w[1] = pack_bf2(x[2 * k][2], x[2 * k][3]); w[2] = pack_bf2(x[2 * k + 1][0], x[2 * k + 1][1]); w[3] = pack_bf2(x[2 * k + 1][2], x[2 * k + 1][3]);
            *(u32x4*)(dst + 8 * k) = w;
        }
    }
    float* tile = (float*)smem;
    for (int u = bid; u < (NTOK / 64) * 4; u += nb) {
        const int t0 = (u >> 2) * 64, kvh = u & 3;
        __syncthreads();
        {
            const int tok = tid >> 3, d8 = (tid & 7) * 8;
            const float* src = P + (size_t)(t0 + tok) * INP + COL_V + kvh * 64 + d8;
            const f32x4 a = *(const f32x4*)src, b2 = *(const f32x4*)(src + 4);
#pragma unroll
            for (int i = 0; i < 4; ++i) { tile[tok * 65 + d8 + i] = a[i]; tile[tok * 65 + d8 + 4 + i] = b2[i]; }
        }
        __syncthreads();
        {
            const int d = tid >> 3, tk = (tid & 7) * 8;
            u32x4 w;
#pragma unroll
            for (int i = 0; i < 4; ++i) w[i] = pack_bf2(tile[(tk + 2 * i) * 65 + d], tile[(tk + 2 * i + 1) * 65 + d]);
            *(u32x4*)(VT + (size_t)(kvh * 64 + d) * NTOK + t0 + tk) = w;
        }
    }
}

constexpr int AT_LD = 72;
constexpr int AT_TILE = 64 * AT_LD;
__device__ void phase_attn(const KP& p, int l, int bid, int nb, char* smem) {
    const bf16_t* Qb = (const bf16_t*)(p.ws + WS_Q);
    const bf16_t* Kb = (const bf16_t*)(p.ws + WS_K);
    const bf16_t* VT = Kb + (size_t)NTOK * 256;
    bf16_t* Y = (bf16_t*)(p.ws + WS_YCAT);
    bf16_t* Kc = (bf16_t*)smem;
    bf16_t* Vc = Kc + AT_TILE;
    const int tid = otid(p.wb), wid = tid >> 6, lane = tid & 63, q = lane & 31, h = lane >> 5, g = wid >> 1, qh = wid & 1;
    const int srow = tid >> 3, sseg = tid & 7;
    const int voff = srow * AT_LD + (sseg >> 2) * 32 + ((sseg >> 1) & 1) * 16 + (sseg & 1) * 4;
    for (int u = bid; u < (NTOK / 64) * 4; u += nb) {
        const int qt = u >> 2, kvh = u & 3, t0 = qt * 64, head = kvh * 4 + g, qrow = t0 + qh * 32 + q;
        int c_lo = 0, n_local = 0;
        if (t0 < SEQ) { c_lo = 2 - (t0 >> 6); if (c_lo < 0) c_lo = 0; int c_hi = (SEQ + 64 - t0) >> 6; if (c_hi > 4) c_hi = 4; n_local = c_hi - c_lo + 1; }
        const int nch = n_local + 4;
        bf16x8 qf[4];
#pragma unroll
        for (int ks = 0; ks < 4; ++ks) qf[ks] = *(const bf16x8*)(Qb + (size_t)qrow * 1024 + head * 64 + ks * 16 + h * 8);
        f32x16 O0, O1;
#pragma unroll
        for (int r = 0; r < 16; ++r) { O0[r] = 0.f; O1[r] = 0.f; }
        float m = p.at_sink[(size_t)l * 16 + head], lsum = h == 0 ? 1.f : 0.f;
        u32x4 rk, rv;
        {
            const int k0 = n_local > 0 ? (t0 - 128 + 64 * c_lo) : SEQ;
            rk = *(const u32x4*)(Kb + (size_t)(k0 + srow) * 256 + kvh * 64 + sseg * 8);
            rv = *(const u32x4*)(VT + (size_t)(kvh * 64 + srow) * NTOK + k0 + sseg * 8);
        }
        for (int ci = 0; ci < nch; ++ci) {
            const bool local = ci < n_local;
            const int k0 = local ? (t0 - 128 + 64 * (c_lo + ci)) : (SEQ + 64 * (ci - n_local));
            __syncthreads();
            *(u32x4*)(Kc + srow * AT_LD + sseg * 8) = rk;
            { u32x2 lo, hi; lo[0] = rv[0]; lo[1] = rv[1]; hi[0] = rv[2]; hi[1] = rv[3]; *(u32x2*)(Vc + voff) = lo; *(u32x2*)(Vc + voff + 8) = hi; }
            __syncthreads();
            if (ci + 1 < nch) {
                const int kn = (ci + 1 < n_local) ? (t0 - 128 + 64 * (c_lo + ci + 1)) : (SEQ + 64 * (ci + 1 - n_local));
                rk = *(const u32x4*)(Kb + (size_t)(kn + srow) * 256 + kvh * 64 + sseg * 8);
                rv = *(const u32x4*)(VT + (size_t)(kvh * 64 + srow) * NTOK + kn + sseg * 8);
            }
            f32x16 s0, s1;
#pragma unroll
            for (int r = 0; r < 16; ++r) { s0[r] = 0.f; s1[r] = 0.f; }
#pragma unroll
            for (int ks = 0; ks < 4; ++ks) {
                const bf16x8 k0f = *(const bf16x8*)(Kc + q * AT_LD + ks * 16 + h * 8);
                const bf16x8 k1f = *(const bf16x8*)(Kc + (32 + q) * AT_LD + ks * 16 + h * 8);
                s0 = __builtin_amdgcn_mfma_f32_32x32x16_bf16(k0f, qf[ks], s0, 0, 0, 0);
                s1 = __builtin_amdgcn_mfma_f32_32x32x16_bf16(k1f, qf[ks], s1, 0, 0, 0);
            }
            if (local) {
                const int base = k0 + 4 * h - qrow;
#pragma unroll
                for (int r = 0; r < 16; ++r) {
                    const int d0 = base + (r & 3) + 8 * (r >> 2), d1 = d0 + 32;
                    if (d0 > 128 || d0 < -128) s0[r] = -INFINITY;
                    if (d1 > 128 || d1 < -128) s1[r] = -INFINITY;
                }
            }
            float mx = fmaxf(s0[0], s1[0]);
#pragma unroll
            for (int r = 1; r < 16; ++r) mx = fmaxf(mx, fmaxf(s0[r], s1[r]));
            mx = fmaxf(mx, bperm(mx, lane ^ 32));
            const float mnew = fmaxf(m, mx);
            const float alpha = __expf(m - mnew);
            m = mnew; lsum *= alpha;
#pragma unroll
            for (int r = 0; r < 16; ++r) { O0[r] *= alpha; O1[r] *= alpha; }
            float ps = 0.f;
#pragma unroll
            for (int r = 0; r < 16; ++r) { s0[r] = __expf(s0[r] - m); s1[r] = __expf(s1[r] - m); ps += s0[r] + s1[r]; }
            lsum += ps;
            bf16x8 pf[2][2];
#pragma unroll
            for (int s = 0; s < 2; ++s) {
                u32x4 w0, w1;
#pragma unroll
                for (int i = 0; i < 4; ++i) { w0[i] = pack_bf2(s0[8 * s + 2 * i], s0[8 * s + 2 * i + 1]); w1[i] = pack_bf2(s1[8 * s + 2 * i], s1[8 * s + 2 * i + 1]); }
                pf[0][s] = __builtin_bit_cast(bf16x8, w0); pf[1][s] = __builtin_bit_cast(bf16x8, w1);
            }
#pragma unroll
            for (int kb = 0; kb < 2; ++kb)
#pragma unroll
                for (int s = 0; s < 2; ++s) {
                    const bf16x8 v0f = *(const bf16x8*)(Vc + q * AT_LD + kb * 32 + s * 16 + h * 8);
                    const bf16x8 v1f = *(const bf16x8*)(Vc + (32 + q) * AT_LD + kb * 32 + s * 16 + h * 8);
                    O0 = __builtin_amdgcn_mfma_f32_32x32x16_bf16(v0f, pf[kb][s], O0, 0, 0, 0);
                    O1 = __builtin_amdgcn_mfma_f32_32x32x16_bf16(v1f, pf[kb][s], O1, 0, 0, 0);
                }
        }
        lsum += bperm(lsum, lane ^ 32);
        const float inv = 1.f / lsum;
        bf16_t* yo = Y + (size_t)qrow * D + 1024 + head * 64 + 4 * h;
#pragma unroll
        for (int rg = 0; rg < 4; ++rg) {
            u32x2 w0, w1;
            w0[0] = pack_bf2(O0[4 * rg] * inv, O0[4 * rg + 1] * inv); w0[1] = pack_bf2(O0[4 * rg + 2] * inv, O0[4 * rg + 3] * inv);
            w1[0] = pack_bf2(O1[4 * rg] * inv, O1[4 * rg + 1] * inv); w1[1] = pack_bf2(O1[4 * rg + 2] * inv, O1[4 * rg + 3] * inv);
            *(u32x2*)(yo + 8 * rg) = w0;
            *(u32x2*)(yo + 32 + 8 * rg) = w1;
        }
    }
}

__device__ void phase_oproj(const KP& p, int l, int bid, int nb, bf16_t* shm) {
    const bf16_t* Y = (const bf16_t*)(p.ws + WS_YCAT);
    const bf16_t* Bt = (const bf16_t*)(p.ws + WS_WOT) + (size_t)l * D * D;
    const RowSrc in = layer_in(p, l);
    const RowDst out = layer_out(p, l);
    const int nM = ntok_of(l) / 256, nN = D / 256, nwg = nM * nN;
    gemm_phase<false>(nwg, bid, nb, D, shm, p.wb,
        [&](int L) { int pm, pn; dense_tile(xcd_remap(L, nwg), nM, nN, pm, pn); GU u; u.A = Y; u.Bt = Bt + (size_t)(pn * 256) * D; u.i0 = pm * 256; u.i1 = pn * 256; u.i2 = 0; u.i3 = 0; return u; },
        [&](const GU& u, int r) { return (u.i0 + r) * D; },
        [&](const GU& u, f32x4 (&acc)[2][2][4][2]) {
            const int m0 = u.i0, n0 = u.i1;
            G_IDX;
#pragma unroll
            for (int ai = 0; ai < 2; ++ai)
#pragma unroll
                for (int m = 0; m < 4; ++m) {
                    const int row = m0 + ai * 128 + wr * 64 + m * 16 + fr;
                    const float* xi = rowp(in, row);
                    float* xo = rowp(out, row);
                    const float* g1 = modp(p, l, row, 2);
#pragma unroll
                    for (int bj = 0; bj < 2; ++bj)
#pragma unroll
                        for (int n = 0; n < 2; ++n) {
                            const int col = n0 + bj * 128 + wc * 32 + n * 16 + fq * 4;
                            *(f32x4*)(xo + col) = *(const f32x4*)(xi + col) + *(const f32x4*)(g1 + col) * acc[ai][bj][m][n];
                        }
                }
        });
}

constexpr int RT_R = 11;
constexpr int RT_LD = D + 8;
__device__ void phase_norm2_route(const KP& p, int l, int bid, int nb, char* smem, const bool dummy = false) {
    const RowDst xs = layer_out(p, l);
    bf16_t* H = (bf16_t*)(p.ws + WS_H);
    int* cnt = (int*)(p.ws + WS_CNT) + l * 64 + (dummy ? 128 : 0);
    int* tokE = (int*)(p.ws + WS_TOKE);
    int* tokP = (int*)(p.ws + WS_TOKP);
    float* tokW = (float*)(p.ws + WS_TOKW);
    const float* g = p.norm2_g + (size_t)l * D;
    const bf16_t* RTH = (const bf16_t*)(p.ws + WS_RT) + (size_t)l * 2 * NE * D;
    const bf16_t* RTL = RTH + (size_t)NE * D;
    const float* rbias = p.moe_bias + (size_t)l * NE;
    bf16_t* hh = (bf16_t*)smem;
    bf16_t* hl = hh + RT_R * RT_LD;
    float* part = (float*)(hl + RT_R * RT_LD);
    int* lcnt = (int*)(part + 8 * 64 * 16);
    int* lbase = lcnt + 64;
    int* lsel = lbase + 64;
    const int tid = otid(p.wb), wid = tid >> 6, lane = tid & 63, c16 = lane & 15, g4 = lane >> 4;
    const int ntok = ntok_of(l), nsteps = (ntok + RT_R - 1) / RT_R;
    __syncthreads();
    if (tid < 64) lcnt[tid] = 0;
    for (int i = tid; i < 4 * RT_R * 8; i += NT) lsel[i] = -1;
    int step = 0;
    for (int blk = bid; blk < nsteps; blk += nb, ++step) {
        const int t0 = blk * RT_R;
        __syncthreads();
        {
            int rrq[2], rowq[2]; bool liveq[2]; const float* xrq[2]; const float* shq[2]; const float* scq[2];
            f32x4 v[2][8]; float ss[2];
#pragma unroll
            for (int q = 0; q < 2; ++q) {
                rrq[q] = wid + 8 * q; liveq[q] = rrq[q] < RT_R && t0 + rrq[q] < ntok;
                rowq[q] = liveq[q] ? t0 + rrq[q] : ntok - 1;
                xrq[q] = rowp(xs, rowq[q]); shq[q] = modp(p, l, rowq[q], 3); scq[q] = modp(p, l, rowq[q], 4); ss[q] = 0.f;
            }
#pragma unroll
            for (int i = 0; i < 8; ++i)
#pragma unroll
                for (int q = 0; q < 2; ++q) { v[q][i] = *(const f32x4*)(xrq[q] + i * 256 + lane * 4); ss[q] += v[q][i][0] * v[q][i][0] + v[q][i][1] * v[q][i][1] + v[q][i][2] * v[q][i][2] + v[q][i][3] * v[q][i][3]; }
            float rstd[2];
#pragma unroll
            for (int q = 0; q < 2; ++q) rstd[q] = rsqrtf(wave_sum(ss[q]) * (1.f / D) + 1e-6f);
#pragma unroll
            for (int i = 0; i < 8; ++i) {
                const int c = i * 256 + lane * 4;
                const f32x4 gv = *(const f32x4*)(g + c);
#pragma unroll
                for (int q = 0; q < 2; ++q) {
                    const f32x4 shv = *(const f32x4*)(shq[q] + c), scv = *(const f32x4*)(scq[q] + c);
                    float o[4]; unsigned hi[4]; float lo[4];
#pragma unroll
                    for (int j = 0; j < 4; ++j) { const float t = v[q][i][j] * rstd[q] * gv[j]; o[j] = fmaf(t, scv[j], t) + shv[j]; hi[j] = f2bf(o[j]); lo[j] = o[j] - __uint_as_float(hi[j] << 16); }
                    u32x2 wh, wl; wh[0] = hi[0] | (hi[1] << 16); wh[1] = hi[2] | (hi[3] << 16); wl[0] = pack_bf2(lo[0], lo[1]); wl[1] = pack_bf2(lo[2], lo[3]);
                    if (rrq[q] < RT_R) { *(u32x2*)(hh + rrq[q] * RT_LD + c) = wh; *(u32x2*)(hl + rrq[q] * RT_LD + c) = wl; }
                    if (liveq[q]) *(u32x2*)(H + (size_t)rowq[q] * D + c) = wh;
                }
            }
        }
        __syncthreads();
        {
            f32x4 acc[4];
#pragma unroll
            for (int et = 0; et < 4; ++et) acc[et] = (f32x4){0.f, 0.f, 0.f, 0.f};
            const int hr = c16 < RT_R ? c16 : RT_R - 1;
            const bf16_t* bh = hh + hr * RT_LD + wid * 256 + g4 * 8;
            const bf16_t* bl = hl + hr * RT_LD + wid * 256 + g4 * 8;
            const bf16_t* ah = RTH + (size_t)c16 * D + wid * 256 + g4 * 8;
            const bf16_t* al = RTL + (size_t)c16 * D + wid * 256 + g4 * 8;
#pragma unroll 2
            for (int ks = 0; ks < 8; ++ks) {
                const bf16x8 bhf = *(const bf16x8*)(bh + ks * 32), blf = *(const bf16x8*)(bl + ks * 32);
#pragma unroll
                for (int et = 0; et < 4; ++et) {
                    const bf16x8 ahf = *(const bf16x8*)(ah + (size_t)et * 16 * D + ks * 32), alf = *(const bf16x8*)(al + (size_t)et * 16 * D + ks * 32);
                    acc[et] = __builtin_amdgcn_mfma_f32_16x16x32_bf16(ahf, bhf, acc[et], 0, 0, 0);
                    acc[et] = __builtin_amdgcn_mfma_f32_16x16x32_bf16(ahf, blf, acc[et], 0, 0, 0);
                    acc[et] = __builtin_amdgcn_mfma_f32_16x16x32_bf16(alf, bhf, acc[et], 0, 0, 0);
                }
            }
#pragma unroll
            for (int et = 0; et < 4; ++et)
#pragma unroll
                for (int r = 0; r < 4; ++r) part[(wid * 64 + et * 16 + g4 * 4 + r) * 16 + c16] = acc[et][r];
        }
        __syncthreads();
        {
            bool liveq[2]; int rowq[2]; float score[2], biased[2], val[2]; int sel[2];
#pragma unroll
            for (int q = 0; q < 2; ++q) {
                const int rr = wid + 8 * q;
                liveq[q] = rr < RT_R && t0 + rr < ntok; rowq[q] = t0 + rr;
                const int rc = rr < RT_R ? rr : RT_R - 1;
                float logit = 0.f;
#pragma unroll
                for (int kq = 0; kq < 8; ++kq) logit += part[(kq * 64 + lane) * 16 + rc];
                score[q] = sigmoidf_(logit); biased[q] = score[q] + rbias[lane]; sel[q] = -1;
            }
            const int gbase = lane & ~7, mygrp = lane >> 3;
#pragma unroll
            for (int q = 0; q < 2; ++q) {
                const float m1 = max8(biased[q]);
                const unsigned long long eq = __ballot(biased[q] == m1);
                const unsigned geq = (unsigned)((eq >> gbase) & 0xffull);
                const int first = gbase + (__ffs(geq) - 1);
                const float m2 = max8((lane == first) ? -INFINITY : biased[q]);
                const float gs = m1 + m2;
                int rank = 0;
#pragma unroll
                for (int k = 0; k < 8; ++k) { const float o = bperm(gs, k * 8); rank += (o > gs || (o == gs && k < mygrp)) ? 1 : 0; }
                val[q] = rank < 4 ? biased[q] : -INFINITY;
            }
#pragma unroll
            for (int j = 0; j < TOPK; ++j)
#pragma unroll
                for (int q = 0; q < 2; ++q) {
                    const float mx = wave_max(val[q]);
                    const unsigned long long bm = __ballot(val[q] == mx);
                    const int win = __ffsll((long long)bm) - 1;
                    if (lane == win) { sel[q] = j; val[q] = -INFINITY; }
                }
#pragma unroll
            for (int q = 0; q < 2; ++q) {
                const float ssum = wave_sum(sel[q] >= 0 ? score[q] : 0.f);
                if (liveq[q] && sel[q] >= 0) {
                    const int lr = atomicAdd(lcnt + lane, 1);
                    lsel[((step * RT_R) + (wid + 8 * q)) * 8 + sel[q]] = (lane << 16) | lr;
                    if (!dummy) { tokE[(size_t)rowq[q] * 8 + sel[q]] = lane; tokW[(size_t)rowq[q] * 8 + sel[q]] = score[q] * frcp(ssum) * 2.5f; }
                }
            }
        }
    }
    __syncthreads();
    if (tid < 64) lbase[tid] = atomicAdd(cnt + tid, lcnt[tid]);
    __syncthreads();
    if (!dummy)
        for (int i = tid; i < step * RT_R * 8; i += NT) {
            const int v = lsel[i];
            if (v < 0) continue;
            const int st = i / (RT_R * 8), rr = (i / 8) % RT_R, j = i & 7;
            const int row = (bid + st * nb) * RT_R + rr;
            tokP[(size_t)row * 8 + j] = lbase[v >> 16] + (v & 0xffff);
        }
}

__device__ void phase_slots(const KP& p, int l, int bid, int nb, char* smem) {
    const int* cnt = (const int*)(p.ws + WS_CNT) + l * 64;
    const int* tokE = (const int*)(p.ws + WS_TOKE);
    const int* tokP = (const int*)(p.ws + WS_TOKP);
    int* slotT = (int*)(p.ws + WS_SLOTT);
    int* tile = (int*)(p.ws + WS_TILE);
    int* tokS = (int*)(p.ws + WS_TOKS);
    int* off = (int*)smem;
    const int tid = otid(p.wb);
    const int ntok = ntok_of(l);
    __syncthreads();
    if (tid == 0) {
        int o = 0;
        for (int e = 0; e < NE; ++e) { off[e] = o; o += (cnt[e] + 255) / 256 * 256; }
        off[NE] = o; off[NE + 1] = o + ntok;
    }
    __syncthreads();
    int nbo = nb; asm volatile("" : "+s"(nbo));
    const int gt = bid * NT + tid, gs = nbo * NT;
    for (int i = gt; i < ntok * 8; i += gs) { const int e = tokE[i]; const int s = off[e] + tokP[i]; slotT[s] = i >> 3; tokS[i] = s; }
    for (int i = gt; i < ntok; i += gs) slotT[off[NE] + i] = i;
    for (int i = gt; i < NE * 256; i += gs) { const int e = i >> 8, j = i & 255; const int s = off[e] + cnt[e] + j; if (s < off[e + 1]) slotT[s] = -1; }
    if (bid == 0) {
        const int nt = off[NE + 1] / 256;
        if (tid == 0) tile[0] = nt;
        for (int i = tid; i < nt; i += NT) {
            const int s = i * 256; int e = 0;
            for (int k = 1; k <= NE; ++k) if (s >= off[k]) e = k;
            tile[1 + i] = e;
        }
    }
}

__device__ void phase_moe1(const KP& p, int l, int bid, int nb, bf16_t* shm) {
    const bf16_t* H = (const bf16_t*)(p.ws + WS_H);
    const bf16_t* W13 = (const bf16_t*)(p.ws + WS_W13T) + (size_t)l * NEX * 1024 * D;
    const int* slotT = (const int*)(p.ws + WS_SLOTT);
    const int* tile = (const int*)(p.ws + WS_TILE);
    bf16_t* ACT = (bf16_t*)(p.ws + WS_ACT);
    const int nt = tile[0], nwg = nt * 4;
    gemm_phase<false>(nwg, bid, nb, D, shm, p.wb,
        [&](int L) { const int wg = xcd_remap(L, nwg), ti = wg >> 2, ct = wg & 3, e = tile[1 + ti]; GU u; u.A = H; u.Bt = W13 + ((size_t)e * 1024 + ct * 256) * D; u.i0 = ti * 256; u.i1 = ct * 256; u.i2 = 0; u.i3 = 0; return u; },
        [&](const GU& u, int r) { const int t = slotT[u.i0 + r]; return (t < 0 ? 0 : t) * D; },
        [&](const GU& u, f32x4 (&acc)[2][2][4][2]) {
            const int s0 = u.i0, n0 = u.i1;
            G_IDX;
#pragma unroll
            for (int ai = 0; ai < 2; ++ai)
#pragma unroll
                for (int m = 0; m < 4; ++m) {
                    const int slot = s0 + ai * 128 + wr * 64 + m * 16 + fr;
#pragma unroll
                    for (int bj = 0; bj < 2; ++bj) {
                        const int ch = (n0 + bj * 128 + wc * 32) / 2 + fq * 4;
                        float a[4];
#pragma unroll
                        for (int r = 0; r < 4; ++r) a[r] = siluf_(acc[ai][bj][m][0][r]) * acc[ai][bj][m][1][r];
                        u32x2 w; w[0] = pack_bf2(a[0], a[1]); w[1] = pack_bf2(a[2], a[3]);
                        *(u32x2*)(ACT + (size_t)slot * EFF + ch) = w;
                    }
                }
        });
}

__device__ void phase_moe2(const KP& p, int l, int bid, int nb, bf16_t* shm) {
    const bf16_t* ACT = (const bf16_t*)(p.ws + WS_ACT);
    const bf16_t* W2 = (const bf16_t*)(p.ws + WS_W2T) + (size_t)l * NEX * D * EFF;
    const int* tile = (const int*)(p.ws + WS_TILE);
    const int* slotT = (const int*)(p.ws + WS_SLOTT);
    bf16_t* OUTS = (bf16_t*)(p.ws + WS_OUTS);
    const int nt = tile[0], nwg = nt * 8;
    for (int k = (bid >> 3) & 3; k > 0; --k) __builtin_amdgcn_s_sleep(127);
    gemm_phase<true>(nwg, bid, nb, EFF, shm, p.wb,
        [&](int L) { const int wg = xcd_remap(L, nwg), ti = wg >> 3, ct = wg & 7, e = tile[1 + ti]; GU u; u.A = ACT; u.Bt = W2 + ((size_t)e * D + ct * 256) * EFF; u.i0 = ti * 256; u.i1 = ct * 256; u.i2 = 0; u.i3 = 0; return u; },
        [&](const GU& u, int r) { return (u.i0 + r) * EFF; },
        [&](const GU& u, f32x4 (&acc)[2][2][4][2]) {
            const int s0 = u.i0, n0 = u.i1;
            G_IDX;
#pragma unroll
            for (int ai = 0; ai < 2; ++ai)
#pragma unroll
                for (int m = 0; m < 4; ++m) {
                    const int slot = s0 + ai * 128 + wr * 64 + m * 16 + fr;
                    if (slotT[slot] < 0) continue;
                    bf16_t* orow = OUTS + (size_t)slot * D + n0 + wc * 32 + fq * 8;
#pragma unroll
                    for (int bj = 0; bj < 2; ++bj) {
                        u32x4 w;
                        w[0] = pack_bf2(acc[ai][bj][m][0][0], acc[ai][bj][m][0][1]); w[1] = pack_bf2(acc[ai][bj][m][0][2], acc[ai][bj][m][0][3]);
                        w[2] = pack_bf2(acc[ai][bj][m][1][0], acc[ai][bj][m][1][1]); w[3] = pack_bf2(acc[ai][bj][m][1][2], acc[ai][bj][m][1][3]);
                        *(u32x4*)(orow + bj * 128) = w;
                    }
                }
        });
}

__device__ void phase_combine(const KP& p, int l, int bid, int nb, char* smem, const bool dummy = false) {
    const bf16_t* OUTS = (const bf16_t*)(p.ws + WS_OUTS);
    const int* tokS = (const int*)(p.ws + WS_TOKS);
    const float* tokW = (const float*)(p.ws + WS_TOKW);
    const int* cnt = (const int*)(p.ws + WS_CNT) + l * 64;
    const RowDst out = layer_out(p, l);
    int* sh0 = (int*)smem;
    const int tid = otid(p.wb), half = tid >> 8, ht = tid & 255;
    __syncthreads();
    if (tid == 0) { int o = 0; for (int e = 0; e < NE; ++e) o += (cnt[e] + 255) / 256 * 256; sh0[0] = o; }
    __syncthreads();
    const int shared0 = sh0[0];
    const int ntok = ntok_of(l);
    for (int row = bid * 2 + half; row < ntok; row += nb * 2) {
        float* xr = rowp(out, row);
        const float* g2 = modp(p, l, row, 5);
        const int c = ht * 8;
        float acc[8];
        {
            const u32x4 v = *(const u32x4*)(OUTS + (size_t)(shared0 + row) * D + c);
#pragma unroll
            for (int q = 0; q < 4; ++q) { acc[2 * q] = __uint_as_float(v[q] << 16); acc[2 * q + 1] = __uint_as_float(v[q] & 0xffff0000u); }
        }
#pragma unroll
        for (int j = 0; j < TOPK; ++j) {
            const int s = tokS[(size_t)row * 8 + j]; const float w = tokW[(size_t)row * 8 + j];
            const u32x4 v = *(const u32x4*)(OUTS + (size_t)s * D + c);
#pragma unroll
            for (int q = 0; q < 4; ++q) { acc[2 * q] += w * __uint_as_float(v[q] << 16); acc[2 * q + 1] += w * __uint_as_float(v[q] & 0xffff0000u); }
        }
        const f32x4 g0 = *(const f32x4*)(g2 + c), g1 = *(const f32x4*)(g2 + c + 4);
        f32x4 x0 = *(const f32x4*)(xr + c), x1 = *(const f32x4*)(xr + c + 4);
#pragma unroll
        for (int q = 0; q < 4; ++q) { x0[q] += g0[q] * acc[q]; x1[q] += g1[q] * acc[4 + q]; }
        if (!dummy || x0[0] == 1234.5f) { *(f32x4*)(xr + c) = x0; *(f32x4*)(xr + c + 4) = x1; }
    }
}

#define XB_TMO      128
#define XB_XCNT(j)  (256  + 64 * (j))
#define XB_XSUB(j)  (1280 + 64 * (j))
#define XB_XGEN(j)  (2304 + 64 * (j))
#define XB_TOP      3328
#define XB_TOPGEN   3392
#define XCD_BAR_WORDS 3456
#define XB_SPIN_CAP (1u << 18)
#define LAS __attribute__((address_space(3)))

__device__ __forceinline__ unsigned xb_ld(unsigned* p)              { return __hip_atomic_load(p, __ATOMIC_RELAXED, __HIP_MEMORY_SCOPE_AGENT); }
__device__ __forceinline__ unsigned xb_add(unsigned* p, unsigned v) { return __hip_atomic_fetch_add(p, v, __ATOMIC_RELAXED, __HIP_MEMORY_SCOPE_AGENT); }
__device__ __forceinline__ unsigned xb_xcc_id() { return (unsigned)__builtin_amdgcn_s_getreg((3 << 11) | 20) & 0xFu; }
#define XB_SPIN(cond, bar) do { unsigned _sp = 0; while (cond) { __builtin_amdgcn_s_sleep(1); \
    if ((++_sp & 255u) == 0u) { if (xb_ld(&(bar)[XB_TMO])) break; if (_sp > XB_SPIN_CAP) { atomicAdd(&(bar)[XB_TMO], 1u); break; } } } } while (0)

struct XcdBarrier {
    unsigned* bar; unsigned x;
    volatile LAS unsigned* st;
};
__device__ __forceinline__ XcdBarrier xcd_barrier_post(unsigned* bar, volatile LAS unsigned* st) {
    XcdBarrier b; b.bar = bar; b.x = (unsigned)__builtin_amdgcn_readfirstlane((int)xb_xcc_id()); b.st = st;
    if (threadIdx.x == 0) (void)xb_add(&bar[XB_XCNT(b.x)], 1u);
    return b;
}
__device__ __forceinline__ void xcd_barrier_complete(unsigned* bar, unsigned x, unsigned& nloc, unsigned& nx) {
    const unsigned G = gridDim.x * gridDim.y * gridDim.z;
    unsigned sum, cnt, mine, sp = 0u;
    for (;;) {
        sum = 0u; cnt = 0u; mine = 0u;
#pragma unroll
        for (unsigned j = 0; j < 16; ++j) { const unsigned c = xb_ld(&bar[XB_XCNT(j)]); sum += c; cnt += (c > 0u) ? 1u : 0u; mine = (j == x) ? c : mine; }
        if (sum == G) break;
        __builtin_amdgcn_s_sleep(1);
        if ((++sp & 255u) == 0u) { if (xb_ld(&bar[XB_TMO])) break; if (sp > XB_SPIN_CAP) { atomicAdd(&bar[XB_TMO], 1u); break; } }
    }
    nloc = mine > 0u ? mine : 1u; nx = cnt > 0u ? cnt : 1u;
}
__device__ __forceinline__ void xcd_barrier(const XcdBarrier& b) {
    asm volatile("s_waitcnt vmcnt(0)" ::: "memory");
    __syncthreads();
    unsigned bx = b.x; asm volatile("" : "+s"(bx));
    if (threadIdx.x == 0) {
        unsigned* bar = b.bar;
        __builtin_amdgcn_s_waitcnt(0);
        unsigned nloc = b.st[0], nx = b.st[1];
        if (nloc == 0u) { xcd_barrier_complete(bar, bx, nloc, nx); b.st[0] = nloc; b.st[1] = nx; }
        const unsigned old = xb_add(&bar[XB_XSUB(bx)], 1u);
        const unsigned gen = old / nloc;
        if (old + 1u == (gen + 1u) * nloc) {
            __builtin_amdgcn_fence(__ATOMIC_RELEASE, "agent");
            asm volatile("s_waitcnt vmcnt(0)" ::: "memory");
            const unsigned og = xb_add(&bar[XB_TOP], 1u);
            const unsigned tg = og / nx;
            if (og + 1u == (tg + 1u) * nx) xb_add(&bar[XB_TOPGEN], 1u);
            else XB_SPIN(xb_ld(&bar[XB_TOPGEN]) == tg, bar);
            __builtin_amdgcn_fence(__ATOMIC_ACQUIRE, "agent");
            xb_add(&bar[XB_XGEN(bx)], 1u);
            asm volatile("s_waitcnt vmcnt(0)" ::: "memory");
        } else {
            XB_SPIN(xb_ld(&bar[XB_XGEN(bx)]) == gen, bar);
            __builtin_amdgcn_fence(__ATOMIC_ACQUIRE, "agent");
            asm volatile("s_waitcnt vmcnt(0)" ::: "memory");
        }
    }
    __syncthreads();
}

#ifndef PROBE_MASK
#define PROBE_MASK 0u
#endif
#ifndef REP2_SKIP
#define REP2_SKIP 0
#endif
#ifndef REP2_SKIP
#define REP2_SKIP 0
#endif
#ifndef REP2_SKIP
#define REP2_SKIP 0
#endif
#ifndef REP2_SKIP
#define REP2_SKIP 0
#endif
#ifndef REP2_SKIP
#define REP2_SKIP 0
#endif
#ifndef REP2_SKIP
#define REP2_SKIP 0
#endif
#ifndef REP3_SKIP
#define REP3_SKIP 0
#endif
#ifndef REP_PHASE
#define REP_PHASE (-1)
#define REP_L 1
#define REP_N 1
#endif
constexpr int FUSED_LDS = G_LDS + 16;
__global__ void __launch_bounds__(512, 2) k_fused(Params p0) {
    extern __shared__ __attribute__((aligned(16))) char dsm[];
    KP p; (Params&)p = p0; p.wb = __builtin_amdgcn_readfirstlane((int)threadIdx.x) & ~63;
    if (threadIdx.x == 0) *(uint4*)(dsm + G_LDS) = make_uint4(0u, 0u, 0u, 0u);
    __syncthreads();
    XcdBarrier bar = xcd_barrier_post((unsigned*)(p.ws + WS_BAR), (volatile LAS unsigned*)(dsm + G_LDS));
    char* sm = dsm;
    bf16_t* shm = (bf16_t*)dsm;
    const int bid = blockIdx.x, nb = gridDim.x;
#if PROBE_MASK
    unsigned long long* stamps = (unsigned long long*)(p.ws + WS_BAR + 14336);
    int nstamp = 0;
#define STAMP() do { if (bid == 0 && threadIdx.x == 0) stamps[nstamp] = wall_clock64(); ++nstamp; } while (0)
    STAMP();
#else
#define STAMP() do { } while (0)
#endif
    for (int _r = 0; _r < (REP_PHASE == 20 ? REP_N : 1); ++_r) {
        phase_ada(p, bid, nb);
        phase_convert_dense(p, 0, bid, nb, (float*)sm);
        phase_convert_dense(p, 1, bid, nb, (float*)sm);
        phase_convert_lora(p, bid, nb);
        xcd_barrier(bar); STAMP();
    }
    phase_ada2(p, bid, nb);
    xcd_barrier(bar); STAMP();
#define RUN(k, body) { const int _n = (REP_PHASE == (k) && l == REP_L) ? REP_N : 1; for (int _r = 0; _r < _n; ++_r) { body; xcd_barrier(bar); STAMP(); } }
    for (int l = 0; l < DEPTH; ++l) {
        RUN(0, phase_norm1(p, l, bid, nb));
        RUN(1, phase_inproj(p, l, bid, nb, shm));
        RUN(2, { if (!(REP2_SKIP & 1) || _r == 0) phase_rwprep(p, l, bid, nb, sm); if (!(REP2_SKIP & 2) || _r == 0) phase_atprep(p, l, bid, nb, sm); });
        RUN(11, phase_cprep(p, bid, nb, sm));
        RUN(3, {
            if (bid < CS_BLOCKS) { if (!(REP3_SKIP & 1) || _r == 0) phase_cscan(p, bid, sm); }
            else {
                if (!(REP3_SKIP & 4) || _r == 0) phase_attn(p, l, bid - CS_BLOCKS, nb - CS_BLOCKS, sm);
                if (!(REP3_SKIP & 2) || _r == 0) phase_gmlp(p, l, bid - CS_BLOCKS, nb - CS_BLOCKS, sm);
            }
            conv_pull(p, l, sm);
            });
        RUN(4, phase_rwpost(p, l, bid, nb));
        RUN(5, phase_oproj(p, l, bid, nb, shm));
        RUN(6, phase_norm2_route(p, l, bid, nb, sm, _r > 0));
        RUN(7, phase_slots(p, l, bid, nb, sm));
        RUN(8, phase_moe1(p, l, bid, nb, shm));
        RUN(9, phase_moe2(p, l, bid, nb, shm));
        RUN(10, phase_combine(p, l, bid, nb, sm, _r + 1 < _n));
    }
#if PROBE_MASK
    if (bid == 0 && threadIdx.x == 0) {
        unsigned long long ticks = 0;
        for (int i = 0; i + 1 < nstamp; ++i) if ((PROBE_MASK >> i) & 1u) ticks += stamps[i + 1] - stamps[i];
        float v = (float)ticks * 10.0f;
        if (PROBE_MASK == 0x40000000u) v = 1.0e5f;
        p.out[0] = v;
    }
#endif
}

extern "C" void kernel_launch(void* const* d_in, const int* in_sizes, int n_in, void* d_out, int out_size, void* d_ws, size_t ws_size, hipStream_t stream) {
    if (n_in != 35 || out_size != SEQ * D || ws_size < WS_END) {
        fprintf(stderr, "kernel_launch: unexpected shapes: n_in %d out %d ws %zu (need %zu)\n", n_in, out_size, ws_size, (size_t)WS_END);
        return;
    }
    static int grid = 0;
    if (!grid) {
        int dev = 0, cus = 0, per_cu = 0;
        (void)hipGetDevice(&dev);
        (void)hipDeviceGetAttribute(&cus, hipDeviceAttributeMultiprocessorCount, dev);
        (void)hipFuncSetAttribute((const void*)k_fused, hipFuncAttributeMaxDynamicSharedMemorySize, FUSED_LDS);
        (void)hipOccupancyMaxActiveBlocksPerMultiprocessor(&per_cu, (const void*)k_fused, NT, FUSED_LDS);
        if (per_cu < 1) fprintf(stderr, "kernel_launch: occupancy query says %d workgroups per CU; launching one per CU anyway\n", per_cu);
        grid = cus;
        if (grid <= CS_BLOCKS) grid = 0;
    }
    if (!grid) { fprintf(stderr, "kernel_launch: bad grid\n"); return; }
    Params p{};
    const float** f = (const float**)&p;
    for (int i = 0; i < 35; ++i) f[i] = (const float*)d_in[i];
    p.out = (float*)d_out;
    p.ws = (char*)d_ws;
    (void)hipMemsetAsync(d_ws, 0, WS_ZERO_END, stream);
    hipLaunchKernelGGL(k_fused, dim3(grid), dim3(NT), FUSED_LDS, stream, p);
}
```

```cpp
#include <hip/hip_runtime.h>
#include <stdint.h>
#include <stdio.h>

typedef unsigned short bf16_t;
typedef short bf16x8 __attribute__((ext_vector_type(8)));
typedef float f32x4 __attribute__((ext_vector_type(4)));
typedef unsigned u32x4 __attribute__((ext_vector_type(4)));
typedef unsigned u32x2 __attribute__((ext_vector_type(2)));
typedef float f32x16 __attribute__((ext_vector_type(16)));

constexpr int D = 2048, SEQ = 8192, CTXL = 256, NTOK = SEQ + CTXL, DEPTH = 2;
constexpr int RW = 512, RWP = 1920, GMW = 512, INP = 4480;
constexpr int COL_GM = 1920, COL_AT = 2944, COL_K = 3968, COL_V = 4224;
constexpr int NE = 64, NEX = 65, EFF = 512, TOPK = 8;
constexpr int SLOT_CAP = 92416;
constexpr int MAX_TILES = SLOT_CAP / 256;
constexpr int INP_PAD = 4608;
constexpr int NT = 512;

constexpr size_t al256(size_t x) { return (x + 255) & ~(size_t)255; }
constexpr size_t WS_BAR = 0;
constexpr size_t WS_CNT = 16384;
constexpr size_t WS_MOD = WS_CNT + 1024;
constexpr size_t WS_ZERO_END = al256(WS_MOD + (size_t)2 * 2 * 12288 * 4);
constexpr size_t WS_WINT = WS_ZERO_END;
constexpr size_t WS_WOT = WS_WINT + (size_t)2 * INP_PAD * D * 2;
constexpr size_t WS_W13T = WS_WOT + (size_t)2 * D * D * 2;
constexpr size_t WS_W2T = WS_W13T + (size_t)2 * NEX * 1024 * D * 2;
constexpr size_t WS_H = WS_W2T + (size_t)2 * NEX * D * EFF * 2;
constexpr size_t WS_P = WS_H + (size_t)NTOK * D * 2;
constexpr size_t WS_REC = WS_P + (size_t)NTOK * INP * 4;
constexpr size_t WS_YD = WS_REC + (size_t)2 * 8 * NTOK * 384 * 4;
constexpr size_t WS_G = WS_YD + (size_t)2 * NTOK * RW * 4;
constexpr size_t WS_BV = WS_G + (size_t)NTOK * RW * 4;
constexpr size_t WS_GMR = WS_BV + (size_t)NTOK * RW * 4;
constexpr size_t WS_YCAT = al256(WS_GMR + (size_t)NTOK * 4);
constexpr size_t WS_Q = WS_YCAT + (size_t)NTOK * D * 2;
constexpr size_t WS_K = WS_Q + (size_t)NTOK * 1024 * 4;
constexpr size_t WS_X1 = WS_K + (size_t)NTOK * 256 * 4;
constexpr size_t WS_X2C = WS_X1 + (size_t)NTOK * D * 4;
constexpr size_t WS_TOKE = WS_X2C + (size_t)CTXL * D * 4;
constexpr size_t WS_TOKP = WS_TOKE + (size_t)NTOK * 8 * 4;
constexpr size_t WS_TOKW = WS_TOKP + (size_t)NTOK * 8 * 4;
constexpr size_t WS_SLOTT = WS_TOKW + (size_t)NTOK * 8 * 4;
constexpr size_t WS_SLOTW = al256(WS_SLOTT + (size_t)SLOT_CAP * 4);
constexpr size_t WS_TILE = al256(WS_SLOTW + (size_t)SLOT_CAP * 4);
constexpr size_t WS_ACT = al256(WS_TILE + (size_t)(MAX_TILES + 64) * 4);
constexpr size_t WS_MODP = WS_ACT + (size_t)SLOT_CAP * EFF * 2;
constexpr size_t WS_TOKS = WS_MODP + (size_t)2 * 2 * 32 * 12288 * 4;
constexpr size_t WS_OUTS = WS_TOKS + (size_t)NTOK * 8 * 4;
constexpr size_t WS_WLT = WS_OUTS + (size_t)SLOT_CAP * D * 2;
constexpr size_t WS_ROPE = WS_WLT + (size_t)2 * RW * 384 * 2;
constexpr size_t WS_RT = WS_ROPE + (size_t)192 * 16 * 2 * 4;
constexpr size_t WS_FR = WS_RT + (size_t)2 * 2 * NE * D * 2;
constexpr size_t WS_END = WS_FR + (size_t)16 * (NTOK / 16) * 12800;

struct Params {
    const float *x, *c, *ctx, *c_ctx, *w_ada, *b_ada, *norm1_g, *norm2_g, *w_in, *w_o;
    const float *rw_mu, *rw_w0, *rw_w2, *rw_a0, *rw_a2, *rw_g2, *rw_kk, *rw_ka, *rw_rk, *rw_ln_g, *rw_ln_b;
    const float *gm_norm_g, *gm_ws, *gm_b, *at_qn, *at_kn, *at_sink;
    const float *moe_router, *moe_bias, *moe_wg, *moe_wu, *moe_wd, *sh_wg, *sh_wu, *sh_wd;
    float* out;
    char* ws;
};

__device__ __forceinline__ bf16_t f2bf(float f) {
    unsigned u = __float_as_uint(f);
    u += 0x7fffu + ((u >> 16) & 1u);
    return (bf16_t)(u >> 16);
}
typedef __bf16 bf16x2n __attribute__((ext_vector_type(2)));
typedef float f32x2n __attribute__((ext_vector_type(2)));
__device__ __forceinline__ unsigned pack_bf2(float lo, float hi) { const f32x2n v = {lo, hi}; const bf16x2n b2 = __builtin_convertvector(v, bf16x2n); return __builtin_bit_cast(unsigned, b2); }
__device__ __forceinline__ int olane() { int t; asm volatile("v_mbcnt_lo_u32_b32 %0, -1, 0\n\tv_mbcnt_hi_u32_b32 %0, -1, %0" : "=v"(t)); return t; }
__device__ __forceinline__ float bperm(float v, int src_lane) { return __int_as_float(__builtin_amdgcn_ds_bpermute(src_lane << 2, __float_as_int(v))); }
template <int CTRL> __device__ __forceinline__ float dppf(float v) {
    return __int_as_float(__builtin_amdgcn_update_dpp(0, __float_as_int(v), CTRL, 0xf, 0xf, true));
}
__device__ __forceinline__ float red16(float v) {
    v += dppf<0xB1>(v); v += dppf<0x4E>(v); v += dppf<0x124>(v); v += dppf<0x128>(v); return v;
}
__device__ __forceinline__ float wave_sum(float v) {
    const int lane = olane();
    v = red16(v);
    v += bperm(v, lane ^ 16); v += bperm(v, lane ^ 32);
    return v;
}
__device__ __forceinline__ float wave_max(float v) {
    const int lane = olane();
    v = fmaxf(v, dppf<0xB1>(v)); v = fmaxf(v, dppf<0x4E>(v)); v = fmaxf(v, dppf<0x124>(v)); v = fmaxf(v, dppf<0x128>(v));
    v = fmaxf(v, bperm(v, lane ^ 16)); v = fmaxf(v, bperm(v, lane ^ 32));
    return v;
}
__device__ __forceinline__ float max8(float v) {
    const int lane = olane();
    v = fmaxf(v, dppf<0xB1>(v)); v = fmaxf(v, dppf<0x4E>(v)); v = fmaxf(v, bperm(v, lane ^ 4));
    return v;
}
__device__ __forceinline__ float fexp(float x) { return __builtin_amdgcn_exp2f(x * 1.4426950408889634f); }
__device__ __forceinline__ float flog(float x) { return __builtin_amdgcn_logf(x) * 0.6931471805599453f; }
__device__ __forceinline__ float frcp(float x) { return __builtin_amdgcn_rcpf(x); }
__device__ __forceinline__ float sigmoidf_(float x) { return frcp(1.f + fexp(-x)); }
__device__ __forceinline__ float siluf_(float x) { return x * frcp(1.f + fexp(-x)); }
__device__ __forceinline__ float ftanh(float u) { const float e = fexp(-2.f * fabsf(u)); const float t = (1.f - e) * frcp(1.f + e); return u < 0.f ? -t : t; }
__device__ __forceinline__ float gelu_tanh(float x) {
    const float u = 0.7978845608028654f * (x + 0.044715f * x * x * x);
    const float hx = 0.5f * x;
    return fmaf(hx, ftanh(u), hx);
}
__device__ __forceinline__ float softplusf_(float x) { return fmaxf(x, 0.f) + flog(1.f + fexp(-fabsf(x))); }

struct RowSrc { const float* a; const float* b; };
__device__ __forceinline__ const float* rowp(const RowSrc& r, int row) { return row < SEQ ? r.a + (size_t)row * D : r.b + (size_t)(row - SEQ) * D; }
struct RowDst { float* a; float* b; };
__device__ __forceinline__ float* rowp(const RowDst& r, int row) { return row < SEQ ? r.a + (size_t)row * D : r.b + (size_t)(row - SEQ) * D; }

__device__ __forceinline__ RowSrc layer_in(const Params& p, int l) {
    RowSrc r; if (l == 0) { r.a = p.x; r.b = p.ctx; } else { float* x1 = (float*)(p.ws + WS_X1); r.a = x1; r.b = x1 + (size_t)SEQ * D; } return r;
}
__device__ __forceinline__ RowDst layer_out(const Params& p, int l) {
    RowDst r; if (l == 0) { float* x1 = (float*)(p.ws + WS_X1); r.a = x1; r.b = x1 + (size_t)SEQ * D; } else { r.a = p.out; r.b = (float*)(p.ws + WS_X2C); } return r;
}
__device__ __forceinline__ const float* modp(const Params& p, int l, int row, int which) {
    return (const float*)(p.ws + WS_MOD) + ((size_t)(l * 2 + (row < SEQ ? 0 : 1)) * 6 + which) * D;
}
__device__ __forceinline__ int ntok_of(int l) { return l == DEPTH - 1 ? SEQ : NTOK; }
struct KP : Params { int wb; };
__device__ __forceinline__ int otid(int wb) {
    int t; asm volatile("v_mbcnt_lo_u32_b32 %0, -1, 0\n\tv_mbcnt_hi_u32_b32 %0, -1, %0" : "=v"(t));
    return t | wb;
}

__device__ void phase_ada(const KP& p, int bid, int nb) {
    float* part = (float*)(p.ws + WS_MODP);
    const int tid = otid(p.wb);
    for (int u = bid; u < 2 * 6 * 32; u += nb) {
        const int l = u / (6 * 32), r = u % (6 * 32), cg = r / 32, kc = r % 32;
        const int n = cg * 2048 + tid * 4;
        const float* w = p.w_ada + (size_t)l * D * 12288 + (size_t)(kc * 64) * 12288 + n;
        f32x4 a0 = {0, 0, 0, 0}, a1 = {0, 0, 0, 0};
#pragma unroll 8
        for (int k = 0; k < 64; ++k) {
            const f32x4 wv = *(const f32x4*)(w + (size_t)k * 12288);
            const float c0 = siluf_(p.c[kc * 64 + k]), c1 = siluf_(p.c_ctx[kc * 64 + k]);
            a0 += wv * c0; a1 += wv * c1;
        }
        *(f32x4*)(part + ((size_t)((l * 2 + 0) * 32 + kc)) * 12288 + n) = a0;
        *(f32x4*)(part + ((size_t)((l * 2 + 1) * 32 + kc)) * 12288 + n) = a1;
    }
}
__device__ void phase_ada2(const KP& p, int bid, int nb) {
    const float* part = (const float*)(p.ws + WS_MODP);
    float* mod = (float*)(p.ws + WS_MOD);
    for (int i = bid * NT + otid(p.wb); i < 2 * 2 * 12288; i += nb * NT) {
        const int ls = i / 12288, n = i % 12288, l = ls >> 1;
        float acc = p.b_ada[(size_t)l * 12288 + n];
        for (int kc = 0; kc < 32; ++kc) acc += part[((size_t)(ls * 32 + kc)) * 12288 + n];
        mod[i] = acc;
    }
}

struct TJob { const float* src; bf16_t* dst; int K, N, batch; size_t sstride, dstride; int mode; };
__device__ __forceinline__ void tconv_pair(const TJob& j, int t0, float* tiles  , int tid) {
    const int half = tid >> 8, ht = tid & 255;
    float* tile = tiles + half * (64 * 65);
    const int tk = j.K / 64, tn = j.N / 64, ntl = j.batch * tk * tn;
    const int t = t0 + half;
    const bool on = t < ntl;
    const int b = t / (tk * tn), r = t % (tk * tn), kt = r / tn, nt = r % tn;
    __syncthreads();
    if (on) {
        const float* src = j.src + (size_t)b * j.sstride + (size_t)(kt * 64) * j.N + nt * 64;
#pragma unroll
        for (int i = 0; i < 4; ++i) {
            const int k = i * 16 + (ht >> 4), n = (ht & 15) * 4;
            const f32x4 v = *(const f32x4*)(src + (size_t)k * j.N + n);
            tile[k * 65 + n + 0] = v[0]; tile[k * 65 + n + 1] = v[1]; tile[k * 65 + n + 2] = v[2]; tile[k * 65 + n + 3] = v[3];
        }
    }
    __syncthreads();
    if (on) {
        const int n = ht >> 2, kq = (ht & 3) * 16;
        int ng = nt * 64 + n;
        if (j.mode == 1) ng = 32 * (ng >> 4) + (ng & 15);
        else if (j.mode == 2) ng = 32 * (ng >> 4) + 16 + (ng & 15);
        bf16_t* dst = j.dst + (size_t)b * j.dstride + (size_t)ng * j.K + kt * 64 + kq;
        u32x4 w0, w1;
#pragma unroll
        for (int i = 0; i < 4; ++i) { w0[i] = pack_bf2(tile[(kq + 2 * i) * 65 + n], tile[(kq + 2 * i + 1) * 65 + n]); w1[i] = pack_bf2(tile[(kq + 8 + 2 * i) * 65 + n], tile[(kq + 8 + 2 * i + 1) * 65 + n]); }
        *(u32x4*)(dst) = w0;
        *(u32x4*)(dst + 8) = w1;
    }
}
__device__ void phase_tconv(const TJob& j, int bid, int nb, float* tiles  , int wb) {
    const int tid = otid(wb);
    const int ntl = j.batch * (j.K / 64) * (j.N / 64);
    for (int t0 = bid * 2; t0 < ntl; t0 += nb * 2) tconv_pair(j, t0, tiles, tid);
}
__device__ void phase_convert_dense(const KP& p, int l, int bid, int nb, float* tile) {
    TJob j;
    j = {p.w_in + (size_t)l * D * INP, (bf16_t*)(p.ws + WS_WINT) + (size_t)l * INP_PAD * D, D, INP, 1, 0, 0, 0}; phase_tconv(j, bid, nb, tile, p.wb);
    j = {p.w_o + (size_t)l * D * D, (bf16_t*)(p.ws + WS_WOT) + (size_t)l * D * D, D, D, 1, 0, 0, 0}; phase_tconv(j, bid, nb, tile, p.wb);
}
constexpr int CQ_ITEM = 16;
constexpr int CQ_T_BIG = NE * (D / 64) * (EFF / 64);
constexpr int CQ_T_SH = (D / 64) * (EFF / 64);
constexpr int CQ_IPL = (3 * CQ_T_BIG + 3 * CQ_T_SH) / CQ_ITEM;
constexpr int CT_LD = 68;
__device__ __forceinline__ void conv_item(const KP& p, int l, int item, float* tiles  , int tid) {
    int t = item * CQ_ITEM;
    bf16_t* w13 = (bf16_t*)(p.ws + WS_W13T) + (size_t)l * NEX * 1024 * D;
    bf16_t* w2 = (bf16_t*)(p.ws + WS_W2T) + (size_t)l * NEX * D * EFF;
    TJob j;
    if (t < CQ_T_BIG) j = {p.moe_wg + (size_t)l * NE * D * EFF, w13, D, EFF, NE, (size_t)D * EFF, (size_t)1024 * D, 1};
    else if (t < 2 * CQ_T_BIG) { t -= CQ_T_BIG; j = {p.moe_wu + (size_t)l * NE * D * EFF, w13, D, EFF, NE, (size_t)D * EFF, (size_t)1024 * D, 2}; }
    else if (t < 3 * CQ_T_BIG) { t -= 2 * CQ_T_BIG; j = {p.moe_wd + (size_t)l * NE * EFF * D, w2, EFF, D, NE, (size_t)EFF * D, (size_t)D * EFF, 0}; }
    else if (t < 3 * CQ_T_BIG + CQ_T_SH) { t -= 3 * CQ_T_BIG; j = {p.sh_wg + (size_t)l * D * EFF, w13 + (size_t)NE * 1024 * D, D, EFF, 1, 0, 0, 1}; }
    else if (t < 3 * CQ_T_BIG + 2 * CQ_T_SH) { t -= 3 * CQ_T_BIG + CQ_T_SH; j = {p.sh_wu + (size_t)l * D * EFF, w13 + (size_t)NE * 1024 * D, D, EFF, 1, 0, 0, 2}; }
    else { t -= 3 * CQ_T_BIG + 2 * CQ_T_SH; j = {p.sh_wd + (size_t)l * EFF * D, w2 + (size_t)NE * D * EFF, EFF, D, 1, 0, 0, 0}; }
    const int half = tid >> 8, ht = tid & 255;
    float* tile = tiles + half * (64 * CT_LD);
    const int tk = j.K / 64, tn = j.N / 64;
    const int lk = ht >> 4, ln = (ht & 15) * 4;
    const int sn = ht >> 2, skq = (ht & 3) * 16;
    f32x4 v[4];
#define CT_SRC(tt) (j.src + (size_t)((tt) / (tk * tn)) * j.sstride + (size_t)((((tt) % (tk * tn)) / tn) * 64) * j.N + (((tt) % (tk * tn)) % tn) * 64)
    { const float* src = CT_SRC(t + half);
#pragma unroll
      for (int i = 0; i < 4; ++i) v[i] = *(const f32x4*)(src + (size_t)(lk + 16 * i) * j.N + ln); }
#pragma unroll 1
    for (int st = 0; st < CQ_ITEM; st += 2) {
        const int tt = t + st + half;
        __syncthreads();
#pragma unroll
        for (int i = 0; i < 4; ++i) *(f32x4*)(tile + (lk + 16 * i) * CT_LD + ln) = v[i];
        __syncthreads();
        if (st + 2 < CQ_ITEM) {
            const float* src = CT_SRC(tt + 2);
#pragma unroll
            for (int i = 0; i < 4; ++i) v[i] = *(const f32x4*)(src + (size_t)(lk + 16 * i) * j.N + ln);
        }
        const int b = tt / (tk * tn), r = tt % (tk * tn), kt = r / tn, nt = r % tn;
        int ng = nt * 64 + sn;
        if (j.mode == 1) ng = 32 * (ng >> 4) + (ng & 15);
        else if (j.mode == 2) ng = 32 * (ng >> 4) + 16 + (ng & 15);
        bf16_t* dst = j.dst + (size_t)b * j.dstride + (size_t)ng * j.K + kt * 64 + skq;
        u32x4 w0, w1;
#pragma unroll
        for (int i = 0; i < 4; ++i) { w0[i] = pack_bf2(tile[(skq + 2 * i) * CT_LD + sn], tile[(skq + 2 * i + 1) * CT_LD + sn]); w1[i] = pack_bf2(tile[(skq + 8 + 2 * i) * CT_LD + sn], tile[(skq + 8 + 2 * i + 1) * CT_LD + sn]); }
        *(u32x4*)(dst) = w0;
        *(u32x4*)(dst + 8) = w1;
    }
#undef CT_SRC
}
__device__ void conv_pull(const KP& p, int l, char* smem) {
    int* qhead = (int*)(p.ws + WS_CNT) + 200 + l;
    float* tiles = (float*)smem;
    int* sh = (int*)(smem + 2 * 64 * CT_LD * 4);
    const int tid = otid(p.wb);
    __syncthreads();
    if (tid == 0) sh[0] = __hip_atomic_fetch_add(qhead, 1, __ATOMIC_RELAXED, __HIP_MEMORY_SCOPE_AGENT);
    __syncthreads();
    int item = sh[0];
    while (item < CQ_IPL) {
        int nxt = 0;
        if (tid == 0) nxt = __hip_atomic_fetch_add(qhead, 1, __ATOMIC_RELAXED, __HIP_MEMORY_SCOPE_AGENT);
        conv_item(p, l, item, tiles, tid);
        __syncthreads();
        if (tid == 0) sh[0] = nxt;
        __syncthreads();
        item = sh[0];
    }
}

__device__ void phase_convert_lora(const KP& p, int bid, int nb) {
    bf16_t* WLT = (bf16_t*)(p.ws + WS_WLT);
    const int tid = otid(p.wb);
    for (int i = bid * NT + tid; i < 2 * D * NE; i += nb * NT) {
        const int l = i / (D * NE), r = i % (D * NE), k = r / NE, e = r % NE;
        const float x = p.moe_router[i];
        const bf16_t hi = f2bf(x); const bf16_t lo = f2bf(x - __uint_as_float((unsigned)hi << 16));
        bf16_t* rt = (bf16_t*)(p.ws + WS_RT) + (size_t)l * 2 * NE * D;
        rt[(size_t)e * D + k] = hi; rt[(size_t)NE * D + (size_t)e * D + k] = lo;
    }
    for (int i = bid * NT + tid; i < 192 * 16; i += nb * NT) {
        const int pos = i >> 4, f = i & 15;
        const float ang = (float)(pos < 128 ? pos : pos - 128) * powf(10000.f, -(float)f / 16.f);
        float* rt = (float*)(p.ws + WS_ROPE) + (size_t)i * 2;
        rt[0] = cosf(ang); rt[1] = sinf(ang);
    }
    for (int i = bid * NT + tid; i < 2 * RW * 384; i += nb * NT) {
        const int l = i / (RW * 384), r = i % (RW * 384), k = r / RW, c = r % RW;
        float v;
        if (k < 128) v = p.rw_w2[((size_t)l * 2 * 64 + k) * RW + c];
        else if (k < 256) v = p.rw_a2[((size_t)l * 2 * 64 + (k - 128)) * RW + c];
        else v = p.rw_g2[((size_t)l * 128 + (k - 256)) * RW + c];
        WLT[((size_t)l * RW + c) * 384 + k] = f2bf(v);
    }
}

__device__ void phase_norm1(const KP& p, int l, int bid, int nb) {
    const RowSrc in = layer_in(p, l);
    bf16_t* H = (bf16_t*)(p.ws + WS_H);
    const float* g = p.norm1_g + (size_t)l * D;
    const int tid = otid(p.wb), wid = tid >> 6, lane = tid & 63;
    for (int row = bid * 8 + wid; row < NTOK; row += nb * 8) {
        const float* xr = rowp(in, row);
        const float* sh = modp(p, l, row, 0);
        const float* sc = modp(p, l, row, 1);
        f32x4 v[8]; float ss = 0.f;
#pragma unroll
        for (int i = 0; i < 8; ++i) { v[i] = *(const f32x4*)(xr + i * 256 + lane * 4); ss += v[i][0] * v[i][0] + v[i][1] * v[i][1] + v[i][2] * v[i][2] + v[i][3] * v[i][3]; }
        ss = wave_sum(ss);
        const float rstd = rsqrtf(ss * (1.f / D) + 1e-6f);
#pragma unroll
        for (int i = 0; i < 8; ++i) {
            const int c = i * 256 + lane * 4;
            const f32x4 gv = *(const f32x4*)(g + c), shv = *(const f32x4*)(sh + c), scv = *(const f32x4*)(sc + c);
            float o[4];
#pragma unroll
            for (int j = 0; j < 4; ++j) { const float t = v[i][j] * rstd * gv[j]; o[j] = fmaf(t, scv[j], t) + shv[j]; }
            u32x2 w; w[0] = pack_bf2(o[0], o[1]); w[1] = pack_bf2(o[2], o[3]);
            *(u32x2*)(H + (size_t)row * D + c) = w;
        }
    }
}

constexpr int G_HT = 128 * 64;
constexpr int G_LDS = 8 * G_HT * 2;
__device__ __forceinline__ int g_lds_byte(int r, int c) {
    const int st = (r >> 4) * 2 + (c >> 5), rr = r & 15, cc = c & 31, ob = rr * 64 + cc * 2;
    return st * 1024 + (ob ^ (((ob >> 9) & 1) << 5));
}
__device__ __forceinline__ void g_stage_rc(int b, int& R, int& C) {
    const int st = b / 1024, sb = b % 1024, swz = sb ^ (((sb >> 9) & 1) << 5);
    R = (st >> 1) * 16 + swz / 64; C = (st & 1) * 32 + (swz % 64) / 2;
}
struct GOff { unsigned ao[2][2], bo; };
#define SA(b, h) (shm + ((b) * 2 + (h)) * G_HT)
#define SB(b, h) (shm + (4 + (b) * 2 + (h)) * G_HT)
#define STG_A(P, h, kt) do { _Pragma("unroll") for (int _i = 0; _i < 2; ++_i) \
    __builtin_amdgcn_global_load_lds((const unsigned*)((const char*)(A + (kt) * 64) + o.ao[h][_i]), (unsigned*)((char*)(P) + tz * 16 + _i * 8192), 16, 0, 0); } while (0)
#define STG_B(P, h, kt) do { _Pragma("unroll") for (int _i = 0; _i < 2; ++_i) \
    __builtin_amdgcn_global_load_lds((const unsigned*)((const char*)(Bt + ((h) * 128 + _i * 64) * K + (kt) * 64) + o.bo), (unsigned*)((char*)(P) + tz * 16 + _i * 8192), 16, 0, 0); } while (0)
template <bool PERM, class ARow>
__device__ __forceinline__ void gemm_offsets(ARow arow, const int K, const int wb, GOff& o) {
    const int tz = otid(wb);
    int r, c; g_stage_rc(tz * 16, r, c);
    const int rb = PERM ? ((r & ~31) + 8 * ((r & 15) >> 2) + 4 * ((r >> 4) & 1) + (r & 3)) : r;
    o.bo = (unsigned)((rb * K + c) * 2);
#pragma unroll
    for (int h = 0; h < 2; ++h)
#pragma unroll
        for (int i = 0; i < 2; ++i) o.ao[h][i] = (unsigned)((arow(h * 128 + i * 64 + r) + c) * 2);
}
__device__ __forceinline__ void gemm_issue(const bf16_t* __restrict__ A, const bf16_t* __restrict__ Bt, const int K, const GOff& o, bf16_t* shm, const int wb) {
    const int tz = otid(wb);
    STG_B(SB(0, 0), 0, 0); STG_A(SA(0, 0), 0, 0);
    STG_B(SB(0, 1), 1, 0); STG_A(SA(0, 1), 1, 0);
    STG_B(SB(1, 0), 0, 1); STG_A(SA(1, 0), 0, 1); STG_B(SB(1, 1), 1, 1);
}
__device__ __forceinline__ void gemm_main(const bf16_t* __restrict__ A, const bf16_t* __restrict__ Bt, const int K, const GOff& o, f32x4 (&acc)[2][2][4][2], bf16_t* shm, const int wb) {
#define LDA(dst, b, h) _Pragma("unroll") for (int m = 0; m < 4; ++m) _Pragma("unroll") for (int k = 0; k < 2; ++k) \
    dst[m][k] = *reinterpret_cast<const bf16x8*>((const char*)SA(b, h) + g_lds_byte(wr * 64 + m * 16 + fr, k * 32 + fq * 8))
#define LDB(dst, b, h) _Pragma("unroll") for (int n = 0; n < 2; ++n) _Pragma("unroll") for (int k = 0; k < 2; ++k) \
    dst[n][k] = *reinterpret_cast<const bf16x8*>((const char*)SB(b, h) + g_lds_byte(wc * 32 + n * 16 + fr, k * 32 + fq * 8))
#define MMA(ai, bj, Af, Bf) do { __builtin_amdgcn_s_setprio(1); \
    _Pragma("unroll") for (int m = 0; m < 4; ++m) _Pragma("unroll") for (int n = 0; n < 2; ++n) _Pragma("unroll") for (int k = 0; k < 2; ++k) \
        acc[ai][bj][m][n] = __builtin_amdgcn_mfma_f32_16x16x32_bf16(Bf[n][k], Af[m][k], acc[ai][bj][m][n], 0, 0, 0); \
    __builtin_amdgcn_s_setprio(0); } while (0)
#define WAIT_V(n) asm volatile("s_waitcnt vmcnt(" #n ")" ::: "memory")
#define WAIT_L(n) asm volatile("s_waitcnt lgkmcnt(" #n ")" ::: "memory")
#define BAR __builtin_amdgcn_s_barrier()
#define SCHED __builtin_amdgcn_sched_barrier(0)
    int tz = otid(wb);
    int wid = tz >> 6, lane = tz & 63, wr = wid >> 2, wc = wid & 3, fr = lane & 15, fq = lane >> 4;
#pragma unroll
    for (int a = 0; a < 2; ++a)
#pragma unroll
        for (int b = 0; b < 2; ++b)
#pragma unroll
            for (int m = 0; m < 4; ++m)
#pragma unroll
                for (int n = 0; n < 2; ++n) acc[a][b][m][n] = (f32x4){0.f, 0.f, 0.f, 0.f};
    bf16x8 At[4][2], B0[2][2], B1[2][2];
    const int nt = K / 64;
    WAIT_V(0); BAR;
    if (wr == 1) BAR;
    for (int t = 0; t < nt - 2; t += 2) {
        LDB(B0, 0, 0); SCHED; LDA(At, 0, 0); STG_A(SA(1, 1), 1, t + 1);
        WAIT_L(8); BAR; WAIT_L(0); MMA(0, 0, At, B0); BAR; SCHED;
        LDB(B1, 0, 1); STG_B(SB(0, 0), 0, t + 2);
        BAR; WAIT_L(0); MMA(0, 1, At, B1); BAR;
        LDA(At, 0, 1); STG_A(SA(0, 0), 0, t + 2);
        BAR; WAIT_L(0); MMA(1, 0, At, B0); BAR; SCHED;
        STG_B(SB(0, 1), 1, t + 2);
        WAIT_V(6); BAR; MMA(1, 1, At, B1); BAR;
        LDB(B0, 1, 0); SCHED; LDA(At, 1, 0); STG_A(SA(0, 1), 1, t + 2);
        WAIT_L(8); BAR; WAIT_L(0); MMA(0, 0, At, B0); BAR; SCHED;
        LDB(B1, 1, 1); STG_B(SB(1, 0), 0, t + 3);
        BAR; WAIT_L(0); MMA(0, 1, At, B1); BAR;
        LDA(At, 1, 1); STG_A(SA(1, 0), 0, t + 3);
        BAR; WAIT_L(0); MMA(1, 0, At, B0); BAR; SCHED;
        STG_B(SB(1, 1), 1, t + 3);
        WAIT_V(6); BAR; MMA(1, 1, At, B1); BAR;
    }
    { LDB(B0, 0, 0); WAIT_V(0); LDA(At, 0, 0); STG_A(SA(1, 1), 1, nt - 1);
      BAR; WAIT_L(0); MMA(0, 0, At, B0); BAR;
      LDB(B1, 0, 1); BAR; WAIT_L(0); MMA(0, 1, At, B1); BAR;
      LDA(At, 0, 1); WAIT_V(4); BAR; WAIT_L(0); MMA(1, 0, At, B0); MMA(1, 1, At, B1); BAR; }
    { LDB(B0, 1, 0); LDA(At, 1, 0); WAIT_V(2); BAR; WAIT_L(0); MMA(0, 0, At, B0); BAR;
      LDB(B1, 1, 1); WAIT_V(0); BAR; WAIT_L(0); MMA(0, 1, At, B1); BAR;
      LDA(At, 1, 1); BAR; WAIT_L(0); MMA(1, 0, At, B0); MMA(1, 1, At, B1); BAR; }
    if (wr == 0) BAR;
#undef LDA
#undef LDB
#undef MMA
#undef WAIT_V
#undef WAIT_L
#undef BAR
#undef SCHED
}
#undef SA
#undef SB
#undef STG_A
#undef STG_B
struct GU { const bf16_t* A; const bf16_t* Bt; int i0, i1, i2, i3; };
template <bool PERM, class Mk, class Row, class Epi>
__device__ __forceinline__ void gemm_phase(const int nwg, const int bid, const int nb, const int K, bf16_t* shm, const int wb, Mk mk, Row row, Epi epi) {
    int L = bid;
    if (L >= nwg) return;
    GU cur = mk(L);
    GOff oc;
    gemm_offsets<PERM>([&](int r) { return row(cur, r); }, K, wb, oc);
    gemm_issue(cur.A, cur.Bt, K, oc, shm, wb);
    for (;;) {
        f32x4 acc[2][2][4][2];
        gemm_main(cur.A, cur.Bt, K, oc, acc, shm, wb);
        const int Ln = L + nb;
        const bool more = Ln < nwg;
        GU nxt = cur; GOff on = oc;
        if (more) {
            nxt = mk(Ln);
            gemm_offsets<PERM>([&](int r) { return row(nxt, r); }, K, wb, on);
            gemm_issue(nxt.A, nxt.Bt, K, on, shm, wb);
        }
        epi(cur, acc);
        if (!more) break;
        cur = nxt; oc = on; L = Ln;
    }
}
#define G_IDX int _tz = otid(p.wb); const int _wid = _tz >> 6, _lane = _tz & 63, wr = _wid >> 2, wc = _wid & 3, fr = _lane & 15, fq = _lane >> 4
__device__ __forceinline__ int xcd_remap(int L, int nwg) {
    const int q = nwg / 8, r = nwg % 8, xcd = L % 8, off = L / 8;
    return (xcd < r ? xcd * (q + 1) : r * (q + 1) + (xcd - r) * q) + off;
}
__device__ __forceinline__ void dense_tile(int wgid, int nM, int nN, int& pm, int& pn) {
    const int nig = 8 * nN, gid = wgid / nig, fm = gid * 8, gsz = (nM - fm) < 8 ? (nM - fm) : 8;
    pm = fm + ((wgid % nig) % gsz); pn = (wgid % nig) / gsz;
}

__device__ void phase_inproj(const KP& p, int l, int bid, int nb, bf16_t* shm) {
    const bf16_t* H = (const bf16_t*)(p.ws + WS_H);
    const bf16_t* Bt = (const bf16_t*)(p.ws + WS_WINT) + (size_t)l * INP_PAD * D;
    float* P = (float*)(p.ws + WS_P);
    constexpr int nM = NTOK / 256, nN = INP_PAD / 256, nwg = nM * nN;
    gemm_phase<false>(nwg, bid, nb, D, shm, p.wb,
        [&](int L) { int pm, pn; dense_tile(xcd_remap(L, nwg), nM, nN, pm, pn); GU u; u.A = H; u.Bt = Bt + (size_t)(pn * 256) * D; u.i0 = pm * 256; u.i1 = pn * 256; u.i2 = 0; u.i3 = 0; return u; },
        [&](const GU& u, int r) { return (u.i0 + r) * D; },
        [&](const GU& u, f32x4 (&acc)[2][2][4][2]) {
            const int m0 = u.i0, n0 = u.i1;
            G_IDX;
#pragma unroll
            for (int ai = 0; ai < 2; ++ai)
#pragma unroll
                for (int m = 0; m < 4; ++m) {
                    float* prow = P + (size_t)(m0 + ai * 128 + wr * 64 + m * 16 + fr) * INP + n0 + wc * 32 + fq * 4;
#pragma unroll
                    for (int bj = 0; bj < 2; ++bj)
#pragma unroll
                        for (int n = 0; n < 2; ++n)
                            if (n0 + bj * 128 + wc * 32 + n * 16 + fq * 4 < INP) *(f32x4*)(prow + bj * 128 + n * 16) = acc[ai][bj][m][n];
                }
        });
}

__device__ __forceinline__ int scan_pos(int d, int row) {
    if (row >= SEQ) { const int c = row - SEQ; return d == 0 ? c : (CTXL - 1 - c); }
    return CTXL + (d == 0 ? row : (SEQ - 1 - row));
}
__device__ __forceinline__ int scan_row(int d, int s) {
    if (s < CTXL) return SEQ + (d == 0 ? s : (CTXL - 1 - s));
    const int q = s - CTXL; return d == 0 ? q : (SEQ - 1 - q);
}
constexpr int RP_TB = 11;
constexpr int RP_LD = 392;
__device__ __forceinline__ f32x4 shifted4(const float* P, int row, int col, const float* mu) {
    const f32x4 cur = *(const f32x4*)(P + (size_t)row * INP + col);
    const bool first = (row == 0) || (row == SEQ), last = (row == SEQ - 1) || (row == NTOK - 1);
    f32x4 prev = {0.f, 0.f, 0.f, 0.f}, nxt = {0.f, 0.f, 0.f, 0.f};
    if (!first) prev = *(const f32x4*)(P + (size_t)(row - 1) * INP + col);
    if (!last) nxt = *(const f32x4*)(P + (size_t)(row + 1) * INP + col);
    const f32x4 m0 = *(const f32x4*)(mu + col), m1 = *(const f32x4*)(mu + RWP + col);
    return cur + m0 * (prev - cur) + m1 * (nxt - cur);
}
__device__ __forceinline__ float shifted(const float* P, int row, int col, float mu0, float mu1) {
    const float cur = P[(size_t)row * INP + col];
    const bool first = (row == 0) || (row == SEQ), last = (row == SEQ - 1) || (row == NTOK - 1);
    const float prev = first ? 0.f : P[(size_t)(row - 1) * INP + col];
    const float nxt = last ? 0.f : P[(size_t)(row + 1) * INP + col];
    return cur + mu0 * (prev - cur) + mu1 * (nxt - cur);
}
__device__ void phase_rwprep(const KP& p, int l, int bid, int nb, char* smem) {
    const float* P = (const float*)(p.ws + WS_P);
    float* RECW = (float*)(p.ws + WS_REC);
    bf16_t* RECD = (bf16_t*)(RECW + (size_t)16 * NTOK * 64);
    bf16_t* RECS = RECD + (size_t)16 * NTOK * 128;
    float* G = (float*)(p.ws + WS_G);
    float* BV = (float*)(p.ws + WS_BV);
    float* GMR = (float*)(p.ws + WS_GMR);
    const bf16_t* WLT = (const bf16_t*)(p.ws + WS_WLT) + (size_t)l * RW * 384;
    bf16_t* lin = (bf16_t*)smem;
    const float* mu = p.rw_mu + (size_t)l * 2 * RWP;
    const float* w0 = p.rw_w0 + (size_t)l * 2 * RW;
    const float* a0 = p.rw_a0 + (size_t)l * 2 * RW;
    const float* kkw = p.rw_kk + (size_t)l * RW;
    const float* kaw = p.rw_ka + (size_t)l * RW;
    const float* rkw = p.rw_rk + (size_t)l * RW;
    const int tid = otid(p.wb), wid = tid >> 6, lane = tid & 63, t16 = lane & 15, g = lane >> 4;
    for (int blk = bid; blk < NTOK / RP_TB; blk += nb) {
        const int t0 = blk * RP_TB;
        __syncthreads();
        for (int i = tid; i < RP_TB * 384; i += NT) {
            const int tt = i / 384, j = i % 384, col = 1536 + j;
            const float v = shifted(P, t0 + tt, col, mu[col], mu[RWP + col]);
            lin[tt * RP_LD + j] = f2bf(j < 128 ? ftanh(v) : (j < 256 ? v : sigmoidf_(v)));
        }
        __syncthreads();
        for (int q = wid; q < RP_TB; q += 8) {
            const int row = t0 + q; float ss = 0.f;
#pragma unroll
            for (int i = 0; i < 8; ++i) { const float gv = gelu_tanh(P[(size_t)row * INP + COL_GM + GMW + i * 64 + lane]); ss += gv * gv; }
            ss = wave_sum(ss);
            if (lane == 0) GMR[row] = rsqrtf(ss * (1.f / GMW) + 1e-6f);
        }
        const bool live = t16 < RP_TB;
        const int row = t0 + (live ? t16 : RP_TB - 1);
        float nrm2 = 0.f, bon = 0.f;
#pragma unroll
        for (int tl = 0; tl < 4; ++tl) {
            const int c = wid * 64 + tl * 16 + g * 4;
            const f32x4 r4 = shifted4(P, row, c, mu), k4 = shifted4(P, row, 512 + c, mu);
            const f32x4 kq = k4 * *(const f32x4*)(kkw + c), rk = *(const f32x4*)(rkw + c);
#pragma unroll
            for (int e = 0; e < 4; ++e) { nrm2 += kq[e] * kq[e]; bon += r4[e] * k4[e] * rk[e]; }
        }
        nrm2 += bperm(nrm2, lane ^ 16); nrm2 += bperm(nrm2, lane ^ 32);
        bon += bperm(bon, lane ^ 16); bon += bperm(bon, lane ^ 32);
        const float inrm = 1.f / fmaxf(sqrtf(nrm2), 1e-12f);
        const bf16_t* lrow = lin + (live ? t16 : RP_TB - 1) * RP_LD + g * 8;
#pragma unroll 1
        for (int tl = 0; tl < 4; ++tl) {
            f32x4 acc[5];
#pragma unroll
            for (int m = 0; m < 5; ++m) acc[m] = (f32x4){0.f, 0.f, 0.f, 0.f};
            const bf16_t* wrow = WLT + (size_t)(wid * 64 + tl * 16 + t16) * 384 + g * 8;
#pragma unroll
            for (int ks = 0; ks < 12; ++ks) {
                const int m = ks < 8 ? (ks >> 1) : 4;
                acc[m] = __builtin_amdgcn_mfma_f32_16x16x32_bf16(*(const bf16x8*)(wrow + ks * 32), *(const bf16x8*)(lrow + ks * 32), acc[m], 0, 0, 0);
            }
            const int c = wid * 64 + tl * 16 + g * 4, ci = tl * 16 + g * 4;
            const f32x4 r4 = shifted4(P, row, c, mu), k4 = shifted4(P, row, 512 + c, mu), v4 = shifted4(P, row, 1024 + c, mu);
            const f32x4 kq = k4 * *(const f32x4*)(kkw + c) * inrm;
            if (live) {
                *(f32x4*)(G + (size_t)row * RW + c) = acc[4];
                *(f32x4*)(BV + (size_t)row * RW + c) = v4 * bon;
            }
            const f32x4 ka = *(const f32x4*)(kaw + c);
#pragma unroll
            for (int d = 0; d < 2; ++d) {
                const f32x4 w0v = *(const f32x4*)(w0 + d * RW + c), a0v = *(const f32x4*)(a0 + d * RW + c);
                f32x4 decay, av, kd;
#pragma unroll
                for (int e = 0; e < 4; ++e) {
                    const float wlog = -softplusf_(-(w0v[e] + acc[d][e])) - 0.5f;
                    decay[e] = fexp(-fexp(wlog));
                    av[e] = sigmoidf_(a0v[e] + acc[2 + d][e]);
                    kd[e] = k4[e] * (1.f + (av[e] - 1.f) * ka[e]);
                }
                if (live) {
                    *(f32x4*)(RECW + ((size_t)(d * 8 + wid) * NTOK + row) * 64 + ci) = decay;
                    bf16_t* rd = RECD + ((size_t)(d * 8 + wid) * NTOK + row) * 128 + ci;
                    const f32x4 bq = kq * av;
                    u32x2 w1, w2; w1[0] = pack_bf2(bq[0], bq[1]); w1[1] = pack_bf2(bq[2], bq[3]); w2[0] = pack_bf2(kd[0], kd[1]); w2[1] = pack_bf2(kd[2], kd[3]);
                    *(u32x2*)(rd) = w1; *(u32x2*)(rd + 64) = w2;
                    if (d == 0) {
                        bf16_t* rs = RECS + ((size_t)wid * NTOK + row) * 192 + ci;
                        u32x2 a1, a2, a3; a1[0] = pack_bf2(kq[0], kq[1]); a1[1] = pack_bf2(kq[2], kq[3]); a2[0] = pack_bf2(r4[0], r4[1]); a2[1] = pack_bf2(r4[2], r4[3]); a3[0] = pack_bf2(v4[0], v4[1]); a3[1] = pack_bf2(v4[2], v4[3]);
                        *(u32x2*)(rs) = a1; *(u32x2*)(rs + 64) = a2; *(u32x2*)(rs + 128) = a3;
                    }
                }
            }
        }
    }
}

constexpr int SC_TS = 16;
constexpr int SCAN_BLOCKS = 128;
constexpr int SC_OPB = SC_TS * 384;
constexpr int SC_SBW = SC_TS * 64 * 4;
constexpr int SC_LDS = (2 * SC_OPB + 2 * 2 * SC_SBW) * 4;
#define SC_LD(slot, s) { const float* b_ = buf + (s) * 384 + 4 * l16; qw[slot] = *(const f32x4*)(b_); qk[slot] = *(const f32x4*)(b_ + 64); \
    qb[slot] = *(const f32x4*)(b_ + 128); qd[slot] = *(const f32x4*)(b_ + 192); qv[slot] = buf[(s) * 384 + 320 + i]; }
__device__ __forceinline__ void scan_chunk(const float* buf, float* sb, int l16, int lane, int i, f32x4& S) {
    f32x4 qw[3], qk[3], qb[3], qd[3]; float qv[3];
    SC_LD(0, 0); SC_LD(1, 1);
#pragma unroll
    for (int s = 0; s < SC_TS; ++s) {
        const int sl = s % 3;
        if (s + 2 < SC_TS) SC_LD((s + 2) % 3, s + 2);
        const f32x4 pk = S * qk[sl];
        const float sa = -red16((pk[0] + pk[1]) + (pk[2] + pk[3]));
        S = (S * qw[sl] + qd[sl] * qv[sl]) + qb[sl] * sa;
        *(f32x4*)(sb + (s * 64 + lane) * 4) = S;
    }
}
#define SC_LOAD(R, ch) { const float* _g = rec + (size_t)(ch) * SC_OPB + lt * 4; _Pragma("unroll") for (int q = 0; q < 12; ++q) R[q] = *(const f32x4*)(_g + q * 512); }
#define SC_WRITE(R, B) { float* _l = (B) + lt * 4; _Pragma("unroll") for (int q = 0; q < 12; ++q) *(f32x4*)(_l + q * 512) = R[q]; }
__device__ void phase_scan(const KP& p, int bid, char* smem) {
    const float* REC = (const float*)(p.ws + WS_REC);
    float* YD = (float*)(p.ws + WS_YD);
    float* B0 = (float*)smem;
    float* B1 = B0 + SC_OPB;
    float* SB0 = B1 + SC_OPB;
    float* SB1 = SB0 + 2 * SC_SBW;
    const int tid = otid(p.wb), wid = tid >> 6, lane = tid & 63, l16 = lane & 15;
    const int xcd = bid & 7, slot = bid >> 3, dh = xcd * 2 + (slot >> 3), rq = slot & 7;
    const int d = dh >> 3, h = dh & 7;
    const float* rec = REC + (size_t)dh * NTOK * 384;
    constexpr int NCH = NTOK / SC_TS;
    if (wid >= 6) {
        __syncthreads();
        for (int c = 0; c <= NCH; ++c) __syncthreads();
    } else if (wid >= 4) {
        const int lt = tid - 256;
        f32x4 R0[12], R1[12];
        SC_LOAD(R0, 0); SC_WRITE(R0, B0);
        SC_LOAD(R1, 1); SC_LOAD(R0, 2);
        __syncthreads();
        for (int c = 0; c < NCH; c += 2) {
            if (c + 1 < NCH) SC_WRITE(R1, B1);
            if (c + 3 < NCH) SC_LOAD(R1, c + 3);
            __syncthreads();
            if (c + 2 < NCH) SC_WRITE(R0, B0);
            if (c + 4 < NCH) SC_LOAD(R0, c + 4);
            __syncthreads();
        }
        __syncthreads();
    } else if (wid >= 2) {
        const int cw = wid - 2, dstep = d == 0 ? 1 : -1;
        float* yout = YD + (size_t)d * NTOK * RW + h * 64 + rq * 8 + cw * 4 + (lane >> 4);
        f32x4 rr[SC_TS];
#define SC_RLOAD(B) { _Pragma("unroll") for (int s = 0; s < SC_TS; ++s) rr[s] = *(const f32x4*)((B) + s * 384 + 256 + 4 * l16); }
#define SC_READOUT(SB, ch) { float yv = 0.f; \
            _Pragma("unroll") for (int s = 0; s < SC_TS; ++s) { const f32x4 sv = *(const f32x4*)((SB) + cw * SC_SBW + (s * 64 + lane) * 4); const f32x4 py = sv * rr[s]; \
                const float y = red16((py[0] + py[1]) + (py[2] + py[3])); yv = (l16 == s) ? y : yv; } \
            yout[(size_t)(scan_row(d, (ch) * SC_TS) + dstep * l16) * RW] = yv; }
        __syncthreads();
        SC_RLOAD(B0);
        __syncthreads();
        for (int c = 1; c < NCH; c += 2) {
            SC_READOUT(SB0, c - 1); SC_RLOAD(B1);
            __syncthreads();
            SC_READOUT(SB1, c);
            if (c + 1 < NCH) SC_RLOAD(B0);
            __syncthreads();
        }
    } else {
        const int i = rq * 8 + wid * 4 + (lane >> 4);
        f32x4 S = {0.f, 0.f, 0.f, 0.f};
        __syncthreads();
        for (int c = 0; c < NCH; c += 2) {
            scan_chunk(B0, SB0 + wid * SC_SBW, l16, lane, i, S);
            __syncthreads();
            scan_chunk(B1, SB1 + wid * SC_SBW, l16, lane, i, S);
            __syncthreads();
        }
        __syncthreads();
    }
}

constexpr int CK = 16, NCHK = NTOK / CK;
constexpr int FR_B = 12800;
constexpr int FR_AT = 0, FR_RT = 2048, FR_SM = 4096, FR_BT = 6144  , FR_VF = 10240, FR_GC = 12288;
template <int SH> __device__ __forceinline__ float row_shr1(float v) {
    return __int_as_float(__builtin_amdgcn_update_dpp(0x3f800000, __float_as_int(v), 0x110 + SH, 0xf, 0xf, false));
}
__device__ __forceinline__ bf16x8 frag8(const float (&v)[16], int q) {
    u32x4 w; w[0] = pack_bf2(v[4 * q], v[4 * q + 1]); w[1] = pack_bf2(v[4 * q + 2], v[4 * q + 3]); w[2] = pack_bf2(v[4 * q + 4], v[4 * q + 5]); w[3] = pack_bf2(v[4 * q + 6], v[4 * q + 7]);
    return __builtin_bit_cast(bf16x8, w);
}
__device__ __forceinline__ bf16x8 frag4(const f32x4 a) {
    u32x4 w; w[0] = pack_bf2(a[0], a[1]); w[1] = pack_bf2(a[2], a[3]); w[2] = 0u; w[3] = 0u;
    return __builtin_bit_cast(bf16x8, w);
}
__device__ __forceinline__ bf16x8 frag4u(unsigned lo, unsigned hi) { u32x4 w; w[0] = lo; w[1] = hi; w[2] = 0u; w[3] = 0u; return __builtin_bit_cast(bf16x8, w); }
#define MM(a, b, c) __builtin_amdgcn_mfma_f32_16x16x32_bf16(a, b, c, 0, 0, 0)
__device__ void phase_cprep(const KP& p, int bid, int nb, char* smem) {
    const float* RECW = (const float*)(p.ws + WS_REC);
    const bf16_t* RECD = (const bf16_t*)(RECW + (size_t)16 * NTOK * 64);
    const bf16_t* RECS = RECD + (size_t)16 * NTOK * 128;
    char* FR = p.ws + WS_FR;
    const int tid = otid(p.wb), wid = tid >> 6, lane = tid & 63, t = lane & 15, g = lane >> 4;
    bf16_t* zt = (bf16_t*)smem + wid * 2048;
    const f32x4 Z4 = {0.f, 0.f, 0.f, 0.f};
    for (int u = bid * 8 + wid; u < 16 * NCHK; u += nb * 8) {
        const int dh = u / NCHK, c = u % NCHK;
        const int d = dh >> 3, hh = dh & 7;
        const int row = scan_row(d, c * CK + t);
        const float* pw = RECW + ((size_t)dh * NTOK + row) * 64;
        const bf16_t* pd = RECD + ((size_t)dh * NTOK + row) * 128;
        const bf16_t* ps = RECS + ((size_t)hh * NTOK + row) * 192;
        float w_[16], kk[16], bb[16], kd[16], rr[16];
#pragma unroll
        for (int q = 0; q < 4; ++q) {
            const int jo = 32 * (q >> 1) + 16 * (q & 1) + 4 * g;
            const f32x4 a0 = *(const f32x4*)(pw + jo);
            const u32x2 ub = *(const u32x2*)(pd + jo), uk = *(const u32x2*)(pd + 64 + jo), ukk = *(const u32x2*)(ps + jo), ur = *(const u32x2*)(ps + 64 + jo);
#pragma unroll
            for (int e = 0; e < 4; ++e) {
                w_[4 * q + e] = a0[e];
                bb[4 * q + e] = __uint_as_float((e & 1) ? (ub[e >> 1] & 0xffff0000u) : (ub[e >> 1] << 16));
                kd[4 * q + e] = __uint_as_float((e & 1) ? (uk[e >> 1] & 0xffff0000u) : (uk[e >> 1] << 16));
                kk[4 * q + e] = __uint_as_float((e & 1) ? (ukk[e >> 1] & 0xffff0000u) : (ukk[e >> 1] << 16));
                rr[4 * q + e] = __uint_as_float((e & 1) ? (ur[e >> 1] & 0xffff0000u) : (ur[e >> 1] << 16));
            }
        }
        float gam[16], At[16], Bh[16], Kh[16], Rt[16], Bt[16], Kt[16];
#pragma unroll
        for (int k = 0; k < 16; ++k) {
            float x = w_[k];
            x *= row_shr1<1>(x); x *= row_shr1<2>(x); x *= row_shr1<4>(x); x *= row_shr1<8>(x);
            gam[k] = x;
        }
#pragma unroll
        for (int k = 0; k < 16; ++k) {
            const float gp = row_shr1<1>(gam[k]), gc = bperm(gam[k], (lane & 48) | 15), ig = frcp(gam[k]);
            At[k] = kk[k] * gp; Bh[k] = bb[k] * ig; Kh[k] = kd[k] * ig; Rt[k] = rr[k] * gam[k];
            Bt[k] = -Bh[k] * gc; Kt[k] = Kh[k] * gc;
        }
        const bf16x8 fA0 = frag8(At, 0), fA1 = frag8(At, 2), fB0 = frag8(Bh, 0), fB1 = frag8(Bh, 2), fK0 = frag8(Kh, 0), fK1 = frag8(Kh, 2), fR0 = frag8(Rt, 0), fR1 = frag8(Rt, 2);
        f32x4 X = MM(fA1, fB1, MM(fA0, fB0, Z4));
        f32x4 XT = MM(fB1, fA1, MM(fB0, fA0, Z4));
        f32x4 Lak = MM(fA1, fK1, MM(fA0, fK0, Z4));
        f32x4 LrbT = MM(fB1, fR1, MM(fB0, fR0, Z4));
        f32x4 LrkT = MM(fK1, fR1, MM(fK0, fR0, Z4));
        f32x4 T, TT;
#pragma unroll
        for (int r = 0; r < 4; ++r) {
            const int row = 4 * g + r;
            X[r] = t < row ? -X[r] : 0.f;
            XT[r] = row < t ? -XT[r] : 0.f;
            Lak[r] = t < row ? Lak[r] : 0.f;
            LrbT[r] = row <= t ? -LrbT[r] : 0.f;
            LrkT[r] = row <= t ? LrkT[r] : 0.f;
            const float id = row == t ? 1.f : 0.f;
            T[r] = id + X[r]; TT[r] = id + XT[r];
        }
#pragma unroll
        for (int it = 0; it < 3; ++it) {
            const f32x4 X2 = MM(frag4(XT), frag4(X), Z4), X2T = MM(frag4(X), frag4(XT), Z4);
            const f32x4 Tn = MM(frag4(TT), frag4(X2), T), TTn = MM(frag4(X2), frag4(TT), TT);
            X = X2; XT = X2T; T = Tn; TT = TTn;
        }
        const f32x4 TLT = MM(frag4(Lak), frag4(TT), Z4);
#pragma unroll
        for (int q = 0; q < 4; ++q)
#pragma unroll
            for (int e = 0; e < 4; ++e) {
                const int j = 32 * (q >> 1) + 16 * (q & 1) + 4 * g + e;
                zt[j * 16 + t] = f2bf(Bt[4 * q + e]); zt[1024 + j * 16 + t] = f2bf(Kt[4 * q + e]);
            }
        char* fb = FR + ((size_t)dh * NCHK + c) * FR_B;
        *(bf16x8*)(fb + FR_AT + lane * 16) = fA0; *(bf16x8*)(fb + FR_AT + 1024 + lane * 16) = fA1;
        *(bf16x8*)(fb + FR_RT + lane * 16) = fR0; *(bf16x8*)(fb + FR_RT + 1024 + lane * 16) = fR1;
        {
            u32x4 s0, s1;
            s0[0] = pack_bf2(TT[0], TT[1]); s0[1] = pack_bf2(TT[2], TT[3]); s0[2] = pack_bf2(TLT[0], TLT[1]); s0[3] = pack_bf2(TLT[2], TLT[3]);
            s1[0] = pack_bf2(LrbT[0], LrbT[1]); s1[1] = pack_bf2(LrbT[2], LrbT[3]); s1[2] = pack_bf2(LrkT[0], LrkT[1]); s1[3] = pack_bf2(LrkT[2], LrkT[3]);
            *(u32x4*)(fb + FR_SM + lane * 32) = s0; *(u32x4*)(fb + FR_SM + lane * 32 + 16) = s1;
        }
#pragma unroll
        for (int jt = 0; jt < 4; ++jt) {
            {
                const u32x2 b2 = *(const u32x2*)(zt + (16 * jt + t) * 16 + 4 * g), k2 = *(const u32x2*)(zt + 1024 + (16 * jt + t) * 16 + 4 * g);
                u32x4 bk; bk[0] = b2[0]; bk[1] = b2[1]; bk[2] = k2[0]; bk[3] = k2[1];
                *(u32x4*)(fb + FR_BT + jt * 1024 + lane * 16) = bk;
            }
            const int dstp = d == 0 ? 1 : -1;
            const bf16_t* vp = RECS + ((size_t)hh * NTOK + scan_row(d, c * CK + 4 * g)) * 192 + 128 + 16 * jt + t;
            u32x2 vw; vw[0] = (unsigned)vp[0] | ((unsigned)vp[dstp * 192] << 16); vw[1] = (unsigned)vp[2 * dstp * 192] | ((unsigned)vp[3 * dstp * 192] << 16);
            *(u32x2*)(fb + FR_VF + jt * 512 + lane * 8) = vw;
        }
        if (t == 15) {
#pragma unroll
            for (int q = 0; q < 4; ++q) { f32x4 gv = {gam[4 * q], gam[4 * q + 1], gam[4 * q + 2], gam[4 * q + 3]}; *(f32x4*)(fb + FR_GC + (32 * (q >> 1) + 16 * (q & 1) + 4 * g) * 4) = gv; }
        }
    }
}

constexpr int CS_BLOCKS = 16, CS_R = 3;
__device__ void phase_cscan(const KP& p, int bid, char* smem) {
    const char* FRs = p.ws + WS_FR + (size_t)bid * NCHK * FR_B;
    float* YD = (float*)(p.ws + WS_YD);
    const int tid = otid(p.wb), wid = tid >> 6, lane = tid & 63, c16 = lane & 15, g = lane >> 4;
    const int d = bid >> 3, h = bid & 7;
    if (wid >= 4) {
        const int lw = wid - 4;
        const bool tail = lw == 0 && lane < 16;
        u32x4 fifo[8][4];
#define CS_LD(k, ch) { const char* _s = FRs + (size_t)(ch) * FR_B + lane * 16; \
            _Pragma("unroll") for (int _q = 0; _q < 3; ++_q) fifo[k][_q] = *(const u32x4*)(_s + (lw + 4 * _q) * 1024); \
            if (tail) fifo[k][3] = *(const u32x4*)(_s + 12288); }
#define CS_WR(k, ch) { char* _d = smem + ((ch) % CS_R) * FR_B + lane * 16; \
            _Pragma("unroll") for (int _q = 0; _q < 3; ++_q) *(u32x4*)(_d + (lw + 4 * _q) * 1024) = fifo[k][_q]; \
            if (tail) *(u32x4*)(_d + 12288) = fifo[k][3]; }
#define CS_BAR() { asm volatile("" ::: "memory"); __builtin_amdgcn_s_barrier(); asm volatile("" ::: "memory"); }
#define CS_PERIOD(r) { if (pch + (r) + 1 < NCHK) CS_WR(((r) + 1) & 7, pch + (r) + 1); if (pch + (r) + 9 < NCHK) CS_LD(((r) + 1) & 7, pch + (r) + 9); CS_BAR(); }
        CS_LD(0, 0); CS_LD(1, 1); CS_LD(2, 2); CS_LD(3, 3); CS_LD(4, 4); CS_LD(5, 5); CS_LD(6, 6); CS_LD(7, 7);
        CS_WR(0, 0); CS_LD(0, 8);
        CS_BAR();
        for (int pch = 0; pch < NCHK; pch += 8) {
            CS_PERIOD(0); CS_PERIOD(1); CS_PERIOD(2); CS_PERIOD(3); CS_PERIOD(4); CS_PERIOD(5); CS_PERIOD(6); CS_PERIOD(7);
        }
    } else {
        const int it = wid, dstep = d == 0 ? 1 : -1;
        float* yout = YD + (size_t)d * NTOK * RW + h * 64 + it * 16 + c16;
        const f32x4 Z4 = {0.f, 0.f, 0.f, 0.f};
        f32x4 ST[4] = {Z4, Z4, Z4, Z4};
        asm volatile("" ::: "memory"); __builtin_amdgcn_s_barrier(); asm volatile("" ::: "memory");
        for (int pch = 0; pch < NCHK; ++pch) {
            const char* sb = smem + (pch % CS_R) * FR_B;
            const bf16x8 A0 = *(const bf16x8*)(sb + FR_AT + lane * 16), A1 = *(const bf16x8*)(sb + FR_AT + 1024 + lane * 16);
            const bf16x8 R0 = *(const bf16x8*)(sb + FR_RT + lane * 16), R1 = *(const bf16x8*)(sb + FR_RT + 1024 + lane * 16);
            const bf16x8 TTL = *(const bf16x8*)(sb + FR_SM + lane * 32), LRR = *(const bf16x8*)(sb + FR_SM + lane * 32 + 16);
            const u32x2 vf = *(const u32x2*)(sb + FR_VF + it * 512 + lane * 8);
            u32x4 b0, b1;
            b0[0] = pack_bf2(ST[0][0], ST[0][1]); b0[1] = pack_bf2(ST[0][2], ST[0][3]); b0[2] = pack_bf2(ST[1][0], ST[1][1]); b0[3] = pack_bf2(ST[1][2], ST[1][3]);
            b1[0] = pack_bf2(ST[2][0], ST[2][1]); b1[1] = pack_bf2(ST[2][2], ST[2][3]); b1[2] = pack_bf2(ST[3][0], ST[3][1]); b1[3] = pack_bf2(ST[3][2], ST[3][3]);
            const bf16x8 Bs0 = __builtin_bit_cast(bf16x8, b0), Bs1 = __builtin_bit_cast(bf16x8, b1);
            const f32x4 Q = MM(A1, Bs1, MM(A0, Bs0, Z4));
            u32x4 qv; qv[0] = pack_bf2(Q[0], Q[1]); qv[1] = pack_bf2(Q[2], Q[3]); qv[2] = vf[0]; qv[3] = vf[1];
            const f32x4 P = MM(TTL, __builtin_bit_cast(bf16x8, qv), Z4);
            u32x4 pv; pv[0] = pack_bf2(P[0], P[1]); pv[1] = pack_bf2(P[2], P[3]); pv[2] = vf[0]; pv[3] = vf[1];
            const bf16x8 PV = __builtin_bit_cast(bf16x8, pv);
            const f32x4 Y = MM(LRR, PV, MM(R1, Bs1, MM(R0, Bs0, Z4)));
#pragma unroll
            for (int jt = 0; jt < 4; ++jt) {
                const f32x4 gc = *(const f32x4*)(sb + FR_GC + (16 * jt + 4 * g) * 4);
                const bf16x8 bk = *(const bf16x8*)(sb + FR_BT + jt * 1024 + lane * 16);
                ST[jt] = MM(bk, PV, ST[jt] * gc);
            }
            const int row0 = scan_row(d, pch * CK) + dstep * 4 * g;
#pragma unroll
            for (int r = 0; r < 4; ++r) yout[(size_t)(row0 + dstep * r) * RW] = Y[r];
            asm volatile("" ::: "memory"); __builtin_amdgcn_s_barrier(); asm volatile("" ::: "memory");
        }
    }
}
#undef MM

__device__ void phase_rwpost(const KP& p, int l, int bid, int nb) {
    const float* YD = (const float*)(p.ws + WS_YD);
    const float* G = (const float*)(p.ws + WS_G);
    const float* BV = (const float*)(p.ws + WS_BV);
    bf16_t* Y = (bf16_t*)(p.ws + WS_YCAT);
    const float* lng = p.rw_ln_g + (size_t)l * RW;
    const float* lnb = p.rw_ln_b + (size_t)l * RW;
    const int tid = otid(p.wb), wid = tid >> 6, lane = tid & 63;
    for (int u = bid * 8 + wid; u < NTOK * 8; u += nb * 8) {
        const int row = u >> 3, h = u & 7, c = h * 64 + lane;
        const float y = YD[(size_t)row * RW + c] + YD[((size_t)NTOK + row) * RW + c];
        const float mean = wave_sum(y) * (1.f / 64);
        const float dv = y - mean;
        const float var = wave_sum(dv * dv) * (1.f / 64);
        const float yn = dv * rsqrtf(var + 64e-5f) * lng[c] + lnb[c];
        Y[(size_t)row * D + c] = f2bf((yn + BV[(size_t)row * RW + c]) * G[(size_t)row * RW + c]);
    }
}

constexpr int GM_LD = 136;
__device__ void phase_gmlp(const KP& p, int l, int bid, int nb, char* smem) {
    const float* P = (const float*)(p.ws + WS_P);
    const float* GMR = (const float*)(p.ws + WS_GMR);
    bf16_t* Y = (bf16_t*)(p.ws + WS_YCAT);
    bf16_t* vt = (bf16_t*)smem;
    const float* ng = p.gm_norm_g + (size_t)l * GMW;
    const int tid = otid(p.wb), wid = tid >> 6, lane = tid & 63, r = lane & 31, h = lane >> 5, mt = wid >> 1, nt = wid & 1;
    for (int u = bid; u < (NTOK / 128) * 8; u += nb) {
        const int n = u >> 3, g = u & 7, t0 = n * 128;
        const float* ws = p.gm_ws + ((size_t)l * 8 + g) * 128 * 128;
        const float* bs = p.gm_b + ((size_t)l * 8 + g) * 128;
        __syncthreads();
        {
            const int c = tid & 63, qp0 = tid >> 6;
            const float gn = ng[g * 64 + c];
#pragma unroll
            for (int i = 0; i < 8; ++i) {
                const int q = (qp0 + 8 * i) * 2;
                const float v0 = gelu_tanh(P[(size_t)(t0 + q) * INP + COL_GM + GMW + g * 64 + c]) * GMR[t0 + q] * gn;
                const float v1 = gelu_tanh(P[(size_t)(t0 + q + 1) * INP + COL_GM + GMW + g * 64 + c]) * GMR[t0 + q + 1] * gn;
                *(unsigned*)(vt + c * GM_LD + q) = pack_bf2(v0, v1);
            }
        }
        __syncthreads();
        f32x16 acc;
#pragma unroll
        for (int i = 0; i < 16; ++i) acc[i] = 0.f;
        const float* arow = ws + (size_t)(mt * 32 + r) * 128 + h * 8;
#pragma unroll
        for (int ks = 0; ks < 8; ++ks) {
            const f32x4 a0 = *(const f32x4*)(arow + ks * 16), a1 = *(const f32x4*)(arow + ks * 16 + 4);
            u32x4 aw; aw[0] = pack_bf2(a0[0], a0[1]); aw[1] = pack_bf2(a0[2], a0[3]); aw[2] = pack_bf2(a1[0], a1[1]); aw[3] = pack_bf2(a1[2], a1[3]);
            const bf16x8 bfr = *(const bf16x8*)(vt + (nt * 32 + r) * GM_LD + ks * 16 + h * 8);
            acc = __builtin_amdgcn_mfma_f32_32x32x16_bf16(__builtin_bit_cast(bf16x8, aw), bfr, acc, 0, 0, 0);
        }
        const int c = nt * 32 + r;
#pragma unroll
        for (int i = 0; i < 16; ++i) {
            const int pp = mt * 32 + (i & 3) + 8 * (i >> 2) + 4 * h;
            const float uu = gelu_tanh(P[(size_t)(t0 + pp) * INP + COL_GM + g * 64 + c]);
            Y[(size_t)(t0 + pp) * D + 512 + g * 64 + c] = f2bf(uu * (acc[i] + bs[pp]));
        }
    }
}

__device__ void phase_atprep(const KP& p, int l, int bid, int nb, char* smem) {
    const float* P = (const float*)(p.ws + WS_P);
    bf16_t* Qb = (bf16_t*)(p.ws + WS_Q);
    bf16_t* Kb = (bf16_t*)(p.ws + WS_K);
    bf16_t* VT = Kb + (size_t)NTOK * 256;
    const float* qn = p.at_qn + (size_t)l * 64;
    const float* kn = p.at_kn + (size_t)l * 64;
    const int tid = otid(p.wb);
    const float* rope = (const float*)(p.ws + WS_ROPE);
    for (int i = bid * NT + tid; i < NTOK * 20; i += nb * NT) {
        const int row = i / 20, hv = i % 20;
        const bool isq = hv < 16;
        const float* src = P + (size_t)row * INP + (isq ? COL_AT + hv * 64 : COL_K + (hv - 16) * 64);
        const float* gn = isq ? qn : kn;
        f32x4 x[16]; float ss = 0.f;
#pragma unroll
        for (int k = 0; k < 16; ++k) { x[k] = *(const f32x4*)(src + 4 * k); ss += x[k][0] * x[k][0] + x[k][1] * x[k][1] + x[k][2] * x[k][2] + x[k][3] * x[k][3]; }
        const float sc = rsqrtf(ss * (1.f / 64) + 1e-6f) * (isq ? 0.125f : 1.f);
#pragma unroll
        for (int k = 0; k < 16; ++k) x[k] = x[k] * *(const f32x4*)(gn + 4 * k) * sc;
        if (row < SEQ) {
#pragma unroll
            for (int sec = 0; sec < 2; ++sec) {
                const float* rt = rope + (size_t)((sec == 0 ? (row >> 6) : (128 + (row & 63))) * 16) * 2;
#pragma unroll
                for (int k = 0; k < 4; ++k) {
                    const f32x4 c0 = *(const f32x4*)(rt + 8 * k), c1 = *(const f32x4*)(rt + 8 * k + 4);
                    f32x4& a = x[8 * sec + k]; f32x4& b2 = x[8 * sec + 4 + k];
                    const float cs[4] = {c0[0], c0[2], c1[0], c1[2]}, sn[4] = {c0[1], c0[3], c1[1], c1[3]};
#pragma unroll
                    for (int e = 0; e < 4; ++e) { const float x1 = a[e], x2 = b2[e]; a[e] = x1 * cs[e] - x2 * sn[e]; b2[e] = x2 * cs[e] + x1 * sn[e]; }
                }
            }
        }
        bf16_t* dst = isq ? (Qb + (size_t)row * 1024 + hv * 64) : (Kb + (size_t)row * 256 + (hv - 16) * 64);
#pragma unroll
        for (int k = 0; k < 8; ++k) {
            u32x4 w; w[0] = pack_bf2(x[2 * k][0], x[2 * k][1]); w[1] = pack_bf2(x[2 * k][2], x[2 * k][3]); w[2] = pack_bf2(x[2 * k + 1][0], x[2 * k + 1][1]); w[3] = pack_bf2(x[2 * k + 1][2], x[2 * k + 1][3]);
            *(u32x4*)(dst + 8 * k) = w;
        }
    }
    float* tile = (float*)smem;
    for (int u = bid; u < (NTOK / 64) * 4; u += nb) {
        const int t0 = (u >> 2) * 64, kvh = u & 3;
        __syncthreads();
        {
            const int tok = tid >> 3, d8 = (tid & 7) * 8;
            const float* src = P + (size_t)(t0 + tok) * INP + COL_V + kvh * 64 + d8;
            const f32x4 a = *(const f32x4*)src, b2 = *(const f32x4*)(src + 4);
#pragma unroll
            for (int i = 0; i < 4; ++i) { tile[tok * 65 + d8 + i] = a[i]; tile[tok * 65 + d8 + 4 + i] = b2[i]; }
        }
        __syncthreads();
        {
            const int d = tid >> 3, tk = (tid & 7) * 8;
            u32x4 w;
#pragma unroll
            for (int i = 0; i < 4; ++i) w[i] = pack_bf2(tile[(tk + 2 * i) * 65 + d], tile[(tk + 2 * i + 1) * 65 + d]);
            *(u32x4*)(VT + (size_t)(kvh * 64 + d) * NTOK + t0 + tk) = w;
        }
    }
}

constexpr int AT_LD = 72;
constexpr int AT_TILE = 64 * AT_LD;
__device__ void phase_attn(const KP& p, int l, int bid, int nb, char* smem) {
    const bf16_t* Qb = (const bf16_t*)(p.ws + WS_Q);
    const bf16_t* Kb = (const bf16_t*)(p.ws + WS_K);
    const bf16_t* VT = Kb + (size_t)NTOK * 256;
    bf16_t* Y = (bf16_t*)(p.ws + WS_YCAT);
    bf16_t* Kc = (bf16_t*)smem;
    bf16_t* Vc = Kc + AT_TILE;
    const int tid = otid(p.wb), wid = tid >> 6, lane = tid & 63, q = lane & 31, h = lane >> 5, g = wid >> 1, qh = wid & 1;
    const int srow = tid >> 3, sseg = tid & 7;
    const int voff = srow * AT_LD + (sseg >> 2) * 32 + ((sseg >> 1) & 1) * 16 + (sseg & 1) * 4;
    for (int u = bid; u < (NTOK / 64) * 4; u += nb) {
        const int qt = u >> 2, kvh = u & 3, t0 = qt * 64, head = kvh * 4 + g, qrow = t0 + qh * 32 + q;
        int c_lo = 0, n_local = 0;
        if (t0 < SEQ) { c_lo = 2 - (t0 >> 6); if (c_lo < 0) c_lo = 0; int c_hi = (SEQ + 64 - t0) >> 6; if (c_hi > 4) c_hi = 4; n_local = c_hi - c_lo + 1; }
        const int nch = n_local + 4;
        bf16x8 qf[4];
#pragma unroll
        for (int ks = 0; ks < 4; ++ks) qf[ks] = *(const bf16x8*)(Qb + (size_t)qrow * 1024 + head * 64 + ks * 16 + h * 8);
        f32x16 O0, O1;
#pragma unroll
        for (int r = 0; r < 16; ++r) { O0[r] = 0.f; O1[r] = 0.f; }
        float m = p.at_sink[(size_t)l * 16 + head], lsum = h == 0 ? 1.f : 0.f;
        u32x4 rk, rv;
        {
            const int k0 = n_local > 0 ? (t0 - 128 + 64 * c_lo) : SEQ;
            rk = *(const u32x4*)(Kb + (size_t)(k0 + srow) * 256 + kvh * 64 + sseg * 8);
            rv = *(const u32x4*)(VT + (size_t)(kvh * 64 + srow) * NTOK + k0 + sseg * 8);
        }
        for (int ci = 0; ci < nch; ++ci) {
            const bool local = ci < n_local;
            const int k0 = local ? (t0 - 128 + 64 * (c_lo + ci)) : (SEQ + 64 * (ci - n_local));
            __syncthreads();
            *(u32x4*)(Kc + srow * AT_LD + sseg * 8) = rk;
            { u32x2 lo, hi; lo[0] = rv[0]; lo[1] = rv[1]; hi[0] = rv[2]; hi[1] = rv[3]; *(u32x2*)(Vc + voff) = lo; *(u32x2*)(Vc + voff + 8) = hi; }
            __syncthreads();
            if (ci + 1 < nch) {
                const int kn = (ci + 1 < n_local) ? (t0 - 128 + 64 * (c_lo + ci + 1)) : (SEQ + 64 * (ci + 1 - n_local));
                rk = *(const u32x4*)(Kb + (size_t)(kn + srow) * 256 + kvh * 64 + sseg * 8);
                rv = *(const u32x4*)(VT + (size_t)(kvh * 64 + srow) * NTOK + kn + sseg * 8);
            }
            f32x16 s0, s1;
#pragma unroll
            for (int r = 0; r < 16; ++r) { s0[r] = 0.f; s1[r] = 0.f; }
#pragma unroll
            for (int ks = 0; ks < 4; ++ks) {
                const bf16x8 k0f = *(const bf16x8*)(Kc + q * AT_LD + ks * 16 + h * 8);
                const bf16x8 k1f = *(const bf16x8*)(Kc + (32 + q) * AT_LD + ks * 16 + h * 8);
                s0 = __builtin_amdgcn_mfma_f32_32x32x16_bf16(k0f, qf[ks], s0, 0, 0, 0);
                s1 = __builtin_amdgcn_mfma_f32_32x32x16_bf16(k1f, qf[ks], s1, 0, 0, 0);
            }
            if (local) {
                const int base = k0 + 4 * h - qrow;
#pragma unroll
                for (int r = 0; r < 16; ++r) {
                    const int d0 = base + (r & 3) + 8 * (r >> 2), d1 = d0 + 32;
                    if (d0 > 128 || d0 < -128) s0[r] = -INFINITY;
                    if (d1 > 128 || d1 < -128) s1[r] = -INFINITY;
                }
            }
            float mx = fmaxf(s0[0], s1[0]);
#pragma unroll
            for (int r = 1; r < 16; ++r) mx = fmaxf(mx, fmaxf(s0[r], s1[r]));
            mx = fmaxf(mx, bperm(mx, lane ^ 32));
            const float mnew = fmaxf(m, mx);
            const float alpha = __expf(m - mnew);
            m = mnew; lsum *= alpha;
#pragma unroll
            for (int r = 0; r < 16; ++r) { O0[r] *= alpha; O1[r] *= alpha; }
            float ps = 0.f;
#pragma unroll
            for (int r = 0; r < 16; ++r) { s0[r] = __expf(s0[r] - m); s1[r] = __expf(s1[r] - m); ps += s0[r] + s1[r]; }
            lsum += ps;
            bf16x8 pf[2][2];
#pragma unroll
            for (int s = 0; s < 2; ++s) {
                u32x4 w0, w1;
#pragma unroll
                for (int i = 0; i < 4; ++i) { w0[i] = pack_bf2(s0[8 * s + 2 * i], s0[8 * s + 2 * i + 1]); w1[i] = pack_bf2(s1[8 * s + 2 * i], s1[8 * s + 2 * i + 1]); }
                pf[0][s] = __builtin_bit_cast(bf16x8, w0); pf[1][s] = __builtin_bit_cast(bf16x8, w1);
            }
#pragma unroll
            for (int kb = 0; kb < 2; ++kb)
#pragma unroll
                for (int s = 0; s < 2; ++s) {
                    const bf16x8 v0f = *(const bf16x8*)(Vc + q * AT_LD + kb * 32 + s * 16 + h * 8);
                    const bf16x8 v1f = *(const bf16x8*)(Vc + (32 + q) * AT_LD + kb * 32 + s * 16 + h * 8);
                    O0 = __builtin_amdgcn_mfma_f32_32x32x16_bf16(v0f, pf[kb][s], O0, 0, 0, 0);
                    O1 = __builtin_amdgcn_mfma_f32_32x32x16_bf16(v1f, pf[kb][s], O1, 0, 0, 0);
                }
        }
        lsum += bperm(lsum, lane ^ 32);
        const float inv = 1.f / lsum;
        bf16_t* yo = Y + (size_t)qrow * D + 1024 + head * 64 + 4 * h;
#pragma unroll
        for (int rg = 0; rg < 4; ++rg) {
            u32x2 w0, w1;
            w0[0] = pack_bf2(O0[4 * rg] * inv, O0[4 * rg + 1] * inv); w0[1] = pack_bf2(O0[4 * rg + 2] * inv, O0[4 * rg + 3] * inv);
            w1[0] = pack_bf2(O1[4 * rg] * inv, O1[4 * rg + 1] * inv); w1[1] = pack_bf2(O1[4 * rg + 2] * inv, O1[4 * rg + 3] * inv);
            *(u32x2*)(yo + 8 * rg) = w0;
            *(u32x2*)(yo + 32 + 8 * rg) = w1;
        }
    }
}

__device__ void phase_oproj(const KP& p, int l, int bid, int nb, bf16_t* shm) {
    const bf16_t* Y = (const bf16_t*)(p.ws + WS_YCAT);
    const bf16_t* Bt = (const bf16_t*)(p.ws + WS_WOT) + (size_t)l * D * D;
    const RowSrc in = layer_in(p, l);
    const RowDst out = layer_out(p, l);
    const int nM = ntok_of(l) / 256, nN = D / 256, nwg = nM * nN;
    gemm_phase<false>(nwg, bid, nb, D, shm, p.wb,
        [&](int L) { int pm, pn; dense_tile(xcd_remap(L, nwg), nM, nN, pm, pn); GU u; u.A = Y; u.Bt = Bt + (size_t)(pn * 256) * D; u.i0 = pm * 256; u.i1 = pn * 256; u.i2 = 0; u.i3 = 0; return u; },
        [&](const GU& u, int r) { return (u.i0 + r) * D; },
        [&](const GU& u, f32x4 (&acc)[2][2][4][2]) {
            const int m0 = u.i0, n0 = u.i1;
            G_IDX;
#pragma unroll
            for (int ai = 0; ai < 2; ++ai)
#pragma unroll
                for (int m = 0; m < 4; ++m) {
                    const int row = m0 + ai * 128 + wr * 64 + m * 16 + fr;
                    const float* xi = rowp(in, row);
                    float* xo = rowp(out, row);
                    const float* g1 = modp(p, l, row, 2);
#pragma unroll
                    for (int bj = 0; bj < 2; ++bj)
#pragma unroll
                        for (int n = 0; n < 2; ++n) {
                            const int col = n0 + bj * 128 + wc * 32 + n * 16 + fq * 4;
                            *(f32x4*)(xo + col) = *(const f32x4*)(xi + col) + *(const f32x4*)(g1 + col) * acc[ai][bj][m][n];
                        }
                }
        });
}

constexpr int RT_R = 11;
constexpr int RT_LD = D + 8;
__device__ void phase_norm2_route(const KP& p, int l, int bid, int nb, char* smem, const bool dummy = false) {
    const RowDst xs = layer_out(p, l);
    bf16_t* H = (bf16_t*)(p.ws + WS_H);
    int* cnt = (int*)(p.ws + WS_CNT) + l * 64 + (dummy ? 128 : 0);
    int* tokE = (int*)(p.ws + WS_TOKE);
    int* tokP = (int*)(p.ws + WS_TOKP);
    float* tokW = (float*)(p.ws + WS_TOKW);
    const float* g = p.norm2_g + (size_t)l * D;
    const bf16_t* RTH = (const bf16_t*)(p.ws + WS_RT) + (size_t)l * 2 * NE * D;
    const bf16_t* RTL = RTH + (size_t)NE * D;
    const float* rbias = p.moe_bias + (size_t)l * NE;
    bf16_t* hh = (bf16_t*)smem;
    bf16_t* hl = hh + RT_R * RT_LD;
    float* part = (float*)(hl + RT_R * RT_LD);
    int* lcnt = (int*)(part + 8 * 64 * 16);
    int* lbase = lcnt + 64;
    int* lsel = lbase + 64;
    const int tid = otid(p.wb), wid = tid >> 6, lane = tid & 63, c16 = lane & 15, g4 = lane >> 4;
    const int ntok = ntok_of(l), nsteps = (ntok + RT_R - 1) / RT_R;
    __syncthreads();
    if (tid < 64) lcnt[tid] = 0;
    for (int i = tid; i < 4 * RT_R * 8; i += NT) lsel[i] = -1;
    int step = 0;
    for (int blk = bid; blk < nsteps; blk += nb, ++step) {
        const int t0 = blk * RT_R;
        __syncthreads();
        {
            int rrq[2], rowq[2]; bool liveq[2]; const float* xrq[2]; const float* shq[2]; const float* scq[2];
            f32x4 v[2][8]; float ss[2];
#pragma unroll
            for (int q = 0; q < 2; ++q) {
                rrq[q] = wid + 8 * q; liveq[q] = rrq[q] < RT_R && t0 + rrq[q] < ntok;
                rowq[q] = liveq[q] ? t0 + rrq[q] : ntok - 1;
                xrq[q] = rowp(xs, rowq[q]); shq[q] = modp(p, l, rowq[q], 3); scq[q] = modp(p, l, rowq[q], 4); ss[q] = 0.f;
            }
#pragma unroll
            for (int i = 0; i < 8; ++i)
#pragma unroll
                for (int q = 0; q < 2; ++q) { v[q][i] = *(const f32x4*)(xrq[q] + i * 256 + lane * 4); ss[q] += v[q][i][0] * v[q][i][0] + v[q][i][1] * v[q][i][1] + v[q][i][2] * v[q][i][2] + v[q][i][3] * v[q][i][3]; }
            float rstd[2];
#pragma unroll
            for (int q = 0; q < 2; ++q) rstd[q] = rsqrtf(wave_sum(ss[q]) * (1.f / D) + 1e-6f);
#pragma unroll
            for (int i = 0; i < 8; ++i) {
                const int c = i * 256 + lane * 4;
                const f32x4 gv = *(const f32x4*)(g + c);
#pragma unroll
                for (int q = 0; q < 2; ++q) {
                    const f32x4 shv = *(const f32x4*)(shq[q] + c), scv = *(const f32x4*)(scq[q] + c);
                    float o[4]; unsigned hi[4]; float lo[4];
#pragma unroll
                    for (int j = 0; j < 4; ++j) { const float t = v[q][i][j] * rstd[q] * gv[j]; o[j] = fmaf(t, scv[j], t) + shv[j]; hi[j] = f2bf(o[j]); lo[j] = o[j] - __uint_as_float(hi[j] << 16); }
                    u32x2 wh, wl; wh[0] = hi[0] | (hi[1] << 16); wh[1] = hi[2] | (hi[3] << 16); wl[0] = pack_bf2(lo[0], lo[1]); wl[1] = pack_bf2(lo[2], lo[3]);
                    if (rrq[q] < RT_R) { *(u32x2*)(hh + rrq[q] * RT_LD + c) = wh; *(u32x2*)(hl + rrq[q] * RT_LD + c) = wl; }
                    if (liveq[q]) *(u32x2*)(H + (size_t)rowq[q] * D + c) = wh;
                }
            }
        }
        __syncthreads();
        {
            f32x4 acc[4];
#pragma unroll
            for (int et = 0; et < 4; ++et) acc[et] = (f32x4){0.f, 0.f, 0.f, 0.f};
            const int hr = c16 < RT_R ? c16 : RT_R - 1;
            const bf16_t* bh = hh + hr * RT_LD + wid * 256 + g4 * 8;
            const bf16_t* bl = hl + hr * RT_LD + wid * 256 + g4 * 8;
            const bf16_t* ah = RTH + (size_t)c16 * D + wid * 256 + g4 * 8;
            const bf16_t* al = RTL + (size_t)c16 * D + wid * 256 + g4 * 8;
#pragma unroll 2
            for (int ks = 0; ks < 8; ++ks) {
                const bf16x8 bhf = *(const bf16x8*)(bh + ks * 32), blf = *(const bf16x8*)(bl + ks * 32);
#pragma unroll
                for (int et = 0; et < 4; ++et) {
                    const bf16x8 ahf = *(const bf16x8*)(ah + (size_t)et * 16 * D + ks * 32), alf = *(const bf16x8*)(al + (size_t)et * 16 * D + ks * 32);
                    acc[et] = __builtin_amdgcn_mfma_f32_16x16x32_bf16(ahf, bhf, acc[et], 0, 0, 0);
                    acc[et] = __builtin_amdgcn_mfma_f32_16x16x32_bf16(ahf, blf, acc[et], 0, 0, 0);
                    acc[et] = __builtin_amdgcn_mfma_f32_16x16x32_bf16(alf, bhf, acc[et], 0, 0, 0);
                }
            }
#pragma unroll
            for (int et = 0; et < 4; ++et)
#pragma unroll
                for (int r = 0; r < 4; ++r) part[(wid * 64 + et * 16 + g4 * 4 + r) * 16 + c16] = acc[et][r];
        }
        __syncthreads();
        {
            bool liveq[2]; int rowq[2]; float score[2], biased[2], val[2]; int sel[2];
#pragma unroll
            for (int q = 0; q < 2; ++q) {
                const int rr = wid + 8 * q;
                liveq[q] = rr < RT_R && t0 + rr < ntok; rowq[q] = t0 + rr;
                const int rc = rr < RT_R ? rr : RT_R - 1;
                float logit = 0.f;
#pragma unroll
                for (int kq = 0; kq < 8; ++kq) logit += part[(kq * 64 + lane) * 16 + rc];
                score[q] = sigmoidf_(logit); biased[q] = score[q] + rbias[lane]; sel[q] = -1;
            }
            const int gbase = lane & ~7, mygrp = lane >> 3;
#pragma unroll
            for (int q = 0; q < 2; ++q) {
                const float m1 = max8(biased[q]);
                const unsigned long long eq = __ballot(biased[q] == m1);
                const unsigned geq = (unsigned)((eq >> gbase) & 0xffull);
                const int first = gbase + (__ffs(geq) - 1);
                const float m2 = max8((lane == first) ? -INFINITY : biased[q]);
                const float gs = m1 + m2;
                int rank = 0;
#pragma unroll
                for (int k = 0; k < 8; ++k) { const float o = bperm(gs, k * 8); rank += (o > gs || (o == gs && k < mygrp)) ? 1 : 0; }
                val[q] = rank < 4 ? biased[q] : -INFINITY;
            }
#pragma unroll
            for (int j = 0; j < TOPK; ++j)
#pragma unroll
                for (int q = 0; q < 2; ++q) {
                    const float mx = wave_max(val[q]);
                    const unsigned long long bm = __ballot(val[q] == mx);
                    const int win = __ffsll((long long)bm) - 1;
                    if (lane == win) { sel[q] = j; val[q] = -INFINITY; }
                }
#pragma unroll
            for (int q = 0; q < 2; ++q) {
                const float ssum = wave_sum(sel[q] >= 0 ? score[q] : 0.f);
                if (liveq[q] && sel[q] >= 0) {
                    const int lr = atomicAdd(lcnt + lane, 1);
                    lsel[((step * RT_R) + (wid + 8 * q)) * 8 + sel[q]] = (lane << 16) | lr;
                    if (!dummy) { tokE[(size_t)rowq[q] * 8 + sel[q]] = lane; tokW[(size_t)rowq[q] * 8 + sel[q]] = score[q] * frcp(ssum) * 2.5f; }
                }
            }
        }
    }
    __syncthreads();
    if (tid < 64) lbase[tid] = atomicAdd(cnt + tid, lcnt[tid]);
    __syncthreads();
    if (!dummy)
        for (int i = tid; i < step * RT_R * 8; i += NT) {
            const int v = lsel[i];
            if (v < 0) continue;
            const int st = i / (RT_R * 8), rr = (i / 8) % RT_R, j = i & 7;
            const int row = (bid + st * nb) * RT_R + rr;
            tokP[(size_t)row * 8 + j] = lbase[v >> 16] + (v & 0xffff);
        }
}

__device__ void phase_slots(const KP& p, int l, int bid, int nb, char* smem) {
    const int* cnt = (const int*)(p.ws + WS_CNT) + l * 64;
    const int* tokE = (const int*)(p.ws + WS_TOKE);
    const int* tokP = (const int*)(p.ws + WS_TOKP);
    int* slotT = (int*)(p.ws + WS_SLOTT);
    int* tile = (int*)(p.ws + WS_TILE);
    int* tokS = (int*)(p.ws + WS_TOKS);
    int* off = (int*)smem;
    const int tid = otid(p.wb);
    const int ntok = ntok_of(l);
    __syncthreads();
    if (tid == 0) {
        int o = 0;
        for (int e = 0; e < NE; ++e) { off[e] = o; o += (cnt[e] + 255) / 256 * 256; }
        off[NE] = o; off[NE + 1] = o + ntok;
    }
    __syncthreads();
    int nbo = nb; asm volatile("" : "+s"(nbo));
    const int gt = bid * NT + tid, gs = nbo * NT;
    for (int i = gt; i < ntok * 8; i += gs) { const int e = tokE[i]; const int s = off[e] + tokP[i]; slotT[s] = i >> 3; tokS[i] = s; }
    for (int i = gt; i < ntok; i += gs) slotT[off[NE] + i] = i;
    for (int i = gt; i < NE * 256; i += gs) { const int e = i >> 8, j = i & 255; const int s = off[e] + cnt[e] + j; if (s < off[e + 1]) slotT[s] = -1; }
    if (bid == 0) {
        const int nt = off[NE + 1] / 256;
        if (tid == 0) tile[0] = nt;
        for (int i = tid; i < nt; i += NT) {
            const int s = i * 256; int e = 0;
            for (int k = 1; k <= NE; ++k) if (s >= off[k]) e = k;
            tile[1 + i] = e;
        }
    }
}

__device__ void phase_moe1(const KP& p, int l, int bid, int nb, bf16_t* shm) {
    const bf16_t* H = (const bf16_t*)(p.ws + WS_H);
    const bf16_t* W13 = (const bf16_t*)(p.ws + WS_W13T) + (size_t)l * NEX * 1024 * D;
    const int* slotT = (const int*)(p.ws + WS_SLOTT);
    const int* tile = (const int*)(p.ws + WS_TILE);
    bf16_t* ACT = (bf16_t*)(p.ws + WS_ACT);
    const int nt = tile[0], nwg = nt * 4;
    gemm_phase<false>(nwg, bid, nb, D, shm, p.wb,
        [&](int L) { const int wg = xcd_remap(L, nwg), ti = wg >> 2, ct = wg & 3, e = tile[1 + ti]; GU u; u.A = H; u.Bt = W13 + ((size_t)e * 1024 + ct * 256) * D; u.i0 = ti * 256; u.i1 = ct * 256; u.i2 = 0; u.i3 = 0; return u; },
        [&](const GU& u, int r) { const int t = slotT[u.i0 + r]; return (t < 0 ? 0 : t) * D; },
        [&](const GU& u, f32x4 (&acc)[2][2][4][2]) {
            const int s0 = u.i0, n0 = u.i1;
            G_IDX;
#pragma unroll
            for (int ai = 0; ai < 2; ++ai)
#pragma unroll
                for (int m = 0; m < 4; ++m) {
                    const int slot = s0 + ai * 128 + wr * 64 + m * 16 + fr;
#pragma unroll
                    for (int bj = 0; bj < 2; ++bj) {
                        const int ch = (n0 + bj * 128 + wc * 32) / 2 + fq * 4;
                        float a[4];
#pragma unroll
                        for (int r = 0; r < 4; ++r) a[r] = siluf_(acc[ai][bj][m][0][r]) * acc[ai][bj][m][1][r];
                        u32x2 w; w[0] = pack_bf2(a[0], a[1]); w[1] = pack_bf2(a[2], a[3]);
                        *(u32x2*)(ACT + (size_t)slot * EFF + ch) = w;
                    }
                }
        });
}

__device__ void phase_moe2(const KP& p, int l, int bid, int nb, bf16_t* shm) {
    const bf16_t* ACT = (const bf16_t*)(p.ws + WS_ACT);
    const bf16_t* W2 = (const bf16_t*)(p.ws + WS_W2T) + (size_t)l * NEX * D * EFF;
    const int* tile = (const int*)(p.ws + WS_TILE);
    const int* slotT = (const int*)(p.ws + WS_SLOTT);
    bf16_t* OUTS = (bf16_t*)(p.ws + WS_OUTS);
    const int nt = tile[0], nwg = nt * 8;
    for (int k = (bid >> 3) & 3; k > 0; --k) __builtin_amdgcn_s_sleep(127);
    gemm_phase<true>(nwg, bid, nb, EFF, shm, p.wb,
        [&](int L) { const int wg = xcd_remap(L, nwg), ti = wg >> 3, ct = wg & 7, e = tile[1 + ti]; GU u; u.A = ACT; u.Bt = W2 + ((size_t)e * D + ct * 256) * EFF; u.i0 = ti * 256; u.i1 = ct * 256; u.i2 = 0; u.i3 = 0; return u; },
        [&](const GU& u, int r) { return (u.i0 + r) * EFF; },
        [&](const GU& u, f32x4 (&acc)[2][2][4][2]) {
            const int s0 = u.i0, n0 = u.i1;
            G_IDX;
#pragma unroll
            for (int ai = 0; ai < 2; ++ai)
#pragma unroll
                for (int m = 0; m < 4; ++m) {
                    const int slot = s0 + ai * 128 + wr * 64 + m * 16 + fr;
                    if (slotT[slot] < 0) continue;
                    bf16_t* orow = OUTS + (size_t)slot * D + n0 + wc * 32 + fq * 8;
#pragma unroll
                    for (int bj = 0; bj < 2; ++bj) {
                        u32x4 w;
                        w[0] = pack_bf2(acc[ai][bj][m][0][0], acc[ai][bj][m][0][1]); w[1] = pack_bf2(acc[ai][bj][m][0][2], acc[ai][bj][m][0][3]);
                        w[2] = pack_bf2(acc[ai][bj][m][1][0], acc[ai][bj][m][1][1]); w[3] = pack_bf2(acc[ai][bj][m][1][2], acc[ai][bj][m][1][3]);
                        *(u32x4*)(orow + bj * 128) = w;
                    }
                }
        });
}

__device__ void phase_combine(const KP& p, int l, int bid, int nb, char* smem, const bool dummy = false) {
    const bf16_t* OUTS = (const bf16_t*)(p.ws + WS_OUTS);
    const int* tokS = (const int*)(p.ws + WS_TOKS);
    const float* tokW = (const float*)(p.ws + WS_TOKW);
    const int* cnt = (const int*)(p.ws + WS_CNT) + l * 64;
    const RowDst out = layer_out(p, l);
    int* sh0 = (int*)smem;
    const int tid = otid(p.wb), half = tid >> 8, ht = tid & 255;
    __syncthreads();
    if (tid == 0) { int o = 0; for (int e = 0; e < NE; ++e) o += (cnt[e] + 255) / 256 * 256; sh0[0] = o; }
    __syncthreads();
    const int shared0 = sh0[0];
    const int ntok = ntok_of(l);
    for (int row = bid * 2 + half; row < ntok; row += nb * 2) {
        float* xr = rowp(out, row);
        const float* g2 = modp(p, l, row, 5);
        const int c = ht * 8;
        float acc[8];
        {
            const u32x4 v = *(const u32x4*)(OUTS + (size_t)(shared0 + row) * D + c);
#pragma unroll
            for (int q = 0; q < 4; ++q) { acc[2 * q] = __uint_as_float(v[q] << 16); acc[2 * q + 1] = __uint_as_float(v[q] & 0xffff0000u); }
        }
#pragma unroll
        for (int j = 0; j < TOPK; ++j) {
            const int s = tokS[(size_t)row * 8 + j]; const float w = tokW[(size_t)row * 8 + j];
            const u32x4 v = *(const u32x4*)(OUTS + (size_t)s * D + c);
#pragma unroll
            for (int q = 0; q < 4; ++q) { acc[2 * q] += w * __uint_as_float(v[q] << 16); acc[2 * q + 1] += w * __uint_as_float(v[q] & 0xffff0000u); }
        }
        const f32x4 g0 = *(const f32x4*)(g2 + c), g1 = *(const f32x4*)(g2 + c + 4);
        f32x4 x0 = *(const f32x4*)(xr + c), x1 = *(const f32x4*)(xr + c + 4);
#pragma unroll
        for (int q = 0; q < 4; ++q) { x0[q] += g0[q] * acc[q]; x1[q] += g1[q] * acc[4 + q]; }
        if (!dummy || x0[0] == 1234.5f) { *(f32x4*)(xr + c) = x0; *(f32x4*)(xr + c + 4) = x1; }
    }
}

#define XB_TMO      128
#define XB_XCNT(j)  (256  + 64 * (j))
#define XB_XSUB(j)  (1280 + 64 * (j))
#define XB_XGEN(j)  (2304 + 64 * (j))
#define XB_TOP      3328
#define XB_TOPGEN   3392
#define XCD_BAR_WORDS 3456
#define XB_SPIN_CAP (1u << 18)
#define LAS __attribute__((address_space(3)))

__device__ __forceinline__ unsigned xb_ld(unsigned* p)              { return __hip_atomic_load(p, __ATOMIC_RELAXED, __HIP_MEMORY_SCOPE_AGENT); }
__device__ __forceinline__ unsigned xb_add(unsigned* p, unsigned v) { return __hip_atomic_fetch_add(p, v, __ATOMIC_RELAXED, __HIP_MEMORY_SCOPE_AGENT); }
__device__ __forceinline__ unsigned xb_xcc_id() { return (unsigned)__builtin_amdgcn_s_getreg((3 << 11) | 20) & 0xFu; }
#define XB_SPIN(cond, bar) do { unsigned _sp = 0; while (cond) { __builtin_amdgcn_s_sleep(1); \
    if ((++_sp & 255u) == 0u) { if (xb_ld(&(bar)[XB_TMO])) break; if (_sp > XB_SPIN_CAP) { atomicAdd(&(bar)[XB_TMO], 1u); break; } } } } while (0)

struct XcdBarrier {
    unsigned* bar; unsigned x;
    volatile LAS unsigned* st;
};
__device__ __forceinline__ XcdBarrier xcd_barrier_post(unsigned* bar, volatile LAS unsigned* st) {
    XcdBarrier b; b.bar = bar; b.x = (unsigned)__builtin_amdgcn_readfirstlane((int)xb_xcc_id()); b.st = st;
    if (threadIdx.x == 0) (void)xb_add(&bar[XB_XCNT(b.x)], 1u);
    return b;
}
__device__ __forceinline__ void xcd_barrier_complete(unsigned* bar, unsigned x, unsigned& nloc, unsigned& nx) {
    const unsigned G = gridDim.x * gridDim.y * gridDim.z;
    unsigned sum, cnt, mine, sp = 0u;
    for (;;) {
        sum = 0u; cnt = 0u; mine = 0u;
#pragma unroll
        for (unsigned j = 0; j < 16; ++j) { const unsigned c = xb_ld(&bar[XB_XCNT(j)]); sum += c; cnt += (c > 0u) ? 1u : 0u; mine = (j == x) ? c : mine; }
        if (sum == G) break;
        __builtin_amdgcn_s_sleep(1);
        if ((++sp & 255u) == 0u) { if (xb_ld(&bar[XB_TMO])) break; if (sp > XB_SPIN_CAP) { atomicAdd(&bar[XB_TMO], 1u); break; } }
    }
    nloc = mine > 0u ? mine : 1u; nx = cnt > 0u ? cnt : 1u;
}
__device__ __forceinline__ void xcd_barrier(const XcdBarrier& b) {
    asm volatile("s_waitcnt vmcnt(0)" ::: "memory");
    __syncthreads();
    unsigned bx = b.x; asm volatile("" : "+s"(bx));
    if (threadIdx.x == 0) {
        unsigned* bar = b.bar;
        __builtin_amdgcn_s_waitcnt(0);
        unsigned nloc = b.st[0], nx = b.st[1];
        if (nloc == 0u) { xcd_barrier_complete(bar, bx, nloc, nx); b.st[0] = nloc; b.st[1] = nx; }
        const unsigned old = xb_add(&bar[XB_XSUB(bx)], 1u);
        const unsigned gen = old / nloc;
        if (old + 1u == (gen + 1u) * nloc) {
            __builtin_amdgcn_fence(__ATOMIC_RELEASE, "agent");
            asm volatile("s_waitcnt vmcnt(0)" ::: "memory");
            const unsigned og = xb_add(&bar[XB_TOP], 1u);
            const unsigned tg = og / nx;
            if (og + 1u == (tg + 1u) * nx) xb_add(&bar[XB_TOPGEN], 1u);
            else XB_SPIN(xb_ld(&bar[XB_TOPGEN]) == tg, bar);
            __builtin_amdgcn_fence(__ATOMIC_ACQUIRE, "agent");
            xb_add(&bar[XB_XGEN(bx)], 1u);
            asm volatile("s_waitcnt vmcnt(0)" ::: "memory");
        } else {
            XB_SPIN(xb_ld(&bar[XB_XGEN(bx)]) == gen, bar);
            __builtin_amdgcn_fence(__ATOMIC_ACQUIRE, "agent");
            asm volatile("s_waitcnt vmcnt(0)" ::: "memory");
        }
    }
    __syncthreads();
}

#ifndef PROBE_MASK
#define PROBE_MASK 0u
#endif
#ifndef REP2_SKIP
#define REP2_SKIP 0
#endif
#ifndef REP2_SKIP
#define REP2_SKIP 0
#endif
#ifndef REP2_SKIP
#define REP2_SKIP 0
#endif
#ifndef REP2_SKIP
#define REP2_SKIP 0
#endif
#ifndef REP2_SKIP
#define REP2_SKIP 0
#endif
#ifndef REP2_SKIP
#define REP2_SKIP 0
#endif
#ifndef REP3_SKIP
#define REP3_SKIP 0
#endif
#ifndef REP_PHASE
#define REP_PHASE (-1)
#define REP_L 1
#define REP_N 1
#endif
constexpr int FUSED_LDS = G_LDS + 16;
__global__ void __launch_bounds__(512, 2) k_fused(Params p0) {
    extern __shared__ __attribute__((aligned(16))) char dsm[];
    KP p; (Params&)p = p0; p.wb = __builtin_amdgcn_readfirstlane((int)threadIdx.x) & ~63;
    if (threadIdx.x == 0) *(uint4*)(dsm + G_LDS) = make_uint4(0u, 0u, 0u, 0u);
    __syncthreads();
    XcdBarrier bar = xcd_barrier_post((unsigned*)(p.ws + WS_BAR), (volatile LAS unsigned*)(dsm + G_LDS));
    char* sm = dsm;
    bf16_t* shm = (bf16_t*)dsm;
    const int bid = blockIdx.x, nb = gridDim.x;
#if PROBE_MASK
    unsigned long long* stamps = (unsigned long long*)(p.ws + WS_BAR + 14336);
    int nstamp = 0;
#define STAMP() do { if (bid == 0 && threadIdx.x == 0) stamps[nstamp] = wall_clock64(); ++nstamp; } while (0)
    STAMP();
#else
#define STAMP() do { } while (0)
#endif
    for (int _r = 0; _r < (REP_PHASE == 20 ? REP_N : 1); ++_r) {
        phase_ada(p, bid, nb);
        phase_convert_dense(p, 0, bid, nb, (float*)sm);
        phase_convert_dense(p, 1, bid, nb, (float*)sm);
        phase_convert_lora(p, bid, nb);
        xcd_barrier(bar); STAMP();
    }
    phase_ada2(p, bid, nb);
    xcd_barrier(bar); STAMP();
#define RUN(k, body) { const int _n = (REP_PHASE == (k) && l == REP_L) ? REP_N : 1; for (int _r = 0; _r < _n; ++_r) { body; xcd_barrier(bar); STAMP(); } }
    for (int l = 0; l < DEPTH; ++l) {
        RUN(0, phase_norm1(p, l, bid, nb));
        RUN(1, phase_inproj(p, l, bid, nb, shm));
        RUN(2, { if (!(REP2_SKIP & 1) || _r == 0) phase_rwprep(p, l, bid, nb, sm); if (!(REP2_SKIP & 2) || _r == 0) phase_atprep(p, l, bid, nb, sm); });
        RUN(11, phase_cprep(p, bid, nb, sm));
        RUN(3, {
            if (bid < CS_BLOCKS) { if (!(REP3_SKIP & 1) || _r == 0) phase_cscan(p, bid, sm); }
            else if ((bid & 1) == 0) {
                const int hb = (bid - CS_BLOCKS) >> 1; const int hn = (nb - CS_BLOCKS + 1) >> 1;
                if (!(REP3_SKIP & 4) || _r == 0) phase_attn(p, l, hb, hn, sm);
                if (!(REP3_SKIP & 2) || _r == 0) phase_gmlp(p, l, hb, hn, sm);
            }
            conv_pull(p, l, sm);
            });
        RUN(4, phase_rwpost(p, l, bid, nb));
        RUN(5, phase_oproj(p, l, bid, nb, shm));
        RUN(6, phase_norm2_route(p, l, bid, nb, sm, _r > 0));
        RUN(7, phase_slots(p, l, bid, nb, sm));
        RUN(8, phase_moe1(p, l, bid, nb, shm));
        RUN(9, phase_moe2(p, l, bid, nb, shm));
        RUN(10, phase_combine(p, l, bid, nb, sm, _r + 1 < _n));
    }
#if PROBE_MASK
    if (bid == 0 && threadIdx.x == 0) {
        unsigned long long ticks = 0;
        for (int i = 0; i + 1 < nstamp; ++i) if ((PROBE_MASK >> i) & 1u) ticks += stamps[i + 1] - stamps[i];
        float v = (float)ticks * 10.0f;
        if (PROBE_MASK == 0x40000000u) v = 1.0e5f;
        p.out[0] = v;
    }
#endif
}

extern "C" void kernel_launch(void* const* d_in, const int* in_sizes, int n_in, void* d_out, int out_size, void* d_ws, size_t ws_size, hipStream_t stream) {
    if (n_in != 35 || out_size != SEQ * D || ws_size < WS_END) {
        fprintf(stderr, "kernel_launch: unexpected shapes: n_in %d out %d ws %zu (need %zu)\n", n_in, out_size, ws_size, (size_t)WS_END);
        return;
    }
    static int grid = 0;
    if (!grid) {
        int dev = 0, cus = 0, per_cu = 0;
        (void)hipGetDevice(&dev);
        (void)hipDeviceGetAttribute(&cus, hipDeviceAttributeMultiprocessorCount, dev);
        (void)hipFuncSetAttribute((const void*)k_fused, hipFuncAttributeMaxDynamicSharedMemorySize, FUSED_LDS);
        (void)hipOccupancyMaxActiveBlocksPerMultiprocessor(&per_cu, (const void*)k_fused, NT, FUSED_LDS);
        if (per_cu < 1) fprintf(stderr, "kernel_launch: occupancy query says %d workgroups per CU; launching one per CU anyway\n", per_cu);
        grid = cus;
        if (grid <= CS_BLOCKS) grid = 0;
    }
    if (!grid) { fprintf(stderr, "kernel_launch: bad grid\n"); return; }
    Params p{};
    const float** f = (const float**)&p;
    for (int i = 0; i < 35; ++i) f[i] = (const float*)d_in[i];
    p.out = (float*)d_out;
    p.ws = (char*)d_ws;
    (void)hipMemsetAsync(d_ws, 0, WS_ZERO_END, stream);
    hipLaunchKernelGGL(k_fused, dim3(grid), dim3(NT), FUSED_LDS, stream, p);
}
```

```cpp
#include <hip/hip_runtime.h>
#include <stdint.h>
#include <stdio.h>

typedef unsigned short bf16_t;
typedef short bf16x8 __attribute__((ext_vector_type(8)));
typedef float f32x4 __attribute__((ext_vector_type(4)));
typedef unsigned u32x4 __attribute__((ext_vector_type(4)));
typedef unsigned u32x2 __attribute__((ext_vector_type(2)));
typedef float f32x16 __attribute__((ext_vector_type(16)));

constexpr int D = 2048, SEQ = 8192, CTXL = 256, NTOK = SEQ + CTXL, DEPTH = 2;
constexpr int RW = 512, RWP = 1920, GMW = 512, INP = 4480;
constexpr int COL_GM = 1920, COL_AT = 2944, COL_K = 3968, COL_V = 4224;
constexpr int NE = 64, NEX = 65, EFF = 512, TOPK = 8;
constexpr int SLOT_CAP = 92416;
constexpr int MAX_TILES = SLOT_CAP / 256;
constexpr int INP_PAD = 4608;
constexpr int NT = 512;

constexpr size_t al256(size_t x) { return (x + 255) & ~(size_t)255; }
constexpr size_t WS_BAR = 0;
constexpr size_t WS_CNT = 16384;
constexpr size_t WS_MOD = WS_CNT + 1024;
constexpr size_t WS_ZERO_END = al256(WS_MOD + (size_t)2 * 2 * 12288 * 4);
constexpr size_t WS_WINT = WS_ZERO_END;
constexpr size_t WS_WOT = WS_WINT + (size_t)2 * INP_PAD * D * 2;
constexpr size_t WS_W13T = WS_WOT + (size_t)2 * D * D * 2;
constexpr size_t WS_W2T = WS_W13T + (size_t)2 * NEX * 1024 * D * 2;
constexpr size_t WS_H = WS_W2T + (size_t)2 * NEX * D * EFF * 2;
constexpr size_t WS_P = WS_H + (size_t)NTOK * D * 2;
constexpr size_t WS_REC = WS_P + (size_t)NTOK * INP * 4;
constexpr size_t WS_YD = WS_REC + (size_t)2 * 8 * NTOK * 384 * 4;
constexpr size_t WS_G = WS_YD + (size_t)2 * NTOK * RW * 4;
constexpr size_t WS_BV = WS_G + (size_t)NTOK * RW * 4;
constexpr size_t WS_GMR = WS_BV + (size_t)NTOK * RW * 4;
constexpr size_t WS_YCAT = al256(WS_GMR + (size_t)NTOK * 4);
constexpr size_t WS_Q = WS_YCAT + (size_t)NTOK * D * 2;
constexpr size_t WS_K = WS_Q + (size_t)NTOK * 1024 * 4;
constexpr size_t WS_X1 = WS_K + (size_t)NTOK * 256 * 4;
constexpr size_t WS_X2C = WS_X1 + (size_t)NTOK * D * 4;
constexpr size_t WS_TOKE = WS_X2C + (size_t)CTXL * D * 4;
constexpr size_t WS_TOKP = WS_TOKE + (size_t)NTOK * 8 * 4;
constexpr size_t WS_TOKW = WS_TOKP + (size_t)NTOK * 8 * 4;
constexpr size_t WS_SLOTT = WS_TOKW + (size_t)NTOK * 8 * 4;
constexpr size_t WS_SLOTW = al256(WS_SLOTT + (size_t)SLOT_CAP * 4);
constexpr size_t WS_TILE = al256(WS_SLOTW + (size_t)SLOT_CAP * 4);
constexpr size_t WS_ACT = al256(WS_TILE + (size_t)(MAX_TILES + 64) * 4);
constexpr size_t WS_MODP = WS_ACT + (size_t)SLOT_CAP * EFF * 2;
constexpr size_t WS_TOKS = WS_MODP + (size_t)2 * 2 * 32 * 12288 * 4;
constexpr size_t WS_OUTS = WS_TOKS + (size_t)NTOK * 8 * 4;
constexpr size_t WS_WLT = WS_OUTS + (size_t)SLOT_CAP * D * 2;
constexpr size_t WS_ROPE = WS_WLT + (size_t)2 * RW * 384 * 2;
constexpr size_t WS_RT = WS_ROPE + (size_t)192 * 16 * 2 * 4;
constexpr size_t WS_FR = WS_RT + (size_t)2 * 2 * NE * D * 2;
constexpr size_t WS_END = WS_FR + (size_t)16 * (NTOK / 16) * 12800;

struct Params {
    const float *x, *c, *ctx, *c_ctx, *w_ada, *b_ada, *norm1_g, *norm2_g, *w_in, *w_o;
    const float *rw_mu, *rw_w0, *rw_w2, *rw_a0, *rw_a2, *rw_g2, *rw_kk, *rw_ka, *rw_rk, *rw_ln_g, *rw_ln_b;
    const float *gm_norm_g, *gm_ws, *gm_b, *at_qn, *at_kn, *at_sink;
    const float *moe_router, *moe_bias, *moe_wg, *moe_wu, *moe_wd, *sh_wg, *sh_wu, *sh_wd;
    float* out;
    char* ws;
};

__device__ __forceinline__ bf16_t f2bf(float f) {
    unsigned u = __float_as_uint(f);
    u += 0x7fffu + ((u >> 16) & 1u);
    return (bf16_t)(u >> 16);
}
typedef __bf16 bf16x2n __attribute__((ext_vector_type(2)));
typedef float f32x2n __attribute__((ext_vector_type(2)));
__device__ __forceinline__ unsigned pack_bf2(float lo, float hi) { const f32x2n v = {lo, hi}; const bf16x2n b2 = __builtin_convertvector(v, bf16x2n); return __builtin_bit_cast(unsigned, b2); }
__device__ __forceinline__ int olane() { int t; asm volatile("v_mbcnt_lo_u32_b32 %0, -1, 0\n\tv_mbcnt_hi_u32_b32 %0, -1, %0" : "=v"(t)); return t; }
__device__ __forceinline__ float bperm(float v, int src_lane) { return __int_as_float(__builtin_amdgcn_ds_bpermute(src_lane << 2, __float_as_int(v))); }
template <int CTRL> __device__ __forceinline__ float dppf(float v) {
    return __int_as_float(__builtin_amdgcn_update_dpp(0, __float_as_int(v), CTRL, 0xf, 0xf, true));
}
__device__ __forceinline__ float red16(float v) {
    v += dppf<0xB1>(v); v += dppf<0x4E>(v); v += dppf<0x124>(v); v += dppf<0x128>(v); return v;
}
__device__ __forceinline__ float wave_sum(float v) {
    const int lane = olane();
    v = red16(v);
    v += bperm(v, lane ^ 16); v += bperm(v, lane ^ 32);
    return v;
}
__device__ __forceinline__ float wave_max(float v) {
    const int lane = olane();
    v = fmaxf(v, dppf<0xB1>(v)); v = fmaxf(v, dppf<0x4E>(v)); v = fmaxf(v, dppf<0x124>(v)); v = fmaxf(v, dppf<0x128>(v));
    v = fmaxf(v, bperm(v, lane ^ 16)); v = fmaxf(v, bperm(v, lane ^ 32));
    return v;
}
__device__ __forceinline__ float max8(float v) {
    const int lane = olane();
    v = fmaxf(v, dppf<0xB1>(v)); v = fmaxf(v, dppf<0x4E>(v)); v = fmaxf(v, bperm(v, lane ^ 4));
    return v;
}
__device__ __forceinline__ float fexp(float x) { return __builtin_amdgcn_exp2f(x * 1.4426950408889634f); }
__device__ __forceinline__ float flog(float x) { return __builtin_amdgcn_logf(x) * 0.6931471805599453f; }
__device__ __forceinline__ float frcp(float x) { return __builtin_amdgcn_rcpf(x); }
__device__ __forceinline__ float sigmoidf_(float x) { return frcp(1.f + fexp(-x)); }
__device__ __forceinline__ float siluf_(float x) { return x * frcp(1.f + fexp(-x)); }
__device__ __forceinline__ float ftanh(float u) { const float e = fexp(-2.f * fabsf(u)); const float t = (1.f - e) * frcp(1.f + e); return u < 0.f ? -t : t; }
__device__ __forceinline__ float gelu_tanh(float x) {
    const float u = 0.7978845608028654f * (x + 0.044715f * x * x * x);
    const float hx = 0.5f * x;
    return fmaf(hx, ftanh(u), hx);
}
__device__ __forceinline__ float softplusf_(float x) { return fmaxf(x, 0.f) + flog(1.f + fexp(-fabsf(x))); }

struct RowSrc { const float* a; const float* b; };
__device__ __forceinline__ const float* rowp(const RowSrc& r, int row) { return row < SEQ ? r.a + (size_t)row * D : r.b + (size_t)(row - SEQ) * D; }
struct RowDst { float* a; float* b; };
__device__ __forceinline__ float* rowp(const RowDst& r, int row) { return row < SEQ ? r.a + (size_t)row * D : r.b + (size_t)(row - SEQ) * D; }

__device__ __forceinline__ RowSrc layer_in(const Params& p, int l) {
    RowSrc r; if (l == 0) { r.a = p.x; r.b = p.ctx; } else { float* x1 = (float*)(p.ws + WS_X1); r.a = x1; r.b = x1 + (size_t)SEQ * D; } return r;
}
__device__ __forceinline__ RowDst layer_out(const Params& p, int l) {
    RowDst r; if (l == 0) { float* x1 = (float*)(p.ws + WS_X1); r.a = x1; r.b = x1 + (size_t)SEQ * D; } else { r.a = p.out; r.b = (float*)(p.ws + WS_X2C); } return r;
}
__device__ __forceinline__ const float* modp(const Params& p, int l, int row, int which) {
    return (const float*)(p.ws + WS_MOD) + ((size_t)(l * 2 + (row < SEQ ? 0 : 1)) * 6 + which) * D;
}
__device__ __forceinline__ int ntok_of(int l) { return l == DEPTH - 1 ? SEQ : NTOK; }
struct KP : Params { int wb; };
__device__ __forceinline__ int otid(int wb) {
    int t; asm volatile("v_mbcnt_lo_u32_b32 %0, -1, 0\n\tv_mbcnt_hi_u32_b32 %0, -1, %0" : "=v"(t));
    return t | wb;
}

__device__ void phase_ada(const KP& p, int bid, int nb) {
    float* part = (float*)(p.ws + WS_MODP);
    const int tid = otid(p.wb);
    for (int u = bid; u < 2 * 6 * 32; u += nb) {
        const int l = u / (6 * 32), r = u % (6 * 32), cg = r / 32, kc = r % 32;
        const int n = cg * 2048 + tid * 4;
        const float* w = p.w_ada + (size_t)l * D * 12288 + (size_t)(kc * 64) * 12288 + n;
        f32x4 a0 = {0, 0, 0, 0}, a1 = {0, 0, 0, 0};
#pragma unroll 8
        for (int k = 0; k < 64; ++k) {
            const f32x4 wv = *(const f32x4*)(w + (size_t)k * 12288);
            const float c0 = siluf_(p.c[kc * 64 + k]), c1 = siluf_(p.c_ctx[kc * 64 + k]);
            a0 += wv * c0; a1 += wv * c1;
        }
        *(f32x4*)(part + ((size_t)((l * 2 + 0) * 32 + kc)) * 12288 + n) = a0;
        *(f32x4*)(part + ((size_t)((l * 2 + 1) * 32 + kc)) * 12288 + n) = a1;
    }
}
__device__ void phase_ada2(const KP& p, int bid, int nb) {
    const float* part = (const float*)(p.ws + WS_MODP);
    float* mod = (float*)(p.ws + WS_MOD);
    for (int i = bid * NT + otid(p.wb); i < 2 * 2 * 12288; i += nb * NT) {
        const int ls = i / 12288, n = i % 12288, l = ls >> 1;
        float acc = p.b_ada[(size_t)l * 12288 + n];
        for (int kc = 0; kc < 32; ++kc) acc += part[((size_t)(ls * 32 + kc)) * 12288 + n];
        mod[i] = acc;
    }
}

struct TJob { const float* src; bf16_t* dst; int K, N, batch; size_t sstride, dstride; int mode; };
__device__ __forceinline__ void tconv_pair(const TJob& j, int t0, float* tiles  , int tid) {
    const int half = tid >> 8, ht = tid & 255;
    float* tile = tiles + half * (64 * 65);
    const int tk = j.K / 64, tn = j.N / 64, ntl = j.batch * tk * tn;
    const int t = t0 + half;
    const bool on = t < ntl;
    const int b = t / (tk * tn), r = t % (tk * tn), kt = r / tn, nt = r % tn;
    __syncthreads();
    if (on) {
        const float* src = j.src + (size_t)b * j.sstride + (size_t)(kt * 64) * j.N + nt * 64;
#pragma unroll
        for (int i = 0; i < 4; ++i) {
            const int k = i * 16 + (ht >> 4), n = (ht & 15) * 4;
            const f32x4 v = *(const f32x4*)(src + (size_t)k * j.N + n);
            tile[k * 65 + n + 0] = v[0]; tile[k * 65 + n + 1] = v[1]; tile[k * 65 + n + 2] = v[2]; tile[k * 65 + n + 3] = v[3];
        }
    }
    __syncthreads();
    if (on) {
        const int n = ht >> 2, kq = (ht & 3) * 16;
        int ng = nt * 64 + n;
        if (j.mode == 1) ng = 32 * (ng >> 4) + (ng & 15);
        else if (j.mode == 2) ng = 32 * (ng >> 4) + 16 + (ng & 15);
        bf16_t* dst = j.dst + (size_t)b * j.dstride + (size_t)ng * j.K + kt * 64 + kq;
        u32x4 w0, w1;
#pragma unroll
        for (int i = 0; i < 4; ++i) { w0[i] = pack_bf2(tile[(kq + 2 * i) * 65 + n], tile[(kq + 2 * i + 1) * 65 + n]); w1[i] = pack_bf2(tile[(kq + 8 + 2 * i) * 65 + n], tile[(kq + 8 + 2 * i + 1) * 65 + n]); }
        *(u32x4*)(dst) = w0;
        *(u32x4*)(dst + 8) = w1;
    }
}
__device__ void phase_tconv(const TJob& j, int bid, int nb, float* tiles  , int wb) {
    const int tid = otid(wb);
    const int ntl = j.batch * (j.K / 64) * (j.N / 64);
    for (int t0 = bid * 2; t0 < ntl; t0 += nb * 2) tconv_pair(j, t0, tiles, tid);
}
__device__ void phase_convert_dense(const KP& p, int l, int bid, int nb, float* tile) {
    TJob j;
    j = {p.w_in + (size_t)l * D * INP, (bf16_t*)(p.ws + WS_WINT) + (size_t)l * INP_PAD * D, D, INP, 1, 0, 0, 0}; phase_tconv(j, bid, nb, tile, p.wb);
    j = {p.w_o + (size_t)l * D * D, (bf16_t*)(p.ws + WS_WOT) + (size_t)l * D * D, D, D, 1, 0, 0, 0}; phase_tconv(j, bid, nb, tile, p.wb);
}
constexpr int CQ_ITEM = 16;
constexpr int CQ_T_BIG = NE * (D / 64) * (EFF / 64);
constexpr int CQ_T_SH = (D / 64) * (EFF / 64);
constexpr int CQ_IPL = (3 * CQ_T_BIG + 3 * CQ_T_SH) / CQ_ITEM;
constexpr int CT_LD = 68;
__device__ __forceinline__ void conv_item(const KP& p, int l, int item, float* tiles  , int tid) {
    int t = item * CQ_ITEM;
    bf16_t* w13 = (bf16_t*)(p.ws + WS_W13T) + (size_t)l * NEX * 1024 * D;
    bf16_t* w2 = (bf16_t*)(p.ws + WS_W2T) + (size_t)l * NEX * D * EFF;
    TJob j;
    if (t < CQ_T_BIG) j = {p.moe_wg + (size_t)l * NE * D * EFF, w13, D, EFF, NE, (size_t)D * EFF, (size_t)1024 * D, 1};
    else if (t < 2 * CQ_T_BIG) { t -= CQ_T_BIG; j = {p.moe_wu + (size_t)l * NE * D * EFF, w13, D, EFF, NE, (size_t)D * EFF, (size_t)1024 * D, 2}; }
    else if (t < 3 * CQ_T_BIG) { t -= 2 * CQ_T_BIG; j = {p.moe_wd + (size_t)l * NE * EFF * D, w2, EFF, D, NE, (size_t)EFF * D, (size_t)D * EFF, 0}; }
    else if (t < 3 * CQ_T_BIG + CQ_T_SH) { t -= 3 * CQ_T_BIG; j = {p.sh_wg + (size_t)l * D * EFF, w13 + (size_t)NE * 1024 * D, D, EFF, 1, 0, 0, 1}; }
    else if (t < 3 * CQ_T_BIG + 2 * CQ_T_SH) { t -= 3 * CQ_T_BIG + CQ_T_SH; j = {p.sh_wu + (size_t)l * D * EFF, w13 + (size_t)NE * 1024 * D, D, EFF, 1, 0, 0, 2}; }
    else { t -= 3 * CQ_T_BIG + 2 * CQ_T_SH; j = {p.sh_wd + (size_t)l * EFF * D, w2 + (size_t)NE * D * EFF, EFF, D, 1, 0, 0, 0}; }
    const int half = tid >> 8, ht = tid & 255;
    float* tile = tiles + half * (64 * CT_LD);
    const int tk = j.K / 64, tn = j.N / 64;
    const int lk = ht >> 4, ln = (ht & 15) * 4;
    const int sn = ht >> 2, skq = (ht & 3) * 16;
    f32x4 v[4];
#define CT_SRC(tt) (j.src + (size_t)((tt) / (tk * tn)) * j.sstride + (size_t)((((tt) % (tk * tn)) / tn) * 64) * j.N + (((tt) % (tk * tn)) % tn) * 64)
    { const float* src = CT_SRC(t + half);
#pragma unroll
      for (int i = 0; i < 4; ++i) v[i] = __builtin_nontemporal_load((const f32x4*)(src + (size_t)(lk + 16 * i) * j.N + ln)); }
#pragma unroll 1
    for (int st = 0; st < CQ_ITEM; st += 2) {
        const int tt = t + st + half;
        __syncthreads();
#pragma unroll
        for (int i = 0; i < 4; ++i) *(f32x4*)(tile + (lk + 16 * i) * CT_LD + ln) = v[i];
        __syncthreads();
        if (st + 2 < CQ_ITEM) {
            const float* src = CT_SRC(tt + 2);
#pragma unroll
            for (int i = 0; i < 4; ++i) v[i] = __builtin_nontemporal_load((const f32x4*)(src + (size_t)(lk + 16 * i) * j.N + ln));
        }
        const int b = tt / (tk * tn), r = tt % (tk * tn), kt = r / tn, nt = r % tn;
        int ng = nt * 64 + sn;
        if (j.mode == 1) ng = 32 * (ng >> 4) + (ng & 15);
        else if (j.mode == 2) ng = 32 * (ng >> 4) + 16 + (ng & 15);
        bf16_t* dst = j.dst + (size_t)b * j.dstride + (size_t)ng * j.K + kt * 64 + skq;
        u32x4 w0, w1;
#pragma unroll
        for (int i = 0; i < 4; ++i) { w0[i] = pack_bf2(tile[(skq + 2 * i) * CT_LD + sn], tile[(skq + 2 * i + 1) * CT_LD + sn]); w1[i] = pack_bf2(tile[(skq + 8 + 2 * i) * CT_LD + sn], tile[(skq + 8 + 2 * i + 1) * CT_LD + sn]); }
        __builtin_nontemporal_store(w0, (u32x4*)(dst));
        __builtin_nontemporal_store(w1, (u32x4*)(dst + 8));
    }
#undef CT_SRC
}
__device__ void conv_pull(const KP& p, int l, char* smem) {
    int* qhead = (int*)(p.ws + WS_CNT) + 200 + l;
    float* tiles = (float*)smem;
    int* sh = (int*)(smem + 2 * 64 * CT_LD * 4);
    const int tid = otid(p.wb);
    __syncthreads();
    if (tid == 0) sh[0] = __hip_atomic_fetch_add(qhead, 1, __ATOMIC_RELAXED, __HIP_MEMORY_SCOPE_AGENT);
    __syncthreads();
    int item = sh[0];
    while (item < CQ_IPL) {
        int nxt = 0;
        if (tid == 0) nxt = __hip_atomic_fetch_add(qhead, 1, __ATOMIC_RELAXED, __HIP_MEMORY_SCOPE_AGENT);
        conv_item(p, l, item, tiles, tid);
        __syncthreads();
        if (tid == 0) sh[0] = nxt;
        __syncthreads();
        item = sh[0];
    }
}

__device__ void phase_convert_lora(const KP& p, int bid, int nb) {
    bf16_t* WLT = (bf16_t*)(p.ws + WS_WLT);
    const int tid = otid(p.wb);
    for (int i = bid * NT + tid; i < 2 * D * NE; i += nb * NT) {
        const int l = i / (D * NE), r = i % (D * NE), k = r / NE, e = r % NE;
        const float x = p.moe_router[i];
        const bf16_t hi = f2bf(x); const bf16_t lo = f2bf(x - __uint_as_float((unsigned)hi << 16));
        bf16_t* rt = (bf16_t*)(p.ws + WS_RT) + (size_t)l * 2 * NE * D;
        rt[(size_t)e * D + k] = hi; rt[(size_t)NE * D + (size_t)e * D + k] = lo;
    }
    for (int i = bid * NT + tid; i < 192 * 16; i += nb * NT) {
        const int pos = i >> 4, f = i & 15;
        const float ang = (float)(pos < 128 ? pos : pos - 128) * powf(10000.f, -(float)f / 16.f);
        float* rt = (float*)(p.ws + WS_ROPE) + (size_t)i * 2;
        rt[0] = cosf(ang); rt[1] = sinf(ang);
    }
    for (int i = bid * NT + tid; i < 2 * RW * 384; i += nb * NT) {
        const int l = i / (RW * 384), r = i % (RW * 384), k = r / RW, c = r % RW;
        float v;
        if (k < 128) v = p.rw_w2[((size_t)l * 2 * 64 + k) * RW + c];
        else if (k < 256) v = p.rw_a2[((size_t)l * 2 * 64 + (k - 128)) * RW + c];
        else v = p.rw_g2[((size_t)l * 128 + (k - 256)) * RW + c];
        WLT[((size_t)l * RW + c) * 384 + k] = f2bf(v);
    }
}

__device__ void phase_norm1(const KP& p, int l, int bid, int nb) {
    const RowSrc in = layer_in(p, l);
    bf16_t* H = (bf16_t*)(p.ws + WS_H);
    const float* g = p.norm1_g + (size_t)l * D;
    const int tid = otid(p.wb), wid = tid >> 6, lane = tid & 63;
    for (int row = bid * 8 + wid; row < NTOK; row += nb * 8) {
        const float* xr = rowp(in, row);
        const float* sh = modp(p, l, row, 0);
        const float* sc = modp(p, l, row, 1);
        f32x4 v[8]; float ss = 0.f;
#pragma unroll
        for (int i = 0; i < 8; ++i) { v[i] = *(const f32x4*)(xr + i * 256 + lane * 4); ss += v[i][0] * v[i][0] + v[i][1] * v[i][1] + v[i][2] * v[i][2] + v[i][3] * v[i][3]; }
        ss = wave_sum(ss);
        const float rstd = rsqrtf(ss * (1.f / D) + 1e-6f);
#pragma unroll
        for (int i = 0; i < 8; ++i) {
            const int c = i * 256 + lane * 4;
            const f32x4 gv = *(const f32x4*)(g + c), shv = *(const f32x4*)(sh + c), scv = *(const f32x4*)(sc + c);
            float o[4];
#pragma unroll
            for (int j = 0; j < 4; ++j) { const float t = v[i][j] * rstd * gv[j]; o[j] = fmaf(t, scv[j], t) + shv[j]; }
            u32x2 w; w[0] = pack_bf2(o[0], o[1]); w[1] = pack_bf2(o[2], o[3]);
            *(u32x2*)(H + (size_t)row * D + c) = w;
        }
    }
}

constexpr int G_HT = 128 * 64;
constexpr int G_LDS = 8 * G_HT * 2;
__device__ __forceinline__ int g_lds_byte(int r, int c) {
    const int st = (r >> 4) * 2 + (c >> 5), rr = r & 15, cc = c & 31, ob = rr * 64 + cc * 2;
    return st * 1024 + (ob ^ (((ob >> 9) & 1) << 5));
}
__device__ __forceinline__ void g_stage_rc(int b, int& R, int& C) {
    const int st = b / 1024, sb = b % 1024, swz = sb ^ (((sb >> 9) & 1) << 5);
    R = (st >> 1) * 16 + swz / 64; C = (st & 1) * 32 + (swz % 64) / 2;
}
struct GOff { unsigned ao[2][2], bo; };
#define SA(b, h) (shm + ((b) * 2 + (h)) * G_HT)
#define SB(b, h) (shm + (4 + (b) * 2 + (h)) * G_HT)
#define STG_A(P, h, kt) do { _Pragma("unroll") for (int _i = 0; _i < 2; ++_i) \
    __builtin_amdgcn_global_load_lds((const unsigned*)((const char*)(A + (kt) * 64) + o.ao[h][_i]), (unsigned*)((char*)(P) + tz * 16 + _i * 8192), 16, 0, 0); } while (0)
#define STG_B(P, h, kt) do { _Pragma("unroll") for (int _i = 0; _i < 2; ++_i) \
    __builtin_amdgcn_global_load_lds((const unsigned*)((const char*)(Bt + ((h) * 128 + _i * 64) * K + (kt) * 64) + o.bo), (unsigned*)((char*)(P) + tz * 16 + _i * 8192), 16, 0, 0); } while (0)
template <bool PERM, class ARow>
__device__ __forceinline__ void gemm_offsets(ARow arow, const int K, const int wb, GOff& o) {
    const int tz = otid(wb);
    int r, c; g_stage_rc(tz * 16, r, c);
    const int rb = PERM ? ((r & ~31) + 8 * ((r & 15) >> 2) + 4 * ((r >> 4) & 1) + (r & 3)) : r;
    o.bo = (unsigned)((rb * K + c) * 2);
#pragma unroll
    for (int h = 0; h < 2; ++h)
#pragma unroll
        for (int i = 0; i < 2; ++i) o.ao[h][i] = (unsigned)((arow(h * 128 + i * 64 + r) + c) * 2);
}
__device__ __forceinline__ void gemm_issue(const bf16_t* __restrict__ A, const bf16_t* __restrict__ Bt, const int K, const GOff& o, bf16_t* shm, const int wb) {
    const int tz = otid(wb);
    STG_B(SB(0, 0), 0, 0); STG_A(SA(0, 0), 0, 0);
    STG_B(SB(0, 1), 1, 0); STG_A(SA(0, 1), 1, 0);
    STG_B(SB(1, 0), 0, 1); STG_A(SA(1, 0), 0, 1); STG_B(SB(1, 1), 1, 1); STG_A(SA(1, 1), 1, 1);
}
__device__ __forceinline__ void gemm_main(const bf16_t* __restrict__ A, const bf16_t* __restrict__ Bt, const int K, const GOff& o, f32x4 (&acc)[2][2][4][2], bf16_t* shm, const int wb, const int nst) {
#define LDA(dst, b, h) _Pragma("unroll") for (int m = 0; m < 4; ++m) _Pragma("unroll") for (int k = 0; k < 2; ++k) \
    dst[m][k] = *reinterpret_cast<const bf16x8*>((const char*)SA(b, h) + g_lds_byte(wr * 64 + m * 16 + fr, k * 32 + fq * 8))
#define LDB(dst, b, h) _Pragma("unroll") for (int n = 0; n < 2; ++n) _Pragma("unroll") for (int k = 0; k < 2; ++k) \
    dst[n][k] = *reinterpret_cast<const bf16x8*>((const char*)SB(b, h) + g_lds_byte(wc * 32 + n * 16 + fr, k * 32 + fq * 8))
#define MMA(ai, bj, Af, Bf) do { __builtin_amdgcn_s_setprio(1); \
    _Pragma("unroll") for (int m = 0; m < 4; ++m) _Pragma("unroll") for (int n = 0; n < 2; ++n) _Pragma("unroll") for (int k = 0; k < 2; ++k) \
        acc[ai][bj][m][n] = __builtin_amdgcn_mfma_f32_16x16x32_bf16(Bf[n][k], Af[m][k], acc[ai][bj][m][n], 0, 0, 0); \
    __builtin_amdgcn_s_setprio(0); } while (0)
#define WAIT_V(n) asm volatile("s_waitcnt vmcnt(" #n ")" ::: "memory")
#define WAIT_L(n) asm volatile("s_waitcnt lgkmcnt(" #n ")" ::: "memory")
#define BAR __builtin_amdgcn_s_barrier()
#define SCHED __builtin_amdgcn_sched_barrier(0)
    int tz = otid(wb);
    int wid = tz >> 6, lane = tz & 63, wr = wid >> 2, wc = wid & 3, fr = lane & 15, fq = lane >> 4;
#pragma unroll
    for (int a = 0; a < 2; ++a)
#pragma unroll
        for (int b = 0; b < 2; ++b)
#pragma unroll
            for (int m = 0; m < 4; ++m)
#pragma unroll
                for (int n = 0; n < 2; ++n) acc[a][b][m][n] = (f32x4){0.f, 0.f, 0.f, 0.f};
    bf16x8 At[4][2], B0[2][2], B1[2][2];
    const int nt = K / 64;
    if (nst >= 32) WAIT_V(32); else if (nst >= 16) WAIT_V(16); else WAIT_V(0);
    BAR;
    if (wr == 1) BAR;
    for (int t = 0; t < nt - 2; t += 2) {
        int tn = t; asm volatile("" : "+s"(tn));
        LDB(B0, 0, 0); SCHED; LDA(At, 0, 0); if (tn) STG_A(SA(1, 1), 1, t + 1);
        WAIT_L(8); BAR; WAIT_L(0); MMA(0, 0, At, B0); BAR; SCHED;
        LDB(B1, 0, 1); STG_B(SB(0, 0), 0, t + 2);
        BAR; WAIT_L(0); MMA(0, 1, At, B1); BAR;
        LDA(At, 0, 1); STG_A(SA(0, 0), 0, t + 2);
        BAR; WAIT_L(0); MMA(1, 0, At, B0); BAR; SCHED;
        STG_B(SB(0, 1), 1, t + 2);
        if (tn) WAIT_V(6);
        BAR; MMA(1, 1, At, B1); BAR;
        LDB(B0, 1, 0); SCHED; LDA(At, 1, 0); STG_A(SA(0, 1), 1, t + 2);
        WAIT_L(8); BAR; WAIT_L(0); MMA(0, 0, At, B0); BAR; SCHED;
        LDB(B1, 1, 1); STG_B(SB(1, 0), 0, t + 3);
        BAR; WAIT_L(0); MMA(0, 1, At, B1); BAR;
        LDA(At, 1, 1); STG_A(SA(1, 0), 0, t + 3);
        BAR; WAIT_L(0); MMA(1, 0, At, B0); BAR; SCHED;
        STG_B(SB(1, 1), 1, t + 3);
        WAIT_V(6); BAR; MMA(1, 1, At, B1); BAR;
    }
    { LDB(B0, 0, 0); WAIT_V(0); LDA(At, 0, 0); STG_A(SA(1, 1), 1, nt - 1);
      BAR; WAIT_L(0); MMA(0, 0, At, B0); BAR;
      LDB(B1, 0, 1); BAR; WAIT_L(0); MMA(0, 1, At, B1); BAR;
      LDA(At, 0, 1); WAIT_V(4); BAR; WAIT_L(0); MMA(1, 0, At, B0); MMA(1, 1, At, B1); BAR; }
    { LDB(B0, 1, 0); LDA(At, 1, 0); WAIT_V(2); BAR; WAIT_L(0); MMA(0, 0, At, B0); BAR;
      LDB(B1, 1, 1); WAIT_V(0); BAR; WAIT_L(0); MMA(0, 1, At, B1); BAR;
      LDA(At, 1, 1); BAR; WAIT_L(0); MMA(1, 0, At, B0); MMA(1, 1, At, B1); BAR; }
    if (wr == 0) BAR;
#undef LDA
#undef LDB
#undef MMA
#undef WAIT_V
#undef WAIT_L
#undef BAR
#undef SCHED
}
#undef SA
#undef SB
#undef STG_A
#undef STG_B
struct GU { const bf16_t* A; const bf16_t* Bt; int i0, i1, i2, i3; };
template <bool PERM, class Mk, class Row, class Epi>
__device__ __forceinline__ void gemm_phase(const int nwg, const int bid, const int nb, const int K, bf16_t* shm, const int wb, Mk mk, Row row, Epi epi) {
    int L = bid;
    if (L >= nwg) return;
    GU cur = mk(L);
    GOff oc;
    gemm_offsets<PERM>([&](int r) { return row(cur, r); }, K, wb, oc);
    gemm_issue(cur.A, cur.Bt, K, oc, shm, wb);
    int nst = 0;
    for (;;) {
        f32x4 acc[2][2][4][2];
        gemm_main(cur.A, cur.Bt, K, oc, acc, shm, wb, nst);
        const int Ln = L + nb;
        const bool more = Ln < nwg;
        GU nxt = cur; GOff on = oc;
        if (more) {
            nxt = mk(Ln);
            gemm_offsets<PERM>([&](int r) { return row(nxt, r); }, K, wb, on);
            gemm_issue(nxt.A, nxt.Bt, K, on, shm, wb);
        }
        nst = epi(cur, acc);
        if (!more) break;
        cur = nxt; oc = on; L = Ln;
    }
}
#define G_IDX int _tz = otid(p.wb); const int _wid = _tz >> 6, _lane = _tz & 63, wr = _wid >> 2, wc = _wid & 3, fr = _lane & 15, fq = _lane >> 4
__device__ __forceinline__ int xcd_remap(int L, int nwg) {
    const int q = nwg / 8, r = nwg % 8, xcd = L % 8, off = L / 8;
    return (xcd < r ? xcd * (q + 1) : r * (q + 1) + (xcd - r) * q) + off;
}
__device__ __forceinline__ void dense_tile(int wgid, int nM, int nN, int& pm, int& pn) {
    const int nig = 8 * nN, gid = wgid / nig, fm = gid * 8, gsz = (nM - fm) < 8 ? (nM - fm) : 8;
    pm = fm + ((wgid % nig) % gsz); pn = (wgid % nig) / gsz;
}

__device__ void phase_inproj(const KP& p, int l, int bid, int nb, bf16_t* shm) {
    const bf16_t* H = (const bf16_t*)(p.ws + WS_H);
    const bf16_t* Bt = (const bf16_t*)(p.ws + WS_WINT) + (size_t)l * INP_PAD * D;
    float* P = (float*)(p.ws + WS_P);
    constexpr int nM = NTOK / 256, nN = INP_PAD / 256, nwg = nM * nN;
    gemm_phase<false>(nwg, bid, nb, D, shm, p.wb,
        [&](int L) { int pm, pn; dense_tile(xcd_remap(L, nwg), nM, nN, pm, pn); GU u; u.A = H; u.Bt = Bt + (size_t)(pn * 256) * D; u.i0 = pm * 256; u.i1 = pn * 256; u.i2 = 0; u.i3 = 0; return u; },
        [&](const GU& u, int r) { return (u.i0 + r) * D; },
        [&](const GU& u, f32x4 (&acc)[2][2][4][2]) {
            const int m0 = u.i0, n0 = u.i1;
            G_IDX;
#pragma unroll
            for (int ai = 0; ai < 2; ++ai)
#pragma unroll
                for (int m = 0; m < 4; ++m) {
                    float* prow = P + (size_t)(m0 + ai * 128 + wr * 64 + m * 16 + fr) * INP + n0 + wc * 32 + fq * 4;
#pragma unroll
                    for (int bj = 0; bj < 2; ++bj)
#pragma unroll
                        for (int n = 0; n < 2; ++n)
                            if (n0 + bj * 128 + wc * 32 + n * 16 + fq * 4 < INP) *(f32x4*)(prow + bj * 128 + n * 16) = acc[ai][bj][m][n];
                }
            return n0 + 256 <= INP ? 32 : 16;
        });
}

__device__ __forceinline__ int scan_pos(int d, int row) {
    if (row >= SEQ) { const int c = row - SEQ; return d == 0 ? c : (CTXL - 1 - c); }
    return CTXL + (d == 0 ? row : (SEQ - 1 - row));
}
__device__ __forceinline__ int scan_row(int d, int s) {
    if (s < CTXL) return SEQ + (d == 0 ? s : (CTXL - 1 - s));
    const int q = s - CTXL; return d == 0 ? q : (SEQ - 1 - q);
}
constexpr int RP_TB = 11;
constexpr int RP_LD = 392;
__device__ __forceinline__ f32x4 shifted4(const float* P, int row, int col, const float* mu) {
    const f32x4 cur = *(const f32x4*)(P + (size_t)row * INP + col);
    const bool first = (row == 0) || (row == SEQ), last = (row == SEQ - 1) || (row == NTOK - 1);
    f32x4 prev = {0.f, 0.f, 0.f, 0.f}, nxt = {0.f, 0.f, 0.f, 0.f};
    if (!first) prev = *(const f32x4*)(P + (size_t)(row - 1) * INP + col);
    if (!last) nxt = *(const f32x4*)(P + (size_t)(row + 1) * INP + col);
    const f32x4 m0 = *(const f32x4*)(mu + col), m1 = *(const f32x4*)(mu + RWP + col);
    return cur + m0 * (prev - cur) + m1 * (nxt - cur);
}
__device__ __forceinline__ float shifted(const float* P, int row, int col, float mu0, float mu1) {
    const float cur = P[(size_t)row * INP + col];
    const bool first = (row == 0) || (row == SEQ), last = (row == SEQ - 1) || (row == NTOK - 1);
    const float prev = first ? 0.f : P[(size_t)(row - 1) * INP + col];
    const float nxt = last ? 0.f : P[(size_t)(row + 1) * INP + col];
    return cur + mu0 * (prev - cur) + mu1 * (nxt - cur);
}
__device__ void phase_rwprep(const KP& p, int l, int bid, int nb, char* smem) {
    const float* P = (const float*)(p.ws + WS_P);
    float* RECW = (float*)(p.ws + WS_REC);
    bf16_t* RECD = (bf16_t*)(RECW + (size_t)16 * NTOK * 64);
    bf16_t* RECS = RECD + (size_t)16 * NTOK * 128;
    float* G = (float*)(p.ws + WS_G);
    float* BV = (float*)(p.ws + WS_BV);
    float* GMR = (float*)(p.ws + WS_GMR);
    const bf16_t* WLT = (const bf16_t*)(p.ws + WS_WLT) + (size_t)l * RW * 384;
    bf16_t* lin = (bf16_t*)smem;
    const float* mu = p.rw_mu + (size_t)l * 2 * RWP;
    const float* w0 = p.rw_w0 + (size_t)l * 2 * RW;
    const float* a0 = p.rw_a0 + (size_t)l * 2 * RW;
    const float* kkw = p.rw_kk + (size_t)l * RW;
    const float* kaw = p.rw_ka + (size_t)l * RW;
    const float* rkw = p.rw_rk + (size_t)l * RW;
    const int tid = otid(p.wb), wid = tid >> 6, lane = tid & 63, t16 = lane & 15, g = lane >> 4;
    for (int blk = bid; blk < NTOK / RP_TB; blk += nb) {
        const int t0 = blk * RP_TB;
        __syncthreads();
        for (int i = tid; i < RP_TB * 384; i += NT) {
            const int tt = i / 384, j = i % 384, col = 1536 + j;
            const float v = shifted(P, t0 + tt, col, mu[col], mu[RWP + col]);
            lin[tt * RP_LD + j] = f2bf(j < 128 ? ftanh(v) : (j < 256 ? v : sigmoidf_(v)));
        }
        __syncthreads();
        for (int q = wid; q < RP_TB; q += 8) {
            const int row = t0 + q; float ss = 0.f;
#pragma unroll
            for (int i = 0; i < 8; ++i) { const float gv = gelu_tanh(P[(size_t)row * INP + COL_GM + GMW + i * 64 + lane]); ss += gv * gv; }
            ss = wave_sum(ss);
            if (lane == 0) GMR[row] = rsqrtf(ss * (1.f / GMW) + 1e-6f);
        }
        const bool live = t16 < RP_TB;
        const int row = t0 + (live ? t16 : RP_TB - 1);
        float nrm2 = 0.f, bon = 0.f;
#pragma unroll
        for (int tl = 0; tl < 4; ++tl) {
            const int c = wid * 64 + tl * 16 + g * 4;
            const f32x4 r4 = shifted4(P, row, c, mu), k4 = shifted4(P, row, 512 + c, mu);
            const f32x4 kq = k4 * *(const f32x4*)(kkw + c), rk = *(const f32x4*)(rkw + c);
#pragma unroll
            for (int e = 0; e < 4; ++e) { nrm2 += kq[e] * kq[e]; bon += r4[e] * k4[e] * rk[e]; }
        }
        nrm2 += bperm(nrm2, lane ^ 16); nrm2 += bperm(nrm2, lane ^ 32);
        bon += bperm(bon, lane ^ 16); bon += bperm(bon, lane ^ 32);
        const float inrm = 1.f / fmaxf(sqrtf(nrm2), 1e-12f);
        const bf16_t* lrow = lin + (live ? t16 : RP_TB - 1) * RP_LD + g * 8;
#pragma unroll 1
        for (int tl = 0; tl < 4; ++tl) {
            f32x4 acc[5];
#pragma unroll
            for (int m = 0; m < 5; ++m) acc[m] = (f32x4){0.f, 0.f, 0.f, 0.f};
            const bf16_t* wrow = WLT + (size_t)(wid * 64 + tl * 16 + t16) * 384 + g * 8;
#pragma unroll
            for (int ks = 0; ks < 12; ++ks) {
                const int m = ks < 8 ? (ks >> 1) : 4;
                acc[m] = __builtin_amdgcn_mfma_f32_16x16x32_bf16(*(const bf16x8*)(wrow + ks * 32), *(const bf16x8*)(lrow + ks * 32), acc[m], 0, 0, 0);
            }
            const int c = wid * 64 + tl * 16 + g * 4, ci = tl * 16 + g * 4;
            const f32x4 r4 = shifted4(P, row, c, mu), k4 = shifted4(P, row, 512 + c, mu), v4 = shifted4(P, row, 1024 + c, mu);
            const f32x4 kq = k4 * *(const f32x4*)(kkw + c) * inrm;
            if (live) {
                *(f32x4*)(G + (size_t)row * RW + c) = acc[4];
                *(f32x4*)(BV + (size_t)row * RW + c) = v4 * bon;
            }
            const f32x4 ka = *(const f32x4*)(kaw + c);
#pragma unroll
            for (int d = 0; d < 2; ++d) {
                const f32x4 w0v = *(const f32x4*)(w0 + d * RW + c), a0v = *(const f32x4*)(a0 + d * RW + c);
                f32x4 decay, av, kd;
#pragma unroll
                for (int e = 0; e < 4; ++e) {
                    const float wlog = -softplusf_(-(w0v[e] + acc[d][e])) - 0.5f;
                    decay[e] = fexp(-fexp(wlog));
                    av[e] = sigmoidf_(a0v[e] + acc[2 + d][e]);
                    kd[e] = k4[e] * (1.f + (av[e] - 1.f) * ka[e]);
                }
                if (live) {
                    *(f32x4*)(RECW + ((size_t)(d * 8 + wid) * NTOK + row) * 64 + ci) = decay;
                    bf16_t* rd = RECD + ((size_t)(d * 8 + wid) * NTOK + row) * 128 + ci;
                    const f32x4 bq = kq * av;
                    u32x2 w1, w2; w1[0] = pack_bf2(bq[0], bq[1]); w1[1] = pack_bf2(bq[2], bq[3]); w2[0] = pack_bf2(kd[0], kd[1]); w2[1] = pack_bf2(kd[2], kd[3]);
                    *(u32x2*)(rd) = w1; *(u32x2*)(rd + 64) = w2;
                    if (d == 0) {
                        bf16_t* rs = RECS + ((size_t)wid * NTOK + row) * 192 + ci;
                        u32x2 a1, a2, a3; a1[0] = pack_bf2(kq[0], kq[1]); a1[1] = pack_bf2(kq[2], kq[3]); a2[0] = pack_bf2(r4[0], r4[1]); a2[1] = pack_bf2(r4[2], r4[3]); a3[0] = pack_bf2(v4[0], v4[1]); a3[1] = pack_bf2(v4[2], v4[3]);
                        *(u32x2*)(rs) = a1; *(u32x2*)(rs + 64) = a2; *(u32x2*)(rs + 128) = a3;
                    }
                }
            }
        }
    }
}

constexpr int SC_TS = 16;
constexpr int SCAN_BLOCKS = 128;
constexpr int SC_OPB = SC_TS * 384;
constexpr int SC_SBW = SC_TS * 64 * 4;
constexpr int SC_LDS = (2 * SC_OPB + 2 * 2 * SC_SBW) * 4;
#define SC_LD(slot, s) { const float* b_ = buf + (s) * 384 + 4 * l16; qw[slot] = *(const f32x4*)(b_); qk[slot] = *(const f32x4*)(b_ + 64); \
    qb[slot] = *(const f32x4*)(b_ + 128); qd[slot] = *(const f32x4*)(b_ + 192); qv[slot] = buf[(s) * 384 + 320 + i]; }
__device__ __forceinline__ void scan_chunk(const float* buf, float* sb, int l16, int lane, int i, f32x4& S) {
    f32x4 qw[3], qk[3], qb[3], qd[3]; float qv[3];
    SC_LD(0, 0); SC_LD(1, 1);
#pragma unroll
    for (int s = 0; s < SC_TS; ++s) {
        const int sl = s % 3;
        if (s + 2 < SC_TS) SC_LD((s + 2) % 3, s + 2);
        const f32x4 pk = S * qk[sl];
        const float sa = -red16((pk[0] + pk[1]) + (pk[2] + pk[3]));
        S = (S * qw[sl] + qd[sl] * qv[sl]) + qb[sl] * sa;
        *(f32x4*)(sb + (s * 64 + lane) * 4) = S;
    }
}
#define SC_LOAD(R, ch) { const float* _g = rec + (size_t)(ch) * SC_OPB + lt * 4; _Pragma("unroll") for (int q = 0; q < 12; ++q) R[q] = *(const f32x4*)(_g + q * 512); }
#define SC_WRITE(R, B) { float* _l = (B) + lt * 4; _Pragma("unroll") for (int q = 0; q < 12; ++q) *(f32x4*)(_l + q * 512) = R[q]; }
__device__ void phase_scan(const KP& p, int bid, char* smem) {
    const float* REC = (const float*)(p.ws + WS_REC);
    float* YD = (float*)(p.ws + WS_YD);
    float* B0 = (float*)smem;
    float* B1 = B0 + SC_OPB;
    float* SB0 = B1 + SC_OPB;
    float* SB1 = SB0 + 2 * SC_SBW;
    const int tid = otid(p.wb), wid = tid >> 6, lane = tid & 63, l16 = lane & 15;
    const int xcd = bid & 7, slot = bid >> 3, dh = xcd * 2 + (slot >> 3), rq = slot & 7;
    const int d = dh >> 3, h = dh & 7;
    const float* rec = REC + (size_t)dh * NTOK * 384;
    constexpr int NCH = NTOK / SC_TS;
    if (wid >= 6) {
        __syncthreads();
        for (int c = 0; c <= NCH; ++c) __syncthreads();
    } else if (wid >= 4) {
        const int lt = tid - 256;
        f32x4 R0[12], R1[12];
        SC_LOAD(R0, 0); SC_WRITE(R0, B0);
        SC_LOAD(R1, 1); SC_LOAD(R0, 2);
        __syncthreads();
        for (int c = 0; c < NCH; c += 2) {
            if (c + 1 < NCH) SC_WRITE(R1, B1);
            if (c + 3 < NCH) SC_LOAD(R1, c + 3);
            __syncthreads();
            if (c + 2 < NCH) SC_WRITE(R0, B0);
            if (c + 4 < NCH) SC_LOAD(R0, c + 4);
            __syncthreads();
        }
        __syncthreads();
    } else if (wid >= 2) {
        const int cw = wid - 2, dstep = d == 0 ? 1 : -1;
        float* yout = YD + (size_t)d * NTOK * RW + h * 64 + rq * 8 + cw * 4 + (lane >> 4);
        f32x4 rr[SC_TS];
#define SC_RLOAD(B) { _Pragma("unroll") for (int s = 0; s < SC_TS; ++s) rr[s] = *(const f32x4*)((B) + s * 384 + 256 + 4 * l16); }
#define SC_READOUT(SB, ch) { float yv = 0.f; \
            _Pragma("unroll") for (int s = 0; s < SC_TS; ++s) { const f32x4 sv = *(const f32x4*)((SB) + cw * SC_SBW + (s * 64 + lane) * 4); const f32x4 py = sv * rr[s]; \
                const float y = red16((py[0] + py[1]) + (py[2] + py[3])); yv = (l16 == s) ? y : yv; } \
            yout[(size_t)(scan_row(d, (ch) * SC_TS) + dstep * l16) * RW] = yv; }
        __syncthreads();
        SC_RLOAD(B0);
        __syncthreads();
        for (int c = 1; c < NCH; c += 2) {
            SC_READOUT(SB0, c - 1); SC_RLOAD(B1);
            __syncthreads();
            SC_READOUT(SB1, c);
            if (c + 1 < NCH) SC_RLOAD(B0);
            __syncthreads();
        }
    } else {
        const int i = rq * 8 + wid * 4 + (lane >> 4);
        f32x4 S = {0.f, 0.f, 0.f, 0.f};
        __syncthreads();
        for (int c = 0; c < NCH; c += 2) {
            scan_chunk(B0, SB0 + wid * SC_SBW, l16, lane, i, S);
            __syncthreads();
            scan_chunk(B1, SB1 + wid * SC_SBW, l16, lane, i, S);
            __syncthreads();
        }
        __syncthreads();
    }
}

constexpr int CK = 16, NCHK = NTOK / CK;
constexpr int FR_B = 12800;
constexpr int FR_AT = 0, FR_RT = 2048, FR_SM = 4096, FR_BT = 6144  , FR_VF = 10240, FR_GC = 12288;
template <int SH> __device__ __forceinline__ float row_shr1(float v) {
    return __int_as_float(__builtin_amdgcn_update_dpp(0x3f800000, __float_as_int(v), 0x110 + SH, 0xf, 0xf, false));
}
__device__ __forceinline__ bf16x8 frag8(const float (&v)[16], int q) {
    u32x4 w; w[0] = pack_bf2(v[4 * q], v[4 * q + 1]); w[1] = pack_bf2(v[4 * q + 2], v[4 * q + 3]); w[2] = pack_bf2(v[4 * q + 4], v[4 * q + 5]); w[3] = pack_bf2(v[4 * q + 6], v[4 * q + 7]);
    return __builtin_bit_cast(bf16x8, w);
}
__device__ __forceinline__ bf16x8 frag4(const f32x4 a) {
    u32x4 w; w[0] = pack_bf2(a[0], a[1]); w[1] = pack_bf2(a[2], a[3]); w[2] = 0u; w[3] = 0u;
    return __builtin_bit_cast(bf16x8, w);
}
__device__ __forceinline__ bf16x8 frag4u(unsigned lo, unsigned hi) { u32x4 w; w[0] = lo; w[1] = hi; w[2] = 0u; w[3] = 0u; return __builtin_bit_cast(bf16x8, w); }
#define MM(a, b, c) __builtin_amdgcn_mfma_f32_16x16x32_bf16(a, b, c, 0, 0, 0)
__device__ void phase_cprep(const KP& p, int bid, int nb, char* smem) {
    const float* RECW = (const float*)(p.ws + WS_REC);
    const bf16_t* RECD = (const bf16_t*)(RECW + (size_t)16 * NTOK * 64);
    const bf16_t* RECS = RECD + (size_t)16 * NTOK * 128;
    char* FR = p.ws + WS_FR;
    const int tid = otid(p.wb), wid = tid >> 6, lane = tid & 63, t = lane & 15, g = lane >> 4;
    bf16_t* zt = (bf16_t*)smem + wid * 2048;
    const f32x4 Z4 = {0.f, 0.f, 0.f, 0.f};
    for (int u = bid * 8 + wid; u < 16 * NCHK; u += nb * 8) {
        const int dh = u / NCHK, c = u % NCHK;
        const int d = dh >> 3, hh = dh & 7;
        const int row = scan_row(d, c * CK + t);
        const float* pw = RECW + ((size_t)dh * NTOK + row) * 64;
        const bf16_t* pd = RECD + ((size_t)dh * NTOK + row) * 128;
        const bf16_t* ps = RECS + ((size_t)hh * NTOK + row) * 192;
        float w_[16], kk[16], bb[16], kd[16], rr[16];
#pragma unroll
        for (int q = 0; q < 4; ++q) {
            const int jo = 32 * (q >> 1) + 16 * (q & 1) + 4 * g;
            const f32x4 a0 = *(const f32x4*)(pw + jo);
            const u32x2 ub = *(const u32x2*)(pd + jo), uk = *(const u32x2*)(pd + 64 + jo), ukk = *(const u32x2*)(ps + jo), ur = *(const u32x2*)(ps + 64 + jo);
#pragma unroll
            for (int e = 0; e < 4; ++e) {
                w_[4 * q + e] = a0[e];
                bb[4 * q + e] = __uint_as_float((e & 1) ? (ub[e >> 1] & 0xffff0000u) : (ub[e >> 1] << 16));
                kd[4 * q + e] = __uint_as_float((e & 1) ? (uk[e >> 1] & 0xffff0000u) : (uk[e >> 1] << 16));
                kk[4 * q + e] = __uint_as_float((e & 1) ? (ukk[e >> 1] & 0xffff0000u) : (ukk[e >> 1] << 16));
                rr[4 * q + e] = __uint_as_float((e & 1) ? (ur[e >> 1] & 0xffff0000u) : (ur[e >> 1] << 16));
            }
        }
        float gam[16], At[16], Bh[16], Kh[16], Rt[16], Bt[16], Kt[16];
#pragma unroll
        for (int k = 0; k < 16; ++k) {
            float x = w_[k];
            x *= row_shr1<1>(x); x *= row_shr1<2>(x); x *= row_shr1<4>(x); x *= row_shr1<8>(x);
            gam[k] = x;
        }
#pragma unroll
        for (int k = 0; k < 16; ++k) {
            const float gp = row_shr1<1>(gam[k]), gc = bperm(gam[k], (lane & 48) | 15), ig = frcp(gam[k]);
            At[k] = kk[k] * gp; Bh[k] = bb[k] * ig; Kh[k] = kd[k] * ig; Rt[k] = rr[k] * gam[k];
            Bt[k] = -Bh[k] * gc; Kt[k] = Kh[k] * gc;
        }
        const bf16x8 fA0 = frag8(At, 0), fA1 = frag8(At, 2), fB0 = frag8(Bh, 0), fB1 = frag8(Bh, 2), fK0 = frag8(Kh, 0), fK1 = frag8(Kh, 2), fR0 = frag8(Rt, 0), fR1 = frag8(Rt, 2);
        f32x4 X = MM(fA1, fB1, MM(fA0, fB0, Z4));
        f32x4 XT = MM(fB1, fA1, MM(fB0, fA0, Z4));
        f32x4 Lak = MM(fA1, fK1, MM(fA0, fK0, Z4));
        f32x4 LrbT = MM(fB1, fR1, MM(fB0, fR0, Z4));
        f32x4 LrkT = MM(fK1, fR1, MM(fK0, fR0, Z4));
        f32x4 T, TT;
#pragma unroll
        for (int r = 0; r < 4; ++r) {
            const int row = 4 * g + r;
            X[r] = t < row ? -X[r] : 0.f;
            XT[r] = row < t ? -XT[r] : 0.f;
            Lak[r] = t < row ? Lak[r] : 0.f;
            LrbT[r] = row <= t ? -LrbT[r] : 0.f;
            LrkT[r] = row <= t ? LrkT[r] : 0.f;
            const float id = row == t ? 1.f : 0.f;
            T[r] = id + X[r]; TT[r] = id + XT[r];
        }
#pragma unroll
        for (int it = 0; it < 3; ++it) {
            const f32x4 X2 = MM(frag4(XT), frag4(X), Z4), X2T = MM(frag4(X), frag4(XT), Z4);
            const f32x4 Tn = MM(frag4(TT), frag4(X2), T), TTn = MM(frag4(X2), frag4(TT), TT);
            X = X2; XT = X2T; T = Tn; TT = TTn;
        }
        const f32x4 TLT = MM(frag4(Lak), frag4(TT), Z4);
#pragma unroll
        for (int q = 0; q < 4; ++q)
#pragma unroll
            for (int e = 0; e < 4; ++e) {
                const int j = 32 * (q >> 1) + 16 * (q & 1) + 4 * g + e;
                zt[j * 16 + t] = f2bf(Bt[4 * q + e]); zt[1024 + j * 16 + t] = f2bf(Kt[4 * q + e]);
            }
        char* fb = FR + ((size_t)dh * NCHK + c) * FR_B;
        *(bf16x8*)(fb + FR_AT + lane * 16) = fA0; *(bf16x8*)(fb + FR_AT + 1024 + lane * 16) = fA1;
        *(bf16x8*)(fb + FR_RT + lane * 16) = fR0; *(bf16x8*)(fb + FR_RT + 1024 + lane * 16) = fR1;
        {
            u32x4 s0, s1;
            s0[0] = pack_bf2(TT[0], TT[1]); s0[1] = pack_bf2(TT[2], TT[3]); s0[2] = pack_bf2(TLT[0], TLT[1]); s0[3] = pack_bf2(TLT[2], TLT[3]);
            s1[0] = pack_bf2(LrbT[0], LrbT[1]); s1[1] = pack_bf2(LrbT[2], LrbT[3]); s1[2] = pack_bf2(LrkT[0], LrkT[1]); s1[3] = pack_bf2(LrkT[2], LrkT[3]);
            *(u32x4*)(fb + FR_SM + lane * 32) = s0; *(u32x4*)(fb + FR_SM + lane * 32 + 16) = s1;
        }
#pragma unroll
        for (int jt = 0; jt < 4; ++jt) {
            {
                const u32x2 b2 = *(const u32x2*)(zt + (16 * jt + t) * 16 + 4 * g), k2 = *(const u32x2*)(zt + 1024 + (16 * jt + t) * 16 + 4 * g);
                u32x4 bk; bk[0] = b2[0]; bk[1] = b2[1]; bk[2] = k2[0]; bk[3] = k2[1];
                *(u32x4*)(fb + FR_BT + jt * 1024 + lane * 16) = bk;
            }
            const int dstp = d == 0 ? 1 : -1;
            const bf16_t* vp = RECS + ((size_t)hh * NTOK + scan_row(d, c * CK + 4 * g)) * 192 + 128 + 16 * jt + t;
            u32x2 vw; vw[0] = (unsigned)vp[0] | ((unsigned)vp[dstp * 192] << 16); vw[1] = (unsigned)vp[2 * dstp * 192] | ((unsigned)vp[3 * dstp * 192] << 16);
            *(u32x2*)(fb + FR_VF + jt * 512 + lane * 8) = vw;
        }
        if (t == 15) {
#pragma unroll
            for (int q = 0; q < 4; ++q) { f32x4 gv = {gam[4 * q], gam[4 * q + 1], gam[4 * q + 2], gam[4 * q + 3]}; *(f32x4*)(fb + FR_GC + (32 * (q >> 1) + 16 * (q & 1) + 4 * g) * 4) = gv; }
        }
    }
}

constexpr int CS_BLOCKS = 16, CS_R = 3;
__device__ void phase_cscan(const KP& p, int bid, char* smem) {
    const char* FRs = p.ws + WS_FR + (size_t)bid * NCHK * FR_B;
    float* YD = (float*)(p.ws + WS_YD);
    const int tid = otid(p.wb), wid = tid >> 6, lane = tid & 63, c16 = lane & 15, g = lane >> 4;
    const int d = bid >> 3, h = bid & 7;
    if (wid >= 4) {
        const int lw = wid - 4;
        const bool tail = lw == 0 && lane < 16;
        u32x4 fifo[8][4];
#define CS_LD(k, ch) { const char* _s = FRs + (size_t)(ch) * FR_B + lane * 16; \
            _Pragma("unroll") for (int _q = 0; _q < 3; ++_q) fifo[k][_q] = *(const u32x4*)(_s + (lw + 4 * _q) * 1024); \
            if (tail) fifo[k][3] = *(const u32x4*)(_s + 12288); }
#define CS_WR(k, ch) { char* _d = smem + ((ch) % CS_R) * FR_B + lane * 16; \
            _Pragma("unroll") for (int _q = 0; _q < 3; ++_q) *(u32x4*)(_d + (lw + 4 * _q) * 1024) = fifo[k][_q]; \
            if (tail) *(u32x4*)(_d + 12288) = fifo[k][3]; }
#define CS_BAR() { asm volatile("" ::: "memory"); __builtin_amdgcn_s_barrier(); asm volatile("" ::: "memory"); }
#define CS_PERIOD(r) { if (pch + (r) + 1 < NCHK) CS_WR(((r) + 1) & 7, pch + (r) + 1); if (pch + (r) + 9 < NCHK) CS_LD(((r) + 1) & 7, pch + (r) + 9); CS_BAR(); }
        CS_LD(0, 0); CS_LD(1, 1); CS_LD(2, 2); CS_LD(3, 3); CS_LD(4, 4); CS_LD(5, 5); CS_LD(6, 6); CS_LD(7, 7);
        CS_WR(0, 0); CS_LD(0, 8);
        CS_BAR();
        for (int pch = 0; pch < NCHK; pch += 8) {
            CS_PERIOD(0); CS_PERIOD(1); CS_PERIOD(2); CS_PERIOD(3); CS_PERIOD(4); CS_PERIOD(5); CS_PERIOD(6); CS_PERIOD(7);
        }
    } else {
        const int it = wid, dstep = d == 0 ? 1 : -1;
        float* yout = YD + (size_t)d * NTOK * RW + h * 64 + it * 16 + c16;
        const f32x4 Z4 = {0.f, 0.f, 0.f, 0.f};
        f32x4 ST[4] = {Z4, Z4, Z4, Z4};
        asm volatile("" ::: "memory"); __builtin_amdgcn_s_barrier(); asm volatile("" ::: "memory");
        for (int pch = 0; pch < NCHK; ++pch) {
            const char* sb = smem + (pch % CS_R) * FR_B;
            const bf16x8 A0 = *(const bf16x8*)(sb + FR_AT + lane * 16), A1 = *(const bf16x8*)(sb + FR_AT + 1024 + lane * 16);
            const bf16x8 R0 = *(const bf16x8*)(sb + FR_RT + lane * 16), R1 = *(const bf16x8*)(sb + FR_RT + 1024 + lane * 16);
            const bf16x8 TTL = *(const bf16x8*)(sb + FR_SM + lane * 32), LRR = *(const bf16x8*)(sb + FR_SM + lane * 32 + 16);
            const u32x2 vf = *(const u32x2*)(sb + FR_VF + it * 512 + lane * 8);
            u32x4 b0, b1;
            b0[0] = pack_bf2(ST[0][0], ST[0][1]); b0[1] = pack_bf2(ST[0][2], ST[0][3]); b0[2] = pack_bf2(ST[1][0], ST[1][1]); b0[3] = pack_bf2(ST[1][2], ST[1][3]);
            b1[0] = pack_bf2(ST[2][0], ST[2][1]); b1[1] = pack_bf2(ST[2][2], ST[2][3]); b1[2] = pack_bf2(ST[3][0], ST[3][1]); b1[3] = pack_bf2(ST[3][2], ST[3][3]);
            const bf16x8 Bs0 = __builtin_bit_cast(bf16x8, b0), Bs1 = __builtin_bit_cast(bf16x8, b1);
            const f32x4 Q = MM(A1, Bs1, MM(A0, Bs0, Z4));
            u32x4 qv; qv[0] = pack_bf2(Q[0], Q[1]); qv[1] = pack_bf2(Q[2], Q[3]); qv[2] = vf[0]; qv[3] = vf[1];
            const f32x4 P = MM(TTL, __builtin_bit_cast(bf16x8, qv), Z4);
            u32x4 pv; pv[0] = pack_bf2(P[0], P[1]); pv[1] = pack_bf2(P[2], P[3]); pv[2] = vf[0]; pv[3] = vf[1];
            const bf16x8 PV = __builtin_bit_cast(bf16x8, pv);
            const f32x4 Y = MM(LRR, PV, MM(R1, Bs1, MM(R0, Bs0, Z4)));
#pragma unroll
            for (int jt = 0; jt < 4; ++jt) {
                const f32x4 gc = *(const f32x4*)(sb + FR_GC + (16 * jt + 4 * g) * 4);
                const bf16x8 bk = *(const bf16x8*)(sb + FR_BT + jt * 1024 + lane * 16);
                ST[jt] = MM(bk, PV, ST[jt] * gc);
            }
            const int row0 = scan_row(d, pch * CK) + dstep * 4 * g;
#pragma unroll
            for (int r = 0; r < 4; ++r) yout[(size_t)(row0 + dstep * r) * RW] = Y[r];
            asm volatile("" ::: "memory"); __builtin_amdgcn_s_barrier(); asm volatile("" ::: "memory");
        }
    }
}
#undef MM

__device__ void phase_rwpost(const KP& p, int l, int bid, int nb) {
    const float* YD = (const float*)(p.ws + WS_YD);
    const float* G = (const float*)(p.ws + WS_G);
    const float* BV = (const float*)(p.ws + WS_BV);
    bf16_t* Y = (bf16_t*)(p.ws + WS_YCAT);
    const float* lng = p.rw_ln_g + (size_t)l * RW;
    const float* lnb = p.rw_ln_b + (size_t)l * RW;
    const int tid = otid(p.wb), wid = tid >> 6, lane = tid & 63;
    for (int u = bid * 8 + wid; u < NTOK * 8; u += nb * 8) {
        const int row = u >> 3, h = u & 7, c = h * 64 + lane;
        const float y = YD[(size_t)row * RW + c] + YD[((size_t)NTOK + row) * RW + c];
        const float mean = wave_sum(y) * (1.f / 64);
        const float dv = y - mean;
        const float var = wave_sum(dv * dv) * (1.f / 64);
        const float yn = dv * rsqrtf(var + 64e-5f) * lng[c] + lnb[c];
        Y[(size_t)row * D + c] = f2bf((yn + BV[(size_t)row * RW + c]) * G[(size_t)row * RW + c]);
    }
}

constexpr int GM_LD = 136;
__device__ void phase_gmlp(const KP& p, int l, int bid, int nb, char* smem) {
    const float* P = (const float*)(p.ws + WS_P);
    const float* GMR = (const float*)(p.ws + WS_GMR);
    bf16_t* Y = (bf16_t*)(p.ws + WS_YCAT);
    bf16_t* vt = (bf16_t*)smem;
    const float* ng = p.gm_norm_g + (size_t)l * GMW;
    const int tid = otid(p.wb), wid = tid >> 6, lane = tid & 63, r = lane & 31, h = lane >> 5, mt = wid >> 1, nt = wid & 1;
    for (int u = bid; u < (NTOK / 128) * 8; u += nb) {
        const int n = u >> 3, g = u & 7, t0 = n * 128;
        const float* ws = p.gm_ws + ((size_t)l * 8 + g) * 128 * 128;
        const float* bs = p.gm_b + ((size_t)l * 8 + g) * 128;
        __syncthreads();
        {
            const int c = tid & 63, qp0 = tid >> 6;
            const float gn = ng[g * 64 + c];
#pragma unroll
            for (int i = 0; i < 8; ++i) {
                const int q = (qp0 + 8 * i) * 2;
                const float v0 = gelu_tanh(P[(size_t)(t0 + q) * INP + COL_GM + GMW + g * 64 + c]) * GMR[t0 + q] * gn;
                const float v1 = gelu_tanh(P[(size_t)(t0 + q + 1) * INP + COL_GM + GMW + g * 64 + c]) * GMR[t0 + q + 1] * gn;
                *(unsigned*)(vt + c * GM_LD + q) = pack_bf2(v0, v1);
            }
        }
        __syncthreads();
        f32x16 acc;
#pragma unroll
        for (int i = 0; i < 16; ++i) acc[i] = 0.f;
        const float* arow = ws + (size_t)(mt * 32 + r) * 128 + h * 8;
#pragma unroll
        for (int ks = 0; ks < 8; ++ks) {
            const f32x4 a0 = *(const f32x4*)(arow + ks * 16), a1 = *(const f32x4*)(arow + ks * 16 + 4);
            u32x4 aw; aw[0] = pack_bf2(a0[0], a0[1]); aw[1] = pack_bf2(a0[2], a0[3]); aw[2] = pack_bf2(a1[0], a1[1]); aw[3] = pack_bf2(a1[2], a1[3]);
            const bf16x8 bfr = *(const bf16x8*)(vt + (nt * 32 + r) * GM_LD + ks * 16 + h * 8);
            acc = __builtin_amdgcn_mfma_f32_32x32x16_bf16(__builtin_bit_cast(bf16x8, aw), bfr, acc, 0, 0, 0);
        }
        const int c = nt * 32 + r;
#pragma unroll
        for (int i = 0; i < 16; ++i) {
            const int pp = mt * 32 + (i & 3) + 8 * (i >> 2) + 4 * h;
            const float uu = gelu_tanh(P[(size_t)(t0 + pp) * INP + COL_GM + g * 64 + c]);
            Y[(size_t)(t0 + pp) * D + 512 + g * 64 + c] = f2bf(uu * (acc[i] + bs[pp]));
        }
    }
}

__device__ void phase_atprep(const KP& p, int l, int bid, int nb, char* smem) {
    const float* P = (const float*)(p.ws + WS_P);
    bf16_t* Qb = (bf16_t*)(p.ws + WS_Q);
    bf16_t* Kb = (bf16_t*)(p.ws + WS_K);
    bf16_t* VT = Kb + (size_t)NTOK * 256;
    const float* qn = p.at_qn + (size_t)l * 64;
    const float* kn = p.at_kn + (size_t)l * 64;
    const int tid = otid(p.wb);
    const float* rope = (const float*)(p.ws + WS_ROPE);
    for (int i = bid * NT + tid; i < NTOK * 20; i += nb * NT) {
        const int row = i / 20, hv = i % 20;
        const bool isq = hv < 16;
        const float* src = P + (size_t)row * INP + (isq ? COL_AT + hv * 64 : COL_K + (hv - 16) * 64);
        const float* gn = isq ? qn : kn;
        f32x4 x[16]; float ss = 0.f;
#pragma unroll
        for (int k = 0; k < 16; ++k) { x[k] = *(const f32x4*)(src + 4 * k); ss += x[k][0] * x[k][0] + x[k][1] * x[k][1] + x[k][2] * x[k][2] + x[k][3] * x[k][3]; }
        const float sc = rsqrtf(ss * (1.f / 64) + 1e-6f) * (isq ? 0.125f : 1.f);
#pragma unroll
        for (int k = 0; k < 16; ++k) x[k] = x[k] * *(const f32x4*)(gn + 4 * k) * sc;
        if (row < SEQ) {
#pragma unroll
            for (int sec = 0; sec < 2; ++sec) {
                const float* rt = rope + (size_t)((sec == 0 ? (row >> 6) : (128 + (row & 63))) * 16) * 2;
#pragma unroll
                for (int k = 0; k < 4; ++k) {
                    const f32x4 c0 = *(const f32x4*)(rt + 8 * k), c1 = *(const f32x4*)(rt + 8 * k + 4);
                    f32x4& a = x[8 * sec + k]; f32x4& b2 = x[8 * sec + 4 + k];
                    const float cs[4] = {c0[0], c0[2], c1[0], c1[2]}, sn[4] = {c0[1], c0[3], c1[1], c1[3]};
#pragma unroll
                    for (int e = 0; e < 4; ++e) { const float x1 = a[e], x2 = b2[e]; a[e] = x1 * cs[e] - x2 * sn[e]; b2[e] = x2 * cs[e] + x1 * sn[e]; }
                }
            }
        }
        bf16_t* dst = isq ? (Qb + (size_t)row * 1024 + hv * 64) : (Kb + (size_t)row * 256 + (hv - 16) * 64);
#pragma unroll
        for (int k = 0; k < 8; ++k) {
            u32x4 w; w[0] = pack_bf2(x[2 * k][0], x[2 * k][1]); w[1] = pack_bf2(x[2 * k][2], x[2 * k][3]); w[2] = pack_bf2(x[2 * k + 1][0], x[2 * k + 1][1]); w[3] = pack_bf2(x[2 * k + 1][2], x[2 * k + 1][3]);
            *(u32x4*)(dst + 8 * k) = w;
        }
    }
    float* tile = (float*)smem;
    for (int u = bid; u < (NTOK / 64) * 4; u += nb) {
        const int t0 = (u >> 2) * 64, kvh = u & 3;
        __syncthreads();
        {
            const int tok = tid >> 3, d8 = (tid & 7) * 8;
            const float* src = P + (size_t)(t0 + tok) * INP + COL_V + kvh * 64 + d8;
            const f32x4 a = *(const f32x4*)src, b2 = *(const f32x4*)(src + 4);
#pragma unroll
            for (int i = 0; i < 4; ++i) { tile[tok * 65 + d8 + i] = a[i]; tile[tok * 65 + d8 + 4 + i] = b2[i]; }
        }
        __syncthreads();
        {
            const int d = tid >> 3, tk = (tid & 7) * 8;
            u32x4 w;
#pragma unroll
            for (int i = 0; i < 4; ++i) w[i] = pack_bf2(tile[(tk + 2 * i) * 65 + d], tile[(tk + 2 * i + 1) * 65 + d]);
            *(u32x4*)(VT + (size_t)(kvh * 64 + d) * NTOK + t0 + tk) = w;
        }
    }
}

constexpr int AT_LD = 72;
constexpr int AT_TILE = 64 * AT_LD;
__device__ void phase_attn(const KP& p, int l, int bid, int nb, char* smem) {
    const bf16_t* Qb = (const bf16_t*)(p.ws + WS_Q);
    const bf16_t* Kb = (const bf16_t*)(p.ws + WS_K);
    const bf16_t* VT = Kb + (size_t)NTOK * 256;
    bf16_t* Y = (bf16_t*)(p.ws + WS_YCAT);
    bf16_t* Kc = (bf16_t*)smem;
    bf16_t* Vc = Kc + AT_TILE;
    const int tid = otid(p.wb), wid = tid >> 6, lane = tid & 63, q = lane & 31, h = lane >> 5, g = wid >> 1, qh = wid & 1;
    const int srow = tid >> 3, sseg = tid & 7;
    const int voff = srow * AT_LD + (sseg >> 2) * 32 + ((sseg >> 1) & 1) * 16 + (sseg & 1) * 4;
    for (int u = bid; u < (NTOK / 64) * 4; u += nb) {
        const int qt = u >> 2, kvh = u & 3, t0 = qt * 64, head = kvh * 4 + g, qrow = t0 + qh * 32 + q;
        int c_lo = 0, n_local = 0;
        if (t0 < SEQ) { c_lo = 2 - (t0 >> 6); if (c_lo < 0) c_lo = 0; int c_hi = (SEQ + 64 - t0) >> 6; if (c_hi > 4) c_hi = 4; n_local = c_hi - c_lo + 1; }
        const int nch = n_local + 4;
        bf16x8 qf[4];
#pragma unroll
        for (int ks = 0; ks < 4; ++ks) qf[ks] = *(const bf16x8*)(Qb + (size_t)qrow * 1024 + head * 64 + ks * 16 + h * 8);
        f32x16 O0, O1;
#pragma unroll
        for (int r = 0; r < 16; ++r) { O0[r] = 0.f; O1[r] = 0.f; }
        float m = p.at_sink[(size_t)l * 16 + head], lsum = h == 0 ? 1.f : 0.f;
        u32x4 rk, rv;
        {
            const int k0 = n_local > 0 ? (t0 - 128 + 64 * c_lo) : SEQ;
            rk = *(const u32x4*)(Kb + (size_t)(k0 + srow) * 256 + kvh * 64 + sseg * 8);
            rv = *(const u32x4*)(VT + (size_t)(kvh * 64 + srow) * NTOK + k0 + sseg * 8);
        }
        for (int ci = 0; ci < nch; ++ci) {
            const bool local = ci < n_local;
            const int k0 = local ? (t0 - 128 + 64 * (c_lo + ci)) : (SEQ + 64 * (ci - n_local));
            __syncthreads();
            *(u32x4*)(Kc + srow * AT_LD + sseg * 8) = rk;
            { u32x2 lo, hi; lo[0] = rv[0]; lo[1] = rv[1]; hi[0] = rv[2]; hi[1] = rv[3]; *(u32x2*)(Vc + voff) = lo; *(u32x2*)(Vc + voff + 8) = hi; }
            __syncthreads();
            if (ci + 1 < nch) {
                const int kn = (ci + 1 < n_local) ? (t0 - 128 + 64 * (c_lo + ci + 1)) : (SEQ + 64 * (ci + 1 - n_local));
                rk = *(const u32x4*)(Kb + (size_t)(kn + srow) * 256 + kvh * 64 + sseg * 8);
                rv = *(const u32x4*)(VT + (size_t)(kvh * 64 + srow) * NTOK + kn + sseg * 8);
            }
            f32x16 s0, s1;
#pragma unroll
            for (int r = 0; r < 16; ++r) { s0[r] = 0.f; s1[r] = 0.f; }
#pragma unroll
            for (int ks = 0; ks < 4; ++ks) {
                const bf16x8 k0f = *(const bf16x8*)(Kc + q * AT_LD + ks * 16 + h * 8);
                const bf16x8 k1f = *(const bf16x8*)(Kc + (32 + q) * AT_LD + ks * 16 + h * 8);
                s0 = __builtin_amdgcn_mfma_f32_32x32x16_bf16(k0f, qf[ks], s0, 0, 0, 0);
                s1 = __builtin_amdgcn_mfma_f32_32x32x16_bf16(k1f, qf[ks], s1, 0, 0, 0);
            }
            if (local) {
                const int base = k0 + 4 * h - qrow;
#pragma unroll
                for (int r = 0; r < 16; ++r) {
                    const int d0 = base + (r & 3) + 8 * (r >> 2), d1 = d0 + 32;
                    if (d0 > 128 || d0 < -128) s0[r] = -INFINITY;
                    if (d1 > 128 || d1 < -128) s1[r] = -INFINITY;
                }
            }
            float mx = fmaxf(s0[0], s1[0]);
#pragma unroll
            for (int r = 1; r < 16; ++r) mx = fmaxf(mx, fmaxf(s0[r], s1[r]));
            mx = fmaxf(mx, bperm(mx, lane ^ 32));
            const float mnew = fmaxf(m, mx);
            const float alpha = __expf(m - mnew);
            m = mnew; lsum *= alpha;
#pragma unroll
            for (int r = 0; r < 16; ++r) { O0[r] *= alpha; O1[r] *= alpha; }
            float ps = 0.f;
#pragma unroll
            for (int r = 0; r < 16; ++r) { s0[r] = __expf(s0[r] - m); s1[r] = __expf(s1[r] - m); ps += s0[r] + s1[r]; }
            lsum += ps;
            bf16x8 pf[2][2];
#pragma unroll
            for (int s = 0; s < 2; ++s) {
                u32x4 w0, w1;
#pragma unroll
                for (int i = 0; i < 4; ++i) { w0[i] = pack_bf2(s0[8 * s + 2 * i], s0[8 * s + 2 * i + 1]); w1[i] = pack_bf2(s1[8 * s + 2 * i], s1[8 * s + 2 * i + 1]); }
                pf[0][s] = __builtin_bit_cast(bf16x8, w0); pf[1][s] = __builtin_bit_cast(bf16x8, w1);
            }
#pragma unroll
            for (int kb = 0; kb < 2; ++kb)
#pragma unroll
                for (int s = 0; s < 2; ++s) {
                    const bf16x8 v0f = *(const bf16x8*)(Vc + q * AT_LD + kb * 32 + s * 16 + h * 8);
                    const bf16x8 v1f = *(const bf16x8*)(Vc + (32 + q) * AT_LD + kb * 32 + s * 16 + h * 8);
                    O0 = __builtin_amdgcn_mfma_f32_32x32x16_bf16(v0f, pf[kb][s], O0, 0, 0, 0);
                    O1 = __builtin_amdgcn_mfma_f32_32x32x16_bf16(v1f, pf[kb][s], O1, 0, 0, 0);
                }
        }
        lsum += bperm(lsum, lane ^ 32);
        const float inv = 1.f / lsum;
        bf16_t* yo = Y + (size_t)qrow * D + 1024 + head * 64 + 4 * h;
#pragma unroll
        for (int rg = 0; rg < 4; ++rg) {
            u32x2 w0, w1;
            w0[0] = pack_bf2(O0[4 * rg] * inv, O0[4 * rg + 1] * inv); w0[1] = pack_bf2(O0[4 * rg + 2] * inv, O0[4 * rg + 3] * inv);
            w1[0] = pack_bf2(O1[4 * rg] * inv, O1[4 * rg + 1] * inv); w1[1] = pack_bf2(O1[4 * rg + 2] * inv, O1[4 * rg + 3] * inv);
            *(u32x2*)(yo + 8 * rg) = w0;
            *(u32x2*)(yo + 32 + 8 * rg) = w1;
        }
    }
}

__device__ void phase_oproj(const KP& p, int l, int bid, int nb, bf16_t* shm) {
    const bf16_t* Y = (const bf16_t*)(p.ws + WS_YCAT);
    const bf16_t* Bt = (const bf16_t*)(p.ws + WS_WOT) + (size_t)l * D * D;
    const RowSrc in = layer_in(p, l);
    const RowDst out = layer_out(p, l);
    const int nM = ntok_of(l) / 256, nN = D / 256, nwg = nM * nN;
    gemm_phase<false>(nwg, bid, nb, D, shm, p.wb,
        [&](int L) { int pm, pn; dense_tile(xcd_remap(L, nwg), nM, nN, pm, pn); GU u; u.A = Y; u.Bt = Bt + (size_t)(pn * 256) * D; u.i0 = pm * 256; u.i1 = pn * 256; u.i2 = 0; u.i3 = 0; return u; },
        [&](const GU& u, int r) { return (u.i0 + r) * D; },
        [&](const GU& u, f32x4 (&acc)[2][2][4][2]) {
            const int m0 = u.i0, n0 = u.i1;
            G_IDX;
#pragma unroll
            for (int ai = 0; ai < 2; ++ai)
#pragma unroll
                for (int m = 0; m < 4; ++m) {
                    const int row = m0 + ai * 128 + wr * 64 + m * 16 + fr;
                    const float* xi = rowp(in, row);
                    float* xo = rowp(out, row);
                    const float* g1 = modp(p, l, row, 2);
#pragma unroll
                    for (int bj = 0; bj < 2; ++bj)
#pragma unroll
                        for (int n = 0; n < 2; ++n) {
                            const int col = n0 + bj * 128 + wc * 32 + n * 16 + fq * 4;
                            *(f32x4*)(xo + col) = *(const f32x4*)(xi + col) + *(const f32x4*)(g1 + col) * acc[ai][bj][m][n];
                        }
                }
            return 32;
        });
}

constexpr int RT_R = 11;
constexpr int RT_LD = D + 8;
__device__ void phase_norm2_route(const KP& p, int l, int bid, int nb, char* smem, const bool dummy = false) {
    const RowDst xs = layer_out(p, l);
    bf16_t* H = (bf16_t*)(p.ws + WS_H);
    int* cnt = (int*)(p.ws + WS_CNT) + l * 64 + (dummy ? 128 : 0);
    int* tokE = (int*)(p.ws + WS_TOKE);
    int* tokP = (int*)(p.ws + WS_TOKP);
    float* tokW = (float*)(p.ws + WS_TOKW);
    const float* g = p.norm2_g + (size_t)l * D;
    const bf16_t* RTH = (const bf16_t*)(p.ws + WS_RT) + (size_t)l * 2 * NE * D;
    const bf16_t* RTL = RTH + (size_t)NE * D;
    const float* rbias = p.moe_bias + (size_t)l * NE;
    bf16_t* hh = (bf16_t*)smem;
    bf16_t* hl = hh + RT_R * RT_LD;
    float* part = (float*)(hl + RT_R * RT_LD);
    int* lcnt = (int*)(part + 8 * 64 * 16);
    int* lbase = lcnt + 64;
    int* lsel = lbase + 64;
    const int tid = otid(p.wb), wid = tid >> 6, lane = tid & 63, c16 = lane & 15, g4 = lane >> 4;
    const int ntok = ntok_of(l), nsteps = (ntok + RT_R - 1) / RT_R;
    __syncthreads();
    if (tid < 64) lcnt[tid] = 0;
    for (int i = tid; i < 4 * RT_R * 8; i += NT) lsel[i] = -1;
    int step = 0;
    for (int blk = bid; blk < nsteps; blk += nb, ++step) {
        const int t0 = blk * RT_R;
        __syncthreads();
        {
            int rrq[2], rowq[2]; bool liveq[2]; const float* xrq[2]; const float* shq[2]; const float* scq[2];
            f32x4 v[2][8]; float ss[2];
#pragma unroll
            for (int q = 0; q < 2; ++q) {
                rrq[q] = wid + 8 * q; liveq[q] = rrq[q] < RT_R && t0 + rrq[q] < ntok;
                rowq[q] = liveq[q] ? t0 + rrq[q] : ntok - 1;
                xrq[q] = rowp(xs, rowq[q]); shq[q] = modp(p, l, rowq[q], 3); scq[q] = modp(p, l, rowq[q], 4); ss[q] = 0.f;
            }
#pragma unroll
            for (int i = 0; i < 8; ++i)
#pragma unroll
                for (int q = 0; q < 2; ++q) { v[q][i] = *(const f32x4*)(xrq[q] + i * 256 + lane * 4); ss[q] += v[q][i][0] * v[q][i][0] + v[q][i][1] * v[q][i][1] + v[q][i][2] * v[q][i][2] + v[q][i][3] * v[q][i][3]; }
            float rstd[2];
#pragma unroll
            for (int q = 0; q < 2; ++q) rstd[q] = rsqrtf(wave_sum(ss[q]) * (1.f / D) + 1e-6f);
#pragma unroll
            for (int i = 0; i < 8; ++i) {
                const int c = i * 256 + lane * 4;
                const f32x4 gv = *(const f32x4*)(g + c);
#pragma unroll
                for (int q = 0; q < 2; ++q) {
                    const f32x4 shv = *(const f32x4*)(shq[q] + c), scv = *(const f32x4*)(scq[q] + c);
                    float o[4]; unsigned hi[4]; float lo[4];
#pragma unroll
                    for (int j = 0; j < 4; ++j) { const float t = v[q][i][j] * rstd[q] * gv[j]; o[j] = fmaf(t, scv[j], t) + shv[j]; hi[j] = f2bf(o[j]); lo[j] = o[j] - __uint_as_float(hi[j] << 16); }
                    u32x2 wh, wl; wh[0] = hi[0] | (hi[1] << 16); wh[1] = hi[2] | (hi[3] << 16); wl[0] = pack_bf2(lo[0], lo[1]); wl[1] = pack_bf2(lo[2], lo[3]);
                    if (rrq[q] < RT_R) { *(u32x2*)(hh + rrq[q] * RT_LD + c) = wh; *(u32x2*)(hl + rrq[q] * RT_LD + c) = wl; }
                    if (liveq[q]) *(u32x2*)(H + (size_t)rowq[q] * D + c) = wh;
                }
            }
        }
        __syncthreads();
        {
            f32x4 acc[4];
#pragma unroll
            for (int et = 0; et < 4; ++et) acc[et] = (f32x4){0.f, 0.f, 0.f, 0.f};
            const int hr = c16 < RT_R ? c16 : RT_R - 1;
            const bf16_t* bh = hh + hr * RT_LD + wid * 256 + g4 * 8;
            const bf16_t* bl = hl + hr * RT_LD + wid * 256 + g4 * 8;
            const bf16_t* ah = RTH + (size_t)c16 * D + wid * 256 + g4 * 8;
            const bf16_t* al = RTL + (size_t)c16 * D + wid * 256 + g4 * 8;
#pragma unroll 2
            for (int ks = 0; ks < 8; ++ks) {
                const bf16x8 bhf = *(const bf16x8*)(bh + ks * 32), blf = *(const bf16x8*)(bl + ks * 32);
#pragma unroll
                for (int et = 0; et < 4; ++et) {
                    const bf16x8 ahf = *(const bf16x8*)(ah + (size_t)et * 16 * D + ks * 32), alf = *(const bf16x8*)(al + (size_t)et * 16 * D + ks * 32);
                    acc[et] = __builtin_amdgcn_mfma_f32_16x16x32_bf16(ahf, bhf, acc[et], 0, 0, 0);
                    acc[et] = __builtin_amdgcn_mfma_f32_16x16x32_bf16(ahf, blf, acc[et], 0, 0, 0);
                    acc[et] = __builtin_amdgcn_mfma_f32_16x16x32_bf16(alf, bhf, acc[et], 0, 0, 0);
                }
            }
#pragma unroll
            for (int et = 0; et < 4; ++et)
#pragma unroll
                for (int r = 0; r < 4; ++r) part[(wid * 64 + et * 16 + g4 * 4 + r) * 16 + c16] = acc[et][r];
        }
        __syncthreads();
        {
            bool liveq[2]; int rowq[2]; float score[2], biased[2], val[2]; int sel[2];
#pragma unroll
            for (int q = 0; q < 2; ++q) {
                const int rr = wid + 8 * q;
                liveq[q] = rr < RT_R && t0 + rr < ntok; rowq[q] = t0 + rr;
                const int rc = rr < RT_R ? rr : RT_R - 1;
                float logit = 0.f;
#pragma unroll
                for (int kq = 0; kq < 8; ++kq) logit += part[(kq * 64 + lane) * 16 + rc];
                score[q] = sigmoidf_(logit); biased[q] = score[q] + rbias[lane]; sel[q] = -1;
            }
            const int gbase = lane & ~7, mygrp = lane >> 3;
#pragma unroll
            for (int q = 0; q < 2; ++q) {
                const float m1 = max8(biased[q]);
                const unsigned long long eq = __ballot(biased[q] == m1);
                const unsigned geq = (unsigned)((eq >> gbase) & 0xffull);
                const int first = gbase + (__ffs(geq) - 1);
                const float m2 = max8((lane == first) ? -INFINITY : biased[q]);
                const float gs = m1 + m2;
                int rank = 0;
#pragma unroll
                for (int k = 0; k < 8; ++k) { const float o = bperm(gs, k * 8); rank += (o > gs || (o == gs && k < mygrp)) ? 1 : 0; }
                val[q] = rank < 4 ? biased[q] : -INFINITY;
            }
#pragma unroll
            for (int j = 0; j < TOPK; ++j)
#pragma unroll
                for (int q = 0; q < 2; ++q) {
                    const float mx = wave_max(val[q]);
                    const unsigned long long bm = __ballot(val[q] == mx);
                    const int win = __ffsll((long long)bm) - 1;
                    if (lane == win) { sel[q] = j; val[q] = -INFINITY; }
                }
#pragma unroll
            for (int q = 0; q < 2; ++q) {
                const float ssum = wave_sum(sel[q] >= 0 ? score[q] : 0.f);
                if (liveq[q] && sel[q] >= 0) {
                    const int lr = atomicAdd(lcnt + lane, 1);
                    lsel[((step * RT_R) + (wid + 8 * q)) * 8 + sel[q]] = (lane << 16) | lr;
                    if (!dummy) { tokE[(size_t)rowq[q] * 8 + sel[q]] = lane; tokW[(size_t)rowq[q] * 8 + sel[q]] = score[q] * frcp(ssum) * 2.5f; }
                }
            }
        }
    }
    __syncthreads();
    if (tid < 64) lbase[tid] = atomicAdd(cnt + tid, lcnt[tid]);
    __syncthreads();
    if (!dummy)
        for (int i = tid; i < step * RT_R * 8; i += NT) {
            const int v = lsel[i];
            if (v < 0) continue;
            const int st = i / (RT_R * 8), rr = (i / 8) % RT_R, j = i & 7;
            const int row = (bid + st * nb) * RT_R + rr;
            tokP[(size_t)row * 8 + j] = lbase[v >> 16] + (v & 0xffff);
        }
}

__device__ void phase_slots(const KP& p, int l, int bid, int nb, char* smem) {
    const int* cnt = (const int*)(p.ws + WS_CNT) + l * 64;
    const int* tokE = (const int*)(p.ws + WS_TOKE);
    const int* tokP = (const int*)(p.ws + WS_TOKP);
    int* slotT = (int*)(p.ws + WS_SLOTT);
    int* tile = (int*)(p.ws + WS_TILE);
    int* tokS = (int*)(p.ws + WS_TOKS);
    int* off = (int*)smem;
    const int tid = otid(p.wb);
    const int ntok = ntok_of(l);
    __syncthreads();
    if (tid == 0) {
        int o = 0;
        for (int e = 0; e < NE; ++e) { off[e] = o; o += (cnt[e] + 255) / 256 * 256; }
        off[NE] = o; off[NE + 1] = o + ntok;
    }
    __syncthreads();
    int nbo = nb; asm volatile("" : "+s"(nbo));
    const int gt = bid * NT + tid, gs = nbo * NT;
    for (int i = gt; i < ntok * 8; i += gs) { const int e = tokE[i]; const int s = off[e] + tokP[i]; slotT[s] = i >> 3; tokS[i] = s; }
    for (int i = gt; i < ntok; i += gs) slotT[off[NE] + i] = i;
    for (int i = gt; i < NE * 256; i += gs) { const int e = i >> 8, j = i & 255; const int s = off[e] + cnt[e] + j; if (s < off[e + 1]) slotT[s] = -1; }
    if (bid == 0) {
        const int nt = off[NE + 1] / 256;
        if (tid == 0) tile[0] = nt;
        for (int i = tid; i < nt; i += NT) {
            const int s = i * 256; int e = 0;
            for (int k = 1; k <= NE; ++k) if (s >= off[k]) e = k;
            int nv = 256;
            if (e < NE) { const int left = off[e] + cnt[e] - s; nv = left < 256 ? left : 256; }
            tile[1 + i] = e | (nv << 8);
        }
    }
}

__device__ void phase_moe1(const KP& p, int l, int bid, int nb, bf16_t* shm) {
    const bf16_t* H = (const bf16_t*)(p.ws + WS_H);
    const bf16_t* W13 = (const bf16_t*)(p.ws + WS_W13T) + (size_t)l * NEX * 1024 * D;
    const int* slotT = (const int*)(p.ws + WS_SLOTT);
    const int* tile = (const int*)(p.ws + WS_TILE);
    bf16_t* ACT = (bf16_t*)(p.ws + WS_ACT);
    const int nt = tile[0], nwg = nt * 4;
    gemm_phase<false>(nwg, bid, nb, D, shm, p.wb,
        [&](int L) { const int wg = xcd_remap(L, nwg), ti = wg >> 2, ct = wg & 3, e = tile[1 + ti] & 255; GU u; u.A = H; u.Bt = W13 + ((size_t)e * 1024 + ct * 256) * D; u.i0 = ti * 256; u.i1 = ct * 256; u.i2 = 0; u.i3 = 0; return u; },
        [&](const GU& u, int r) { const int t = slotT[u.i0 + r]; return (t < 0 ? 0 : t) * D; },
        [&](const GU& u, f32x4 (&acc)[2][2][4][2]) {
            const int s0 = u.i0, n0 = u.i1;
            G_IDX;
#pragma unroll
            for (int ai = 0; ai < 2; ++ai)
#pragma unroll
                for (int m = 0; m < 4; ++m) {
                    const int slot = s0 + ai * 128 + wr * 64 + m * 16 + fr;
#pragma unroll
                    for (int bj = 0; bj < 2; ++bj) {
                        const int ch = (n0 + bj * 128 + wc * 32) / 2 + fq * 4;
                        float a[4];
#pragma unroll
                        for (int r = 0; r < 4; ++r) a[r] = siluf_(acc[ai][bj][m][0][r]) * acc[ai][bj][m][1][r];
                        u32x2 w; w[0] = pack_bf2(a[0], a[1]); w[1] = pack_bf2(a[2], a[3]);
                        *(u32x2*)(ACT + (size_t)slot * EFF + ch) = w;
                    }
                }
            return 16;
        });
}

__device__ void phase_moe2(const KP& p, int l, int bid, int nb, bf16_t* shm) {
    const bf16_t* ACT = (const bf16_t*)(p.ws + WS_ACT);
    const bf16_t* W2 = (const bf16_t*)(p.ws + WS_W2T) + (size_t)l * NEX * D * EFF;
    const int* tile = (const int*)(p.ws + WS_TILE);
    bf16_t* OUTS = (bf16_t*)(p.ws + WS_OUTS);
    const int nt = tile[0], nwg = nt * 8;
    for (int k = (bid >> 3) & 3; k > 0; --k) __builtin_amdgcn_s_sleep(127);
    gemm_phase<true>(nwg, bid, nb, EFF, shm, p.wb,
        [&](int L) { const int wg = xcd_remap(L, nwg), ti = wg >> 3, ct = wg & 7, te = tile[1 + ti], e = te & 255; GU u; u.A = ACT; u.Bt = W2 + ((size_t)e * D + ct * 256) * EFF; u.i0 = ti * 256; u.i1 = ct * 256; u.i2 = te >> 8; u.i3 = 0; return u; },
        [&](const GU& u, int r) { return (u.i0 + r) * EFF; },
        [&](const GU& u, f32x4 (&acc)[2][2][4][2]) {
            const int s0 = u.i0, n0 = u.i1, nvalid = u.i2;
            G_IDX;
#pragma unroll
            for (int ai = 0; ai < 2; ++ai)
#pragma unroll
                for (int m = 0; m < 4; ++m) {
                    const int rt = ai * 128 + wr * 64 + m * 16 + fr, slot = s0 + rt;
                    if (rt >= nvalid) continue;
                    bf16_t* orow = OUTS + (size_t)slot * D + n0 + wc * 32 + fq * 8;
#pragma unroll
                    for (int bj = 0; bj < 2; ++bj) {
                        u32x4 w;
                        w[0] = pack_bf2(acc[ai][bj][m][0][0], acc[ai][bj][m][0][1]); w[1] = pack_bf2(acc[ai][bj][m][0][2], acc[ai][bj][m][0][3]);
                        w[2] = pack_bf2(acc[ai][bj][m][1][0], acc[ai][bj][m][1][1]); w[3] = pack_bf2(acc[ai][bj][m][1][2], acc[ai][bj][m][1][3]);
                        *(u32x4*)(orow + bj * 128) = w;
                    }
                }
            return nvalid == 256 ? 16 : 0;
        });
}

__device__ void phase_combine(const KP& p, int l, int bid, int nb, char* smem, const bool dummy = false) {
    const bf16_t* OUTS = (const bf16_t*)(p.ws + WS_OUTS);
    const int* tokS = (const int*)(p.ws + WS_TOKS);
    const float* tokW = (const float*)(p.ws + WS_TOKW);
    const int* cnt = (const int*)(p.ws + WS_CNT) + l * 64;
    const RowDst out = layer_out(p, l);
    int* sh0 = (int*)smem;
    const int tid = otid(p.wb), half = tid >> 8, ht = tid & 255;
    __syncthreads();
    if (tid == 0) { int o = 0; for (int e = 0; e < NE; ++e) o += (cnt[e] + 255) / 256 * 256; sh0[0] = o; }
    __syncthreads();
    const int shared0 = sh0[0];
    const int ntok = ntok_of(l);
    for (int row = bid * 2 + half; row < ntok; row += nb * 2) {
        float* xr = rowp(out, row);
        const float* g2 = modp(p, l, row, 5);
        const int c = ht * 8;
        float acc[8];
        {
            const u32x4 v = *(const u32x4*)(OUTS + (size_t)(shared0 + row) * D + c);
#pragma unroll
            for (int q = 0; q < 4; ++q) { acc[2 * q] = __uint_as_float(v[q] << 16); acc[2 * q + 1] = __uint_as_float(v[q] & 0xffff0000u); }
        }
#pragma unroll
        for (int j = 0; j < TOPK; ++j) {
            const int s = tokS[(size_t)row * 8 + j]; const float w = tokW[(size_t)row * 8 + j];
            const u32x4 v = *(const u32x4*)(OUTS + (size_t)s * D + c);
#pragma unroll
            for (int q = 0; q < 4; ++q) { acc[2 * q] += w * __uint_as_float(v[q] << 16); acc[2 * q + 1] += w * __uint_as_float(v[q] & 0xffff0000u); }
        }
        const f32x4 g0 = *(const f32x4*)(g2 + c), g1 = *(const f32x4*)(g2 + c + 4);
        f32x4 x0 = *(const f32x4*)(xr + c), x1 = *(const f32x4*)(xr + c + 4);
#pragma unroll
        for (int q = 0; q < 4; ++q) { x0[q] += g0[q] * acc[q]; x1[q] += g1[q] * acc[4 + q]; }
        if (!dummy || x0[0] == 1234.5f) { *(f32x4*)(xr + c) = x0; *(f32x4*)(xr + c + 4) = x1; }
    }
}

#define XB_TMO      128
#define XB_XCNT(j)  (256  + 64 * (j))
#define XB_XSUB(j)  (1280 + 64 * (j))
#define XB_XGEN(j)  (2304 + 64 * (j))
#define XB_TOP      3328
#define XB_TOPGEN   3392
#define XCD_BAR_WORDS 3456
#define XB_SPIN_CAP (1u << 18)
#define LAS __attribute__((address_space(3)))

__device__ __forceinline__ unsigned xb_ld(unsigned* p)              { return __hip_atomic_load(p, __ATOMIC_RELAXED, __HIP_MEMORY_SCOPE_AGENT); }
__device__ __forceinline__ unsigned xb_add(unsigned* p, unsigned v) { return __hip_atomic_fetch_add(p, v, __ATOMIC_RELAXED, __HIP_MEMORY_SCOPE_AGENT); }
__device__ __forceinline__ unsigned xb_xcc_id() { return (unsigned)__builtin_amdgcn_s_getreg((3 << 11) | 20) & 0xFu; }
#define XB_SPIN(cond, bar) do { unsigned _sp = 0; while (cond) { __builtin_amdgcn_s_sleep(1); \
    if ((++_sp & 255u) == 0u) { if (xb_ld(&(bar)[XB_TMO])) break; if (_sp > XB_SPIN_CAP) { atomicAdd(&(bar)[XB_TMO], 1u); break; } } } } while (0)

struct XcdBarrier {
    unsigned* bar; unsigned x;
    volatile LAS unsigned* st;
};
__device__ __forceinline__ XcdBarrier xcd_barrier_post(unsigned* bar, volatile LAS unsigned* st) {
    XcdBarrier b; b.bar = bar; b.x = (unsigned)__builtin_amdgcn_readfirstlane((int)xb_xcc_id()); b.st = st;
    if (threadIdx.x == 0) (void)xb_add(&bar[XB_XCNT(b.x)], 1u);
    return b;
}
__device__ __forceinline__ void xcd_barrier_complete(unsigned* bar, unsigned x, unsigned& nloc, unsigned& nx) {
    const unsigned G = gridDim.x * gridDim.y * gridDim.z;
    unsigned sum, cnt, mine, sp = 0u;
    for (;;) {
        sum = 0u; cnt = 0u; mine = 0u;
#pragma unroll
        for (unsigned j = 0; j < 16; ++j) { const unsigned c = xb_ld(&bar[XB_XCNT(j)]); sum += c; cnt += (c > 0u) ? 1u : 0u; mine = (j == x) ? c : mine; }
        if (sum == G) break;
        __builtin_amdgcn_s_sleep(1);
        if ((++sp & 255u) == 0u) { if (xb_ld(&bar[XB_TMO])) break; if (sp > XB_SPIN_CAP) { atomicAdd(&bar[XB_TMO], 1u); break; } }
    }
    nloc = mine > 0u ? mine : 1u; nx = cnt > 0u ? cnt : 1u;
}
__device__ __forceinline__ void xcd_barrier(const XcdBarrier& b) {
    asm volatile("s_waitcnt vmcnt(0)" ::: "memory");
    __syncthreads();
    unsigned bx = b.x; asm volatile("" : "+s"(bx));
    if (threadIdx.x == 0) {
        unsigned* bar = b.bar;
        __builtin_amdgcn_s_waitcnt(0);
        unsigned nloc = b.st[0], nx = b.st[1];
        if (nloc == 0u) { xcd_barrier_complete(bar, bx, nloc, nx); b.st[0] = nloc; b.st[1] = nx; }
        const unsigned old = xb_add(&bar[XB_XSUB(bx)], 1u);
        const unsigned gen = old / nloc;
        if (old + 1u == (gen + 1u) * nloc) {
            __builtin_amdgcn_fence(__ATOMIC_RELEASE, "agent");
            asm volatile("s_waitcnt vmcnt(0)" ::: "memory");
            const unsigned og = xb_add(&bar[XB_TOP], 1u);
            const unsigned tg = og / nx;
            if (og + 1u == (tg + 1u) * nx) xb_add(&bar[XB_TOPGEN], 1u);
            else XB_SPIN(xb_ld(&bar[XB_TOPGEN]) == tg, bar);
            __builtin_amdgcn_fence(__ATOMIC_ACQUIRE, "agent");
            xb_add(&bar[XB_XGEN(bx)], 1u);
            asm volatile("s_waitcnt vmcnt(0)" ::: "memory");
        } else {
            XB_SPIN(xb_ld(&bar[XB_XGEN(bx)]) == gen, bar);
            __builtin_amdgcn_fence(__ATOMIC_ACQUIRE, "agent");
            asm volatile("s_waitcnt vmcnt(0)" ::: "memory");
        }
    }
    __syncthreads();
}

#ifndef PROBE_MASK
#define PROBE_MASK 0u
#endif
#ifndef REP2_SKIP
#define REP2_SKIP 0
#endif
#ifndef REP2_SKIP
#define REP2_SKIP 0
#endif
#ifndef REP2_SKIP
#define REP2_SKIP 0
#endif
#ifndef REP2_SKIP
#define REP2_SKIP 0
#endif
#ifndef REP2_SKIP
#define REP2_SKIP 0
#endif
#ifndef REP2_SKIP
#define REP2_SKIP 0
#endif
#ifndef REP3_SKIP
#define REP3_SKIP 0
#endif
#ifndef REP_PHASE
#define REP_PHASE (-1)
#define REP_L 1
#define REP_N 1
#endif
constexpr int FUSED_LDS = G_LDS + 16;
__global__ void __launch_bounds__(512, 2) k_fused(Params p0) {
    extern __shared__ __attribute__((aligned(16))) char dsm[];
    KP p; (Params&)p = p0; p.wb = __builtin_amdgcn_readfirstlane((int)threadIdx.x) & ~63;
    if (threadIdx.x == 0) *(uint4*)(dsm + G_LDS) = make_uint4(0u, 0u, 0u, 0u);
    __syncthreads();
    XcdBarrier bar = xcd_barrier_post((unsigned*)(p.ws + WS_BAR), (volatile LAS unsigned*)(dsm + G_LDS));
    char* sm = dsm;
    bf16_t* shm = (bf16_t*)dsm;
    const int bid = blockIdx.x, nb = gridDim.x;
#if PROBE_MASK
    unsigned long long* stamps = (unsigned long long*)(p.ws + WS_BAR + 14336);
    int nstamp = 0;
#define STAMP() do { if (bid == 0 && threadIdx.x == 0) stamps[nstamp] = wall_clock64(); ++nstamp; } while (0)
    STAMP();
#else
#define STAMP() do { } while (0)
#endif
    for (int _r = 0; _r < (REP_PHASE == 20 ? REP_N : 1); ++_r) {
        phase_ada(p, bid, nb);
        phase_convert_dense(p, 0, bid, nb, (float*)sm);
        phase_convert_dense(p, 1, bid, nb, (float*)sm);
        phase_convert_lora(p, bid, nb);
        xcd_barrier(bar); STAMP();
    }
    phase_ada2(p, bid, nb);
    xcd_barrier(bar); STAMP();
#define RUN(k, body) { const int _n = (REP_PHASE == (k) && l == REP_L) ? REP_N : 1; for (int _r = 0; _r < _n; ++_r) { body; xcd_barrier(bar); STAMP(); } }
    for (int l = 0; l < DEPTH; ++l) {
        RUN(0, phase_norm1(p, l, bid, nb));
        RUN(1, phase_inproj(p, l, bid, nb, shm));
        RUN(2, { if (!(REP2_SKIP & 1) || _r == 0) phase_rwprep(p, l, bid, nb, sm); if (!(REP2_SKIP & 2) || _r == 0) phase_atprep(p, l, bid, nb, sm); });
        RUN(11, phase_cprep(p, bid, nb, sm));
        RUN(3, {
            if (bid < CS_BLOCKS) { if (!(REP3_SKIP & 1) || _r == 0) phase_cscan(p, bid, sm); }
            else if ((bid & 1) == 0) {
                const int hb = (bid - CS_BLOCKS) >> 1; const int hn = (nb - CS_BLOCKS + 1) >> 1;
                if (!(REP3_SKIP & 4) || _r == 0) phase_attn(p, l, hb, hn, sm);
                if (!(REP3_SKIP & 2) || _r == 0) phase_gmlp(p, l, hb, hn, sm);
            }
            conv_pull(p, l, sm);
            });
        RUN(4, phase_rwpost(p, l, bid, nb));
        RUN(5, phase_oproj(p, l, bid, nb, shm));
        RUN(6, phase_norm2_route(p, l, bid, nb, sm, _r > 0));
        RUN(7, phase_slots(p, l, bid, nb, sm));
        RUN(8, phase_moe1(p, l, bid, nb, shm));
        RUN(9, phase_moe2(p, l, bid, nb, shm));
        RUN(10, phase_combine(p, l, bid, nb, sm, _r + 1 < _n));
    }
#if PROBE_MASK
    if (bid == 0 && threadIdx.x == 0) {
        unsigned long long ticks = 0;
        for (int i = 0; i + 1 < nstamp; ++i) if ((PROBE_MASK >> i) & 1u) ticks += stamps[i + 1] - stamps[i];
        float v = (float)ticks * 10.0f;
        if (PROBE_MASK == 0x40000000u) v = 1.0e5f;
        p.out[0] = v;
    }
#endif
}

extern "C" void kernel_launch(void* const* d_in, const int* in_sizes, int n_in, void* d_out, int out_size, void* d_ws, size_t ws_size, hipStream_t stream) {
    if (n_in != 35 || out_size != SEQ * D || ws_size < WS_END) {
        fprintf(stderr, "kernel_launch: unexpected shapes: n_in %d out %d ws %zu (need %zu)\n", n_in, out_size, ws_size, (size_t)WS_END);
        return;
    }
    static int grid = 0;
    if (!grid) {
        int dev = 0, cus = 0, per_cu = 0;
        (void)hipGetDevice(&dev);
        (void)hipDeviceGetAttribute(&cus, hipDeviceAttributeMultiprocessorCount, dev);
        (void)hipFuncSetAttribute((const void*)k_fused, hipFuncAttributeMaxDynamicSharedMemorySize, FUSED_LDS);
        (void)hipOccupancyMaxActiveBlocksPerMultiprocessor(&per_cu, (const void*)k_fused, NT, FUSED_LDS);
        if (per_cu < 1) fprintf(stderr, "kernel_launch: occupancy query says %d workgroups per CU; launching one per CU anyway\n", per_cu);
        grid = cus;
        if (grid <= CS_BLOCKS) grid = 0;
    }
    if (!grid) { fprintf(stderr, "kernel_launch: bad grid\n"); return; }
    Params p{};
    const float** f = (const float**)&p;
    for (int i = 0; i < 35; ++i) f[i] = (const float*)d_in[i];
    p.out = (float*)d_out;
    p.ws = (char*)d_ws;
    (void)hipMemsetAsync(d_ws, 0, WS_ZERO_END, stream);
    hipLaunchKernelGGL(k_fused, dim3(grid), dim3(NT), FUSED_LDS, stream, p);
}
```

```cpp
#include <hip/hip_runtime.h>
#include <stdint.h>
#include <stdio.h>

typedef unsigned short bf16_t;
typedef short bf16x8 __attribute__((ext_vector_type(8)));
typedef float f32x4 __attribute__((ext_vector_type(4)));
typedef unsigned u32x4 __attribute__((ext_vector_type(4)));
typedef unsigned u32x2 __attribute__((ext_vector_type(2)));
typedef float f32x16 __attribute__((ext_vector_type(16)));

constexpr int D = 2048, SEQ = 8192, CTXL = 256, NTOK = SEQ + CTXL, DEPTH = 2;
constexpr int RW = 512, RWP = 1920, GMW = 512, INP = 4480;
constexpr int COL_GM = 1920, COL_AT = 2944, COL_K = 3968, COL_V = 4224;
constexpr int NE = 64, NEX = 65, EFF = 512, TOPK = 8;
constexpr int SLOT_CAP = 92416;
constexpr int MAX_TILES = SLOT_CAP / 256;
constexpr int INP_PAD = 4608;
constexpr int NT = 512;

constexpr size_t al256(size_t x) { return (x + 255) & ~(size_t)255; }
constexpr size_t WS_BAR = 0;
constexpr size_t WS_CNT = 16384;
constexpr size_t WS_MOD = WS_CNT + 1024;
constexpr size_t WS_ZERO_END = al256(WS_MOD + (size_t)2 * 2 * 12288 * 4);
constexpr size_t WS_WINT = WS_ZERO_END;
constexpr size_t WS_WOT = WS_WINT + (size_t)2 * INP_PAD * D * 2;
constexpr size_t WS_W13T = WS_WOT + (size_t)2 * D * D * 2;
constexpr size_t WS_W2T = WS_W13T + (size_t)2 * NEX * 1024 * D * 2;
constexpr size_t WS_H = WS_W2T + (size_t)2 * NEX * D * EFF * 2;
constexpr size_t WS_P = WS_H + (size_t)NTOK * D * 2;
constexpr size_t WS_REC = WS_P + (size_t)NTOK * INP * 4;
constexpr size_t WS_YD = WS_REC + (size_t)2 * 8 * NTOK * 384 * 4;
constexpr size_t WS_G = WS_YD + (size_t)2 * NTOK * RW * 4;
constexpr size_t WS_BV = WS_G + (size_t)NTOK * RW * 4;
constexpr size_t WS_GMR = WS_BV + (size_t)NTOK * RW * 4;
constexpr size_t WS_YCAT = al256(WS_GMR + (size_t)NTOK * 4);
constexpr size_t WS_Q = WS_YCAT + (size_t)NTOK * D * 2;
constexpr size_t WS_K = WS_Q + (size_t)NTOK * 1024 * 4;
constexpr size_t WS_X1 = WS_K + (size_t)NTOK * 256 * 4;
constexpr size_t WS_X2C = WS_X1 + (size_t)NTOK * D * 4;
constexpr size_t WS_TOKE = WS_X2C + (size_t)CTXL * D * 4;
constexpr size_t WS_TOKP = WS_TOKE + (size_t)NTOK * 8 * 4;
constexpr size_t WS_TOKW = WS_TOKP + (size_t)NTOK * 8 * 4;
constexpr size_t WS_SLOTT = WS_TOKW + (size_t)NTOK * 8 * 4;
constexpr size_t WS_SLOTW = al256(WS_SLOTT + (size_t)SLOT_CAP * 4);
constexpr size_t WS_TILE = al256(WS_SLOTW + (size_t)SLOT_CAP * 4);
constexpr size_t WS_ACT = al256(WS_TILE + (size_t)(MAX_TILES + 64) * 4);
constexpr size_t WS_MODP = WS_ACT + (size_t)SLOT_CAP * EFF * 2;
constexpr size_t WS_TOKS = WS_MODP + (size_t)2 * 2 * 32 * 12288 * 4;
constexpr size_t WS_OUTS = WS_TOKS + (size_t)NTOK * 8 * 4;
constexpr size_t WS_WLT = WS_OUTS + (size_t)SLOT_CAP * D * 2;
constexpr size_t WS_ROPE = WS_WLT + (size_t)2 * RW * 384 * 2;
constexpr size_t WS_RT = WS_ROPE + (size_t)192 * 16 * 2 * 4;
constexpr size_t WS_FR = WS_RT + (size_t)2 * 2 * NE * D * 2;
constexpr size_t WS_END = WS_FR + (size_t)16 * (NTOK / 16) * 12800;

struct Params {
    const float *x, *c, *ctx, *c_ctx, *w_ada, *b_ada, *norm1_g, *norm2_g, *w_in, *w_o;
    const float *rw_mu, *rw_w0, *rw_w2, *rw_a0, *rw_a2, *rw_g2, *rw_kk, *rw_ka, *rw_rk, *rw_ln_g, *rw_ln_b;
    const float *gm_norm_g, *gm_ws, *gm_b, *at_qn, *at_kn, *at_sink;
    const float *moe_router, *moe_bias, *moe_wg, *moe_wu, *moe_wd, *sh_wg, *sh_wu, *sh_wd;
    float* out;
    char* ws;
};

__device__ __forceinline__ bf16_t f2bf(float f) {
    unsigned u = __float_as_uint(f);
    u += 0x7fffu + ((u >> 16) & 1u);
    return (bf16_t)(u >> 16);
}
typedef __bf16 bf16x2n __attribute__((ext_vector_type(2)));
typedef float f32x2n __attribute__((ext_vector_type(2)));
__device__ __forceinline__ unsigned pack_bf2(float lo, float hi) { const f32x2n v = {lo, hi}; const bf16x2n b2 = __builtin_convertvector(v, bf16x2n); return __builtin_bit_cast(unsigned, b2); }
__device__ __forceinline__ int olane() { int t; asm volatile("v_mbcnt_lo_u32_b32 %0, -1, 0\n\tv_mbcnt_hi_u32_b32 %0, -1, %0" : "=v"(t)); return t; }
__device__ __forceinline__ float bperm(float v, int src_lane) { return __int_as_float(__builtin_amdgcn_ds_bpermute(src_lane << 2, __float_as_int(v))); }
template <int CTRL> __device__ __forceinline__ float dppf(float v) {
    return __int_as_float(__builtin_amdgcn_update_dpp(0, __float_as_int(v), CTRL, 0xf, 0xf, true));
}
__device__ __forceinline__ float red16(float v) {
    v += dppf<0xB1>(v); v += dppf<0x4E>(v); v += dppf<0x124>(v); v += dppf<0x128>(v); return v;
}
__device__ __forceinline__ float wave_sum(float v) {
    const int lane = olane();
    v = red16(v);
    v += bperm(v, lane ^ 16); v += bperm(v, lane ^ 32);
    return v;
}
__device__ __forceinline__ float wave_max(float v) {
    const int lane = olane();
    v = fmaxf(v, dppf<0xB1>(v)); v = fmaxf(v, dppf<0x4E>(v)); v = fmaxf(v, dppf<0x124>(v)); v = fmaxf(v, dppf<0x128>(v));
    v = fmaxf(v, bperm(v, lane ^ 16)); v = fmaxf(v, bperm(v, lane ^ 32));
    return v;
}
__device__ __forceinline__ float max8(float v) {
    const int lane = olane();
    v = fmaxf(v, dppf<0xB1>(v)); v = fmaxf(v, dppf<0x4E>(v)); v = fmaxf(v, bperm(v, lane ^ 4));
    return v;
}
__device__ __forceinline__ float fexp(float x) { return __builtin_amdgcn_exp2f(x * 1.4426950408889634f); }
__device__ __forceinline__ float flog(float x) { return __builtin_amdgcn_logf(x) * 0.6931471805599453f; }
__device__ __forceinline__ float frcp(float x) { return __builtin_amdgcn_rcpf(x); }
__device__ __forceinline__ float sigmoidf_(float x) { return frcp(1.f + fexp(-x)); }
__device__ __forceinline__ float siluf_(float x) { return x * frcp(1.f + fexp(-x)); }
__device__ __forceinline__ float ftanh(float u) { const float e = fexp(-2.f * fabsf(u)); const float t = (1.f - e) * frcp(1.f + e); return u < 0.f ? -t : t; }
__device__ __forceinline__ float gelu_tanh(float x) {
    const float u = 0.7978845608028654f * (x + 0.044715f * x * x * x);
    const float hx = 0.5f * x;
    return fmaf(hx, ftanh(u), hx);
}
__device__ __forceinline__ float softplusf_(float x) { return fmaxf(x, 0.f) + flog(1.f + fexp(-fabsf(x))); }

struct RowSrc { const float* a; const float* b; };
__device__ __forceinline__ const float* rowp(const RowSrc& r, int row) { return row < SEQ ? r.a + (size_t)row * D : r.b + (size_t)(row - SEQ) * D; }
struct RowDst { float* a; float* b; };
__device__ __forceinline__ float* rowp(const RowDst& r, int row) { return row < SEQ ? r.a + (size_t)row * D : r.b + (size_t)(row - SEQ) * D; }

__device__ __forceinline__ RowSrc layer_in(const Params& p, int l) {
    RowSrc r; if (l == 0) { r.a = p.x; r.b = p.ctx; } else { float* x1 = (float*)(p.ws + WS_X1); r.a = x1; r.b = x1 + (size_t)SEQ * D; } return r;
}
__device__ __forceinline__ RowDst layer_out(const Params& p, int l) {
    RowDst r; if (l == 0) { float* x1 = (float*)(p.ws + WS_X1); r.a = x1; r.b = x1 + (size_t)SEQ * D; } else { r.a = p.out; r.b = (float*)(p.ws + WS_X2C); } return r;
}
__device__ __forceinline__ const float* modp(const Params& p, int l, int row, int which) {
    return (const float*)(p.ws + WS_MOD) + ((size_t)(l * 2 + (row < SEQ ? 0 : 1)) * 6 + which) * D;
}
__device__ __forceinline__ int ntok_of(int l) { return l == DEPTH - 1 ? SEQ : NTOK; }
struct KP : Params { int wb; };
__device__ __forceinline__ int otid(int wb) {
    int t; asm volatile("v_mbcnt_lo_u32_b32 %0, -1, 0\n\tv_mbcnt_hi_u32_b32 %0, -1, %0" : "=v"(t));
    return t | wb;
}

__device__ void phase_ada(const KP& p, int bid, int nb) {
    float* part = (float*)(p.ws + WS_MODP);
    const int tid = otid(p.wb);
    for (int u = bid; u < 2 * 6 * 32; u += nb) {
        const int l = u / (6 * 32), r = u % (6 * 32), cg = r / 32, kc = r % 32;
        const int n = cg * 2048 + tid * 4;
        const float* w = p.w_ada + (size_t)l * D * 12288 + (size_t)(kc * 64) * 12288 + n;
        f32x4 a0 = {0, 0, 0, 0}, a1 = {0, 0, 0, 0};
#pragma unroll 8
        for (int k = 0; k < 64; ++k) {
            const f32x4 wv = *(const f32x4*)(w + (size_t)k * 12288);
            const float c0 = siluf_(p.c[kc * 64 + k]), c1 = siluf_(p.c_ctx[kc * 64 + k]);
            a0 += wv * c0; a1 += wv * c1;
        }
        *(f32x4*)(part + ((size_t)((l * 2 + 0) * 32 + kc)) * 12288 + n) = a0;
        *(f32x4*)(part + ((size_t)((l * 2 + 1) * 32 + kc)) * 12288 + n) = a1;
    }
}
__device__ void phase_ada2(const KP& p, int bid, int nb) {
    const float* part = (const float*)(p.ws + WS_MODP);
    float* mod = (float*)(p.ws + WS_MOD);
    for (int i = bid * NT + otid(p.wb); i < 2 * 2 * 12288; i += nb * NT) {
        const int ls = i / 12288, n = i % 12288, l = ls >> 1;
        float acc = p.b_ada[(size_t)l * 12288 + n];
        for (int kc = 0; kc < 32; ++kc) acc += part[((size_t)(ls * 32 + kc)) * 12288 + n];
        mod[i] = acc;
    }
}

struct TJob { const float* src; bf16_t* dst; int K, N, batch; size_t sstride, dstride; int mode; };
__device__ __forceinline__ void tconv_pair(const TJob& j, int t0, float* tiles  , int tid) {
    const int half = tid >> 8, ht = tid & 255;
    float* tile = tiles + half * (64 * 65);
    const int tk = j.K / 64, tn = j.N / 64, ntl = j.batch * tk * tn;
    const int t = t0 + half;
    const bool on = t < ntl;
    const int b = t / (tk * tn), r = t % (tk * tn), kt = r / tn, nt = r % tn;
    __syncthreads();
    if (on) {
        const float* src = j.src + (size_t)b * j.sstride + (size_t)(kt * 64) * j.N + nt * 64;
#pragma unroll
        for (int i = 0; i < 4; ++i) {
            const int k = i * 16 + (ht >> 4), n = (ht & 15) * 4;
            const f32x4 v = *(const f32x4*)(src + (size_t)k * j.N + n);
            tile[k * 65 + n + 0] = v[0]; tile[k * 65 + n + 1] = v[1]; tile[k * 65 + n + 2] = v[2]; tile[k * 65 + n + 3] = v[3];
        }
    }
    __syncthreads();
    if (on) {
        const int n = ht >> 2, kq = (ht & 3) * 16;
        int ng = nt * 64 + n;
        if (j.mode == 1) ng = 32 * (ng >> 4) + (ng & 15);
        else if (j.mode == 2) ng = 32 * (ng >> 4) + 16 + (ng & 15);
        bf16_t* dst = j.dst + (size_t)b * j.dstride + (size_t)ng * j.K + kt * 64 + kq;
        u32x4 w0, w1;
#pragma unroll
        for (int i = 0; i < 4; ++i) { w0[i] = pack_bf2(tile[(kq + 2 * i) * 65 + n], tile[(kq + 2 * i + 1) * 65 + n]); w1[i] = pack_bf2(tile[(kq + 8 + 2 * i) * 65 + n], tile[(kq + 8 + 2 * i + 1) * 65 + n]); }
        *(u32x4*)(dst) = w0;
        *(u32x4*)(dst + 8) = w1;
    }
}
__device__ void phase_tconv(const TJob& j, int bid, int nb, float* tiles  , int wb) {
    const int tid = otid(wb);
    const int ntl = j.batch * (j.K / 64) * (j.N / 64);
    for (int t0 = bid * 2; t0 < ntl; t0 += nb * 2) tconv_pair(j, t0, tiles, tid);
}
__device__ void phase_convert_dense(const KP& p, int l, int bid, int nb, float* tile) {
    TJob j;
    j = {p.w_in + (size_t)l * D * INP, (bf16_t*)(p.ws + WS_WINT) + (size_t)l * INP_PAD * D, D, INP, 1, 0, 0, 0}; phase_tconv(j, bid, nb, tile, p.wb);
    j = {p.w_o + (size_t)l * D * D, (bf16_t*)(p.ws + WS_WOT) + (size_t)l * D * D, D, D, 1, 0, 0, 0}; phase_tconv(j, bid, nb, tile, p.wb);
}
constexpr int CQ_ITEM = 16;
constexpr int CQ_T_BIG = NE * (D / 64) * (EFF / 64);
constexpr int CQ_T_SH = (D / 64) * (EFF / 64);
constexpr int CQ_IPL = (3 * CQ_T_BIG + 3 * CQ_T_SH) / CQ_ITEM;
constexpr int CT_LD = 68;
__device__ __forceinline__ void conv_item(const KP& p, int l, int item, float* tiles  , int tid) {
    int t = item * CQ_ITEM;
    bf16_t* w13 = (bf16_t*)(p.ws + WS_W13T) + (size_t)l * NEX * 1024 * D;
    bf16_t* w2 = (bf16_t*)(p.ws + WS_W2T) + (size_t)l * NEX * D * EFF;
    TJob j;
    if (t < CQ_T_BIG) j = {p.moe_wg + (size_t)l * NE * D * EFF, w13, D, EFF, NE, (size_t)D * EFF, (size_t)1024 * D, 1};
    else if (t < 2 * CQ_T_BIG) { t -= CQ_T_BIG; j = {p.moe_wu + (size_t)l * NE * D * EFF, w13, D, EFF, NE, (size_t)D * EFF, (size_t)1024 * D, 2}; }
    else if (t < 3 * CQ_T_BIG) { t -= 2 * CQ_T_BIG; j = {p.moe_wd + (size_t)l * NE * EFF * D, w2, EFF, D, NE, (size_t)EFF * D, (size_t)D * EFF, 0}; }
    else if (t < 3 * CQ_T_BIG + CQ_T_SH) { t -= 3 * CQ_T_BIG; j = {p.sh_wg + (size_t)l * D * EFF, w13 + (size_t)NE * 1024 * D, D, EFF, 1, 0, 0, 1}; }
    else if (t < 3 * CQ_T_BIG + 2 * CQ_T_SH) { t -= 3 * CQ_T_BIG + CQ_T_SH; j = {p.sh_wu + (size_t)l * D * EFF, w13 + (size_t)NE * 1024 * D, D, EFF, 1, 0, 0, 2}; }
    else { t -= 3 * CQ_T_BIG + 2 * CQ_T_SH; j = {p.sh_wd + (size_t)l * EFF * D, w2 + (size_t)NE * D * EFF, EFF, D, 1, 0, 0, 0}; }
    const int half = tid >> 8, ht = tid & 255;
    float* tile = tiles + half * (64 * CT_LD);
    const int tk = j.K / 64, tn = j.N / 64;
    const int lk = ht >> 4, ln = (ht & 15) * 4;
    const int sn = ht >> 2, skq = (ht & 3) * 16;
    f32x4 v[4];
#define CT_SRC(tt) (j.src + (size_t)((tt) / (tk * tn)) * j.sstride + (size_t)((((tt) % (tk * tn)) / tn) * 64) * j.N + (((tt) % (tk * tn)) % tn) * 64)
    { const float* src = CT_SRC(t + half);
#pragma unroll
      for (int i = 0; i < 4; ++i) v[i] = __builtin_nontemporal_load((const f32x4*)(src + (size_t)(lk + 16 * i) * j.N + ln)); }
#pragma unroll 1
    for (int st = 0; st < CQ_ITEM; st += 2) {
        const int tt = t + st + half;
        __syncthreads();
#pragma unroll
        for (int i = 0; i < 4; ++i) *(f32x4*)(tile + (lk + 16 * i) * CT_LD + ln) = v[i];
        __syncthreads();
        if (st + 2 < CQ_ITEM) {
            const float* src = CT_SRC(tt + 2);
#pragma unroll
            for (int i = 0; i < 4; ++i) v[i] = __builtin_nontemporal_load((const f32x4*)(src + (size_t)(lk + 16 * i) * j.N + ln));
        }
        const int b = tt / (tk * tn), r = tt % (tk * tn), kt = r / tn, nt = r % tn;
        int ng = nt * 64 + sn;
        if (j.mode == 1) ng = 32 * (ng >> 4) + (ng & 15);
        else if (j.mode == 2) ng = 32 * (ng >> 4) + 16 + (ng & 15);
        bf16_t* dst = j.dst + (size_t)b * j.dstride + (size_t)ng * j.K + kt * 64 + skq;
        u32x4 w0, w1;
#pragma unroll
        for (int i = 0; i < 4; ++i) { w0[i] = pack_bf2(tile[(skq + 2 * i) * CT_LD + sn], tile[(skq + 2 * i + 1) * CT_LD + sn]); w1[i] = pack_bf2(tile[(skq + 8 + 2 * i) * CT_LD + sn], tile[(skq + 8 + 2 * i + 1) * CT_LD + sn]); }
        __builtin_nontemporal_store(w0, (u32x4*)(dst));
        __builtin_nontemporal_store(w1, (u32x4*)(dst + 8));
    }
#undef CT_SRC
}
__device__ void conv_pull(const KP& p, int l, char* smem) {
    int* qhead = (int*)(p.ws + WS_CNT) + 200 + l;
    float* tiles = (float*)smem;
    int* sh = (int*)(smem + 2 * 64 * CT_LD * 4);
    const int tid = otid(p.wb);
    __syncthreads();
    if (tid == 0) sh[0] = __hip_atomic_fetch_add(qhead, 1, __ATOMIC_RELAXED, __HIP_MEMORY_SCOPE_AGENT);
    __syncthreads();
    int item = sh[0];
    while (item < CQ_IPL) {
        int nxt = 0;
        if (tid == 0) nxt = __hip_atomic_fetch_add(qhead, 1, __ATOMIC_RELAXED, __HIP_MEMORY_SCOPE_AGENT);
        conv_item(p, l, item, tiles, tid);
        __syncthreads();
        if (tid == 0) sh[0] = nxt;
        __syncthreads();
        item = sh[0];
    }
}

__device__ void phase_convert_lora(const KP& p, int bid, int nb) {
    bf16_t* WLT = (bf16_t*)(p.ws + WS_WLT);
    const int tid = otid(p.wb);
    for (int i = bid * NT + tid; i < 2 * D * NE; i += nb * NT) {
        const int l = i / (D * NE), r = i % (D * NE), k = r / NE, e = r % NE;
        const float x = p.moe_router[i];
        const bf16_t hi = f2bf(x); const bf16_t lo = f2bf(x - __uint_as_float((unsigned)hi << 16));
        bf16_t* rt = (bf16_t*)(p.ws + WS_RT) + (size_t)l * 2 * NE * D;
        rt[(size_t)e * D + k] = hi; rt[(size_t)NE * D + (size_t)e * D + k] = lo;
    }
    for (int i = bid * NT + tid; i < 192 * 16; i += nb * NT) {
        const int pos = i >> 4, f = i & 15;
        const float ang = (float)(pos < 128 ? pos : pos - 128) * powf(10000.f, -(float)f / 16.f);
        float* rt = (float*)(p.ws + WS_ROPE) + (size_t)i * 2;
        rt[0] = cosf(ang); rt[1] = sinf(ang);
    }
    for (int i = bid * NT + tid; i < 2 * RW * 384; i += nb * NT) {
        const int l = i / (RW * 384), r = i % (RW * 384), k = r / RW, c = r % RW;
        float v;
        if (k < 128) v = p.rw_w2[((size_t)l * 2 * 64 + k) * RW + c];
        else if (k < 256) v = p.rw_a2[((size_t)l * 2 * 64 + (k - 128)) * RW + c];
        else v = p.rw_g2[((size_t)l * 128 + (k - 256)) * RW + c];
        WLT[((size_t)l * RW + c) * 384 + k] = f2bf(v);
    }
}

__device__ void phase_norm1(const KP& p, int l, int bid, int nb) {
    const RowSrc in = layer_in(p, l);
    bf16_t* H = (bf16_t*)(p.ws + WS_H);
    const float* g = p.norm1_g + (size_t)l * D;
    const int tid = otid(p.wb), wid = tid >> 6, lane = tid & 63;
    for (int row = bid * 8 + wid; row < NTOK; row += nb * 8) {
        const float* xr = rowp(in, row);
        const float* sh = modp(p, l, row, 0);
        const float* sc = modp(p, l, row, 1);
        f32x4 v[8]; float ss = 0.f;
#pragma unroll
        for (int i = 0; i < 8; ++i) { v[i] = *(const f32x4*)(xr + i * 256 + lane * 4); ss += v[i][0] * v[i][0] + v[i][1] * v[i][1] + v[i][2] * v[i][2] + v[i][3] * v[i][3]; }
        ss = wave_sum(ss);
        const float rstd = rsqrtf(ss * (1.f / D) + 1e-6f);
#pragma unroll
        for (int i = 0; i < 8; ++i) {
            const int c = i * 256 + lane * 4;
            const f32x4 gv = *(const f32x4*)(g + c), shv = *(const f32x4*)(sh + c), scv = *(const f32x4*)(sc + c);
            float o[4];
#pragma unroll
            for (int j = 0; j < 4; ++j) { const float t = v[i][j] * rstd * gv[j]; o[j] = fmaf(t, scv[j], t) + shv[j]; }
            u32x2 w; w[0] = pack_bf2(o[0], o[1]); w[1] = pack_bf2(o[2], o[3]);
            *(u32x2*)(H + (size_t)row * D + c) = w;
        }
    }
}

constexpr int G_HT = 128 * 64;
constexpr int G_LDS = 8 * G_HT * 2;
__device__ __forceinline__ int g_lds_byte(int r, int c) {
    const int st = (r >> 4) * 2 + (c >> 5), rr = r & 15, cc = c & 31, ob = rr * 64 + cc * 2;
    return st * 1024 + (ob ^ (((ob >> 9) & 1) << 5));
}
__device__ __forceinline__ void g_stage_rc(int b, int& R, int& C) {
    const int st = b / 1024, sb = b % 1024, swz = sb ^ (((sb >> 9) & 1) << 5);
    R = (st >> 1) * 16 + swz / 64; C = (st & 1) * 32 + (swz % 64) / 2;
}
struct GOff { unsigned ao[2][2], bo; };
#define SA(b, h) (shm + ((b) * 2 + (h)) * G_HT)
#define SB(b, h) (shm + (4 + (b) * 2 + (h)) * G_HT)
#define STG_A(P, h, kt) do { _Pragma("unroll") for (int _i = 0; _i < 2; ++_i) \
    __builtin_amdgcn_global_load_lds((const unsigned*)((const char*)(A + (kt) * 64) + o.ao[h][_i]), (unsigned*)((char*)(P) + tz * 16 + _i * 8192), 16, 0, 0); } while (0)
#define STG_B(P, h, kt) do { _Pragma("unroll") for (int _i = 0; _i < 2; ++_i) \
    __builtin_amdgcn_global_load_lds((const unsigned*)((const char*)(Bt + ((h) * (PERM ? 32 : 128) + _i * (PERM ? 128 : 64)) * K + (kt) * 64) + o.bo), (unsigned*)((char*)(P) + tz * 16 + _i * 8192), 16, 0, 0); } while (0)
template <bool PERM, class ARow>
__device__ __forceinline__ void gemm_offsets(ARow arow, const int K, const int wb, GOff& o) {
    const int tz = otid(wb);
    int r, c; g_stage_rc(tz * 16, r, c);
    const int rb = PERM ? (64 * (r >> 5) + 8 * ((r & 15) >> 2) + 4 * ((r >> 4) & 1) + (r & 3)) : r;
    o.bo = (unsigned)((rb * K + c) * 2);
#pragma unroll
    for (int h = 0; h < 2; ++h)
#pragma unroll
        for (int i = 0; i < 2; ++i) o.ao[h][i] = (unsigned)((arow(h * 128 + i * 64 + r) + c) * 2);
}
template <bool PERM>
__device__ __forceinline__ void gemm_issue(const bf16_t* __restrict__ A, const bf16_t* __restrict__ Bt, const int K, const GOff& o, bf16_t* shm, const int wb) {
    const int tz = otid(wb);
    STG_B(SB(0, 0), 0, 0); STG_A(SA(0, 0), 0, 0);
    STG_B(SB(0, 1), 1, 0); STG_A(SA(0, 1), 1, 0);
    STG_B(SB(1, 0), 0, 1); STG_A(SA(1, 0), 0, 1); STG_B(SB(1, 1), 1, 1); STG_A(SA(1, 1), 1, 1);
}
template <bool PERM>
__device__ __forceinline__ void gemm_main(const bf16_t* __restrict__ A, const bf16_t* __restrict__ Bt, const int K, const GOff& o, f32x4 (&acc)[2][2][4][2], bf16_t* shm, const int wb, const int nst) {
#define LDA(dst, b, h) _Pragma("unroll") for (int m = 0; m < 4; ++m) _Pragma("unroll") for (int k = 0; k < 2; ++k) \
    dst[m][k] = *reinterpret_cast<const bf16x8*>((const char*)SA(b, h) + g_lds_byte(wr * 64 + m * 16 + fr, k * 32 + fq * 8))
#define LDB(dst, b, h) _Pragma("unroll") for (int n = 0; n < 2; ++n) _Pragma("unroll") for (int k = 0; k < 2; ++k) \
    dst[n][k] = *reinterpret_cast<const bf16x8*>((const char*)SB(b, h) + g_lds_byte(wc * 32 + n * 16 + fr, k * 32 + fq * 8))
#define MMA(ai, bj, Af, Bf) do { __builtin_amdgcn_s_setprio(1); \
    _Pragma("unroll") for (int m = 0; m < 4; ++m) _Pragma("unroll") for (int n = 0; n < 2; ++n) _Pragma("unroll") for (int k = 0; k < 2; ++k) \
        acc[ai][bj][m][n] = __builtin_amdgcn_mfma_f32_16x16x32_bf16(Bf[n][k], Af[m][k], acc[ai][bj][m][n], 0, 0, 0); \
    __builtin_amdgcn_s_setprio(0); } while (0)
#define WAIT_V(n) asm volatile("s_waitcnt vmcnt(" #n ")" ::: "memory")
#define WAIT_L(n) asm volatile("s_waitcnt lgkmcnt(" #n ")" ::: "memory")
#define BAR __builtin_amdgcn_s_barrier()
#define SCHED __builtin_amdgcn_sched_barrier(0)
    int tz = otid(wb);
    int wid = tz >> 6, lane = tz & 63, wr = wid >> 2, wc = wid & 3, fr = lane & 15, fq = lane >> 4;
#pragma unroll
    for (int a = 0; a < 2; ++a)
#pragma unroll
        for (int b = 0; b < 2; ++b)
#pragma unroll
            for (int m = 0; m < 4; ++m)
#pragma unroll
                for (int n = 0; n < 2; ++n) acc[a][b][m][n] = (f32x4){0.f, 0.f, 0.f, 0.f};
    bf16x8 At[4][2], B0[2][2], B1[2][2];
    const int nt = K / 64;
    if (nst >= 32) WAIT_V(32); else if (nst >= 16) WAIT_V(16); else WAIT_V(0);
    BAR;
    if (wr == 1) BAR;
    for (int t = 0; t < nt - 2; t += 2) {
        int tn = t; asm volatile("" : "+s"(tn));
        LDB(B0, 0, 0); SCHED; LDA(At, 0, 0); if (tn) STG_A(SA(1, 1), 1, t + 1);
        WAIT_L(8); BAR; WAIT_L(0); MMA(0, 0, At, B0); BAR; SCHED;
        LDB(B1, 0, 1); STG_B(SB(0, 0), 0, t + 2);
        BAR; WAIT_L(0); MMA(0, 1, At, B1); BAR;
        LDA(At, 0, 1); STG_A(SA(0, 0), 0, t + 2);
        BAR; WAIT_L(0); MMA(1, 0, At, B0); BAR; SCHED;
        STG_B(SB(0, 1), 1, t + 2);
        if (tn) WAIT_V(6);
        BAR; MMA(1, 1, At, B1); BAR;
        LDB(B0, 1, 0); SCHED; LDA(At, 1, 0); STG_A(SA(0, 1), 1, t + 2);
        WAIT_L(8); BAR; WAIT_L(0); MMA(0, 0, At, B0); BAR; SCHED;
        LDB(B1, 1, 1); STG_B(SB(1, 0), 0, t + 3);
        BAR; WAIT_L(0); MMA(0, 1, At, B1); BAR;
        LDA(At, 1, 1); STG_A(SA(1, 0), 0, t + 3);
        BAR; WAIT_L(0); MMA(1, 0, At, B0); BAR; SCHED;
        STG_B(SB(1, 1), 1, t + 3);
        WAIT_V(6); BAR; MMA(1, 1, At, B1); BAR;
    }
    { LDB(B0, 0, 0); WAIT_V(0); LDA(At, 0, 0); STG_A(SA(1, 1), 1, nt - 1);
      BAR; WAIT_L(0); MMA(0, 0, At, B0); BAR;
      LDB(B1, 0, 1); BAR; WAIT_L(0); MMA(0, 1, At, B1); BAR;
      LDA(At, 0, 1); WAIT_V(4); BAR; WAIT_L(0); MMA(1, 0, At, B0); MMA(1, 1, At, B1); BAR; }
    { LDB(B0, 1, 0); LDA(At, 1, 0); WAIT_V(2); BAR; WAIT_L(0); MMA(0, 0, At, B0); BAR;
      LDB(B1, 1, 1); WAIT_V(0); BAR; WAIT_L(0); MMA(0, 1, At, B1); BAR;
      LDA(At, 1, 1); BAR; WAIT_L(0); MMA(1, 0, At, B0); MMA(1, 1, At, B1); BAR; }
    if (wr == 0) BAR;
#undef LDA
#undef LDB
#undef MMA
#undef WAIT_V
#undef WAIT_L
#undef BAR
#undef SCHED
}
#undef SA
#undef SB
#undef STG_A
#undef STG_B
struct GU { const bf16_t* A; const bf16_t* Bt; int i0, i1, i2, i3; };
template <bool PERM, class Mk, class Row, class Epi>
__device__ __forceinline__ void gemm_phase(const int nwg, const int bid, const int nb, const int K, bf16_t* shm, const int wb, Mk mk, Row row, Epi epi) {
    int L = bid;
    if (L >= nwg) return;
    GU cur = mk(L);
    GOff oc;
    gemm_offsets<PERM>([&](int r) { return row(cur, r); }, K, wb, oc);
    gemm_issue<PERM>(cur.A, cur.Bt, K, oc, shm, wb);
    int nst = 0;
    for (;;) {
        f32x4 acc[2][2][4][2];
        gemm_main<PERM>(cur.A, cur.Bt, K, oc, acc, shm, wb, nst);
        const int Ln = L + nb;
        const bool more = Ln < nwg;
        GU nxt = cur; GOff on = oc;
        if (more) {
            nxt = mk(Ln);
            gemm_offsets<PERM>([&](int r) { return row(nxt, r); }, K, wb, on);
            gemm_issue<PERM>(nxt.A, nxt.Bt, K, on, shm, wb);
        }
        nst = epi(cur, acc);
        if (!more) break;
        cur = nxt; oc = on; L = Ln;
    }
}
#define G_IDX int _tz = otid(p.wb); const int _wid = _tz >> 6, _lane = _tz & 63, wr = _wid >> 2, wc = _wid & 3, fr = _lane & 15, fq = _lane >> 4
__device__ __forceinline__ int xcd_remap(int L, int nwg) {
    const int q = nwg / 8, r = nwg % 8, xcd = L % 8, off = L / 8;
    return (xcd < r ? xcd * (q + 1) : r * (q + 1) + (xcd - r) * q) + off;
}
__device__ __forceinline__ void dense_tile(int wgid, int nM, int nN, int& pm, int& pn) {
    const int nig = 8 * nN, gid = wgid / nig, fm = gid * 8, gsz = (nM - fm) < 8 ? (nM - fm) : 8;
    pm = fm + ((wgid % nig) % gsz); pn = (wgid % nig) / gsz;
}

__device__ void phase_inproj(const KP& p, int l, int bid, int nb, bf16_t* shm) {
    const bf16_t* H = (const bf16_t*)(p.ws + WS_H);
    const bf16_t* Bt = (const bf16_t*)(p.ws + WS_WINT) + (size_t)l * INP_PAD * D;
    float* P = (float*)(p.ws + WS_P);
    constexpr int nM = NTOK / 256, nN = INP_PAD / 256, nwg = nM * nN;
    gemm_phase<false>(nwg, bid, nb, D, shm, p.wb,
        [&](int L) { int pm, pn; dense_tile(xcd_remap(L, nwg), nM, nN, pm, pn); GU u; u.A = H; u.Bt = Bt + (size_t)(pn * 256) * D; u.i0 = pm * 256; u.i1 = pn * 256; u.i2 = 0; u.i3 = 0; return u; },
        [&](const GU& u, int r) { return (u.i0 + r) * D; },
        [&](const GU& u, f32x4 (&acc)[2][2][4][2]) {
            const int m0 = u.i0, n0 = u.i1;
            G_IDX;
#pragma unroll
            for (int ai = 0; ai < 2; ++ai)
#pragma unroll
                for (int m = 0; m < 4; ++m) {
                    float* prow = P + (size_t)(m0 + ai * 128 + wr * 64 + m * 16 + fr) * INP + n0 + wc * 32 + fq * 4;
#pragma unroll
                    for (int bj = 0; bj < 2; ++bj)
#pragma unroll
                        for (int n = 0; n < 2; ++n)
                            if (n0 + bj * 128 + wc * 32 + n * 16 + fq * 4 < INP) *(f32x4*)(prow + bj * 128 + n * 16) = acc[ai][bj][m][n];
                }
            return n0 + 256 <= INP ? 32 : 16;
        });
}

__device__ __forceinline__ int scan_pos(int d, int row) {
    if (row >= SEQ) { const int c = row - SEQ; return d == 0 ? c : (CTXL - 1 - c); }
    return CTXL + (d == 0 ? row : (SEQ - 1 - row));
}
__device__ __forceinline__ int scan_row(int d, int s) {
    if (s < CTXL) return SEQ + (d == 0 ? s : (CTXL - 1 - s));
    const int q = s - CTXL; return d == 0 ? q : (SEQ - 1 - q);
}
constexpr int RP_TB = 11;
constexpr int RP_LD = 392;
__device__ __forceinline__ f32x4 shifted4(const float* P, int row, int col, const float* mu) {
    const f32x4 cur = *(const f32x4*)(P + (size_t)row * INP + col);
    const bool first = (row == 0) || (row == SEQ), last = (row == SEQ - 1) || (row == NTOK - 1);
    f32x4 prev = {0.f, 0.f, 0.f, 0.f}, nxt = {0.f, 0.f, 0.f, 0.f};
    if (!first) prev = *(const f32x4*)(P + (size_t)(row - 1) * INP + col);
    if (!last) nxt = *(const f32x4*)(P + (size_t)(row + 1) * INP + col);
    const f32x4 m0 = *(const f32x4*)(mu + col), m1 = *(const f32x4*)(mu + RWP + col);
    return cur + m0 * (prev - cur) + m1 * (nxt - cur);
}
__device__ __forceinline__ float shifted(const float* P, int row, int col, float mu0, float mu1) {
    const float cur = P[(size_t)row * INP + col];
    const bool first = (row == 0) || (row == SEQ), last = (row == SEQ - 1) || (row == NTOK - 1);
    const float prev = first ? 0.f : P[(size_t)(row - 1) * INP + col];
    const float nxt = last ? 0.f : P[(size_t)(row + 1) * INP + col];
    return cur + mu0 * (prev - cur) + mu1 * (nxt - cur);
}
__device__ void phase_rwprep(const KP& p, int l, int bid, int nb, char* smem) {
    const float* P = (const float*)(p.ws + WS_P);
    float* RECW = (float*)(p.ws + WS_REC);
    bf16_t* RECD = (bf16_t*)(RECW + (size_t)16 * NTOK * 64);
    bf16_t* RECS = RECD + (size_t)16 * NTOK * 128;
    float* G = (float*)(p.ws + WS_G);
    float* BV = (float*)(p.ws + WS_BV);
    float* GMR = (float*)(p.ws + WS_GMR);
    const bf16_t* WLT = (const bf16_t*)(p.ws + WS_WLT) + (size_t)l * RW * 384;
    bf16_t* lin = (bf16_t*)smem;
    const float* mu = p.rw_mu + (size_t)l * 2 * RWP;
    const float* w0 = p.rw_w0 + (size_t)l * 2 * RW;
    const float* a0 = p.rw_a0 + (size_t)l * 2 * RW;
    const float* kkw = p.rw_kk + (size_t)l * RW;
    const float* kaw = p.rw_ka + (size_t)l * RW;
    const float* rkw = p.rw_rk + (size_t)l * RW;
    const int tid = otid(p.wb), wid = tid >> 6, lane = tid & 63, t16 = lane & 15, g = lane >> 4;
    for (int blk = bid; blk < NTOK / RP_TB; blk += nb) {
        const int t0 = blk * RP_TB;
        __syncthreads();
        for (int i = tid; i < RP_TB * 384; i += NT) {
            const int tt = i / 384, j = i % 384, col = 1536 + j;
            const float v = shifted(P, t0 + tt, col, mu[col], mu[RWP + col]);
            lin[tt * RP_LD + j] = f2bf(j < 128 ? ftanh(v) : (j < 256 ? v : sigmoidf_(v)));
        }
        __syncthreads();
        for (int q = wid; q < RP_TB; q += 8) {
            const int row = t0 + q; float ss = 0.f;
#pragma unroll
            for (int i = 0; i < 8; ++i) { const float gv = gelu_tanh(P[(size_t)row * INP + COL_GM + GMW + i * 64 + lane]); ss += gv * gv; }
            ss = wave_sum(ss);
            if (lane == 0) GMR[row] = rsqrtf(ss * (1.f / GMW) + 1e-6f);
        }
        const bool live = t16 < RP_TB;
        const int row = t0 + (live ? t16 : RP_TB - 1);
        float nrm2 = 0.f, bon = 0.f;
#pragma unroll
        for (int tl = 0; tl < 4; ++tl) {
            const int c = wid * 64 + tl * 16 + g * 4;
            const f32x4 r4 = shifted4(P, row, c, mu), k4 = shifted4(P, row, 512 + c, mu);
            const f32x4 kq = k4 * *(const f32x4*)(kkw + c), rk = *(const f32x4*)(rkw + c);
#pragma unroll
            for (int e = 0; e < 4; ++e) { nrm2 += kq[e] * kq[e]; bon += r4[e] * k4[e] * rk[e]; }
        }
        nrm2 += bperm(nrm2, lane ^ 16); nrm2 += bperm(nrm2, lane ^ 32);
        bon += bperm(bon, lane ^ 16); bon += bperm(bon, lane ^ 32);
        const float inrm = 1.f / fmaxf(sqrtf(nrm2), 1e-12f);
        const bf16_t* lrow = lin + (live ? t16 : RP_TB - 1) * RP_LD + g * 8;
#pragma unroll 1
        for (int tl = 0; tl < 4; ++tl) {
            f32x4 acc[5];
#pragma unroll
            for (int m = 0; m < 5; ++m) acc[m] = (f32x4){0.f, 0.f, 0.f, 0.f};
            const bf16_t* wrow = WLT + (size_t)(wid * 64 + tl * 16 + t16) * 384 + g * 8;
#pragma unroll
            for (int ks = 0; ks < 12; ++ks) {
                const int m = ks < 8 ? (ks >> 1) : 4;
                acc[m] = __builtin_amdgcn_mfma_f32_16x16x32_bf16(*(const bf16x8*)(wrow + ks * 32), *(const bf16x8*)(lrow + ks * 32), acc[m], 0, 0, 0);
            }
            const int c = wid * 64 + tl * 16 + g * 4, ci = tl * 16 + g * 4;
            const f32x4 r4 = shifted4(P, row, c, mu), k4 = shifted4(P, row, 512 + c, mu), v4 = shifted4(P, row, 1024 + c, mu);
            const f32x4 kq = k4 * *(const f32x4*)(kkw + c) * inrm;
            if (live) {
                *(f32x4*)(G + (size_t)row * RW + c) = acc[4];
                *(f32x4*)(BV + (size_t)row * RW + c) = v4 * bon;
            }
            const f32x4 ka = *(const f32x4*)(kaw + c);
#pragma unroll
            for (int d = 0; d < 2; ++d) {
                const f32x4 w0v = *(const f32x4*)(w0 + d * RW + c), a0v = *(const f32x4*)(a0 + d * RW + c);
                f32x4 decay, av, kd;
#pragma unroll
                for (int e = 0; e < 4; ++e) {
                    const float wlog = -softplusf_(-(w0v[e] + acc[d][e])) - 0.5f;
                    decay[e] = fexp(-fexp(wlog));
                    av[e] = sigmoidf_(a0v[e] + acc[2 + d][e]);
                    kd[e] = k4[e] * (1.f + (av[e] - 1.f) * ka[e]);
                }
                if (live) {
                    *(f32x4*)(RECW + ((size_t)(d * 8 + wid) * NTOK + row) * 64 + ci) = decay;
                    bf16_t* rd = RECD + ((size_t)(d * 8 + wid) * NTOK + row) * 128 + ci;
                    const f32x4 bq = kq * av;
                    u32x2 w1, w2; w1[0] = pack_bf2(bq[0], bq[1]); w1[1] = pack_bf2(bq[2], bq[3]); w2[0] = pack_bf2(kd[0], kd[1]); w2[1] = pack_bf2(kd[2], kd[3]);
                    *(u32x2*)(rd) = w1; *(u32x2*)(rd + 64) = w2;
                    if (d == 0) {
                        bf16_t* rs = RECS + ((size_t)wid * NTOK + row) * 192 + ci;
                        u32x2 a1, a2, a3; a1[0] = pack_bf2(kq[0], kq[1]); a1[1] = pack_bf2(kq[2], kq[3]); a2[0] = pack_bf2(r4[0], r4[1]); a2[1] = pack_bf2(r4[2], r4[3]); a3[0] = pack_bf2(v4[0], v4[1]); a3[1] = pack_bf2(v4[2], v4[3]);
                        *(u32x2*)(rs) = a1; *(u32x2*)(rs + 64) = a2; *(u32x2*)(rs + 128) = a3;
                    }
                }
            }
        }
    }
}

constexpr int SC_TS = 16;
constexpr int SCAN_BLOCKS = 128;
constexpr int SC_OPB = SC_TS * 384;
constexpr int SC_SBW = SC_TS * 64 * 4;
constexpr int SC_LDS = (2 * SC_OPB + 2 * 2 * SC_SBW) * 4;
#define SC_LD(slot, s) { const float* b_ = buf + (s) * 384 + 4 * l16; qw[slot] = *(const f32x4*)(b_); qk[slot] = *(const f32x4*)(b_ + 64); \
    qb[slot] = *(const f32x4*)(b_ + 128); qd[slot] = *(const f32x4*)(b_ + 192); qv[slot] = buf[(s) * 384 + 320 + i]; }
__device__ __forceinline__ void scan_chunk(const float* buf, float* sb, int l16, int lane, int i, f32x4& S) {
    f32x4 qw[3], qk[3], qb[3], qd[3]; float qv[3];
    SC_LD(0, 0); SC_LD(1, 1);
#pragma unroll
    for (int s = 0; s < SC_TS; ++s) {
        const int sl = s % 3;
        if (s + 2 < SC_TS) SC_LD((s + 2) % 3, s + 2);
        const f32x4 pk = S * qk[sl];
        const float sa = -red16((pk[0] + pk[1]) + (pk[2] + pk[3]));
        S = (S * qw[sl] + qd[sl] * qv[sl]) + qb[sl] * sa;
        *(f32x4*)(sb + (s * 64 + lane) * 4) = S;
    }
}
#define SC_LOAD(R, ch) { const float* _g = rec + (size_t)(ch) * SC_OPB + lt * 4; _Pragma("unroll") for (int q = 0; q < 12; ++q) R[q] = *(const f32x4*)(_g + q * 512); }
#define SC_WRITE(R, B) { float* _l = (B) + lt * 4; _Pragma("unroll") for (int q = 0; q < 12; ++q) *(f32x4*)(_l + q * 512) = R[q]; }
__device__ void phase_scan(const KP& p, int bid, char* smem) {
    const float* REC = (const float*)(p.ws + WS_REC);
    float* YD = (float*)(p.ws + WS_YD);
    float* B0 = (float*)smem;
    float* B1 = B0 + SC_OPB;
    float* SB0 = B1 + SC_OPB;
    float* SB1 = SB0 + 2 * SC_SBW;
    const int tid = otid(p.wb), wid = tid >> 6, lane = tid & 63, l16 = lane & 15;
    const int xcd = bid & 7, slot = bid >> 3, dh = xcd * 2 + (slot >> 3), rq = slot & 7;
    const int d = dh >> 3, h = dh & 7;
    const float* rec = REC + (size_t)dh * NTOK * 384;
    constexpr int NCH = NTOK / SC_TS;
    if (wid >= 6) {
        __syncthreads();
        for (int c = 0; c <= NCH; ++c) __syncthreads();
    } else if (wid >= 4) {
        const int lt = tid - 256;
        f32x4 R0[12], R1[12];
        SC_LOAD(R0, 0); SC_WRITE(R0, B0);
        SC_LOAD(R1, 1); SC_LOAD(R0, 2);
        __syncthreads();
        for (int c = 0; c < NCH; c += 2) {
            if (c + 1 < NCH) SC_WRITE(R1, B1);
            if (c + 3 < NCH) SC_LOAD(R1, c + 3);
            __syncthreads();
            if (c + 2 < NCH) SC_WRITE(R0, B0);
            if (c + 4 < NCH) SC_LOAD(R0, c + 4);
            __syncthreads();
        }
        __syncthreads();
    } else if (wid >= 2) {
        const int cw = wid - 2, dstep = d == 0 ? 1 : -1;
        float* yout = YD + (size_t)d * NTOK * RW + h * 64 + rq * 8 + cw * 4 + (lane >> 4);
        f32x4 rr[SC_TS];
#define SC_RLOAD(B) { _Pragma("unroll") for (int s = 0; s < SC_TS; ++s) rr[s] = *(const f32x4*)((B) + s * 384 + 256 + 4 * l16); }
#define SC_READOUT(SB, ch) { float yv = 0.f; \
            _Pragma("unroll") for (int s = 0; s < SC_TS; ++s) { const f32x4 sv = *(const f32x4*)((SB) + cw * SC_SBW + (s * 64 + lane) * 4); const f32x4 py = sv * rr[s]; \
                const float y = red16((py[0] + py[1]) + (py[2] + py[3])); yv = (l16 == s) ? y : yv; } \
            yout[(size_t)(scan_row(d, (ch) * SC_TS) + dstep * l16) * RW] = yv; }
        __syncthreads();
        SC_RLOAD(B0);
        __syncthreads();
        for (int c = 1; c < NCH; c += 2) {
            SC_READOUT(SB0, c - 1); SC_RLOAD(B1);
            __syncthreads();
            SC_READOUT(SB1, c);
            if (c + 1 < NCH) SC_RLOAD(B0);
            __syncthreads();
        }
    } else {
        const int i = rq * 8 + wid * 4 + (lane >> 4);
        f32x4 S = {0.f, 0.f, 0.f, 0.f};
        __syncthreads();
        for (int c = 0; c < NCH; c += 2) {
            scan_chunk(B0, SB0 + wid * SC_SBW, l16, lane, i, S);
            __syncthreads();
            scan_chunk(B1, SB1 + wid * SC_SBW, l16, lane, i, S);
            __syncthreads();
        }
        __syncthreads();
    }
}

constexpr int CK = 16, NCHK = NTOK / CK;
constexpr int FR_B = 12800;
constexpr int FR_AT = 0, FR_RT = 2048, FR_SM = 4096, FR_BT = 6144  , FR_VF = 10240, FR_GC = 12288;
template <int SH> __device__ __forceinline__ float row_shr1(float v) {
    return __int_as_float(__builtin_amdgcn_update_dpp(0x3f800000, __float_as_int(v), 0x110 + SH, 0xf, 0xf, false));
}
__device__ __forceinline__ bf16x8 frag8(const float (&v)[16], int q) {
    u32x4 w; w[0] = pack_bf2(v[4 * q], v[4 * q + 1]); w[1] = pack_bf2(v[4 * q + 2], v[4 * q + 3]); w[2] = pack_bf2(v[4 * q + 4], v[4 * q + 5]); w[3] = pack_bf2(v[4 * q + 6], v[4 * q + 7]);
    return __builtin_bit_cast(bf16x8, w);
}
__device__ __forceinline__ bf16x8 frag4(const f32x4 a) {
    u32x4 w; w[0] = pack_bf2(a[0], a[1]); w[1] = pack_bf2(a[2], a[3]); w[2] = 0u; w[3] = 0u;
    return __builtin_bit_cast(bf16x8, w);
}
__device__ __forceinline__ bf16x8 frag4u(unsigned lo, unsigned hi) { u32x4 w; w[0] = lo; w[1] = hi; w[2] = 0u; w[3] = 0u; return __builtin_bit_cast(bf16x8, w); }
#define MM(a, b, c) __builtin_amdgcn_mfma_f32_16x16x32_bf16(a, b, c, 0, 0, 0)
__device__ void phase_cprep(const KP& p, int bid, int nb, char* smem) {
    const float* RECW = (const float*)(p.ws + WS_REC);
    const bf16_t* RECD = (const bf16_t*)(RECW + (size_t)16 * NTOK * 64);
    const bf16_t* RECS = RECD + (size_t)16 * NTOK * 128;
    char* FR = p.ws + WS_FR;
    const int tid = otid(p.wb), wid = tid >> 6, lane = tid & 63, t = lane & 15, g = lane >> 4;
    bf16_t* zt = (bf16_t*)smem + wid * 2048;
    const f32x4 Z4 = {0.f, 0.f, 0.f, 0.f};
    for (int u = bid * 8 + wid; u < 16 * NCHK; u += nb * 8) {
        const int dh = u / NCHK, c = u % NCHK;
        const int d = dh >> 3, hh = dh & 7;
        const int row = scan_row(d, c * CK + t);
        const float* pw = RECW + ((size_t)dh * NTOK + row) * 64;
        const bf16_t* pd = RECD + ((size_t)dh * NTOK + row) * 128;
        const bf16_t* ps = RECS + ((size_t)hh * NTOK + row) * 192;
        float w_[16], kk[16], bb[16], kd[16], rr[16];
#pragma unroll
        for (int q = 0; q < 4; ++q) {
            const int jo = 32 * (q >> 1) + 16 * (q & 1) + 4 * g;
            const f32x4 a0 = *(const f32x4*)(pw + jo);
            const u32x2 ub = *(const u32x2*)(pd + jo), uk = *(const u32x2*)(pd + 64 + jo), ukk = *(const u32x2*)(ps + jo), ur = *(const u32x2*)(ps + 64 + jo);
#pragma unroll
            for (int e = 0; e < 4; ++e) {
                w_[4 * q + e] = a0[e];
                bb[4 * q + e] = __uint_as_float((e & 1) ? (ub[e >> 1] & 0xffff0000u) : (ub[e >> 1] << 16));
                kd[4 * q + e] = __uint_as_float((e & 1) ? (uk[e >> 1] & 0xffff0000u) : (uk[e >> 1] << 16));
                kk[4 * q + e] = __uint_as_float((e & 1) ? (ukk[e >> 1] & 0xffff0000u) : (ukk[e >> 1] << 16));
                rr[4 * q + e] = __uint_as_float((e & 1) ? (ur[e >> 1] & 0xffff0000u) : (ur[e >> 1] << 16));
            }
        }
        float gam[16], At[16], Bh[16], Kh[16], Rt[16], Bt[16], Kt[16];
#pragma unroll
        for (int k = 0; k < 16; ++k) {
            float x = w_[k];
            x *= row_shr1<1>(x); x *= row_shr1<2>(x); x *= row_shr1<4>(x); x *= row_shr1<8>(x);
            gam[k] = x;
        }
#pragma unroll
        for (int k = 0; k < 16; ++k) {
            const float gp = row_shr1<1>(gam[k]), gc = bperm(gam[k], (lane & 48) | 15), ig = frcp(gam[k]);
            At[k] = kk[k] * gp; Bh[k] = bb[k] * ig; Kh[k] = kd[k] * ig; Rt[k] = rr[k] * gam[k];
            Bt[k] = -Bh[k] * gc; Kt[k] = Kh[k] * gc;
        }
        const bf16x8 fA0 = frag8(At, 0), fA1 = frag8(At, 2), fB0 = frag8(Bh, 0), fB1 = frag8(Bh, 2), fK0 = frag8(Kh, 0), fK1 = frag8(Kh, 2), fR0 = frag8(Rt, 0), fR1 = frag8(Rt, 2);
        f32x4 X = MM(fA1, fB1, MM(fA0, fB0, Z4));
        f32x4 XT = MM(fB1, fA1, MM(fB0, fA0, Z4));
        f32x4 Lak = MM(fA1, fK1, MM(fA0, fK0, Z4));
        f32x4 LrbT = MM(fB1, fR1, MM(fB0, fR0, Z4));
        f32x4 LrkT = MM(fK1, fR1, MM(fK0, fR0, Z4));
        f32x4 T, TT;
#pragma unroll
        for (int r = 0; r < 4; ++r) {
            const int row = 4 * g + r;
            X[r] = t < row ? -X[r] : 0.f;
            XT[r] = row < t ? -XT[r] : 0.f;
            Lak[r] = t < row ? Lak[r] : 0.f;
            LrbT[r] = row <= t ? -LrbT[r] : 0.f;
            LrkT[r] = row <= t ? LrkT[r] : 0.f;
            const float id = row == t ? 1.f : 0.f;
            T[r] = id + X[r]; TT[r] = id + XT[r];
        }
#pragma unroll
        for (int it = 0; it < 3; ++it) {
            const f32x4 X2 = MM(frag4(XT), frag4(X), Z4), X2T = MM(frag4(X), frag4(XT), Z4);
            const f32x4 Tn = MM(frag4(TT), frag4(X2), T), TTn = MM(frag4(X2), frag4(TT), TT);
            X = X2; XT = X2T; T = Tn; TT = TTn;
        }
        const f32x4 TLT = MM(frag4(Lak), frag4(TT), Z4);
#pragma unroll
        for (int q = 0; q < 4; ++q)
#pragma unroll
            for (int e = 0; e < 4; ++e) {
                const int j = 32 * (q >> 1) + 16 * (q & 1) + 4 * g + e;
                zt[j * 16 + t] = f2bf(Bt[4 * q + e]); zt[1024 + j * 16 + t] = f2bf(Kt[4 * q + e]);
            }
        char* fb = FR + ((size_t)dh * NCHK + c) * FR_B;
        *(bf16x8*)(fb + FR_AT + lane * 16) = fA0; *(bf16x8*)(fb + FR_AT + 1024 + lane * 16) = fA1;
        *(bf16x8*)(fb + FR_RT + lane * 16) = fR0; *(bf16x8*)(fb + FR_RT + 1024 + lane * 16) = fR1;
        {
            u32x4 s0, s1;
            s0[0] = pack_bf2(TT[0], TT[1]); s0[1] = pack_bf2(TT[2], TT[3]); s0[2] = pack_bf2(TLT[0], TLT[1]); s0[3] = pack_bf2(TLT[2], TLT[3]);
            s1[0] = pack_bf2(LrbT[0], LrbT[1]); s1[1] = pack_bf2(LrbT[2], LrbT[3]); s1[2] = pack_bf2(LrkT[0], LrkT[1]); s1[3] = pack_bf2(LrkT[2], LrkT[3]);
            *(u32x4*)(fb + FR_SM + lane * 32) = s0; *(u32x4*)(fb + FR_SM + lane * 32 + 16) = s1;
        }
#pragma unroll
        for (int jt = 0; jt < 4; ++jt) {
            {
                const u32x2 b2 = *(const u32x2*)(zt + (16 * jt + t) * 16 + 4 * g), k2 = *(const u32x2*)(zt + 1024 + (16 * jt + t) * 16 + 4 * g);
                u32x4 bk; bk[0] = b2[0]; bk[1] = b2[1]; bk[2] = k2[0]; bk[3] = k2[1];
                *(u32x4*)(fb + FR_BT + jt * 1024 + lane * 16) = bk;
            }
            const int dstp = d == 0 ? 1 : -1;
            const bf16_t* vp = RECS + ((size_t)hh * NTOK + scan_row(d, c * CK + 4 * g)) * 192 + 128 + 16 * jt + t;
            u32x2 vw; vw[0] = (unsigned)vp[0] | ((unsigned)vp[dstp * 192] << 16); vw[1] = (unsigned)vp[2 * dstp * 192] | ((unsigned)vp[3 * dstp * 192] << 16);
            *(u32x2*)(fb + FR_VF + jt * 512 + lane * 8) = vw;
        }
        if (t == 15) {
#pragma unroll
            for (int q = 0; q < 4; ++q) { f32x4 gv = {gam[4 * q], gam[4 * q + 1], gam[4 * q + 2], gam[4 * q + 3]}; *(f32x4*)(fb + FR_GC + (32 * (q >> 1) + 16 * (q & 1) + 4 * g) * 4) = gv; }
        }
    }
}

constexpr int CS_BLOCKS = 16, CS_R = 3;
__device__ void phase_cscan(const KP& p, int bid, char* smem) {
    const char* FRs = p.ws + WS_FR + (size_t)bid * NCHK * FR_B;
    float* YD = (float*)(p.ws + WS_YD);
    const int tid = otid(p.wb), wid = tid >> 6, lane = tid & 63, c16 = lane & 15, g = lane >> 4;
    const int d = bid >> 3, h = bid & 7;
    if (wid >= 4) {
        const int lw = wid - 4;
        const bool tail = lw == 0 && lane < 16;
        u32x4 fifo[8][4];
#define CS_LD(k, ch) { const char* _s = FRs + (size_t)(ch) * FR_B + lane * 16; \
            _Pragma("unroll") for (int _q = 0; _q < 3; ++_q) fifo[k][_q] = *(const u32x4*)(_s + (lw + 4 * _q) * 1024); \
            if (tail) fifo[k][3] = *(const u32x4*)(_s + 12288); }
#define CS_WR(k, ch) { char* _d = smem + ((ch) % CS_R) * FR_B + lane * 16; \
            _Pragma("unroll") for (int _q = 0; _q < 3; ++_q) *(u32x4*)(_d + (lw + 4 * _q) * 1024) = fifo[k][_q]; \
            if (tail) *(u32x4*)(_d + 12288) = fifo[k][3]; }
#define CS_BAR() { asm volatile("" ::: "memory"); __builtin_amdgcn_s_barrier(); asm volatile("" ::: "memory"); }
#define CS_PERIOD(r) { if (pch + (r) + 1 < NCHK) CS_WR(((r) + 1) & 7, pch + (r) + 1); if (pch + (r) + 9 < NCHK) CS_LD(((r) + 1) & 7, pch + (r) + 9); CS_BAR(); }
        CS_LD(0, 0); CS_LD(1, 1); CS_LD(2, 2); CS_LD(3, 3); CS_LD(4, 4); CS_LD(5, 5); CS_LD(6, 6); CS_LD(7, 7);
        CS_WR(0, 0); CS_LD(0, 8);
        CS_BAR();
        for (int pch = 0; pch < NCHK; pch += 8) {
            CS_PERIOD(0); CS_PERIOD(1); CS_PERIOD(2); CS_PERIOD(3); CS_PERIOD(4); CS_PERIOD(5); CS_PERIOD(6); CS_PERIOD(7);
        }
    } else {
        const int it = wid, dstep = d == 0 ? 1 : -1;
        float* yout = YD + (size_t)d * NTOK * RW + h * 64 + it * 16 + c16;
        const f32x4 Z4 = {0.f, 0.f, 0.f, 0.f};
        f32x4 ST[4] = {Z4, Z4, Z4, Z4};
        asm volatile("" ::: "memory"); __builtin_amdgcn_s_barrier(); asm volatile("" ::: "memory");
        for (int pch = 0; pch < NCHK; ++pch) {
            const char* sb = smem + (pch % CS_R) * FR_B;
            const bf16x8 A0 = *(const bf16x8*)(sb + FR_AT + lane * 16), A1 = *(const bf16x8*)(sb + FR_AT + 1024 + lane * 16);
            const bf16x8 R0 = *(const bf16x8*)(sb + FR_RT + lane * 16), R1 = *(const bf16x8*)(sb + FR_RT + 1024 + lane * 16);
            const bf16x8 TTL = *(const bf16x8*)(sb + FR_SM + lane * 32), LRR = *(const bf16x8*)(sb + FR_SM + lane * 32 + 16);
            const u32x2 vf = *(const u32x2*)(sb + FR_VF + it * 512 + lane * 8);
            u32x4 b0, b1;
            b0[0] = pack_bf2(ST[0][0], ST[0][1]); b0[1] = pack_bf2(ST[0][2], ST[0][3]); b0[2] = pack_bf2(ST[1][0], ST[1][1]); b0[3] = pack_bf2(ST[1][2], ST[1][3]);
            b1[0] = pack_bf2(ST[2][0], ST[2][1]); b1[1] = pack_bf2(ST[2][2], ST[2][3]); b1[2] = pack_bf2(ST[3][0], ST[3][1]); b1[3] = pack_bf2(ST[3][2], ST[3][3]);
            const bf16x8 Bs0 = __builtin_bit_cast(bf16x8, b0), Bs1 = __builtin_bit_cast(bf16x8, b1);
            const f32x4 Q = MM(A1, Bs1, MM(A0, Bs0, Z4));
            u32x4 qv; qv[0] = pack_bf2(Q[0], Q[1]); qv[1] = pack_bf2(Q[2], Q[3]); qv[2] = vf[0]; qv[3] = vf[1];
            const f32x4 P = MM(TTL, __builtin_bit_cast(bf16x8, qv), Z4);
            u32x4 pv; pv[0] = pack_bf2(P[0], P[1]); pv[1] = pack_bf2(P[2], P[3]); pv[2] = vf[0]; pv[3] = vf[1];
            const bf16x8 PV = __builtin_bit_cast(bf16x8, pv);
            const f32x4 Y = MM(LRR, PV, MM(R1, Bs1, MM(R0, Bs0, Z4)));
#pragma unroll
            for (int jt = 0; jt < 4; ++jt) {
                const f32x4 gc = *(const f32x4*)(sb + FR_GC + (16 * jt + 4 * g) * 4);
                const bf16x8 bk = *(const bf16x8*)(sb + FR_BT + jt * 1024 + lane * 16);
                ST[jt] = MM(bk, PV, ST[jt] * gc);
            }
            const int row0 = scan_row(d, pch * CK) + dstep * 4 * g;
#pragma unroll
            for (int r = 0; r < 4; ++r) yout[(size_t)(row0 + dstep * r) * RW] = Y[r];
            asm volatile("" ::: "memory"); __builtin_amdgcn_s_barrier(); asm volatile("" ::: "memory");
        }
    }
}
#undef MM

__device__ void phase_rwpost(const KP& p, int l, int bid, int nb) {
    const float* YD = (const float*)(p.ws + WS_YD);
    const float* G = (const float*)(p.ws + WS_G);
    const float* BV = (const float*)(p.ws + WS_BV);
    bf16_t* Y = (bf16_t*)(p.ws + WS_YCAT);
    const float* lng = p.rw_ln_g + (size_t)l * RW;
    const float* lnb = p.rw_ln_b + (size_t)l * RW;
    const int tid = otid(p.wb), wid = tid >> 6, lane = tid & 63;
    for (int u = bid * 8 + wid; u < NTOK * 8; u += nb * 8) {
        const int row = u >> 3, h = u & 7, c = h * 64 + lane;
        const float y = YD[(size_t)row * RW + c] + YD[((size_t)NTOK + row) * RW + c];
        const float mean = wave_sum(y) * (1.f / 64);
        const float dv = y - mean;
        const float var = wave_sum(dv * dv) * (1.f / 64);
        const float yn = dv * rsqrtf(var + 64e-5f) * lng[c] + lnb[c];
        Y[(size_t)row * D + c] = f2bf((yn + BV[(size_t)row * RW + c]) * G[(size_t)row * RW + c]);
    }
}

constexpr int GM_LD = 136;
__device__ void phase_gmlp(const KP& p, int l, int bid, int nb, char* smem) {
    const float* P = (const float*)(p.ws + WS_P);
    const float* GMR = (const float*)(p.ws + WS_GMR);
    bf16_t* Y = (bf16_t*)(p.ws + WS_YCAT);
    bf16_t* vt = (bf16_t*)smem;
    const float* ng = p.gm_norm_g + (size_t)l * GMW;
    const int tid = otid(p.wb), wid = tid >> 6, lane = tid & 63, r = lane & 31, h = lane >> 5, mt = wid >> 1, nt = wid & 1;
    for (int u = bid; u < (NTOK / 128) * 8; u += nb) {
        const int n = u >> 3, g = u & 7, t0 = n * 128;
        const float* ws = p.gm_ws + ((size_t)l * 8 + g) * 128 * 128;
        const float* bs = p.gm_b + ((size_t)l * 8 + g) * 128;
        __syncthreads();
        {
            const int c = tid & 63, qp0 = tid >> 6;
            const float gn = ng[g * 64 + c];
#pragma unroll
            for (int i = 0; i < 8; ++i) {
                const int q = (qp0 + 8 * i) * 2;
                const float v0 = gelu_tanh(P[(size_t)(t0 + q) * INP + COL_GM + GMW + g * 64 + c]) * GMR[t0 + q] * gn;
                const float v1 = gelu_tanh(P[(size_t)(t0 + q + 1) * INP + COL_GM + GMW + g * 64 + c]) * GMR[t0 + q + 1] * gn;
                *(unsigned*)(vt + c * GM_LD + q) = pack_bf2(v0, v1);
            }
        }
        __syncthreads();
        f32x16 acc;
#pragma unroll
        for (int i = 0; i < 16; ++i) acc[i] = 0.f;
        const float* arow = ws + (size_t)(mt * 32 + r) * 128 + h * 8;
#pragma unroll
        for (int ks = 0; ks < 8; ++ks) {
            const f32x4 a0 = *(const f32x4*)(arow + ks * 16), a1 = *(const f32x4*)(arow + ks * 16 + 4);
            u32x4 aw; aw[0] = pack_bf2(a0[0], a0[1]); aw[1] = pack_bf2(a0[2], a0[3]); aw[2] = pack_bf2(a1[0], a1[1]); aw[3] = pack_bf2(a1[2], a1[3]);
            const bf16x8 bfr = *(const bf16x8*)(vt + (nt * 32 + r) * GM_LD + ks * 16 + h * 8);
            acc = __builtin_amdgcn_mfma_f32_32x32x16_bf16(__builtin_bit_cast(bf16x8, aw), bfr, acc, 0, 0, 0);
        }
        const int c = nt * 32 + r;
#pragma unroll
        for (int i = 0; i < 16; ++i) {
            const int pp = mt * 32 + (i & 3) + 8 * (i >> 2) + 4 * h;
            const float uu = gelu_tanh(P[(size_t)(t0 + pp) * INP + COL_GM + g * 64 + c]);
            Y[(size_t)(t0 + pp) * D + 512 + g * 64 + c] = f2bf(uu * (acc[i] + bs[pp]));
        }
    }
}

__device__ void phase_atprep(const KP& p, int l, int bid, int nb, char* smem) {
    const float* P = (const float*)(p.ws + WS_P);
    bf16_t* Qb = (bf16_t*)(p.ws + WS_Q);
    bf16_t* Kb = (bf16_t*)(p.ws + WS_K);
    bf16_t* VT = Kb + (size_t)NTOK * 256;
    const float* qn = p.at_qn + (size_t)l * 64;
    const float* kn = p.at_kn + (size_t)l * 64;
    const int tid = otid(p.wb);
    const float* rope = (const float*)(p.ws + WS_ROPE);
    for (int i = bid * NT + tid; i < NTOK * 20; i += nb * NT) {
        const int row = i / 20, hv = i % 20;
        const bool isq = hv < 16;
        const float* src = P + (size_t)row * INP + (isq ? COL_AT + hv * 64 : COL_K + (hv - 16) * 64);
        const float* gn = isq ? qn : kn;
        f32x4 x[16]; float ss = 0.f;
#pragma unroll
        for (int k = 0; k < 16; ++k) { x[k] = *(const f32x4*)(src + 4 * k); ss += x[k][0] * x[k][0] + x[k][1] * x[k][1] + x[k][2] * x[k][2] + x[k][3] * x[k][3]; }
        const float sc = rsqrtf(ss * (1.f / 64) + 1e-6f) * (isq ? 0.125f : 1.f);
#pragma unroll
        for (int k = 0; k < 16; ++k) x[k] = x[k] * *(const f32x4*)(gn + 4 * k) * sc;
        if (row < SEQ) {
#pragma unroll
            for (int sec = 0; sec < 2; ++sec) {
                const float* rt = rope + (size_t)((sec == 0 ? (row >> 6) : (128 + (row & 63))) * 16) * 2;
#pragma unroll
                for (int k = 0; k < 4; ++k) {
                    const f32x4 c0 = *(const f32x4*)(rt + 8 * k), c1 = *(const f32x4*)(rt + 8 * k + 4);
                    f32x4& a = x[8 * sec + k]; f32x4& b2 = x[8 * sec + 4 + k];
                    const float cs[4] = {c0[0], c0[2], c1[0], c1[2]}, sn[4] = {c0[1], c0[3], c1[1], c1[3]};
#pragma unroll
                    for (int e = 0; e < 4; ++e) { const float x1 = a[e], x2 = b2[e]; a[e] = x1 * cs[e] - x2 * sn[e]; b2[e] = x2 * cs[e] + x1 * sn[e]; }
                }
            }
        }
        bf16_t* dst = isq ? (Qb + (size_t)row * 1024 + hv * 64) : (Kb + (size_t)row * 256 + (hv - 16) * 64);
#pragma unroll
        for (int k = 0; k < 8; ++k) {
            u32x4 w; w[0] = pack_bf2(x[2 * k][0], x[2 * k][1]); w[1] = pack_bf2(x[2 * k][2], x[2 * k][3]); w[2] = pack_bf2(x[2 * k + 1][0], x[2 * k + 1][1]); w[3] = pack_bf2(x[2 * k + 1][2], x[2 * k + 1][3]);
            *(u32x4*)(dst + 8 * k) = w;
        }
    }
    float* tile = (float*)smem;
    for (int u = bid; u < (NTOK / 64) * 4; u += nb) {
        const int t0 = (u >> 2) * 64, kvh = u & 3;
        __syncthreads();
        {
            const int tok = tid >> 3, d8 = (tid & 7) * 8;
            const float* src = P + (size_t)(t0 + tok) * INP + COL_V + kvh * 64 + d8;
            const f32x4 a = *(const f32x4*)src, b2 = *(const f32x4*)(src + 4);
#pragma unroll
            for (int i = 0; i < 4; ++i) { tile[tok * 65 + d8 + i] = a[i]; tile[tok * 65 + d8 + 4 + i] = b2[i]; }
        }
        __syncthreads();
        {
            const int d = tid >> 3, tk = (tid & 7) * 8;
            u32x4 w;
#pragma unroll
            for (int i = 0; i < 4; ++i) w[i] = pack_bf2(tile[(tk + 2 * i) * 65 + d], tile[(tk + 2 * i + 1) * 65 + d]);
            *(u32x4*)(VT + (size_t)(kvh * 64 + d) * NTOK + t0 + tk) = w;
        }
    }
}

constexpr int AT_LD = 72;
constexpr int AT_TILE = 64 * AT_LD;
__device__ void phase_attn(const KP& p, int l, int bid, int nb, char* smem) {
    const bf16_t* Qb = (const bf16_t*)(p.ws + WS_Q);
    const bf16_t* Kb = (const bf16_t*)(p.ws + WS_K);
    const bf16_t* VT = Kb + (size_t)NTOK * 256;
    bf16_t* Y = (bf16_t*)(p.ws + WS_YCAT);
    bf16_t* Kc = (bf16_t*)smem;
    bf16_t* Vc = Kc + AT_TILE;
    const int tid = otid(p.wb), wid = tid >> 6, lane = tid & 63, q = lane & 31, h = lane >> 5, g = wid >> 1, qh = wid & 1;
    const int srow = tid >> 3, sseg = tid & 7;
    const int voff = srow * AT_LD + (sseg >> 2) * 32 + ((sseg >> 1) & 1) * 16 + (sseg & 1) * 4;
    for (int u = bid; u < (NTOK / 64) * 4; u += nb) {
        const int qt = u >> 2, kvh = u & 3, t0 = qt * 64, head = kvh * 4 + g, qrow = t0 + qh * 32 + q;
        int c_lo = 0, n_local = 0;
        if (t0 < SEQ) { c_lo = 2 - (t0 >> 6); if (c_lo < 0) c_lo = 0; int c_hi = (SEQ + 64 - t0) >> 6; if (c_hi > 4) c_hi = 4; n_local = c_hi - c_lo + 1; }
        const int nch = n_local + 4;
        bf16x8 qf[4];
#pragma unroll
        for (int ks = 0; ks < 4; ++ks) qf[ks] = *(const bf16x8*)(Qb + (size_t)qrow * 1024 + head * 64 + ks * 16 + h * 8);
        f32x16 O0, O1;
#pragma unroll
        for (int r = 0; r < 16; ++r) { O0[r] = 0.f; O1[r] = 0.f; }
        float m = p.at_sink[(size_t)l * 16 + head], lsum = h == 0 ? 1.f : 0.f;
        u32x4 rk, rv;
        {
            const int k0 = n_local > 0 ? (t0 - 128 + 64 * c_lo) : SEQ;
            rk = *(const u32x4*)(Kb + (size_t)(k0 + srow) * 256 + kvh * 64 + sseg * 8);
            rv = *(const u32x4*)(VT + (size_t)(kvh * 64 + srow) * NTOK + k0 + sseg * 8);
        }
        for (int ci = 0; ci < nch; ++ci) {
            const bool local = ci < n_local;
            const int k0 = local ? (t0 - 128 + 64 * (c_lo + ci)) : (SEQ + 64 * (ci - n_local));
            __syncthreads();
            *(u32x4*)(Kc + srow * AT_LD + sseg * 8) = rk;
            { u32x2 lo, hi; lo[0] = rv[0]; lo[1] = rv[1]; hi[0] = rv[2]; hi[1] = rv[3]; *(u32x2*)(Vc + voff) = lo; *(u32x2*)(Vc + voff + 8) = hi; }
            __syncthreads();
            if (ci + 1 < nch) {
                const int kn = (ci + 1 < n_local) ? (t0 - 128 + 64 * (c_lo + ci + 1)) : (SEQ + 64 * (ci + 1 - n_local));
                rk = *(const u32x4*)(Kb + (size_t)(kn + srow) * 256 + kvh * 64 + sseg * 8);
                rv = *(const u32x4*)(VT + (size_t)(kvh * 64 + srow) * NTOK + kn + sseg * 8);
            }
            f32x16 s0, s1;
#pragma unroll
            for (int r = 0; r < 16; ++r) { s0[r] = 0.f; s1[r] = 0.f; }
#pragma unroll
            for (int ks = 0; ks < 4; ++ks) {
                const bf16x8 k0f = *(const bf16x8*)(Kc + q * AT_LD + ks * 16 + h * 8);
                const bf16x8 k1f = *(const bf16x8*)(Kc + (32 + q) * AT_LD + ks * 16 + h * 8);
                s0 = __builtin_amdgcn_mfma_f32_32x32x16_bf16(k0f, qf[ks], s0, 0, 0, 0);
                s1 = __builtin_amdgcn_mfma_f32_32x32x16_bf16(k1f, qf[ks], s1, 0, 0, 0);
            }
            if (local) {
                const int base = k0 + 4 * h - qrow;
#pragma unroll
                for (int r = 0; r < 16; ++r) {
                    const int d0 = base + (r & 3) + 8 * (r >> 2), d1 = d0 + 32;
                    if (d0 > 128 || d0 < -128) s0[r] = -INFINITY;
                    if (d1 > 128 || d1 < -128) s1[r] = -INFINITY;
                }
            }
            float mx = fmaxf(s0[0], s1[0]);
#pragma unroll
            for (int r = 1; r < 16; ++r) mx = fmaxf(mx, fmaxf(s0[r], s1[r]));
            mx = fmaxf(mx, bperm(mx, lane ^ 32));
            const float mnew = fmaxf(m, mx);
            const float alpha = __expf(m - mnew);
            m = mnew; lsum *= alpha;
#pragma unroll
            for (int r = 0; r < 16; ++r) { O0[r] *= alpha; O1[r] *= alpha; }
            float ps = 0.f;
#pragma unroll
            for (int r = 0; r < 16; ++r) { s0[r] = __expf(s0[r] - m); s1[r] = __expf(s1[r] - m); ps += s0[r] + s1[r]; }
            lsum += ps;
            bf16x8 pf[2][2];
#pragma unroll
            for (int s = 0; s < 2; ++s) {
                u32x4 w0, w1;
#pragma unroll
                for (int i = 0; i < 4; ++i) { w0[i] = pack_bf2(s0[8 * s + 2 * i], s0[8 * s + 2 * i + 1]); w1[i] = pack_bf2(s1[8 * s + 2 * i], s1[8 * s + 2 * i + 1]); }
                pf[0][s] = __builtin_bit_cast(bf16x8, w0); pf[1][s] = __builtin_bit_cast(bf16x8, w1);
            }
#pragma unroll
            for (int kb = 0; kb < 2; ++kb)
#pragma unroll
                for (int s = 0; s < 2; ++s) {
                    const bf16x8 v0f = *(const bf16x8*)(Vc + q * AT_LD + kb * 32 + s * 16 + h * 8);
                    const bf16x8 v1f = *(const bf16x8*)(Vc + (32 + q) * AT_LD + kb * 32 + s * 16 + h * 8);
                    O0 = __builtin_amdgcn_mfma_f32_32x32x16_bf16(v0f, pf[kb][s], O0, 0, 0, 0);
                    O1 = __builtin_amdgcn_mfma_f32_32x32x16_bf16(v1f, pf[kb][s], O1, 0, 0, 0);
                }
        }
        lsum += bperm(lsum, lane ^ 32);
        const float inv = 1.f / lsum;
        bf16_t* yo = Y + (size_t)qrow * D + 1024 + head * 64 + 4 * h;
#pragma unroll
        for (int rg = 0; rg < 4; ++rg) {
            u32x2 w0, w1;
            w0[0] = pack_bf2(O0[4 * rg] * inv, O0[4 * rg + 1] * inv); w0[1] = pack_bf2(O0[4 * rg + 2] * inv, O0[4 * rg + 3] * inv);
            w1[0] = pack_bf2(O1[4 * rg] * inv, O1[4 * rg + 1] * inv); w1[1] = pack_bf2(O1[4 * rg + 2] * inv, O1[4 * rg + 3] * inv);
            *(u32x2*)(yo + 8 * rg) = w0;
            *(u32x2*)(yo + 32 + 8 * rg) = w1;
        }
    }
}

__device__ void phase_oproj(const KP& p, int l, int bid, int nb, bf16_t* shm) {
    const bf16_t* Y = (const bf16_t*)(p.ws + WS_YCAT);
    const bf16_t* Bt = (const bf16_t*)(p.ws + WS_WOT) + (size_t)l * D * D;
    const RowSrc in = layer_in(p, l);
    const RowDst out = layer_out(p, l);
    const int nM = ntok_of(l) / 256, nN = D / 256, nwg = nM * nN;
    gemm_phase<false>(nwg, bid, nb, D, shm, p.wb,
        [&](int L) { int pm, pn; dense_tile(xcd_remap(L, nwg), nM, nN, pm, pn); GU u; u.A = Y; u.Bt = Bt + (size_t)(pn * 256) * D; u.i0 = pm * 256; u.i1 = pn * 256; u.i2 = 0; u.i3 = 0; return u; },
        [&](const GU& u, int r) { return (u.i0 + r) * D; },
        [&](const GU& u, f32x4 (&acc)[2][2][4][2]) {
            const int m0 = u.i0, n0 = u.i1;
            G_IDX;
#pragma unroll
            for (int ai = 0; ai < 2; ++ai)
#pragma unroll
                for (int m = 0; m < 4; ++m) {
                    const int row = m0 + ai * 128 + wr * 64 + m * 16 + fr;
                    const float* xi = rowp(in, row);
                    float* xo = rowp(out, row);
                    const float* g1 = modp(p, l, row, 2);
#pragma unroll
                    for (int bj = 0; bj < 2; ++bj)
#pragma unroll
                        for (int n = 0; n < 2; ++n) {
                            const int col = n0 + bj * 128 + wc * 32 + n * 16 + fq * 4;
                            *(f32x4*)(xo + col) = *(const f32x4*)(xi + col) + *(const f32x4*)(g1 + col) * acc[ai][bj][m][n];
                        }
                }
            return 32;
        });
}

constexpr int RT_R = 11;
constexpr int RT_LD = D + 8;
__device__ void phase_norm2_route(const KP& p, int l, int bid, int nb, char* smem, const bool dummy = false) {
    const RowDst xs = layer_out(p, l);
    bf16_t* H = (bf16_t*)(p.ws + WS_H);
    int* cnt = (int*)(p.ws + WS_CNT) + l * 64 + (dummy ? 128 : 0);
    int* tokE = (int*)(p.ws + WS_TOKE);
    int* tokP = (int*)(p.ws + WS_TOKP);
    float* tokW = (float*)(p.ws + WS_TOKW);
    const float* g = p.norm2_g + (size_t)l * D;
    const bf16_t* RTH = (const bf16_t*)(p.ws + WS_RT) + (size_t)l * 2 * NE * D;
    const bf16_t* RTL = RTH + (size_t)NE * D;
    const float* rbias = p.moe_bias + (size_t)l * NE;
    bf16_t* hh = (bf16_t*)smem;
    bf16_t* hl = hh + RT_R * RT_LD;
    float* part = (float*)(hl + RT_R * RT_LD);
    int* lcnt = (int*)(part + 8 * 64 * 16);
    int* lbase = lcnt + 64;
    int* lsel = lbase + 64;
    const int tid = otid(p.wb), wid = tid >> 6, lane = tid & 63, c16 = lane & 15, g4 = lane >> 4;
    const int ntok = ntok_of(l), nsteps = (ntok + RT_R - 1) / RT_R;
    __syncthreads();
    if (tid < 64) lcnt[tid] = 0;
    for (int i = tid; i < 4 * RT_R * 8; i += NT) lsel[i] = -1;
    int step = 0;
    for (int blk = bid; blk < nsteps; blk += nb, ++step) {
        const int t0 = blk * RT_R;
        __syncthreads();
        {
            int rrq[2], rowq[2]; bool liveq[2]; const float* xrq[2]; const float* shq[2]; const float* scq[2];
            f32x4 v[2][8]; float ss[2];
#pragma unroll
            for (int q = 0; q < 2; ++q) {
                rrq[q] = wid + 8 * q; liveq[q] = rrq[q] < RT_R && t0 + rrq[q] < ntok;
                rowq[q] = liveq[q] ? t0 + rrq[q] : ntok - 1;
                xrq[q] = rowp(xs, rowq[q]); shq[q] = modp(p, l, rowq[q], 3); scq[q] = modp(p, l, rowq[q], 4); ss[q] = 0.f;
            }
#pragma unroll
            for (int i = 0; i < 8; ++i)
#pragma unroll
                for (int q = 0; q < 2; ++q) { v[q][i] = *(const f32x4*)(xrq[q] + i * 256 + lane * 4); ss[q] += v[q][i][0] * v[q][i][0] + v[q][i][1] * v[q][i][1] + v[q][i][2] * v[q][i][2] + v[q][i][3] * v[q][i][3]; }
            float rstd[2];
#pragma unroll
            for (int q = 0; q < 2; ++q) rstd[q] = rsqrtf(wave_sum(ss[q]) * (1.f / D) + 1e-6f);
#pragma unroll
            for (int i = 0; i < 8; ++i) {
                const int c = i * 256 + lane * 4;
                const f32x4 gv = *(const f32x4*)(g + c);
#pragma unroll
                for (int q = 0; q < 2; ++q) {
                    const f32x4 shv = *(const f32x4*)(shq[q] + c), scv = *(const f32x4*)(scq[q] + c);
                    float o[4]; unsigned hi[4]; float lo[4];
#pragma unroll
                    for (int j = 0; j < 4; ++j) { const float t = v[q][i][j] * rstd[q] * gv[j]; o[j] = fmaf(t, scv[j], t) + shv[j]; hi[j] = f2bf(o[j]); lo[j] = o[j] - __uint_as_float(hi[j] << 16); }
                    u32x2 wh, wl; wh[0] = hi[0] | (hi[1] << 16); wh[1] = hi[2] | (hi[3] << 16); wl[0] = pack_bf2(lo[0], lo[1]); wl[1] = pack_bf2(lo[2], lo[3]);
                    if (rrq[q] < RT_R) { *(u32x2*)(hh + rrq[q] * RT_LD + c) = wh; *(u32x2*)(hl + rrq[q] * RT_LD + c) = wl; }
                    if (liveq[q]) *(u32x2*)(H + (size_t)rowq[q] * D + c) = wh;
                }
            }
        }
        __syncthreads();
        {
            f32x4 acc[4];
#pragma unroll
            for (int et = 0; et < 4; ++et) acc[et] = (f32x4){0.f, 0.f, 0.f, 0.f};
            const int hr = c16 < RT_R ? c16 : RT_R - 1;
            const bf16_t* bh = hh + hr * RT_LD + wid * 256 + g4 * 8;
            const bf16_t* bl = hl + hr * RT_LD + wid * 256 + g4 * 8;
            const bf16_t* ah = RTH + (size_t)c16 * D + wid * 256 + g4 * 8;
            const bf16_t* al = RTL + (size_t)c16 * D + wid * 256 + g4 * 8;
#pragma unroll 2
            for (int ks = 0; ks < 8; ++ks) {
                const bf16x8 bhf = *(const bf16x8*)(bh + ks * 32), blf = *(const bf16x8*)(bl + ks * 32);
#pragma unroll
                for (int et = 0; et < 4; ++et) {
                    const bf16x8 ahf = *(const bf16x8*)(ah + (size_t)et * 16 * D + ks * 32), alf = *(const bf16x8*)(al + (size_t)et * 16 * D + ks * 32);
                    acc[et] = __builtin_amdgcn_mfma_f32_16x16x32_bf16(ahf, bhf, acc[et], 0, 0, 0);
                    acc[et] = __builtin_amdgcn_mfma_f32_16x16x32_bf16(ahf, blf, acc[et], 0, 0, 0);
                    acc[et] = __builtin_amdgcn_mfma_f32_16x16x32_bf16(alf, bhf, acc[et], 0, 0, 0);
                }
            }
#pragma unroll
            for (int et = 0; et < 4; ++et)
#pragma unroll
                for (int r = 0; r < 4; ++r) part[(wid * 64 + et * 16 + g4 * 4 + r) * 16 + c16] = acc[et][r];
        }
        __syncthreads();
        {
            bool liveq[2]; int rowq[2]; float score[2], biased[2], val[2]; int sel[2];
#pragma unroll
            for (int q = 0; q < 2; ++q) {
                const int rr = wid + 8 * q;
                liveq[q] = rr < RT_R && t0 + rr < ntok; rowq[q] = t0 + rr;
                const int rc = rr < RT_R ? rr : RT_R - 1;
                float logit = 0.f;
#pragma unroll
                for (int kq = 0; kq < 8; ++kq) logit += part[(kq * 64 + lane) * 16 + rc];
                score[q] = sigmoidf_(logit); biased[q] = score[q] + rbias[lane]; sel[q] = -1;
            }
            const int gbase = lane & ~7, mygrp = lane >> 3;
#pragma unroll
            for (int q = 0; q < 2; ++q) {
                const float m1 = max8(biased[q]);
                const unsigned long long eq = __ballot(biased[q] == m1);
                const unsigned geq = (unsigned)((eq >> gbase) & 0xffull);
                const int first = gbase + (__ffs(geq) - 1);
                const float m2 = max8((lane == first) ? -INFINITY : biased[q]);
                const float gs = m1 + m2;
                int rank = 0;
#pragma unroll
                for (int k = 0; k < 8; ++k) { const float o = bperm(gs, k * 8); rank += (o > gs || (o == gs && k < mygrp)) ? 1 : 0; }
                val[q] = rank < 4 ? biased[q] : -INFINITY;
            }
#pragma unroll
            for (int j = 0; j < TOPK; ++j)
#pragma unroll
                for (int q = 0; q < 2; ++q) {
                    const float mx = wave_max(val[q]);
                    const unsigned long long bm = __ballot(val[q] == mx);
                    const int win = __ffsll((long long)bm) - 1;
                    if (lane == win) { sel[q] = j; val[q] = -INFINITY; }
                }
#pragma unroll
            for (int q = 0; q < 2; ++q) {
                const float ssum = wave_sum(sel[q] >= 0 ? score[q] : 0.f);
                if (liveq[q] && sel[q] >= 0) {
                    const int lr = atomicAdd(lcnt + lane, 1);
                    lsel[((step * RT_R) + (wid + 8 * q)) * 8 + sel[q]] = (lane << 16) | lr;
                    if (!dummy) { tokE[(size_t)rowq[q] * 8 + sel[q]] = lane; tokW[(size_t)rowq[q] * 8 + sel[q]] = score[q] * frcp(ssum) * 2.5f; }
                }
            }
        }
    }
    __syncthreads();
    if (tid < 64) lbase[tid] = atomicAdd(cnt + tid, lcnt[tid]);
    __syncthreads();
    if (!dummy)
        for (int i = tid; i < step * RT_R * 8; i += NT) {
            const int v = lsel[i];
            if (v < 0) continue;
            const int st = i / (RT_R * 8), rr = (i / 8) % RT_R, j = i & 7;
            const int row = (bid + st * nb) * RT_R + rr;
            tokP[(size_t)row * 8 + j] = lbase[v >> 16] + (v & 0xffff);
        }
}

__device__ void phase_slots(const KP& p, int l, int bid, int nb, char* smem) {
    const int* cnt = (const int*)(p.ws + WS_CNT) + l * 64;
    const int* tokE = (const int*)(p.ws + WS_TOKE);
    const int* tokP = (const int*)(p.ws + WS_TOKP);
    int* slotT = (int*)(p.ws + WS_SLOTT);
    int* tile = (int*)(p.ws + WS_TILE);
    int* tokS = (int*)(p.ws + WS_TOKS);
    int* off = (int*)smem;
    const int tid = otid(p.wb);
    const int ntok = ntok_of(l);
    __syncthreads();
    if (tid == 0) {
        int o = 0;
        for (int e = 0; e < NE; ++e) { off[e] = o; o += (cnt[e] + 255) / 256 * 256; }
        off[NE] = o; off[NE + 1] = o + ntok;
    }
    __syncthreads();
    int nbo = nb; asm volatile("" : "+s"(nbo));
    const int gt = bid * NT + tid, gs = nbo * NT;
    for (int i = gt; i < ntok * 8; i += gs) { const int e = tokE[i]; const int s = off[e] + tokP[i]; slotT[s] = i >> 3; tokS[i] = s; }
    for (int i = gt; i < ntok; i += gs) slotT[off[NE] + i] = i;
    for (int i = gt; i < NE * 256; i += gs) { const int e = i >> 8, j = i & 255; const int s = off[e] + cnt[e] + j; if (s < off[e + 1]) slotT[s] = -1; }
    if (bid == 0) {
        const int nt = off[NE + 1] / 256;
        if (tid == 0) tile[0] = nt;
        for (int i = tid; i < nt; i += NT) {
            const int s = i * 256; int e = 0;
            for (int k = 1; k <= NE; ++k) if (s >= off[k]) e = k;
            int nv = 256;
            if (e < NE) { const int left = off[e] + cnt[e] - s; nv = left < 256 ? left : 256; }
            tile[1 + i] = e | (nv << 8);
        }
    }
}

__device__ void phase_moe1(const KP& p, int l, int bid, int nb, bf16_t* shm) {
    const bf16_t* H = (const bf16_t*)(p.ws + WS_H);
    const bf16_t* W13 = (const bf16_t*)(p.ws + WS_W13T) + (size_t)l * NEX * 1024 * D;
    const int* slotT = (const int*)(p.ws + WS_SLOTT);
    const int* tile = (const int*)(p.ws + WS_TILE);
    bf16_t* ACT = (bf16_t*)(p.ws + WS_ACT);
    const int nt = tile[0], nwg = nt * 4;
    gemm_phase<false>(nwg, bid, nb, D, shm, p.wb,
        [&](int L) { const int wg = xcd_remap(L, nwg), ti = wg >> 2, ct = wg & 3, e = tile[1 + ti] & 255; GU u; u.A = H; u.Bt = W13 + ((size_t)e * 1024 + ct * 256) * D; u.i0 = ti * 256; u.i1 = ct * 256; u.i2 = 0; u.i3 = 0; return u; },
        [&](const GU& u, int r) { const int t = slotT[u.i0 + r]; return (t < 0 ? 0 : t) * D; },
        [&](const GU& u, f32x4 (&acc)[2][2][4][2]) {
            const int s0 = u.i0, n0 = u.i1;
            G_IDX;
#pragma unroll
            for (int ai = 0; ai < 2; ++ai)
#pragma unroll
                for (int m = 0; m < 4; ++m) {
                    const int slot = s0 + ai * 128 + wr * 64 + m * 16 + fr;
#pragma unroll
                    for (int bj = 0; bj < 2; ++bj) {
                        const int ch = (n0 + bj * 128 + wc * 32) / 2 + fq * 4;
                        float a[4];
#pragma unroll
                        for (int r = 0; r < 4; ++r) a[r] = siluf_(acc[ai][bj][m][0][r]) * acc[ai][bj][m][1][r];
                        u32x2 w; w[0] = pack_bf2(a[0], a[1]); w[1] = pack_bf2(a[2], a[3]);
                        *(u32x2*)(ACT + (size_t)slot * EFF + ch) = w;
                    }
                }
            return 16;
        });
}

__device__ void phase_moe2(const KP& p, int l, int bid, int nb, bf16_t* shm) {
    const bf16_t* ACT = (const bf16_t*)(p.ws + WS_ACT);
    const bf16_t* W2 = (const bf16_t*)(p.ws + WS_W2T) + (size_t)l * NEX * D * EFF;
    const int* tile = (const int*)(p.ws + WS_TILE);
    bf16_t* OUTS = (bf16_t*)(p.ws + WS_OUTS);
    const int nt = tile[0], nwg = nt * 8;
    for (int k = (bid >> 3) & 3; k > 0; --k) __builtin_amdgcn_s_sleep(127);
    gemm_phase<true>(nwg, bid, nb, EFF, shm, p.wb,
        [&](int L) { const int wg = xcd_remap(L, nwg), ti = wg >> 3, ct = wg & 7, te = tile[1 + ti], e = te & 255; GU u; u.A = ACT; u.Bt = W2 + ((size_t)e * D + ct * 256) * EFF; u.i0 = ti * 256; u.i1 = ct * 256; u.i2 = te >> 8; u.i3 = 0; return u; },
        [&](const GU& u, int r) { return (u.i0 + r) * EFF; },
        [&](const GU& u, f32x4 (&acc)[2][2][4][2]) {
            const int s0 = u.i0, n0 = u.i1, nvalid = u.i2;
            G_IDX;
            const bool odd = fr & 1;
#pragma unroll
            for (int ai = 0; ai < 2; ++ai)
#pragma unroll
                for (int m = 0; m < 4; ++m) {
                    const int rp = ai * 128 + wr * 64 + m * 16 + (fr & ~1);
                    u32x4 c0, c1, dA, dB;
                    c0[0] = pack_bf2(acc[ai][0][m][0][0], acc[ai][0][m][0][1]); c0[1] = pack_bf2(acc[ai][0][m][0][2], acc[ai][0][m][0][3]);
                    c0[2] = pack_bf2(acc[ai][0][m][1][0], acc[ai][0][m][1][1]); c0[3] = pack_bf2(acc[ai][0][m][1][2], acc[ai][0][m][1][3]);
                    c1[0] = pack_bf2(acc[ai][1][m][0][0], acc[ai][1][m][0][1]); c1[1] = pack_bf2(acc[ai][1][m][0][2], acc[ai][1][m][0][3]);
                    c1[2] = pack_bf2(acc[ai][1][m][1][0], acc[ai][1][m][1][1]); c1[3] = pack_bf2(acc[ai][1][m][1][2], acc[ai][1][m][1][3]);
#pragma unroll
                    for (int q = 0; q < 4; ++q) {
                        const unsigned snd = odd ? c0[q] : c1[q];
                        const unsigned rcv = (unsigned)__builtin_amdgcn_update_dpp(0, (int)snd, 0xB1, 0xf, 0xf, true);
                        dA[q] = odd ? rcv : c0[q]; dB[q] = odd ? c1[q] : rcv;
                    }
                    bf16_t* o = OUTS + (size_t)(s0 + rp) * D + n0 + wc * 64 + fq * 8 + (odd ? 32 : 0);
                    if (rp < nvalid) *(u32x4*)o = dA;
                    if (rp + 1 < nvalid) *(u32x4*)(o + D) = dB;
                }
            return nvalid == 256 ? 16 : 0;
        });
}

__device__ void phase_combine(const KP& p, int l, int bid, int nb, char* smem, const bool dummy = false) {
    const bf16_t* OUTS = (const bf16_t*)(p.ws + WS_OUTS);
    const int* tokS = (const int*)(p.ws + WS_TOKS);
    const float* tokW = (const float*)(p.ws + WS_TOKW);
    const int* cnt = (const int*)(p.ws + WS_CNT) + l * 64;
    const RowDst out = layer_out(p, l);
    int* sh0 = (int*)smem;
    const int tid = otid(p.wb), half = tid >> 8, ht = tid & 255;
    __syncthreads();
    if (tid == 0) { int o = 0; for (int e = 0; e < NE; ++e) o += (cnt[e] + 255) / 256 * 256; sh0[0] = o; }
    __syncthreads();
    const int shared0 = sh0[0];
    const int ntok = ntok_of(l);
    for (int row = bid * 2 + half; row < ntok; row += nb * 2) {
        float* xr = rowp(out, row);
        const float* g2 = modp(p, l, row, 5);
        const int c = ht * 8;
        float acc[8];
        {
            const u32x4 v = *(const u32x4*)(OUTS + (size_t)(shared0 + row) * D + c);
#pragma unroll
            for (int q = 0; q < 4; ++q) { acc[2 * q] = __uint_as_float(v[q] << 16); acc[2 * q + 1] = __uint_as_float(v[q] & 0xffff0000u); }
        }
#pragma unroll
        for (int j = 0; j < TOPK; ++j) {
            const int s = tokS[(size_t)row * 8 + j]; const float w = tokW[(size_t)row * 8 + j];
            const u32x4 v = *(const u32x4*)(OUTS + (size_t)s * D + c);
#pragma unroll
            for (int q = 0; q < 4; ++q) { acc[2 * q] += w * __uint_as_float(v[q] << 16); acc[2 * q + 1] += w * __uint_as_float(v[q] & 0xffff0000u); }
        }
        const f32x4 g0 = *(const f32x4*)(g2 + c), g1 = *(const f32x4*)(g2 + c + 4);
        f32x4 x0 = *(const f32x4*)(xr + c), x1 = *(const f32x4*)(xr + c + 4);
#pragma unroll
        for (int q = 0; q < 4; ++q) { x0[q] += g0[q] * acc[q]; x1[q] += g1[q] * acc[4 + q]; }
        if (!dummy || x0[0] == 1234.5f) { *(f32x4*)(xr + c) = x0; *(f32x4*)(xr + c + 4) = x1; }
    }
}

#define XB_TMO      128
#define XB_XCNT(j)  (256  + 64 * (j))
#define XB_XSUB(j)  (1280 + 64 * (j))
#define XB_XGEN(j)  (2304 + 64 * (j))
#define XB_TOP      3328
#define XB_TOPGEN   3392
#define XCD_BAR_WORDS 3456
#define XB_SPIN_CAP (1u << 18)
#define LAS __attribute__((address_space(3)))

__device__ __forceinline__ unsigned xb_ld(unsigned* p)              { return __hip_atomic_load(p, __ATOMIC_RELAXED, __HIP_MEMORY_SCOPE_AGENT); }
__device__ __forceinline__ unsigned xb_add(unsigned* p, unsigned v) { return __hip_atomic_fetch_add(p, v, __ATOMIC_RELAXED, __HIP_MEMORY_SCOPE_AGENT); }
__device__ __forceinline__ unsigned xb_xcc_id() { return (unsigned)__builtin_amdgcn_s_getreg((3 << 11) | 20) & 0xFu; }
#define XB_SPIN(cond, bar) do { unsigned _sp = 0; while (cond) { __builtin_amdgcn_s_sleep(1); \
    if ((++_sp & 255u) == 0u) { if (xb_ld(&(bar)[XB_TMO])) break; if (_sp > XB_SPIN_CAP) { atomicAdd(&(bar)[XB_TMO], 1u); break; } } } } while (0)

struct XcdBarrier {
    unsigned* bar; unsigned x;
    volatile LAS unsigned* st;
};
__device__ __forceinline__ XcdBarrier xcd_barrier_post(unsigned* bar, volatile LAS unsigned* st) {
    XcdBarrier b; b.bar = bar; b.x = (unsigned)__builtin_amdgcn_readfirstlane((int)xb_xcc_id()); b.st = st;
    if (threadIdx.x == 0) (void)xb_add(&bar[XB_XCNT(b.x)], 1u);
    return b;
}
__device__ __forceinline__ void xcd_barrier_complete(unsigned* bar, unsigned x, unsigned& nloc, unsigned& nx) {
    const unsigned G = gridDim.x * gridDim.y * gridDim.z;
    unsigned sum, cnt, mine, sp = 0u;
    for (;;) {
        sum = 0u; cnt = 0u; mine = 0u;
#pragma unroll
        for (unsigned j = 0; j < 16; ++j) { const unsigned c = xb_ld(&bar[XB_XCNT(j)]); sum += c; cnt += (c > 0u) ? 1u : 0u; mine = (j == x) ? c : mine; }
        if (sum == G) break;
        __builtin_amdgcn_s_sleep(1);
        if ((++sp & 255u) == 0u) { if (xb_ld(&bar[XB_TMO])) break; if (sp > XB_SPIN_CAP) { atomicAdd(&bar[XB_TMO], 1u); break; } }
    }
    nloc = mine > 0u ? mine : 1u; nx = cnt > 0u ? cnt : 1u;
}
__device__ __forceinline__ void xcd_barrier(const XcdBarrier& b) {
    asm volatile("s_waitcnt vmcnt(0)" ::: "memory");
    __syncthreads();
    unsigned bx = b.x; asm volatile("" : "+s"(bx));
    if (threadIdx.x == 0) {
        unsigned* bar = b.bar;
        __builtin_amdgcn_s_waitcnt(0);
        unsigned nloc = b.st[0], nx = b.st[1];
        if (nloc == 0u) { xcd_barrier_complete(bar, bx, nloc, nx); b.st[0] = nloc; b.st[1] = nx; }
        const unsigned old = xb_add(&bar[XB_XSUB(bx)], 1u);
        const unsigned gen = old / nloc;
        if (old + 1u == (gen + 1u) * nloc) {
            __builtin_amdgcn_fence(__ATOMIC_RELEASE, "agent");
            asm volatile("s_waitcnt vmcnt(0)" ::: "memory");
            const unsigned og = xb_add(&bar[XB_TOP], 1u);
            const unsigned tg = og / nx;
            if (og + 1u == (tg + 1u) * nx) xb_add(&bar[XB_TOPGEN], 1u);
            else XB_SPIN(xb_ld(&bar[XB_TOPGEN]) == tg, bar);
            __builtin_amdgcn_fence(__ATOMIC_ACQUIRE, "agent");
            xb_add(&bar[XB_XGEN(bx)], 1u);
            asm volatile("s_waitcnt vmcnt(0)" ::: "memory");
        } else {
            XB_SPIN(xb_ld(&bar[XB_XGEN(bx)]) == gen, bar);
            __builtin_amdgcn_fence(__ATOMIC_ACQUIRE, "agent");
            asm volatile("s_waitcnt vmcnt(0)" ::: "memory");
        }
    }
    __syncthreads();
}

#ifndef PROBE_MASK
#define PROBE_MASK 0u
#endif
#ifndef REP2_SKIP
#define REP2_SKIP 0
#endif
#ifndef REP2_SKIP
#define REP2_SKIP 0
#endif
#ifndef REP2_SKIP
#define REP2_SKIP 0
#endif
#ifndef REP2_SKIP
#define REP2_SKIP 0
#endif
#ifndef REP2_SKIP
#define REP2_SKIP 0
#endif
#ifndef REP2_SKIP
#define REP2_SKIP 0
#endif
#ifndef REP3_SKIP
#define REP3_SKIP 0
#endif
#ifndef REP_PHASE
#define REP_PHASE (-1)
#define REP_L 1
#define REP_N 1
#endif
constexpr int FUSED_LDS = G_LDS + 16;
__global__ void __launch_bounds__(512, 2) k_fused(Params p0) {
    extern __shared__ __attribute__((aligned(16))) char dsm[];
    KP p; (Params&)p = p0; p.wb = __builtin_amdgcn_readfirstlane((int)threadIdx.x) & ~63;
    if (threadIdx.x == 0) *(uint4*)(dsm + G_LDS) = make_uint4(0u, 0u, 0u, 0u);
    __syncthreads();
    XcdBarrier bar = xcd_barrier_post((unsigned*)(p.ws + WS_BAR), (volatile LAS unsigned*)(dsm + G_LDS));
    char* sm = dsm;
    bf16_t* shm = (bf16_t*)dsm;
    const int bid = blockIdx.x, nb = gridDim.x;
#if PROBE_MASK
    unsigned long long* stamps = (unsigned long long*)(p.ws + WS_BAR + 14336);
    int nstamp = 0;
#define STAMP() do { if (bid == 0 && threadIdx.x == 0) stamps[nstamp] = wall_clock64(); ++nstamp; } while (0)
    STAMP();
#else
#define STAMP() do { } while (0)
#endif
    for (int _r = 0; _r < (REP_PHASE == 20 ? REP_N : 1); ++_r) {
        phase_ada(p, bid, nb);
        phase_convert_dense(p, 0, bid, nb, (float*)sm);
        phase_convert_dense(p, 1, bid, nb, (float*)sm);
        phase_convert_lora(p, bid, nb);
        xcd_barrier(bar); STAMP();
    }
    phase_ada2(p, bid, nb);
    xcd_barrier(bar); STAMP();
#define RUN(k, body) { const int _n = (REP_PHASE == (k) && l == REP_L) ? REP_N : 1; for (int _r = 0; _r < _n; ++_r) { body; xcd_barrier(bar); STAMP(); } }
    for (int l = 0; l < DEPTH; ++l) {
        RUN(0, phase_norm1(p, l, bid, nb));
        RUN(1, phase_inproj(p, l, bid, nb, shm));
        RUN(2, { if (!(REP2_SKIP & 1) || _r == 0) phase_rwprep(p, l, bid, nb, sm); if (!(REP2_SKIP & 2) || _r == 0) phase_atprep(p, l, bid, nb, sm); });
        RUN(11, phase_cprep(p, bid, nb, sm));
        RUN(3, {
            if (bid < CS_BLOCKS) { if (!(REP3_SKIP & 1) || _r == 0) phase_cscan(p, bid, sm); }
            else if ((bid & 1) == 0) {
                const int hb = (bid - CS_BLOCKS) >> 1; const int hn = (nb - CS_BLOCKS + 1) >> 1;
                if (!(REP3_SKIP & 4) || _r == 0) phase_attn(p, l, hb, hn, sm);
                if (!(REP3_SKIP & 2) || _r == 0) phase_gmlp(p, l, hb, hn, sm);
            }
            conv_pull(p, l, sm);
            });
        RUN(4, phase_rwpost(p, l, bid, nb));
        RUN(5, phase_oproj(p, l, bid, nb, shm));
        RUN(6, phase_norm2_route(p, l, bid, nb, sm, _r > 0));
        RUN(7, phase_slots(p, l, bid, nb, sm));
        RUN(8, phase_moe1(p, l, bid, nb, shm));
        RUN(9, phase_moe2(p, l, bid, nb, shm));
        RUN(10, phase_combine(p, l, bid, nb, sm, _r + 1 < _n));
    }
#if PROBE_MASK
    if (bid == 0 && threadIdx.x == 0) {
        unsigned long long ticks = 0;
        for (int i = 0; i + 1 < nstamp; ++i) if ((PROBE_MASK >> i) & 1u) ticks += stamps[i + 1] - stamps[i];
        float v = (float)ticks * 10.0f;
        if (PROBE_MASK == 0x40000000u) v = 1.0e5f;
        p.out[0] = v;
    }
#endif
}

extern "C" void kernel_launch(void* const* d_in, const int* in_sizes, int n_in, void* d_out, int out_size, void* d_ws, size_t ws_size, hipStream_t stream) {
    if (n_in != 35 || out_size != SEQ * D || ws_size < WS_END) {
        fprintf(stderr, "kernel_launch: unexpected shapes: n_in %d out %d ws %zu (need %zu)\n", n_in, out_size, ws_size, (size_t)WS_END);
        return;
    }
    static int grid = 0;
    if (!grid) {
        int dev = 0, cus = 0, per_cu = 0;
        (void)hipGetDevice(&dev);
        (void)hipDeviceGetAttribute(&cus, hipDeviceAttributeMultiprocessorCount, dev);
        (void)hipFuncSetAttribute((const void*)k_fused, hipFuncAttributeMaxDynamicSharedMemorySize, FUSED_LDS);
        (void)hipOccupancyMaxActiveBlocksPerMultiprocessor(&per_cu, (const void*)k_fused, NT, FUSED_LDS);
        if (per_cu < 1) fprintf(stderr, "kernel_launch: occupancy query says %d workgroups per CU; launching one per CU anyway\n", per_cu);
        grid = cus;
        if (grid <= CS_BLOCKS) grid = 0;
    }
    if (!grid) { fprintf(stderr, "kernel_launch: bad grid\n"); return; }
    Params p{};
    const float** f = (const float**)&p;
    for (int i = 0; i < 35; ++i) f[i] = (const float*)d_in[i];
    p.out = (float*)d_out;
    p.ws = (char*)d_ws;
    (void)hipMemsetAsync(d_ws, 0, WS_ZERO_END, stream);
    hipLaunchKernelGGL(k_fused, dim3(grid), dim3(NT), FUSED_LDS, stream, p);
}
```

```cpp
#include <hip/hip_runtime.h>
#include <stdint.h>
#include <stdio.h>

typedef unsigned short bf16_t;
typedef short bf16x8 __attribute__((ext_vector_type(8)));
typedef float f32x4 __attribute__((ext_vector_type(4)));
typedef unsigned u32x4 __attribute__((ext_vector_type(4)));
typedef unsigned u32x2 __attribute__((ext_vector_type(2)));
typedef float f32x16 __attribute__((ext_vector_type(16)));

constexpr int D = 2048, SEQ = 8192, CTXL = 256, NTOK = SEQ + CTXL, DEPTH = 2;
constexpr int RW = 512, RWP = 1920, GMW = 512, INP = 4480;
constexpr int COL_GM = 1920, COL_AT = 2944, COL_K = 3968, COL_V = 4224;
constexpr int NE = 64, NEX = 65, EFF = 512, TOPK = 8;
constexpr int SLOT_CAP = 92416;
constexpr int MAX_TILES = SLOT_CAP / 256;
constexpr int INP_PAD = 4608;
constexpr int NT = 512;

constexpr size_t al256(size_t x) { return (x + 255) & ~(size_t)255; }
constexpr size_t WS_BAR = 0;
constexpr size_t WS_CNT = 16384;
constexpr size_t WS_MOD = WS_CNT + 1024;
constexpr size_t WS_ZERO_END = al256(WS_MOD + (size_t)2 * 2 * 12288 * 4);
constexpr size_t WS_WINT = WS_ZERO_END;
constexpr size_t WS_WOT = WS_WINT + (size_t)2 * INP_PAD * D * 2;
constexpr size_t WS_W13T = WS_WOT + (size_t)2 * D * D * 2;
constexpr size_t WS_W2T = WS_W13T + (size_t)2 * NEX * 1024 * D * 2;
constexpr size_t WS_H = WS_W2T + (size_t)2 * NEX * D * EFF * 2;
constexpr size_t WS_P = WS_H + (size_t)NTOK * D * 2;
constexpr size_t WS_REC = WS_P + (size_t)NTOK * INP * 4;
constexpr size_t WS_YD = WS_REC + (size_t)2 * 8 * NTOK * 384 * 4;
constexpr size_t WS_G = WS_YD + (size_t)2 * NTOK * RW * 4;
constexpr size_t WS_BV = WS_G + (size_t)NTOK * RW * 4;
constexpr size_t WS_GMR = WS_BV + (size_t)NTOK * RW * 4;
constexpr size_t WS_YCAT = al256(WS_GMR + (size_t)NTOK * 4);
constexpr size_t WS_Q = WS_YCAT + (size_t)NTOK * D * 2;
constexpr size_t WS_K = WS_Q + (size_t)NTOK * 1024 * 4;
constexpr size_t WS_X1 = WS_K + (size_t)NTOK * 256 * 4;
constexpr size_t WS_X2C = WS_X1 + (size_t)NTOK * D * 4;
constexpr size_t WS_TOKE = WS_X2C + (size_t)CTXL * D * 4;
constexpr size_t WS_TOKP = WS_TOKE + (size_t)NTOK * 8 * 4;
constexpr size_t WS_TOKW = WS_TOKP + (size_t)NTOK * 8 * 4;
constexpr size_t WS_SLOTT = WS_TOKW + (size_t)NTOK * 8 * 4;
constexpr size_t WS_SLOTW = al256(WS_SLOTT + (size_t)SLOT_CAP * 4);
constexpr size_t WS_TILE = al256(WS_SLOTW + (size_t)SLOT_CAP * 4);
constexpr size_t WS_ACT = al256(WS_TILE + (size_t)(MAX_TILES + 64) * 4);
constexpr size_t WS_MODP = WS_ACT + (size_t)SLOT_CAP * EFF * 2;
constexpr size_t WS_TOKS = WS_MODP + (size_t)2 * 2 * 32 * 12288 * 4;
constexpr size_t WS_OUTS = WS_TOKS + (size_t)NTOK * 8 * 4;
constexpr size_t WS_WLT = WS_OUTS + (size_t)SLOT_CAP * D * 2;
constexpr size_t WS_ROPE = WS_WLT + (size_t)2 * RW * 384 * 2;
constexpr size_t WS_RT = WS_ROPE + (size_t)192 * 16 * 2 * 4;
constexpr size_t WS_FR = WS_RT + (size_t)2 * 2 * NE * D * 2;
constexpr size_t WS_END = WS_FR + (size_t)16 * (NTOK / 16) * 12800;

struct Params {
    const float *x, *c, *ctx, *c_ctx, *w_ada, *b_ada, *norm1_g, *norm2_g, *w_in, *w_o;
    const float *rw_mu, *rw_w0, *rw_w2, *rw_a0, *rw_a2, *rw_g2, *rw_kk, *rw_ka, *rw_rk, *rw_ln_g, *rw_ln_b;
    const float *gm_norm_g, *gm_ws, *gm_b, *at_qn, *at_kn, *at_sink;
    const float *moe_router, *moe_bias, *moe_wg, *moe_wu, *moe_wd, *sh_wg, *sh_wu, *sh_wd;
    float* out;
    char* ws;
};

__device__ __forceinline__ bf16_t f2bf(float f) {
    unsigned u = __float_as_uint(f);
    u += 0x7fffu + ((u >> 16) & 1u);
    return (bf16_t)(u >> 16);
}
typedef __bf16 bf16x2n __attribute__((ext_vector_type(2)));
typedef float f32x2n __attribute__((ext_vector_type(2)));
__device__ __forceinline__ unsigned pack_bf2(float lo, float hi) { const f32x2n v = {lo, hi}; const bf16x2n b2 = __builtin_convertvector(v, bf16x2n); return __builtin_bit_cast(unsigned, b2); }
__device__ __forceinline__ int olane() { int t; asm volatile("v_mbcnt_lo_u32_b32 %0, -1, 0\n\tv_mbcnt_hi_u32_b32 %0, -1, %0" : "=v"(t)); return t; }
__device__ __forceinline__ float bperm(float v, int src_lane) { return __int_as_float(__builtin_amdgcn_ds_bpermute(src_lane << 2, __float_as_int(v))); }
template <int CTRL> __device__ __forceinline__ float dppf(float v) {
    return __int_as_float(__builtin_amdgcn_update_dpp(0, __float_as_int(v), CTRL, 0xf, 0xf, true));
}
__device__ __forceinline__ float red16(float v) {
    v += dppf<0xB1>(v); v += dppf<0x4E>(v); v += dppf<0x124>(v); v += dppf<0x128>(v); return v;
}
__device__ __forceinline__ float wave_sum(float v) {
    const int lane = olane();
    v = red16(v);
    v += bperm(v, lane ^ 16); v += bperm(v, lane ^ 32);
    return v;
}
__device__ __forceinline__ float wave_max(float v) {
    const int lane = olane();
    v = fmaxf(v, dppf<0xB1>(v)); v = fmaxf(v, dppf<0x4E>(v)); v = fmaxf(v, dppf<0x124>(v)); v = fmaxf(v, dppf<0x128>(v));
    v = fmaxf(v, bperm(v, lane ^ 16)); v = fmaxf(v, bperm(v, lane ^ 32));
    return v;
}
__device__ __forceinline__ float max8(float v) {
    const int lane = olane();
    v = fmaxf(v, dppf<0xB1>(v)); v = fmaxf(v, dppf<0x4E>(v)); v = fmaxf(v, bperm(v, lane ^ 4));
    return v;
}
__device__ __forceinline__ float fexp(float x) { return __builtin_amdgcn_exp2f(x * 1.4426950408889634f); }
__device__ __forceinline__ float flog(float x) { return __builtin_amdgcn_logf(x) * 0.6931471805599453f; }
__device__ __forceinline__ float frcp(float x) { return __builtin_amdgcn_rcpf(x); }
__device__ __forceinline__ float sigmoidf_(float x) { return frcp(1.f + fexp(-x)); }
__device__ __forceinline__ float siluf_(float x) { return x * frcp(1.f + fexp(-x)); }
__device__ __forceinline__ float ftanh(float u) { const float e = fexp(-2.f * fabsf(u)); const float t = (1.f - e) * frcp(1.f + e); return u < 0.f ? -t : t; }
__device__ __forceinline__ float gelu_tanh(float x) {
    const float u = 0.7978845608028654f * (x + 0.044715f * x * x * x);
    const float hx = 0.5f * x;
    return fmaf(hx, ftanh(u), hx);
}
__device__ __forceinline__ float softplusf_(float x) { return fmaxf(x, 0.f) + flog(1.f + fexp(-fabsf(x))); }

struct RowSrc { const float* a; const float* b; };
__device__ __forceinline__ const float* rowp(const RowSrc& r, int row) { return row < SEQ ? r.a + (size_t)row * D : r.b + (size_t)(row - SEQ) * D; }
struct RowDst { float* a; float* b; };
__device__ __forceinline__ float* rowp(const RowDst& r, int row) { return row < SEQ ? r.a + (size_t)row * D : r.b + (size_t)(row - SEQ) * D; }

__device__ __forceinline__ RowSrc layer_in(const Params& p, int l) {
    RowSrc r; if (l == 0) { r.a = p.x; r.b = p.ctx; } else { float* x1 = (float*)(p.ws + WS_X1); r.a = x1; r.b = x1 + (size_t)SEQ * D; } return r;
}
__device__ __forceinline__ RowDst layer_out(const Params& p, int l) {
    RowDst r; if (l == 0) { float* x1 = (float*)(p.ws + WS_X1); r.a = x1; r.b = x1 + (size_t)SEQ * D; } else { r.a = p.out; r.b = (float*)(p.ws + WS_X2C); } return r;
}
__device__ __forceinline__ const float* modp(const Params& p, int l, int row, int which) {
    return (const float*)(p.ws + WS_MOD) + ((size_t)(l * 2 + (row < SEQ ? 0 : 1)) * 6 + which) * D;
}
__device__ __forceinline__ int ntok_of(int l) { return l == DEPTH - 1 ? SEQ : NTOK; }
struct KP : Params { int wb; };
__device__ __forceinline__ int otid(int wb) {
    int t; asm volatile("v_mbcnt_lo_u32_b32 %0, -1, 0\n\tv_mbcnt_hi_u32_b32 %0, -1, %0" : "=v"(t));
    return t | wb;
}

__device__ void phase_ada(const KP& p, int bid, int nb) {
    float* part = (float*)(p.ws + WS_MODP);
    const int tid = otid(p.wb);
    for (int u = bid; u < 2 * 6 * 32; u += nb) {
        const int l = u / (6 * 32), r = u % (6 * 32), cg = r / 32, kc = r % 32;
        const int n = cg * 2048 + tid * 4;
        const float* w = p.w_ada + (size_t)l * D * 12288 + (size_t)(kc * 64) * 12288 + n;
        f32x4 a0 = {0, 0, 0, 0}, a1 = {0, 0, 0, 0};
#pragma unroll 8
        for (int k = 0; k < 64; ++k) {
            const f32x4 wv = *(const f32x4*)(w + (size_t)k * 12288);
            const float c0 = siluf_(p.c[kc * 64 + k]), c1 = siluf_(p.c_ctx[kc * 64 + k]);
            a0 += wv * c0; a1 += wv * c1;
        }
        *(f32x4*)(part + ((size_t)((l * 2 + 0) * 32 + kc)) * 12288 + n) = a0;
        *(f32x4*)(part + ((size_t)((l * 2 + 1) * 32 + kc)) * 12288 + n) = a1;
    }
}
__device__ void phase_ada2(const KP& p, int bid, int nb) {
    const float* part = (const float*)(p.ws + WS_MODP);
    float* mod = (float*)(p.ws + WS_MOD);
    for (int i = bid * NT + otid(p.wb); i < 2 * 2 * 12288; i += nb * NT) {
        const int ls = i / 12288, n = i % 12288, l = ls >> 1;
        float acc = p.b_ada[(size_t)l * 12288 + n];
        for (int kc = 0; kc < 32; ++kc) acc += part[((size_t)(ls * 32 + kc)) * 12288 + n];
        mod[i] = acc;
    }
}

struct TJob { const float* src; bf16_t* dst; int K, N, batch; size_t sstride, dstride; int mode; };
__device__ __forceinline__ void tconv_pair(const TJob& j, int t0, float* tiles  , int tid) {
    const int half = tid >> 8, ht = tid & 255;
    float* tile = tiles + half * (64 * 65);
    const int tk = j.K / 64, tn = j.N / 64, ntl = j.batch * tk * tn;
    const int t = t0 + half;
    const bool on = t < ntl;
    const int b = t / (tk * tn), r = t % (tk * tn), kt = r / tn, nt = r % tn;
    __syncthreads();
    if (on) {
        const float* src = j.src + (size_t)b * j.sstride + (size_t)(kt * 64) * j.N + nt * 64;
#pragma unroll
        for (int i = 0; i < 4; ++i) {
            const int k = i * 16 + (ht >> 4), n = (ht & 15) * 4;
            const f32x4 v = *(const f32x4*)(src + (size_t)k * j.N + n);
            tile[k * 65 + n + 0] = v[0]; tile[k * 65 + n + 1] = v[1]; tile[k * 65 + n + 2] = v[2]; tile[k * 65 + n + 3] = v[3];
        }
    }
    __syncthreads();
    if (on) {
        const int n = ht >> 2, kq = (ht & 3) * 16;
        int ng = nt * 64 + n;
        if (j.mode == 1) ng = 32 * (ng >> 4) + (ng & 15);
        else if (j.mode == 2) ng = 32 * (ng >> 4) + 16 + (ng & 15);
        bf16_t* dst = j.dst + (size_t)b * j.dstride + (size_t)ng * j.K + kt * 64 + kq;
        u32x4 w0, w1;
#pragma unroll
        for (int i = 0; i < 4; ++i) { w0[i] = pack_bf2(tile[(kq + 2 * i) * 65 + n], tile[(kq + 2 * i + 1) * 65 + n]); w1[i] = pack_bf2(tile[(kq + 8 + 2 * i) * 65 + n], tile[(kq + 8 + 2 * i + 1) * 65 + n]); }
        *(u32x4*)(dst) = w0;
        *(u32x4*)(dst + 8) = w1;
    }
}
__device__ void phase_tconv(const TJob& j, int bid, int nb, float* tiles  , int wb) {
    const int tid = otid(wb);
    const int ntl = j.batch * (j.K / 64) * (j.N / 64);
    for (int t0 = bid * 2; t0 < ntl; t0 += nb * 2) tconv_pair(j, t0, tiles, tid);
}
__device__ void phase_convert_dense(const KP& p, int l, int bid, int nb, float* tile) {
    TJob j;
    j = {p.w_in + (size_t)l * D * INP, (bf16_t*)(p.ws + WS_WINT) + (size_t)l * INP_PAD * D, D, INP, 1, 0, 0, 0}; phase_tconv(j, bid, nb, tile, p.wb);
    j = {p.w_o + (size_t)l * D * D, (bf16_t*)(p.ws + WS_WOT) + (size_t)l * D * D, D, D, 1, 0, 0, 0}; phase_tconv(j, bid, nb, tile, p.wb);
}
constexpr int CQ_ITEM = 16;
constexpr int CQ_T_BIG = NE * (D / 64) * (EFF / 64);
constexpr int CQ_T_SH = (D / 64) * (EFF / 64);
constexpr int CQ_IPL = (3 * CQ_T_BIG + 3 * CQ_T_SH) / CQ_ITEM;
constexpr int CT_LD = 68;
__device__ __forceinline__ void conv_item(const KP& p, int l, int item, float* tiles  , int tid) {
    int t = item * CQ_ITEM;
    bf16_t* w13 = (bf16_t*)(p.ws + WS_W13T) + (size_t)l * NEX * 1024 * D;
    bf16_t* w2 = (bf16_t*)(p.ws + WS_W2T) + (size_t)l * NEX * D * EFF;
    TJob j;
    if (t < CQ_T_BIG) j = {p.moe_wg + (size_t)l * NE * D * EFF, w13, D, EFF, NE, (size_t)D * EFF, (size_t)1024 * D, 1};
    else if (t < 2 * CQ_T_BIG) { t -= CQ_T_BIG; j = {p.moe_wu + (size_t)l * NE * D * EFF, w13, D, EFF, NE, (size_t)D * EFF, (size_t)1024 * D, 2}; }
    else if (t < 3 * CQ_T_BIG) { t -= 2 * CQ_T_BIG; j = {p.moe_wd + (size_t)l * NE * EFF * D, w2, EFF, D, NE, (size_t)EFF * D, (size_t)D * EFF, 0}; }
    else if (t < 3 * CQ_T_BIG + CQ_T_SH) { t -= 3 * CQ_T_BIG; j = {p.sh_wg + (size_t)l * D * EFF, w13 + (size_t)NE * 1024 * D, D, EFF, 1, 0, 0, 1}; }
    else if (t < 3 * CQ_T_BIG + 2 * CQ_T_SH) { t -= 3 * CQ_T_BIG + CQ_T_SH; j = {p.sh_wu + (size_t)l * D * EFF, w13 + (size_t)NE * 1024 * D, D, EFF, 1, 0, 0, 2}; }
    else { t -= 3 * CQ_T_BIG + 2 * CQ_T_SH; j = {p.sh_wd + (size_t)l * EFF * D, w2 + (size_t)NE * D * EFF, EFF, D, 1, 0, 0, 0}; }
    const int half = tid >> 8, ht = tid & 255;
    float* tile = tiles + half * (64 * CT_LD);
    const int tk = j.K / 64, tn = j.N / 64;
    const int lk = ht >> 4, ln = (ht & 15) * 4;
    const int sn = ht >> 2, skq = (ht & 3) * 16;
    f32x4 v[4];
#define CT_SRC(tt) (j.src + (size_t)((tt) / (tk * tn)) * j.sstride + (size_t)((((tt) % (tk * tn)) / tn) * 64) * j.N + (((tt) % (tk * tn)) % tn) * 64)
    { const float* src = CT_SRC(t + half);
#pragma unroll
      for (int i = 0; i < 4; ++i) v[i] = __builtin_nontemporal_load((const f32x4*)(src + (size_t)(lk + 16 * i) * j.N + ln)); }
#pragma unroll 1
    for (int st = 0; st < CQ_ITEM; st += 2) {
        const int tt = t + st + half;
        __syncthreads();
#pragma unroll
        for (int i = 0; i < 4; ++i) *(f32x4*)(tile + (lk + 16 * i) * CT_LD + ln) = v[i];
        __syncthreads();
        if (st + 2 < CQ_ITEM) {
            const float* src = CT_SRC(tt + 2);
#pragma unroll
            for (int i = 0; i < 4; ++i) v[i] = __builtin_nontemporal_load((const f32x4*)(src + (size_t)(lk + 16 * i) * j.N + ln));
        }
        const int b = tt / (tk * tn), r = tt % (tk * tn), kt = r / tn, nt = r % tn;
        int ng = nt * 64 + sn;
        if (j.mode == 1) ng = 32 * (ng >> 4) + (ng & 15);
        else if (j.mode == 2) ng = 32 * (ng >> 4) + 16 + (ng & 15);
        bf16_t* dst = j.dst + (size_t)b * j.dstride + (size_t)ng * j.K + kt * 64 + skq;
        u32x4 w0, w1;
#pragma unroll
        for (int i = 0; i < 4; ++i) { w0[i] = pack_bf2(tile[(skq + 2 * i) * CT_LD + sn], tile[(skq + 2 * i + 1) * CT_LD + sn]); w1[i] = pack_bf2(tile[(skq + 8 + 2 * i) * CT_LD + sn], tile[(skq + 8 + 2 * i + 1) * CT_LD + sn]); }
        __builtin_nontemporal_store(w0, (u32x4*)(dst));
        __builtin_nontemporal_store(w1, (u32x4*)(dst + 8));
    }
#undef CT_SRC
}
__device__ void conv_pull(const KP& p, int l, char* smem) {
    int* qhead = (int*)(p.ws + WS_CNT) + 200 + l;
    float* tiles = (float*)smem;
    int* sh = (int*)(smem + 2 * 64 * CT_LD * 4);
    const int tid = otid(p.wb);
    __syncthreads();
    if (tid == 0) sh[0] = __hip_atomic_fetch_add(qhead, 1, __ATOMIC_RELAXED, __HIP_MEMORY_SCOPE_AGENT);
    __syncthreads();
    int item = sh[0];
    while (item < CQ_IPL) {
        int nxt = 0;
        if (tid == 0) nxt = __hip_atomic_fetch_add(qhead, 1, __ATOMIC_RELAXED, __HIP_MEMORY_SCOPE_AGENT);
        conv_item(p, l, item, tiles, tid);
        __syncthreads();
        if (tid == 0) sh[0] = nxt;
        __syncthreads();
        item = sh[0];
    }
}

__device__ void phase_convert_lora(const KP& p, int bid, int nb) {
    bf16_t* WLT = (bf16_t*)(p.ws + WS_WLT);
    const int tid = otid(p.wb);
    for (int i = bid * NT + tid; i < 2 * D * NE; i += nb * NT) {
        const int l = i / (D * NE), r = i % (D * NE), k = r / NE, e = r % NE;
        const float x = p.moe_router[i];
        const bf16_t hi = f2bf(x); const bf16_t lo = f2bf(x - __uint_as_float((unsigned)hi << 16));
        bf16_t* rt = (bf16_t*)(p.ws + WS_RT) + (size_t)l * 2 * NE * D;
        const size_t fo = ((size_t)((k >> 5) * 4 + (e >> 4)) * 64 + ((k >> 3) & 3) * 16 + (e & 15)) * 8 + (k & 7);
        rt[fo] = hi; rt[(size_t)NE * D + fo] = lo;
    }
    for (int i = bid * NT + tid; i < 192 * 16; i += nb * NT) {
        const int pos = i >> 4, f = i & 15;
        const float ang = (float)(pos < 128 ? pos : pos - 128) * powf(10000.f, -(float)f / 16.f);
        float* rt = (float*)(p.ws + WS_ROPE) + (size_t)i * 2;
        rt[0] = cosf(ang); rt[1] = sinf(ang);
    }
    for (int i = bid * NT + tid; i < 2 * RW * 384; i += nb * NT) {
        const int l = i / (RW * 384), r = i % (RW * 384), k = r / RW, c = r % RW;
        float v;
        if (k < 128) v = p.rw_w2[((size_t)l * 2 * 64 + k) * RW + c];
        else if (k < 256) v = p.rw_a2[((size_t)l * 2 * 64 + (k - 128)) * RW + c];
        else v = p.rw_g2[((size_t)l * 128 + (k - 256)) * RW + c];
        WLT[((size_t)l * RW + c) * 384 + k] = f2bf(v);
    }
}

__device__ void phase_norm1(const KP& p, int l, int bid, int nb) {
    const RowSrc in = layer_in(p, l);
    bf16_t* H = (bf16_t*)(p.ws + WS_H);
    const float* g = p.norm1_g + (size_t)l * D;
    const int tid = otid(p.wb), wid = tid >> 6, lane = tid & 63;
    for (int row = bid * 8 + wid; row < NTOK; row += nb * 8) {
        const float* xr = rowp(in, row);
        const float* sh = modp(p, l, row, 0);
        const float* sc = modp(p, l, row, 1);
        f32x4 v[8]; float ss = 0.f;
#pragma unroll
        for (int i = 0; i < 8; ++i) { v[i] = *(const f32x4*)(xr + i * 256 + lane * 4); ss += v[i][0] * v[i][0] + v[i][1] * v[i][1] + v[i][2] * v[i][2] + v[i][3] * v[i][3]; }
        ss = wave_sum(ss);
        const float rstd = rsqrtf(ss * (1.f / D) + 1e-6f);
#pragma unroll
        for (int i = 0; i < 8; ++i) {
            const int c = i * 256 + lane * 4;
            const f32x4 gv = *(const f32x4*)(g + c), shv = *(const f32x4*)(sh + c), scv = *(const f32x4*)(sc + c);
            float o[4];
#pragma unroll
            for (int j = 0; j < 4; ++j) { const float t = v[i][j] * rstd * gv[j]; o[j] = fmaf(t, scv[j], t) + shv[j]; }
            u32x2 w; w[0] = pack_bf2(o[0], o[1]); w[1] = pack_bf2(o[2], o[3]);
            *(u32x2*)(H + (size_t)row * D + c) = w;
        }
    }
}

constexpr int G_HT = 128 * 64;
constexpr int G_LDS = 8 * G_HT * 2;
__device__ __forceinline__ int g_lds_byte(int r, int c) {
    const int st = (r >> 4) * 2 + (c >> 5), rr = r & 15, cc = c & 31, ob = rr * 64 + cc * 2;
    return st * 1024 + (ob ^ (((ob >> 9) & 1) << 5));
}
__device__ __forceinline__ void g_stage_rc(int b, int& R, int& C) {
    const int st = b / 1024, sb = b % 1024, swz = sb ^ (((sb >> 9) & 1) << 5);
    R = (st >> 1) * 16 + swz / 64; C = (st & 1) * 32 + (swz % 64) / 2;
}
struct GOff { unsigned ao[2][2], bo; };
#define SA(b, h) (shm + ((b) * 2 + (h)) * G_HT)
#define SB(b, h) (shm + (4 + (b) * 2 + (h)) * G_HT)
#define STG_A(P, h, kt) do { _Pragma("unroll") for (int _i = 0; _i < 2; ++_i) \
    __builtin_amdgcn_global_load_lds((const unsigned*)((const char*)(A + (kt) * 64) + o.ao[h][_i]), (unsigned*)((char*)(P) + tz * 16 + _i * 8192), 16, 0, 0); } while (0)
#define STG_B(P, h, kt) do { _Pragma("unroll") for (int _i = 0; _i < 2; ++_i) \
    __builtin_amdgcn_global_load_lds((const unsigned*)((const char*)(Bt + ((h) * (PERM ? 32 : 128) + _i * (PERM ? 128 : 64)) * K + (kt) * 64) + o.bo), (unsigned*)((char*)(P) + tz * 16 + _i * 8192), 16, 0, 0); } while (0)
template <bool PERM, class ARow>
__device__ __forceinline__ void gemm_offsets(ARow arow, const int K, const int wb, GOff& o) {
    const int tz = otid(wb);
    int r, c; g_stage_rc(tz * 16, r, c);
    const int rb = PERM ? (64 * (r >> 5) + 8 * ((r & 15) >> 2) + 4 * ((r >> 4) & 1) + (r & 3)) : r;
    o.bo = (unsigned)((rb * K + c) * 2);
#pragma unroll
    for (int h = 0; h < 2; ++h)
#pragma unroll
        for (int i = 0; i < 2; ++i) o.ao[h][i] = (unsigned)((arow(h * 128 + i * 64 + r) + c) * 2);
}
template <bool PERM>
__device__ __forceinline__ void gemm_issue(const bf16_t* __restrict__ A, const bf16_t* __restrict__ Bt, const int K, const GOff& o, bf16_t* shm, const int wb) {
    const int tz = otid(wb);
    STG_B(SB(0, 0), 0, 0); STG_A(SA(0, 0), 0, 0);
    STG_B(SB(0, 1), 1, 0); STG_A(SA(0, 1), 1, 0);
    STG_B(SB(1, 0), 0, 1); STG_A(SA(1, 0), 0, 1); STG_B(SB(1, 1), 1, 1); STG_A(SA(1, 1), 1, 1);
}
template <bool PERM>
__device__ __forceinline__ void gemm_main(const bf16_t* __restrict__ A, const bf16_t* __restrict__ Bt, const int K, const GOff& o, f32x4 (&acc)[2][2][4][2], bf16_t* shm, const int wb, const int nst) {
#define LDA(dst, b, h) _Pragma("unroll") for (int m = 0; m < 4; ++m) _Pragma("unroll") for (int k = 0; k < 2; ++k) \
    dst[m][k] = *reinterpret_cast<const bf16x8*>((const char*)SA(b, h) + g_lds_byte(wr * 64 + m * 16 + fr, k * 32 + fq * 8))
#define LDB(dst, b, h) _Pragma("unroll") for (int n = 0; n < 2; ++n) _Pragma("unroll") for (int k = 0; k < 2; ++k) \
    dst[n][k] = *reinterpret_cast<const bf16x8*>((const char*)SB(b, h) + g_lds_byte(wc * 32 + n * 16 + fr, k * 32 + fq * 8))
#define MMA(ai, bj, Af, Bf) do { __builtin_amdgcn_s_setprio(1); \
    _Pragma("unroll") for (int m = 0; m < 4; ++m) _Pragma("unroll") for (int n = 0; n < 2; ++n) _Pragma("unroll") for (int k = 0; k < 2; ++k) \
        acc[ai][bj][m][n] = __builtin_amdgcn_mfma_f32_16x16x32_bf16(Bf[n][k], Af[m][k], acc[ai][bj][m][n], 0, 0, 0); \
    __builtin_amdgcn_s_setprio(0); } while (0)
#define WAIT_V(n) asm volatile("s_waitcnt vmcnt(" #n ")" ::: "memory")
#define WAIT_L(n) asm volatile("s_waitcnt lgkmcnt(" #n ")" ::: "memory")
#define BAR __builtin_amdgcn_s_barrier()
#define SCHED __builtin_amdgcn_sched_barrier(0)
    int tz = otid(wb);
    int wid = tz >> 6, lane = tz & 63, wr = wid >> 2, wc = wid & 3, fr = lane & 15, fq = lane >> 4;
#pragma unroll
    for (int a = 0; a < 2; ++a)
#pragma unroll
        for (int b = 0; b < 2; ++b)
#pragma unroll
            for (int m = 0; m < 4; ++m)
#pragma unroll
                for (int n = 0; n < 2; ++n) acc[a][b][m][n] = (f32x4){0.f, 0.f, 0.f, 0.f};
    bf16x8 At[4][2], B0[2][2], B1[2][2];
    const int nt = K / 64;
    if (nst >= 32) WAIT_V(32); else if (nst >= 16) WAIT_V(16); else WAIT_V(0);
    BAR;
    if (wr == 1) BAR;
    for (int t = 0; t < nt - 2; t += 2) {
        int tn = t; asm volatile("" : "+s"(tn));
        LDB(B0, 0, 0); SCHED; LDA(At, 0, 0); if (tn) STG_A(SA(1, 1), 1, t + 1);
        WAIT_L(8); BAR; WAIT_L(0); MMA(0, 0, At, B0); BAR; SCHED;
        LDB(B1, 0, 1); STG_B(SB(0, 0), 0, t + 2);
        BAR; WAIT_L(0); MMA(0, 1, At, B1); BAR;
        LDA(At, 0, 1); STG_A(SA(0, 0), 0, t + 2);
        BAR; WAIT_L(0); MMA(1, 0, At, B0); BAR; SCHED;
        STG_B(SB(0, 1), 1, t + 2);
        if (tn) WAIT_V(6);
        BAR; MMA(1, 1, At, B1); BAR;
        LDB(B0, 1, 0); SCHED; LDA(At, 1, 0); STG_A(SA(0, 1), 1, t + 2);
        WAIT_L(8); BAR; WAIT_L(0); MMA(0, 0, At, B0); BAR; SCHED;
        LDB(B1, 1, 1); STG_B(SB(1, 0), 0, t + 3);
        BAR; WAIT_L(0); MMA(0, 1, At, B1); BAR;
        LDA(At, 1, 1); STG_A(SA(1, 0), 0, t + 3);
        BAR; WAIT_L(0); MMA(1, 0, At, B0); BAR; SCHED;
        STG_B(SB(1, 1), 1, t + 3);
        WAIT_V(6); BAR; MMA(1, 1, At, B1); BAR;
    }
    { LDB(B0, 0, 0); WAIT_V(0); LDA(At, 0, 0); STG_A(SA(1, 1), 1, nt - 1);
      BAR; WAIT_L(0); MMA(0, 0, At, B0); BAR;
      LDB(B1, 0, 1); BAR; WAIT_L(0); MMA(0, 1, At, B1); BAR;
      LDA(At, 0, 1); WAIT_V(4); BAR; WAIT_L(0); MMA(1, 0, At, B0); MMA(1, 1, At, B1); BAR; }
    { LDB(B0, 1, 0); LDA(At, 1, 0); WAIT_V(2); BAR; WAIT_L(0); MMA(0, 0, At, B0); BAR;
      LDB(B1, 1, 1); WAIT_V(0); BAR; WAIT_L(0); MMA(0, 1, At, B1); BAR;
      LDA(At, 1, 1); BAR; WAIT_L(0); MMA(1, 0, At, B0); MMA(1, 1, At, B1); BAR; }
    if (wr == 0) BAR;
#undef LDA
#undef LDB
#undef MMA
#undef WAIT_V
#undef WAIT_L
#undef BAR
#undef SCHED
}
#undef SA
#undef SB
#undef STG_A
#undef STG_B
struct GU { const bf16_t* A; const bf16_t* Bt; int i0, i1, i2, i3; };
template <bool PERM, class Mk, class Row, class Epi>
__device__ __forceinline__ void gemm_phase(const int nwg, const int bid, const int nb, const int K, bf16_t* shm, const int wb, Mk mk, Row row, Epi epi) {
    int L = bid;
    if (L >= nwg) return;
    GU cur = mk(L);
    GOff oc;
    gemm_offsets<PERM>([&](int r) { return row(cur, r); }, K, wb, oc);
    gemm_issue<PERM>(cur.A, cur.Bt, K, oc, shm, wb);
    int nst = 0;
    for (;;) {
        f32x4 acc[2][2][4][2];
        gemm_main<PERM>(cur.A, cur.Bt, K, oc, acc, shm, wb, nst);
        const int Ln = L + nb;
        const bool more = Ln < nwg;
        GU nxt = cur; GOff on = oc;
        if (more) {
            nxt = mk(Ln);
            gemm_offsets<PERM>([&](int r) { return row(nxt, r); }, K, wb, on);
            gemm_issue<PERM>(nxt.A, nxt.Bt, K, on, shm, wb);
        }
        nst = epi(cur, acc);
        if (!more) break;
        cur = nxt; oc = on; L = Ln;
    }
}
#define G_IDX int _tz = otid(p.wb); const int _wid = _tz >> 6, _lane = _tz & 63, wr = _wid >> 2, wc = _wid & 3, fr = _lane & 15, fq = _lane >> 4
__device__ __forceinline__ int xcd_remap(int L, int nwg) {
    const int q = nwg / 8, r = nwg % 8, xcd = L % 8, off = L / 8;
    return (xcd < r ? xcd * (q + 1) : r * (q + 1) + (xcd - r) * q) + off;
}
__device__ __forceinline__ void dense_tile(int wgid, int nM, int nN, int& pm, int& pn) {
    const int nig = 8 * nN, gid = wgid / nig, fm = gid * 8, gsz = (nM - fm) < 8 ? (nM - fm) : 8;
    pm = fm + ((wgid % nig) % gsz); pn = (wgid % nig) / gsz;
}

__device__ void phase_inproj(const KP& p, int l, int bid, int nb, bf16_t* shm) {
    const bf16_t* H = (const bf16_t*)(p.ws + WS_H);
    const bf16_t* Bt = (const bf16_t*)(p.ws + WS_WINT) + (size_t)l * INP_PAD * D;
    float* P = (float*)(p.ws + WS_P);
    constexpr int nM = NTOK / 256, nN = INP_PAD / 256, nwg = nM * nN;
    gemm_phase<false>(nwg, bid, nb, D, shm, p.wb,
        [&](int L) { int pm, pn; dense_tile(xcd_remap(L, nwg), nM, nN, pm, pn); GU u; u.A = H; u.Bt = Bt + (size_t)(pn * 256) * D; u.i0 = pm * 256; u.i1 = pn * 256; u.i2 = 0; u.i3 = 0; return u; },
        [&](const GU& u, int r) { return (u.i0 + r) * D; },
        [&](const GU& u, f32x4 (&acc)[2][2][4][2]) {
            const int m0 = u.i0, n0 = u.i1;
            G_IDX;
#pragma unroll
            for (int ai = 0; ai < 2; ++ai)
#pragma unroll
                for (int m = 0; m < 4; ++m) {
                    float* prow = P + (size_t)(m0 + ai * 128 + wr * 64 + m * 16 + fr) * INP + n0 + wc * 32 + fq * 4;
#pragma unroll
                    for (int bj = 0; bj < 2; ++bj)
#pragma unroll
                        for (int n = 0; n < 2; ++n)
                            if (n0 + bj * 128 + wc * 32 + n * 16 + fq * 4 < INP) *(f32x4*)(prow + bj * 128 + n * 16) = acc[ai][bj][m][n];
                }
            return n0 + 256 <= INP ? 32 : 16;
        });
}

__device__ __forceinline__ int scan_pos(int d, int row) {
    if (row >= SEQ) { const int c = row - SEQ; return d == 0 ? c : (CTXL - 1 - c); }
    return CTXL + (d == 0 ? row : (SEQ - 1 - row));
}
__device__ __forceinline__ int scan_row(int d, int s) {
    if (s < CTXL) return SEQ + (d == 0 ? s : (CTXL - 1 - s));
    const int q = s - CTXL; return d == 0 ? q : (SEQ - 1 - q);
}
constexpr int RP_TB = 11;
constexpr int RP_LD = 392;
__device__ __forceinline__ f32x4 shifted4(const float* P, int row, int col, const float* mu) {
    const f32x4 cur = *(const f32x4*)(P + (size_t)row * INP + col);
    const bool first = (row == 0) || (row == SEQ), last = (row == SEQ - 1) || (row == NTOK - 1);
    f32x4 prev = {0.f, 0.f, 0.f, 0.f}, nxt = {0.f, 0.f, 0.f, 0.f};
    if (!first) prev = *(const f32x4*)(P + (size_t)(row - 1) * INP + col);
    if (!last) nxt = *(const f32x4*)(P + (size_t)(row + 1) * INP + col);
    const f32x4 m0 = *(const f32x4*)(mu + col), m1 = *(const f32x4*)(mu + RWP + col);
    return cur + m0 * (prev - cur) + m1 * (nxt - cur);
}
__device__ __forceinline__ float shifted(const float* P, int row, int col, float mu0, float mu1) {
    const float cur = P[(size_t)row * INP + col];
    const bool first = (row == 0) || (row == SEQ), last = (row == SEQ - 1) || (row == NTOK - 1);
    const float prev = first ? 0.f : P[(size_t)(row - 1) * INP + col];
    const float nxt = last ? 0.f : P[(size_t)(row + 1) * INP + col];
    return cur + mu0 * (prev - cur) + mu1 * (nxt - cur);
}
__device__ void phase_rwprep(const KP& p, int l, int bid, int nb, char* smem) {
    const float* P = (const float*)(p.ws + WS_P);
    float* RECW = (float*)(p.ws + WS_REC);
    bf16_t* RECD = (bf16_t*)(RECW + (size_t)16 * NTOK * 64);
    bf16_t* RECS = RECD + (size_t)16 * NTOK * 128;
    float* G = (float*)(p.ws + WS_G);
    float* BV = (float*)(p.ws + WS_BV);
    float* GMR = (float*)(p.ws + WS_GMR);
    const bf16_t* WLT = (const bf16_t*)(p.ws + WS_WLT) + (size_t)l * RW * 384;
    bf16_t* lin = (bf16_t*)smem;
    const float* mu = p.rw_mu + (size_t)l * 2 * RWP;
    const float* w0 = p.rw_w0 + (size_t)l * 2 * RW;
    const float* a0 = p.rw_a0 + (size_t)l * 2 * RW;
    const float* kkw = p.rw_kk + (size_t)l * RW;
    const float* kaw = p.rw_ka + (size_t)l * RW;
    const float* rkw = p.rw_rk + (size_t)l * RW;
    const int tid = otid(p.wb), wid = tid >> 6, lane = tid & 63, t16 = lane & 15, g = lane >> 4;
    for (int blk = bid; blk < NTOK / RP_TB; blk += nb) {
        const int t0 = blk * RP_TB;
        __syncthreads();
        for (int i = tid; i < RP_TB * 384; i += NT) {
            const int tt = i / 384, j = i % 384, col = 1536 + j;
            const float v = shifted(P, t0 + tt, col, mu[col], mu[RWP + col]);
            lin[tt * RP_LD + j] = f2bf(j < 128 ? ftanh(v) : (j < 256 ? v : sigmoidf_(v)));
        }
        __syncthreads();
        for (int q = wid; q < RP_TB; q += 8) {
            const int row = t0 + q; float ss = 0.f;
#pragma unroll
            for (int i = 0; i < 8; ++i) { const float gv = gelu_tanh(P[(size_t)row * INP + COL_GM + GMW + i * 64 + lane]); ss += gv * gv; }
            ss = wave_sum(ss);
            if (lane == 0) GMR[row] = rsqrtf(ss * (1.f / GMW) + 1e-6f);
        }
        const bool live = t16 < RP_TB;
        const int row = t0 + (live ? t16 : RP_TB - 1);
        float nrm2 = 0.f, bon = 0.f;
#pragma unroll
        for (int tl = 0; tl < 4; ++tl) {
            const int c = wid * 64 + tl * 16 + g * 4;
            const f32x4 r4 = shifted4(P, row, c, mu), k4 = shifted4(P, row, 512 + c, mu);
            const f32x4 kq = k4 * *(const f32x4*)(kkw + c), rk = *(const f32x4*)(rkw + c);
#pragma unroll
            for (int e = 0; e < 4; ++e) { nrm2 += kq[e] * kq[e]; bon += r4[e] * k4[e] * rk[e]; }
        }
        nrm2 += bperm(nrm2, lane ^ 16); nrm2 += bperm(nrm2, lane ^ 32);
        bon += bperm(bon, lane ^ 16); bon += bperm(bon, lane ^ 32);
        const float inrm = 1.f / fmaxf(sqrtf(nrm2), 1e-12f);
        const bf16_t* lrow = lin + (live ? t16 : RP_TB - 1) * RP_LD + g * 8;
#pragma unroll 1
        for (int tl = 0; tl < 4; ++tl) {
            f32x4 acc[5];
#pragma unroll
            for (int m = 0; m < 5; ++m) acc[m] = (f32x4){0.f, 0.f, 0.f, 0.f};
            const bf16_t* wrow = WLT + (size_t)(wid * 64 + tl * 16 + t16) * 384 + g * 8;
#pragma unroll
            for (int ks = 0; ks < 12; ++ks) {
                const int m = ks < 8 ? (ks >> 1) : 4;
                acc[m] = __builtin_amdgcn_mfma_f32_16x16x32_bf16(*(const bf16x8*)(wrow + ks * 32), *(const bf16x8*)(lrow + ks * 32), acc[m], 0, 0, 0);
            }
            const int c = wid * 64 + tl * 16 + g * 4, ci = tl * 16 + g * 4;
            const f32x4 r4 = shifted4(P, row, c, mu), k4 = shifted4(P, row, 512 + c, mu), v4 = shifted4(P, row, 1024 + c, mu);
            const f32x4 kq = k4 * *(const f32x4*)(kkw + c) * inrm;
            if (live) {
                *(f32x4*)(G + (size_t)row * RW + c) = acc[4];
                *(f32x4*)(BV + (size_t)row * RW + c) = v4 * bon;
            }
            const f32x4 ka = *(const f32x4*)(kaw + c);
#pragma unroll
            for (int d = 0; d < 2; ++d) {
                const f32x4 w0v = *(const f32x4*)(w0 + d * RW + c), a0v = *(const f32x4*)(a0 + d * RW + c);
                f32x4 decay, av, kd;
#pragma unroll
                for (int e = 0; e < 4; ++e) {
                    const float wlog = -softplusf_(-(w0v[e] + acc[d][e])) - 0.5f;
                    decay[e] = fexp(-fexp(wlog));
                    av[e] = sigmoidf_(a0v[e] + acc[2 + d][e]);
                    kd[e] = k4[e] * (1.f + (av[e] - 1.f) * ka[e]);
                }
                if (live) {
                    *(f32x4*)(RECW + ((size_t)(d * 8 + wid) * NTOK + row) * 64 + ci) = decay;
                    bf16_t* rd = RECD + ((size_t)(d * 8 + wid) * NTOK + row) * 128 + ci;
                    const f32x4 bq = kq * av;
                    u32x2 w1, w2; w1[0] = pack_bf2(bq[0], bq[1]); w1[1] = pack_bf2(bq[2], bq[3]); w2[0] = pack_bf2(kd[0], kd[1]); w2[1] = pack_bf2(kd[2], kd[3]);
                    *(u32x2*)(rd) = w1; *(u32x2*)(rd + 64) = w2;
                    if (d == 0) {
                        bf16_t* rs = RECS + ((size_t)wid * NTOK + row) * 192 + ci;
                        u32x2 a1, a2, a3; a1[0] = pack_bf2(kq[0], kq[1]); a1[1] = pack_bf2(kq[2], kq[3]); a2[0] = pack_bf2(r4[0], r4[1]); a2[1] = pack_bf2(r4[2], r4[3]); a3[0] = pack_bf2(v4[0], v4[1]); a3[1] = pack_bf2(v4[2], v4[3]);
                        *(u32x2*)(rs) = a1; *(u32x2*)(rs + 64) = a2; *(u32x2*)(rs + 128) = a3;
                    }
                }
            }
        }
    }
}

constexpr int SC_TS = 16;
constexpr int SCAN_BLOCKS = 128;
constexpr int SC_OPB = SC_TS * 384;
constexpr int SC_SBW = SC_TS * 64 * 4;
constexpr int SC_LDS = (2 * SC_OPB + 2 * 2 * SC_SBW) * 4;
#define SC_LD(slot, s) { const float* b_ = buf + (s) * 384 + 4 * l16; qw[slot] = *(const f32x4*)(b_); qk[slot] = *(const f32x4*)(b_ + 64); \
    qb[slot] = *(const f32x4*)(b_ + 128); qd[slot] = *(const f32x4*)(b_ + 192); qv[slot] = buf[(s) * 384 + 320 + i]; }
__device__ __forceinline__ void scan_chunk(const float* buf, float* sb, int l16, int lane, int i, f32x4& S) {
    f32x4 qw[3], qk[3], qb[3], qd[3]; float qv[3];
    SC_LD(0, 0); SC_LD(1, 1);
#pragma unroll
    for (int s = 0; s < SC_TS; ++s) {
        const int sl = s % 3;
        if (s + 2 < SC_TS) SC_LD((s + 2) % 3, s + 2);
        const f32x4 pk = S * qk[sl];
        const float sa = -red16((pk[0] + pk[1]) + (pk[2] + pk[3]));
        S = (S * qw[sl] + qd[sl] * qv[sl]) + qb[sl] * sa;
        *(f32x4*)(sb + (s * 64 + lane) * 4) = S;
    }
}
#define SC_LOAD(R, ch) { const float* _g = rec + (size_t)(ch) * SC_OPB + lt * 4; _Pragma("unroll") for (int q = 0; q < 12; ++q) R[q] = *(const f32x4*)(_g + q * 512); }
#define SC_WRITE(R, B) { float* _l = (B) + lt * 4; _Pragma("unroll") for (int q = 0; q < 12; ++q) *(f32x4*)(_l + q * 512) = R[q]; }
__device__ void phase_scan(const KP& p, int bid, char* smem) {
    const float* REC = (const float*)(p.ws + WS_REC);
    float* YD = (float*)(p.ws + WS_YD);
    float* B0 = (float*)smem;
    float* B1 = B0 + SC_OPB;
    float* SB0 = B1 + SC_OPB;
    float* SB1 = SB0 + 2 * SC_SBW;
    const int tid = otid(p.wb), wid = tid >> 6, lane = tid & 63, l16 = lane & 15;
    const int xcd = bid & 7, slot = bid >> 3, dh = xcd * 2 + (slot >> 3), rq = slot & 7;
    const int d = dh >> 3, h = dh & 7;
    const float* rec = REC + (size_t)dh * NTOK * 384;
    constexpr int NCH = NTOK / SC_TS;
    if (wid >= 6) {
        __syncthreads();
        for (int c = 0; c <= NCH; ++c) __syncthreads();
    } else if (wid >= 4) {
        const int lt = tid - 256;
        f32x4 R0[12], R1[12];
        SC_LOAD(R0, 0); SC_WRITE(R0, B0);
        SC_LOAD(R1, 1); SC_LOAD(R0, 2);
        __syncthreads();
        for (int c = 0; c < NCH; c += 2) {
            if (c + 1 < NCH) SC_WRITE(R1, B1);
            if (c + 3 < NCH) SC_LOAD(R1, c + 3);
            __syncthreads();
            if (c + 2 < NCH) SC_WRITE(R0, B0);
            if (c + 4 < NCH) SC_LOAD(R0, c + 4);
            __syncthreads();
        }
        __syncthreads();
    } else if (wid >= 2) {
        const int cw = wid - 2, dstep = d == 0 ? 1 : -1;
        float* yout = YD + (size_t)d * NTOK * RW + h * 64 + rq * 8 + cw * 4 + (lane >> 4);
        f32x4 rr[SC_TS];
#define SC_RLOAD(B) { _Pragma("unroll") for (int s = 0; s < SC_TS; ++s) rr[s] = *(const f32x4*)((B) + s * 384 + 256 + 4 * l16); }
#define SC_READOUT(SB, ch) { float yv = 0.f; \
            _Pragma("unroll") for (int s = 0; s < SC_TS; ++s) { const f32x4 sv = *(const f32x4*)((SB) + cw * SC_SBW + (s * 64 + lane) * 4); const f32x4 py = sv * rr[s]; \
                const float y = red16((py[0] + py[1]) + (py[2] + py[3])); yv = (l16 == s) ? y : yv; } \
            yout[(size_t)(scan_row(d, (ch) * SC_TS) + dstep * l16) * RW] = yv; }
        __syncthreads();
        SC_RLOAD(B0);
        __syncthreads();
        for (int c = 1; c < NCH; c += 2) {
            SC_READOUT(SB0, c - 1); SC_RLOAD(B1);
            __syncthreads();
            SC_READOUT(SB1, c);
            if (c + 1 < NCH) SC_RLOAD(B0);
            __syncthreads();
        }
    } else {
        const int i = rq * 8 + wid * 4 + (lane >> 4);
        f32x4 S = {0.f, 0.f, 0.f, 0.f};
        __syncthreads();
        for (int c = 0; c < NCH; c += 2) {
            scan_chunk(B0, SB0 + wid * SC_SBW, l16, lane, i, S);
            __syncthreads();
            scan_chunk(B1, SB1 + wid * SC_SBW, l16, lane, i, S);
            __syncthreads();
        }
        __syncthreads();
    }
}

constexpr int CK = 16, NCHK = NTOK / CK;
constexpr int FR_B = 12800;
constexpr int FR_AT = 0, FR_RT = 2048, FR_SM = 4096, FR_BT = 6144  , FR_VF = 10240, FR_GC = 12288;
template <int SH> __device__ __forceinline__ float row_shr1(float v) {
    return __int_as_float(__builtin_amdgcn_update_dpp(0x3f800000, __float_as_int(v), 0x110 + SH, 0xf, 0xf, false));
}
__device__ __forceinline__ bf16x8 frag8(const float (&v)[16], int q) {
    u32x4 w; w[0] = pack_bf2(v[4 * q], v[4 * q + 1]); w[1] = pack_bf2(v[4 * q + 2], v[4 * q + 3]); w[2] = pack_bf2(v[4 * q + 4], v[4 * q + 5]); w[3] = pack_bf2(v[4 * q + 6], v[4 * q + 7]);
    return __builtin_bit_cast(bf16x8, w);
}
__device__ __forceinline__ bf16x8 frag4(const f32x4 a) {
    u32x4 w; w[0] = pack_bf2(a[0], a[1]); w[1] = pack_bf2(a[2], a[3]); w[2] = 0u; w[3] = 0u;
    return __builtin_bit_cast(bf16x8, w);
}
__device__ __forceinline__ bf16x8 frag4u(unsigned lo, unsigned hi) { u32x4 w; w[0] = lo; w[1] = hi; w[2] = 0u; w[3] = 0u; return __builtin_bit_cast(bf16x8, w); }
#define MM(a, b, c) __builtin_amdgcn_mfma_f32_16x16x32_bf16(a, b, c, 0, 0, 0)
__device__ void phase_cprep(const KP& p, int bid, int nb, char* smem) {
    const float* RECW = (const float*)(p.ws + WS_REC);
    const bf16_t* RECD = (const bf16_t*)(RECW + (size_t)16 * NTOK * 64);
    const bf16_t* RECS = RECD + (size_t)16 * NTOK * 128;
    char* FR = p.ws + WS_FR;
    const int tid = otid(p.wb), wid = tid >> 6, lane = tid & 63, t = lane & 15, g = lane >> 4;
    bf16_t* zt = (bf16_t*)smem + wid * 2048;
    const f32x4 Z4 = {0.f, 0.f, 0.f, 0.f};
    for (int u = bid * 8 + wid; u < 16 * NCHK; u += nb * 8) {
        const int dh = u / NCHK, c = u % NCHK;
        const int d = dh >> 3, hh = dh & 7;
        const int row = scan_row(d, c * CK + t);
        const float* pw = RECW + ((size_t)dh * NTOK + row) * 64;
        const bf16_t* pd = RECD + ((size_t)dh * NTOK + row) * 128;
        const bf16_t* ps = RECS + ((size_t)hh * NTOK + row) * 192;
        float w_[16], kk[16], bb[16], kd[16], rr[16];
#pragma unroll
        for (int q = 0; q < 4; ++q) {
            const int jo = 32 * (q >> 1) + 16 * (q & 1) + 4 * g;
            const f32x4 a0 = *(const f32x4*)(pw + jo);
            const u32x2 ub = *(const u32x2*)(pd + jo), uk = *(const u32x2*)(pd + 64 + jo), ukk = *(const u32x2*)(ps + jo), ur = *(const u32x2*)(ps + 64 + jo);
#pragma unroll
            for (int e = 0; e < 4; ++e) {
                w_[4 * q + e] = a0[e];
                bb[4 * q + e] = __uint_as_float((e & 1) ? (ub[e >> 1] & 0xffff0000u) : (ub[e >> 1] << 16));
                kd[4 * q + e] = __uint_as_float((e & 1) ? (uk[e >> 1] & 0xffff0000u) : (uk[e >> 1] << 16));
                kk[4 * q + e] = __uint_as_float((e & 1) ? (ukk[e >> 1] & 0xffff0000u) : (ukk[e >> 1] << 16));
                rr[4 * q + e] = __uint_as_float((e & 1) ? (ur[e >> 1] & 0xffff0000u) : (ur[e >> 1] << 16));
            }
        }
        float gam[16], At[16], Bh[16], Kh[16], Rt[16], Bt[16], Kt[16];
#pragma unroll
        for (int k = 0; k < 16; ++k) {
            float x = w_[k];
            x *= row_shr1<1>(x); x *= row_shr1<2>(x); x *= row_shr1<4>(x); x *= row_shr1<8>(x);
            gam[k] = x;
        }
#pragma unroll
        for (int k = 0; k < 16; ++k) {
            const float gp = row_shr1<1>(gam[k]), gc = bperm(gam[k], (lane & 48) | 15), ig = frcp(gam[k]);
            At[k] = kk[k] * gp; Bh[k] = bb[k] * ig; Kh[k] = kd[k] * ig; Rt[k] = rr[k] * gam[k];
            Bt[k] = -Bh[k] * gc; Kt[k] = Kh[k] * gc;
        }
        const bf16x8 fA0 = frag8(At, 0), fA1 = frag8(At, 2), fB0 = frag8(Bh, 0), fB1 = frag8(Bh, 2), fK0 = frag8(Kh, 0), fK1 = frag8(Kh, 2), fR0 = frag8(Rt, 0), fR1 = frag8(Rt, 2);
        f32x4 X = MM(fA1, fB1, MM(fA0, fB0, Z4));
        f32x4 XT = MM(fB1, fA1, MM(fB0, fA0, Z4));
        f32x4 Lak = MM(fA1, fK1, MM(fA0, fK0, Z4));
        f32x4 LrbT = MM(fB1, fR1, MM(fB0, fR0, Z4));
        f32x4 LrkT = MM(fK1, fR1, MM(fK0, fR0, Z4));
        f32x4 T, TT;
#pragma unroll
        for (int r = 0; r < 4; ++r) {
            const int row = 4 * g + r;
            X[r] = t < row ? -X[r] : 0.f;
            XT[r] = row < t ? -XT[r] : 0.f;
            Lak[r] = t < row ? Lak[r] : 0.f;
            LrbT[r] = row <= t ? -LrbT[r] : 0.f;
            LrkT[r] = row <= t ? LrkT[r] : 0.f;
            const float id = row == t ? 1.f : 0.f;
            T[r] = id + X[r]; TT[r] = id + XT[r];
        }
#pragma unroll
        for (int it = 0; it < 3; ++it) {
            const f32x4 X2 = MM(frag4(XT), frag4(X), Z4), X2T = MM(frag4(X), frag4(XT), Z4);
            const f32x4 Tn = MM(frag4(TT), frag4(X2), T), TTn = MM(frag4(X2), frag4(TT), TT);
            X = X2; XT = X2T; T = Tn; TT = TTn;
        }
        const f32x4 TLT = MM(frag4(Lak), frag4(TT), Z4);
#pragma unroll
        for (int q = 0; q < 4; ++q)
#pragma unroll
            for (int e = 0; e < 4; ++e) {
                const int j = 32 * (q >> 1) + 16 * (q & 1) + 4 * g + e;
                zt[j * 16 + t] = f2bf(Bt[4 * q + e]); zt[1024 + j * 16 + t] = f2bf(Kt[4 * q + e]);
            }
        char* fb = FR + ((size_t)dh * NCHK + c) * FR_B;
        *(bf16x8*)(fb + FR_AT + lane * 16) = fA0; *(bf16x8*)(fb + FR_AT + 1024 + lane * 16) = fA1;
        *(bf16x8*)(fb + FR_RT + lane * 16) = fR0; *(bf16x8*)(fb + FR_RT + 1024 + lane * 16) = fR1;
        {
            u32x4 s0, s1;
            s0[0] = pack_bf2(TT[0], TT[1]); s0[1] = pack_bf2(TT[2], TT[3]); s0[2] = pack_bf2(TLT[0], TLT[1]); s0[3] = pack_bf2(TLT[2], TLT[3]);
            s1[0] = pack_bf2(LrbT[0], LrbT[1]); s1[1] = pack_bf2(LrbT[2], LrbT[3]); s1[2] = pack_bf2(LrkT[0], LrkT[1]); s1[3] = pack_bf2(LrkT[2], LrkT[3]);
            *(u32x4*)(fb + FR_SM + lane * 32) = s0; *(u32x4*)(fb + FR_SM + lane * 32 + 16) = s1;
        }
#pragma unroll
        for (int jt = 0; jt < 4; ++jt) {
            {
                const u32x2 b2 = *(const u32x2*)(zt + (16 * jt + t) * 16 + 4 * g), k2 = *(const u32x2*)(zt + 1024 + (16 * jt + t) * 16 + 4 * g);
                u32x4 bk; bk[0] = b2[0]; bk[1] = b2[1]; bk[2] = k2[0]; bk[3] = k2[1];
                *(u32x4*)(fb + FR_BT + jt * 1024 + lane * 16) = bk;
            }
            const int dstp = d == 0 ? 1 : -1;
            const bf16_t* vp = RECS + ((size_t)hh * NTOK + scan_row(d, c * CK + 4 * g)) * 192 + 128 + 16 * jt + t;
            u32x2 vw; vw[0] = (unsigned)vp[0] | ((unsigned)vp[dstp * 192] << 16); vw[1] = (unsigned)vp[2 * dstp * 192] | ((unsigned)vp[3 * dstp * 192] << 16);
            *(u32x2*)(fb + FR_VF + jt * 512 + lane * 8) = vw;
        }
        if (t == 15) {
#pragma unroll
            for (int q = 0; q < 4; ++q) { f32x4 gv = {gam[4 * q], gam[4 * q + 1], gam[4 * q + 2], gam[4 * q + 3]}; *(f32x4*)(fb + FR_GC + (32 * (q >> 1) + 16 * (q & 1) + 4 * g) * 4) = gv; }
        }
    }
}

constexpr int CS_BLOCKS = 16, CS_R = 3;
__device__ void phase_cscan(const KP& p, int bid, char* smem) {
    const char* FRs = p.ws + WS_FR + (size_t)bid * NCHK * FR_B;
    float* YD = (float*)(p.ws + WS_YD);
    const int tid = otid(p.wb), wid = tid >> 6, lane = tid & 63, c16 = lane & 15, g = lane >> 4;
    const int d = bid >> 3, h = bid & 7;
    if (wid >= 4) {
        const int lw = wid - 4;
        const bool tail = lw == 0;
        u32x4 fifo[16][3]; unsigned ftl[16];
#define CS_LD(k, ch) { const char* _s = FRs + (size_t)(ch) * FR_B + lane * 16; \
            _Pragma("unroll") for (int _q = 0; _q < 3; ++_q) fifo[k][_q] = *(const u32x4*)(_s + (lw + 4 * _q) * 1024); \
            if (tail) ftl[k] = *(const unsigned*)(FRs + (size_t)(ch) * FR_B + 12288 + lane * 4); }
#define CS_WR(k, ch) { char* _d = smem + ((ch) % CS_R) * FR_B + lane * 16; \
            _Pragma("unroll") for (int _q = 0; _q < 3; ++_q) *(u32x4*)(_d + (lw + 4 * _q) * 1024) = fifo[k][_q]; \
            if (tail) *(unsigned*)(smem + ((ch) % CS_R) * FR_B + 12288 + lane * 4) = ftl[k]; }
#define CS_BAR() { asm volatile("" ::: "memory"); __builtin_amdgcn_s_barrier(); asm volatile("" ::: "memory"); }
#define CS_PERIOD(r) { if (pch + (r) + 1 < NCHK) CS_WR(((r) + 1) & 15, pch + (r) + 1); if (pch + (r) + 17 < NCHK) CS_LD(((r) + 1) & 15, pch + (r) + 17); CS_BAR(); }
        CS_LD(0, 0); CS_LD(1, 1); CS_LD(2, 2); CS_LD(3, 3); CS_LD(4, 4); CS_LD(5, 5); CS_LD(6, 6); CS_LD(7, 7);
        CS_LD(8, 8); CS_LD(9, 9); CS_LD(10, 10); CS_LD(11, 11); CS_LD(12, 12); CS_LD(13, 13); CS_LD(14, 14); CS_LD(15, 15);
        CS_WR(0, 0); CS_LD(0, 16);
        CS_BAR();
        for (int pch = 0; pch < NCHK; pch += 16) {
            CS_PERIOD(0); CS_PERIOD(1); CS_PERIOD(2); CS_PERIOD(3); CS_PERIOD(4); CS_PERIOD(5); CS_PERIOD(6); CS_PERIOD(7);
            CS_PERIOD(8); CS_PERIOD(9); CS_PERIOD(10); CS_PERIOD(11); CS_PERIOD(12); CS_PERIOD(13); CS_PERIOD(14); CS_PERIOD(15);
        }
    } else {
        const int it = wid, dstep = d == 0 ? 1 : -1;
        float* yout = YD + (size_t)d * NTOK * RW + h * 64 + it * 16 + c16;
        const f32x4 Z4 = {0.f, 0.f, 0.f, 0.f};
        f32x4 ST[4] = {Z4, Z4, Z4, Z4};
        asm volatile("" ::: "memory"); __builtin_amdgcn_s_barrier(); asm volatile("" ::: "memory");
        for (int pch = 0; pch < NCHK; ++pch) {
            const char* sb = smem + (pch % CS_R) * FR_B;
            const bf16x8 A0 = *(const bf16x8*)(sb + FR_AT + lane * 16), A1 = *(const bf16x8*)(sb + FR_AT + 1024 + lane * 16);
            const bf16x8 R0 = *(const bf16x8*)(sb + FR_RT + lane * 16), R1 = *(const bf16x8*)(sb + FR_RT + 1024 + lane * 16);
            const bf16x8 TTL = *(const bf16x8*)(sb + FR_SM + lane * 32), LRR = *(const bf16x8*)(sb + FR_SM + lane * 32 + 16);
            const u32x2 vf = *(const u32x2*)(sb + FR_VF + it * 512 + lane * 8);
            u32x4 b0, b1;
            b0[0] = pack_bf2(ST[0][0], ST[0][1]); b0[1] = pack_bf2(ST[0][2], ST[0][3]); b0[2] = pack_bf2(ST[1][0], ST[1][1]); b0[3] = pack_bf2(ST[1][2], ST[1][3]);
            b1[0] = pack_bf2(ST[2][0], ST[2][1]); b1[1] = pack_bf2(ST[2][2], ST[2][3]); b1[2] = pack_bf2(ST[3][0], ST[3][1]); b1[3] = pack_bf2(ST[3][2], ST[3][3]);
            const bf16x8 Bs0 = __builtin_bit_cast(bf16x8, b0), Bs1 = __builtin_bit_cast(bf16x8, b1);
            const f32x4 Q = MM(A1, Bs1, MM(A0, Bs0, Z4));
            u32x4 qv; qv[0] = pack_bf2(Q[0], Q[1]); qv[1] = pack_bf2(Q[2], Q[3]); qv[2] = vf[0]; qv[3] = vf[1];
            const f32x4 P = MM(TTL, __builtin_bit_cast(bf16x8, qv), Z4);
            u32x4 pv; pv[0] = pack_bf2(P[0], P[1]); pv[1] = pack_bf2(P[2], P[3]); pv[2] = vf[0]; pv[3] = vf[1];
            const bf16x8 PV = __builtin_bit_cast(bf16x8, pv);
            const f32x4 Y = MM(LRR, PV, MM(R1, Bs1, MM(R0, Bs0, Z4)));
#pragma unroll
            for (int jt = 0; jt < 4; ++jt) {
                const f32x4 gc = *(const f32x4*)(sb + FR_GC + (16 * jt + 4 * g) * 4);
                const bf16x8 bk = *(const bf16x8*)(sb + FR_BT + jt * 1024 + lane * 16);
                ST[jt] = MM(bk, PV, ST[jt] * gc);
            }
            const int row0 = scan_row(d, pch * CK) + dstep * 4 * g;
#pragma unroll
            for (int r = 0; r < 4; ++r) yout[(size_t)(row0 + dstep * r) * RW] = Y[r];
            asm volatile("" ::: "memory"); __builtin_amdgcn_s_barrier(); asm volatile("" ::: "memory");
        }
    }
}
#undef MM

__device__ void phase_rwpost(const KP& p, int l, int bid, int nb) {
    const float* YD = (const float*)(p.ws + WS_YD);
    const float* G = (const float*)(p.ws + WS_G);
    const float* BV = (const float*)(p.ws + WS_BV);
    bf16_t* Y = (bf16_t*)(p.ws + WS_YCAT);
    const float* lng = p.rw_ln_g + (size_t)l * RW;
    const float* lnb = p.rw_ln_b + (size_t)l * RW;
    const int tid = otid(p.wb), wid = tid >> 6, lane = tid & 63;
    for (int u = bid * 8 + wid; u < NTOK * 8; u += nb * 8) {
        const int row = u >> 3, h = u & 7, c = h * 64 + lane;
        const float y = YD[(size_t)row * RW + c] + YD[((size_t)NTOK + row) * RW + c];
        const float mean = wave_sum(y) * (1.f / 64);
        const float dv = y - mean;
        const float var = wave_sum(dv * dv) * (1.f / 64);
        const float yn = dv * rsqrtf(var + 64e-5f) * lng[c] + lnb[c];
        Y[(size_t)row * D + c] = f2bf((yn + BV[(size_t)row * RW + c]) * G[(size_t)row * RW + c]);
    }
}

constexpr int GM_LD = 136;
__device__ void phase_gmlp(const KP& p, int l, int bid, int nb, char* smem) {
    const float* P = (const float*)(p.ws + WS_P);
    const float* GMR = (const float*)(p.ws + WS_GMR);
    bf16_t* Y = (bf16_t*)(p.ws + WS_YCAT);
    bf16_t* vt = (bf16_t*)smem;
    const float* ng = p.gm_norm_g + (size_t)l * GMW;
    const int tid = otid(p.wb), wid = tid >> 6, lane = tid & 63, r = lane & 31, h = lane >> 5, mt = wid >> 1, nt = wid & 1;
    for (int u = bid; u < (NTOK / 128) * 8; u += nb) {
        const int n = u >> 3, g = u & 7, t0 = n * 128;
        const float* ws = p.gm_ws + ((size_t)l * 8 + g) * 128 * 128;
        const float* bs = p.gm_b + ((size_t)l * 8 + g) * 128;
        __syncthreads();
        {
            const int c = tid & 63, qp0 = tid >> 6;
            const float gn = ng[g * 64 + c];
#pragma unroll
            for (int i = 0; i < 8; ++i) {
                const int q = (qp0 + 8 * i) * 2;
                const float v0 = gelu_tanh(P[(size_t)(t0 + q) * INP + COL_GM + GMW + g * 64 + c]) * GMR[t0 + q] * gn;
                const float v1 = gelu_tanh(P[(size_t)(t0 + q + 1) * INP + COL_GM + GMW + g * 64 + c]) * GMR[t0 + q + 1] * gn;
                *(unsigned*)(vt + c * GM_LD + q) = pack_bf2(v0, v1);
            }
        }
        __syncthreads();
        f32x16 acc;
#pragma unroll
        for (int i = 0; i < 16; ++i) acc[i] = 0.f;
        const float* arow = ws + (size_t)(mt * 32 + r) * 128 + h * 8;
#pragma unroll
        for (int ks = 0; ks < 8; ++ks) {
            const f32x4 a0 = *(const f32x4*)(arow + ks * 16), a1 = *(const f32x4*)(arow + ks * 16 + 4);
            u32x4 aw; aw[0] = pack_bf2(a0[0], a0[1]); aw[1] = pack_bf2(a0[2], a0[3]); aw[2] = pack_bf2(a1[0], a1[1]); aw[3] = pack_bf2(a1[2], a1[3]);
            const bf16x8 bfr = *(const bf16x8*)(vt + (nt * 32 + r) * GM_LD + ks * 16 + h * 8);
            acc = __builtin_amdgcn_mfma_f32_32x32x16_bf16(__builtin_bit_cast(bf16x8, aw), bfr, acc, 0, 0, 0);
        }
        const int c = nt * 32 + r;
#pragma unroll
        for (int i = 0; i < 16; ++i) {
            const int pp = mt * 32 + (i & 3) + 8 * (i >> 2) + 4 * h;
            const float uu = gelu_tanh(P[(size_t)(t0 + pp) * INP + COL_GM + g * 64 + c]);
            Y[(size_t)(t0 + pp) * D + 512 + g * 64 + c] = f2bf(uu * (acc[i] + bs[pp]));
        }
    }
}

__device__ void phase_atprep(const KP& p, int l, int bid, int nb, char* smem) {
    const float* P = (const float*)(p.ws + WS_P);
    bf16_t* Qb = (bf16_t*)(p.ws + WS_Q);
    bf16_t* Kb = (bf16_t*)(p.ws + WS_K);
    bf16_t* VT = Kb + (size_t)NTOK * 256;
    const float* qn = p.at_qn + (size_t)l * 64;
    const float* kn = p.at_kn + (size_t)l * 64;
    const int tid = otid(p.wb);
    const float* rope = (const float*)(p.ws + WS_ROPE);
    for (int i = bid * NT + tid; i < NTOK * 20; i += nb * NT) {
        const int row = i / 20, hv = i % 20;
        const bool isq = hv < 16;
        const float* src = P + (size_t)row * INP + (isq ? COL_AT + hv * 64 : COL_K + (hv - 16) * 64);
        const float* gn = isq ? qn : kn;
        f32x4 x[16]; float ss = 0.f;
#pragma unroll
        for (int k = 0; k < 16; ++k) { x[k] = *(const f32x4*)(src + 4 * k); ss += x[k][0] * x[k][0] + x[k][1] * x[k][1] + x[k][2] * x[k][2] + x[k][3] * x[k][3]; }
        const float sc = rsqrtf(ss * (1.f / 64) + 1e-6f) * (isq ? 0.125f : 1.f);
#pragma unroll
        for (int k = 0; k < 16; ++k) x[k] = x[k] * *(const f32x4*)(gn + 4 * k) * sc;
        if (row < SEQ) {
#pragma unroll
            for (int sec = 0; sec < 2; ++sec) {
                const float* rt = rope + (size_t)((sec == 0 ? (row >> 6) : (128 + (row & 63))) * 16) * 2;
#pragma unroll
                for (int k = 0; k < 4; ++k) {
                    const f32x4 c0 = *(const f32x4*)(rt + 8 * k), c1 = *(const f32x4*)(rt + 8 * k + 4);
                    f32x4& a = x[8 * sec + k]; f32x4& b2 = x[8 * sec + 4 + k];
                    const float cs[4] = {c0[0], c0[2], c1[0], c1[2]}, sn[4] = {c0[1], c0[3], c1[1], c1[3]};
#pragma unroll
                    for (int e = 0; e < 4; ++e) { const float x1 = a[e], x2 = b2[e]; a[e] = x1 * cs[e] - x2 * sn[e]; b2[e] = x2 * cs[e] + x1 * sn[e]; }
                }
            }
        }
        bf16_t* dst = isq ? (Qb + (size_t)row * 1024 + hv * 64) : (Kb + (size_t)row * 256 + (hv - 16) * 64);
#pragma unroll
        for (int k = 0; k < 8; ++k) {
            u32x4 w; w[0] = pack_bf2(x[2 * k][0], x[2 * k][1]); w[1] = pack_bf2(x[2 * k][2], x[2 * k][3]); w[2] = pack_bf2(x[2 * k + 1][0], x[2 * k + 1][1]); w[3] = pack_bf2(x[2 * k + 1][2], x[2 * k + 1][3]);
            *(u32x4*)(dst + 8 * k) = w;
        }
    }
    float* tile = (float*)smem;
    for (int u = bid; u < (NTOK / 64) * 4; u += nb) {
        const int t0 = (u >> 2) * 64, kvh = u & 3;
        __syncthreads();
        {
            const int tok = tid >> 3, d8 = (tid & 7) * 8;
            const float* src = P + (size_t)(t0 + tok) * INP + COL_V + kvh * 64 + d8;
            const f32x4 a = *(const f32x4*)src, b2 = *(const f32x4*)(src + 4);
#pragma unroll
            for (int i = 0; i < 4; ++i) { tile[tok * 65 + d8 + i] = a[i]; tile[tok * 65 + d8 + 4 + i] = b2[i]; }
        }
        __syncthreads();
        {
            const int d = tid >> 3, tk = (tid & 7) * 8;
            u32x4 w;
#pragma unroll
            for (int i = 0; i < 4; ++i) w[i] = pack_bf2(tile[(tk + 2 * i) * 65 + d], tile[(tk + 2 * i + 1) * 65 + d]);
            *(u32x4*)(VT + (size_t)(kvh * 64 + d) * NTOK + t0 + tk) = w;
        }
    }
}

constexpr int AT_LD = 72;
constexpr int AT_TILE = 64 * AT_LD;
__device__ void phase_attn(const KP& p, int l, int bid, int nb, char* smem) {
    const bf16_t* Qb = (const bf16_t*)(p.ws + WS_Q);
    const bf16_t* Kb = (const bf16_t*)(p.ws + WS_K);
    const bf16_t* VT = Kb + (size_t)NTOK * 256;
    bf16_t* Y = (bf16_t*)(p.ws + WS_YCAT);
    bf16_t* Kc = (bf16_t*)smem;
    bf16_t* Vc = Kc + AT_TILE;
    const int tid = otid(p.wb), wid = tid >> 6, lane = tid & 63, q = lane & 31, h = lane >> 5, g = wid >> 1, qh = wid & 1;
    const int srow = tid >> 3, sseg = tid & 7;
    const int voff = srow * AT_LD + (sseg >> 2) * 32 + ((sseg >> 1) & 1) * 16 + (sseg & 1) * 4;
    for (int u = bid; u < (NTOK / 64) * 4; u += nb) {
        const int qt = u >> 2, kvh = u & 3, t0 = qt * 64, head = kvh * 4 + g, qrow = t0 + qh * 32 + q;
        int c_lo = 0, n_local = 0;
        if (t0 < SEQ) { c_lo = 2 - (t0 >> 6); if (c_lo < 0) c_lo = 0; int c_hi = (SEQ + 64 - t0) >> 6; if (c_hi > 4) c_hi = 4; n_local = c_hi - c_lo + 1; }
        const int nch = n_local + 4;
        bf16x8 qf[4];
#pragma unroll
        for (int ks = 0; ks < 4; ++ks) qf[ks] = *(const bf16x8*)(Qb + (size_t)qrow * 1024 + head * 64 + ks * 16 + h * 8);
        f32x16 O0, O1;
#pragma unroll
        for (int r = 0; r < 16; ++r) { O0[r] = 0.f; O1[r] = 0.f; }
        float m = p.at_sink[(size_t)l * 16 + head], lsum = h == 0 ? 1.f : 0.f;
        u32x4 rk, rv;
        {
            const int k0 = n_local > 0 ? (t0 - 128 + 64 * c_lo) : SEQ;
            rk = *(const u32x4*)(Kb + (size_t)(k0 + srow) * 256 + kvh * 64 + sseg * 8);
            rv = *(const u32x4*)(VT + (size_t)(kvh * 64 + srow) * NTOK + k0 + sseg * 8);
        }
        for (int ci = 0; ci < nch; ++ci) {
            const bool local = ci < n_local;
            const int k0 = local ? (t0 - 128 + 64 * (c_lo + ci)) : (SEQ + 64 * (ci - n_local));
            __syncthreads();
            *(u32x4*)(Kc + srow * AT_LD + sseg * 8) = rk;
            { u32x2 lo, hi; lo[0] = rv[0]; lo[1] = rv[1]; hi[0] = rv[2]; hi[1] = rv[3]; *(u32x2*)(Vc + voff) = lo; *(u32x2*)(Vc + voff + 8) = hi; }
            __syncthreads();
            if (ci + 1 < nch) {
                const int kn = (ci + 1 < n_local) ? (t0 - 128 + 64 * (c_lo + ci + 1)) : (SEQ + 64 * (ci + 1 - n_local));
                rk = *(const u32x4*)(Kb + (size_t)(kn + srow) * 256 + kvh * 64 + sseg * 8);
                rv = *(const u32x4*)(VT + (size_t)(kvh * 64 + srow) * NTOK + kn + sseg * 8);
            }
            f32x16 s0, s1;
#pragma unroll
            for (int r = 0; r < 16; ++r) { s0[r] = 0.f; s1[r] = 0.f; }
#pragma unroll
            for (int ks = 0; ks < 4; ++ks) {
                const bf16x8 k0f = *(const bf16x8*)(Kc + q * AT_LD + ks * 16 + h * 8);
                const bf16x8 k1f = *(const bf16x8*)(Kc + (32 + q) * AT_LD + ks * 16 + h * 8);
                s0 = __builtin_amdgcn_mfma_f32_32x32x16_bf16(k0f, qf[ks], s0, 0, 0, 0);
                s1 = __builtin_amdgcn_mfma_f32_32x32x16_bf16(k1f, qf[ks], s1, 0, 0, 0);
            }
            if (local) {
                const int base = k0 + 4 * h - qrow;
#pragma unroll
                for (int r = 0; r < 16; ++r) {
                    const int d0 = base + (r & 3) + 8 * (r >> 2), d1 = d0 + 32;
                    if (d0 > 128 || d0 < -128) s0[r] = -INFINITY;
                    if (d1 > 128 || d1 < -128) s1[r] = -INFINITY;
                }
            }
            float mx = fmaxf(s0[0], s1[0]);
#pragma unroll
            for (int r = 1; r < 16; ++r) mx = fmaxf(mx, fmaxf(s0[r], s1[r]));
            mx = fmaxf(mx, bperm(mx, lane ^ 32));
            const float mnew = fmaxf(m, mx);
            const float alpha = __expf(m - mnew);
            m = mnew; lsum *= alpha;
#pragma unroll
            for (int r = 0; r < 16; ++r) { O0[r] *= alpha; O1[r] *= alpha; }
            float ps = 0.f;
#pragma unroll
            for (int r = 0; r < 16; ++r) { s0[r] = __expf(s0[r] - m); s1[r] = __expf(s1[r] - m); ps += s0[r] + s1[r]; }
            lsum += ps;
            bf16x8 pf[2][2];
#pragma unroll
            for (int s = 0; s < 2; ++s) {
                u32x4 w0, w1;
#pragma unroll
                for (int i = 0; i < 4; ++i) { w0[i] = pack_bf2(s0[8 * s + 2 * i], s0[8 * s + 2 * i + 1]); w1[i] = pack_bf2(s1[8 * s + 2 * i], s1[8 * s + 2 * i + 1]); }
                pf[0][s] = __builtin_bit_cast(bf16x8, w0); pf[1][s] = __builtin_bit_cast(bf16x8, w1);
            }
#pragma unroll
            for (int kb = 0; kb < 2; ++kb)
#pragma unroll
                for (int s = 0; s < 2; ++s) {
                    const bf16x8 v0f = *(const bf16x8*)(Vc + q * AT_LD + kb * 32 + s * 16 + h * 8);
                    const bf16x8 v1f = *(const bf16x8*)(Vc + (32 + q) * AT_LD + kb * 32 + s * 16 + h * 8);
                    O0 = __builtin_amdgcn_mfma_f32_32x32x16_bf16(v0f, pf[kb][s], O0, 0, 0, 0);
                    O1 = __builtin_amdgcn_mfma_f32_32x32x16_bf16(v1f, pf[kb][s], O1, 0, 0, 0);
                }
        }
        lsum += bperm(lsum, lane ^ 32);
        const float inv = 1.f / lsum;
        bf16_t* yo = Y + (size_t)qrow * D + 1024 + head * 64 + 4 * h;
#pragma unroll
        for (int rg = 0; rg < 4; ++rg) {
            u32x2 w0, w1;
            w0[0] = pack_bf2(O0[4 * rg] * inv, O0[4 * rg + 1] * inv); w0[1] = pack_bf2(O0[4 * rg + 2] * inv, O0[4 * rg + 3] * inv);
            w1[0] = pack_bf2(O1[4 * rg] * inv, O1[4 * rg + 1] * inv); w1[1] = pack_bf2(O1[4 * rg + 2] * inv, O1[4 * rg + 3] * inv);
            *(u32x2*)(yo + 8 * rg) = w0;
            *(u32x2*)(yo + 32 + 8 * rg) = w1;
        }
    }
}

__device__ void phase_oproj(const KP& p, int l, int bid, int nb, bf16_t* shm) {
    const bf16_t* Y = (const bf16_t*)(p.ws + WS_YCAT);
    const bf16_t* Bt = (const bf16_t*)(p.ws + WS_WOT) + (size_t)l * D * D;
    const RowSrc in = layer_in(p, l);
    const RowDst out = layer_out(p, l);
    const int nM = ntok_of(l) / 256, nN = D / 256, nwg = nM * nN;
    gemm_phase<false>(nwg, bid, nb, D, shm, p.wb,
        [&](int L) { int pm, pn; dense_tile(xcd_remap(L, nwg), nM, nN, pm, pn); GU u; u.A = Y; u.Bt = Bt + (size_t)(pn * 256) * D; u.i0 = pm * 256; u.i1 = pn * 256; u.i2 = 0; u.i3 = 0; return u; },
        [&](const GU& u, int r) { return (u.i0 + r) * D; },
        [&](const GU& u, f32x4 (&acc)[2][2][4][2]) {
            const int m0 = u.i0, n0 = u.i1;
            G_IDX;
#pragma unroll
            for (int ai = 0; ai < 2; ++ai)
#pragma unroll
                for (int m = 0; m < 4; ++m) {
                    const int row = m0 + ai * 128 + wr * 64 + m * 16 + fr;
                    const float* xi = rowp(in, row);
                    float* xo = rowp(out, row);
                    const float* g1 = modp(p, l, row, 2);
#pragma unroll
                    for (int bj = 0; bj < 2; ++bj)
#pragma unroll
                        for (int n = 0; n < 2; ++n) {
                            const int col = n0 + bj * 128 + wc * 32 + n * 16 + fq * 4;
                            *(f32x4*)(xo + col) = *(const f32x4*)(xi + col) + *(const f32x4*)(g1 + col) * acc[ai][bj][m][n];
                        }
                }
            return 32;
        });
}

constexpr int RT_R = 11;
constexpr int RT_LD = D + 8;
__device__ void phase_norm2_route(const KP& p, int l, int bid, int nb, char* smem, const bool dummy = false) {
    const RowDst xs = layer_out(p, l);
    bf16_t* H = (bf16_t*)(p.ws + WS_H);
    int* cnt = (int*)(p.ws + WS_CNT) + l * 64 + (dummy ? 128 : 0);
    int* tokE = (int*)(p.ws + WS_TOKE);
    int* tokP = (int*)(p.ws + WS_TOKP);
    float* tokW = (float*)(p.ws + WS_TOKW);
    const float* g = p.norm2_g + (size_t)l * D;
    const bf16_t* RTH = (const bf16_t*)(p.ws + WS_RT) + (size_t)l * 2 * NE * D;
    const bf16_t* RTL = RTH + (size_t)NE * D;
    const float* rbias = p.moe_bias + (size_t)l * NE;
    bf16_t* hh = (bf16_t*)smem;
    bf16_t* hl = hh + RT_R * RT_LD;
    float* part = (float*)(hl + RT_R * RT_LD);
    int* lcnt = (int*)(part + 8 * 64 * 16);
    int* lbase = lcnt + 64;
    int* lsel = lbase + 64;
    const int tid = otid(p.wb), wid = tid >> 6, lane = tid & 63, c16 = lane & 15, g4 = lane >> 4;
    const int ntok = ntok_of(l), nsteps = (ntok + RT_R - 1) / RT_R;
    __syncthreads();
    if (tid < 64) lcnt[tid] = 0;
    for (int i = tid; i < 4 * RT_R * 8; i += NT) lsel[i] = -1;
    int step = 0;
    for (int blk = bid; blk < nsteps; blk += nb, ++step) {
        const int t0 = blk * RT_R;
        __syncthreads();
        {
            int rrq[2], rowq[2]; bool liveq[2]; const float* xrq[2]; const float* shq[2]; const float* scq[2];
            f32x4 v[2][8]; float ss[2];
#pragma unroll
            for (int q = 0; q < 2; ++q) {
                rrq[q] = wid + 8 * q; liveq[q] = rrq[q] < RT_R && t0 + rrq[q] < ntok;
                rowq[q] = liveq[q] ? t0 + rrq[q] : ntok - 1;
                xrq[q] = rowp(xs, rowq[q]); shq[q] = modp(p, l, rowq[q], 3); scq[q] = modp(p, l, rowq[q], 4); ss[q] = 0.f;
            }
#pragma unroll
            for (int i = 0; i < 8; ++i)
#pragma unroll
                for (int q = 0; q < 2; ++q) { v[q][i] = *(const f32x4*)(xrq[q] + i * 256 + lane * 4); ss[q] += v[q][i][0] * v[q][i][0] + v[q][i][1] * v[q][i][1] + v[q][i][2] * v[q][i][2] + v[q][i][3] * v[q][i][3]; }
            float rstd[2];
#pragma unroll
            for (int q = 0; q < 2; ++q) rstd[q] = rsqrtf(wave_sum(ss[q]) * (1.f / D) + 1e-6f);
#pragma unroll
            for (int i = 0; i < 8; ++i) {
                const int c = i * 256 + lane * 4;
                const f32x4 gv = *(const f32x4*)(g + c);
#pragma unroll
                for (int q = 0; q < 2; ++q) {
                    const f32x4 shv = *(const f32x4*)(shq[q] + c), scv = *(const f32x4*)(scq[q] + c);
                    float o[4]; unsigned hi[4]; float lo[4];
#pragma unroll
                    for (int j = 0; j < 4; ++j) { const float t = v[q][i][j] * rstd[q] * gv[j]; o[j] = fmaf(t, scv[j], t) + shv[j]; hi[j] = f2bf(o[j]); lo[j] = o[j] - __uint_as_float(hi[j] << 16); }
                    u32x2 wh, wl; wh[0] = hi[0] | (hi[1] << 16); wh[1] = hi[2] | (hi[3] << 16); wl[0] = pack_bf2(lo[0], lo[1]); wl[1] = pack_bf2(lo[2], lo[3]);
                    if (rrq[q] < RT_R) { *(u32x2*)(hh + rrq[q] * RT_LD + c) = wh; *(u32x2*)(hl + rrq[q] * RT_LD + c) = wl; }
                    if (liveq[q]) *(u32x2*)(H + (size_t)rowq[q] * D + c) = wh;
                }
            }
        }
        __syncthreads();
        {
            f32x4 acc[4];
#pragma unroll
            for (int et = 0; et < 4; ++et) acc[et] = (f32x4){0.f, 0.f, 0.f, 0.f};
            const int hr = c16 < RT_R ? c16 : RT_R - 1;
            const bf16_t* bh = hh + hr * RT_LD + wid * 256 + g4 * 8;
            const bf16_t* bl = hl + hr * RT_LD + wid * 256 + g4 * 8;
            const bf16_t* ah = RTH + (size_t)(wid * 8) * 2048 + lane * 8;
            const bf16_t* al = RTL + (size_t)(wid * 8) * 2048 + lane * 8;
#pragma unroll 2
            for (int ks = 0; ks < 8; ++ks) {
                const bf16x8 bhf = *(const bf16x8*)(bh + ks * 32), blf = *(const bf16x8*)(bl + ks * 32);
#pragma unroll
                for (int et = 0; et < 4; ++et) {
                    const bf16x8 ahf = *(const bf16x8*)(ah + (ks * 4 + et) * 512), alf = *(const bf16x8*)(al + (ks * 4 + et) * 512);
                    acc[et] = __builtin_amdgcn_mfma_f32_16x16x32_bf16(ahf, bhf, acc[et], 0, 0, 0);
                    acc[et] = __builtin_amdgcn_mfma_f32_16x16x32_bf16(ahf, blf, acc[et], 0, 0, 0);
                    acc[et] = __builtin_amdgcn_mfma_f32_16x16x32_bf16(alf, bhf, acc[et], 0, 0, 0);
                }
            }
#pragma unroll
            for (int et = 0; et < 4; ++et)
#pragma unroll
                for (int r = 0; r < 4; ++r) part[(wid * 64 + et * 16 + g4 * 4 + r) * 16 + c16] = acc[et][r];
        }
        __syncthreads();
        {
            bool liveq[2]; int rowq[2]; float score[2], biased[2], val[2]; int sel[2];
#pragma unroll
            for (int q = 0; q < 2; ++q) {
                const int rr = wid + 8 * q;
                liveq[q] = rr < RT_R && t0 + rr < ntok; rowq[q] = t0 + rr;
                const int rc = rr < RT_R ? rr : RT_R - 1;
                float logit = 0.f;
#pragma unroll
                for (int kq = 0; kq < 8; ++kq) logit += part[(kq * 64 + lane) * 16 + rc];
                score[q] = sigmoidf_(logit); biased[q] = score[q] + rbias[lane]; sel[q] = -1;
            }
            const int gbase = lane & ~7, mygrp = lane >> 3;
#pragma unroll
            for (int q = 0; q < 2; ++q) {
                const float m1 = max8(biased[q]);
                const unsigned long long eq = __ballot(biased[q] == m1);
                const unsigned geq = (unsigned)((eq >> gbase) & 0xffull);
                const int first = gbase + (__ffs(geq) - 1);
                const float m2 = max8((lane == first) ? -INFINITY : biased[q]);
                const float gs = m1 + m2;
                int rank = 0;
#pragma unroll
                for (int k = 0; k < 8; ++k) { const float o = bperm(gs, k * 8); rank += (o > gs || (o == gs && k < mygrp)) ? 1 : 0; }
                val[q] = rank < 4 ? biased[q] : -INFINITY;
            }
#pragma unroll
            for (int j = 0; j < TOPK; ++j)
#pragma unroll
                for (int q = 0; q < 2; ++q) {
                    const float mx = wave_max(val[q]);
                    const unsigned long long bm = __ballot(val[q] == mx);
                    const int win = __ffsll((long long)bm) - 1;
                    if (lane == win) { sel[q] = j; val[q] = -INFINITY; }
                }
#pragma unroll
            for (int q = 0; q < 2; ++q) {
                const float ssum = wave_sum(sel[q] >= 0 ? score[q] : 0.f);
                if (liveq[q] && sel[q] >= 0) {
                    const int lr = atomicAdd(lcnt + lane, 1);
                    lsel[((step * RT_R) + (wid + 8 * q)) * 8 + sel[q]] = (lane << 16) | lr;
                    if (!dummy) { tokE[(size_t)rowq[q] * 8 + sel[q]] = lane; tokW[(size_t)rowq[q] * 8 + sel[q]] = score[q] * frcp(ssum) * 2.5f; }
                }
            }
        }
    }
    __syncthreads();
    if (tid < 64) lbase[tid] = atomicAdd(cnt + tid, lcnt[tid]);
    __syncthreads();
    if (!dummy)
        for (int i = tid; i < step * RT_R * 8; i += NT) {
            const int v = lsel[i];
            if (v < 0) continue;
            const int st = i / (RT_R * 8), rr = (i / 8) % RT_R, j = i & 7;
            const int row = (bid + st * nb) * RT_R + rr;
            tokP[(size_t)row * 8 + j] = lbase[v >> 16] + (v & 0xffff);
        }
}

__device__ void phase_slots(const KP& p, int l, int bid, int nb, char* smem) {
    const int* cnt = (const int*)(p.ws + WS_CNT) + l * 64;
    const int* tokE = (const int*)(p.ws + WS_TOKE);
    const int* tokP = (const int*)(p.ws + WS_TOKP);
    int* slotT = (int*)(p.ws + WS_SLOTT);
    int* tile = (int*)(p.ws + WS_TILE);
    int* tokS = (int*)(p.ws + WS_TOKS);
    int* off = (int*)smem;
    const int tid = otid(p.wb);
    const int ntok = ntok_of(l);
    __syncthreads();
    if (tid == 0) {
        int o = 0;
        for (int e = 0; e < NE; ++e) { off[e] = o; o += (cnt[e] + 255) / 256 * 256; }
        off[NE] = o; off[NE + 1] = o + ntok;
    }
    __syncthreads();
    int nbo = nb; asm volatile("" : "+s"(nbo));
    const int gt = bid * NT + tid, gs = nbo * NT;
    for (int i = gt; i < ntok * 8; i += gs) { const int e = tokE[i]; const int s = off[e] + tokP[i]; slotT[s] = i >> 3; tokS[i] = s; }
    for (int i = gt; i < ntok; i += gs) slotT[off[NE] + i] = i;
    for (int i = gt; i < NE * 256; i += gs) { const int e = i >> 8, j = i & 255; const int s = off[e] + cnt[e] + j; if (s < off[e + 1]) slotT[s] = -1; }
    if (bid == 0) {
        const int nt = off[NE + 1] / 256;
        if (tid == 0) tile[0] = nt;
        for (int i = tid; i < nt; i += NT) {
            const int s = i * 256; int e = 0;
            for (int k = 1; k <= NE; ++k) if (s >= off[k]) e = k;
            int nv = 256;
            if (e < NE) { const int left = off[e] + cnt[e] - s; nv = left < 256 ? left : 256; }
            tile[1 + i] = e | (nv << 8);
        }
    }
}

__device__ void phase_moe1(const KP& p, int l, int bid, int nb, bf16_t* shm) {
    const bf16_t* H = (const bf16_t*)(p.ws + WS_H);
    const bf16_t* W13 = (const bf16_t*)(p.ws + WS_W13T) + (size_t)l * NEX * 1024 * D;
    const int* slotT = (const int*)(p.ws + WS_SLOTT);
    const int* tile = (const int*)(p.ws + WS_TILE);
    bf16_t* ACT = (bf16_t*)(p.ws + WS_ACT);
    const int nt = tile[0], nwg = nt * 4;
    gemm_phase<false>(nwg, bid, nb, D, shm, p.wb,
        [&](int L) { const int wg = xcd_remap(L, nwg), ti = wg >> 2, ct = wg & 3, e = tile[1 + ti] & 255; GU u; u.A = H; u.Bt = W13 + ((size_t)e * 1024 + ct * 256) * D; u.i0 = ti * 256; u.i1 = ct * 256; u.i2 = 0; u.i3 = 0; return u; },
        [&](const GU& u, int r) { const int t = slotT[u.i0 + r]; return (t < 0 ? 0 : t) * D; },
        [&](const GU& u, f32x4 (&acc)[2][2][4][2]) {
            const int s0 = u.i0, n0 = u.i1;
            G_IDX;
#pragma unroll
            for (int ai = 0; ai < 2; ++ai)
#pragma unroll
                for (int m = 0; m < 4; ++m) {
                    const int slot = s0 + ai * 128 + wr * 64 + m * 16 + fr;
#pragma unroll
                    for (int bj = 0; bj < 2; ++bj) {
                        const int ch = (n0 + bj * 128 + wc * 32) / 2 + fq * 4;
                        float a[4];
#pragma unroll
                        for (int r = 0; r < 4; ++r) a[r] = siluf_(acc[ai][bj][m][0][r]) * acc[ai][bj][m][1][r];
                        u32x2 w; w[0] = pack_bf2(a[0], a[1]); w[1] = pack_bf2(a[2], a[3]);
                        *(u32x2*)(ACT + (size_t)slot * EFF + ch) = w;
                    }
                }
            return 16;
        });
}

__device__ void phase_moe2(const KP& p, int l, int bid, int nb, bf16_t* shm) {
    const bf16_t* ACT = (const bf16_t*)(p.ws + WS_ACT);
    const bf16_t* W2 = (const bf16_t*)(p.ws + WS_W2T) + (size_t)l * NEX * D * EFF;
    const int* tile = (const int*)(p.ws + WS_TILE);
    bf16_t* OUTS = (bf16_t*)(p.ws + WS_OUTS);
    const int nt = tile[0], nwg = nt * 8;
    for (int k = (bid >> 3) & 3; k > 0; --k) __builtin_amdgcn_s_sleep(127);
    gemm_phase<true>(nwg, bid, nb, EFF, shm, p.wb,
        [&](int L) { const int wg = xcd_remap(L, nwg), ti = wg >> 3, ct = wg & 7, te = tile[1 + ti], e = te & 255; GU u; u.A = ACT; u.Bt = W2 + ((size_t)e * D + ct * 256) * EFF; u.i0 = ti * 256; u.i1 = ct * 256; u.i2 = te >> 8; u.i3 = 0; return u; },
        [&](const GU& u, int r) { return (u.i0 + r) * EFF; },
        [&](const GU& u, f32x4 (&acc)[2][2][4][2]) {
            const int s0 = u.i0, n0 = u.i1, nvalid = u.i2;
            G_IDX;
            const bool odd = fr & 1;
#pragma unroll
            for (int ai = 0; ai < 2; ++ai)
#pragma unroll
                for (int m = 0; m < 4; ++m) {
                    const int rp = ai * 128 + wr * 64 + m * 16 + (fr & ~1);
                    u32x4 c0, c1, dA, dB;
                    c0[0] = pack_bf2(acc[ai][0][m][0][0], acc[ai][0][m][0][1]); c0[1] = pack_bf2(acc[ai][0][m][0][2], acc[ai][0][m][0][3]);
                    c0[2] = pack_bf2(acc[ai][0][m][1][0], acc[ai][0][m][1][1]); c0[3] = pack_bf2(acc[ai][0][m][1][2], acc[ai][0][m][1][3]);
                    c1[0] = pack_bf2(acc[ai][1][m][0][0], acc[ai][1][m][0][1]); c1[1] = pack_bf2(acc[ai][1][m][0][2], acc[ai][1][m][0][3]);
                    c1[2] = pack_bf2(acc[ai][1][m][1][0], acc[ai][1][m][1][1]); c1[3] = pack_bf2(acc[ai][1][m][1][2], acc[ai][1][m][1][3]);
#pragma unroll
                    for (int q = 0; q < 4; ++q) {
                        const unsigned snd = odd ? c0[q] : c1[q];
                        const unsigned rcv = (unsigned)__builtin_amdgcn_update_dpp(0, (int)snd, 0xB1, 0xf, 0xf, true);
                        dA[q] = odd ? rcv : c0[q]; dB[q] = odd ? c1[q] : rcv;
                    }
                    bf16_t* o = OUTS + (size_t)(s0 + rp) * D + n0 + wc * 64 + fq * 8 + (odd ? 32 : 0);
                    if (rp < nvalid) *(u32x4*)o = dA;
                    if (rp + 1 < nvalid) *(u32x4*)(o + D) = dB;
                }
            return nvalid == 256 ? 16 : 0;
        });
}

__device__ void phase_combine(const KP& p, int l, int bid, int nb, char* smem, const bool dummy = false) {
    const bf16_t* OUTS = (const bf16_t*)(p.ws + WS_OUTS);
    const int* tokS = (const int*)(p.ws + WS_TOKS);
    const float* tokW = (const float*)(p.ws + WS_TOKW);
    const int* cnt = (const int*)(p.ws + WS_CNT) + l * 64;
    const RowDst out = layer_out(p, l);
    int* sh0 = (int*)smem;
    const int tid = otid(p.wb), half = tid >> 8, ht = tid & 255;
    __syncthreads();
    if (tid == 0) { int o = 0; for (int e = 0; e < NE; ++e) o += (cnt[e] + 255) / 256 * 256; sh0[0] = o; }
    __syncthreads();
    const int shared0 = sh0[0];
    const int ntok = ntok_of(l);
    for (int row = bid * 2 + half; row < ntok; row += nb * 2) {
        float* xr = rowp(out, row);
        const float* g2 = modp(p, l, row, 5);
        const int c = ht * 8;
        float acc[8];
        {
            const u32x4 v = *(const u32x4*)(OUTS + (size_t)(shared0 + row) * D + c);
#pragma unroll
            for (int q = 0; q < 4; ++q) { acc[2 * q] = __uint_as_float(v[q] << 16); acc[2 * q + 1] = __uint_as_float(v[q] & 0xffff0000u); }
        }
#pragma unroll
        for (int j = 0; j < TOPK; ++j) {
            const int s = tokS[(size_t)row * 8 + j]; const float w = tokW[(size_t)row * 8 + j];
            const u32x4 v = *(const u32x4*)(OUTS + (size_t)s * D + c);
#pragma unroll
            for (int q = 0; q < 4; ++q) { acc[2 * q] += w * __uint_as_float(v[q] << 16); acc[2 * q + 1] += w * __uint_as_float(v[q] & 0xffff0000u); }
        }
        const f32x4 g0 = *(const f32x4*)(g2 + c), g1 = *(const f32x4*)(g2 + c + 4);
        f32x4 x0 = *(const f32x4*)(xr + c), x1 = *(const f32x4*)(xr + c + 4);
#pragma unroll
        for (int q = 0; q < 4; ++q) { x0[q] += g0[q] * acc[q]; x1[q] += g1[q] * acc[4 + q]; }
        if (!dummy || x0[0] == 1234.5f) { *(f32x4*)(xr + c) = x0; *(f32x4*)(xr + c + 4) = x1; }
    }
}

#define XB_TMO      128
#define XB_XCNT(j)  (256  + 64 * (j))
#define XB_XSUB(j)  (1280 + 64 * (j))
#define XB_XGEN(j)  (2304 + 64 * (j))
#define XB_TOP      3328
#define XB_TOPGEN   3392
#define XCD_BAR_WORDS 3456
#define XB_SPIN_CAP (1u << 18)
#define LAS __attribute__((address_space(3)))

__device__ __forceinline__ unsigned xb_ld(unsigned* p)              { return __hip_atomic_load(p, __ATOMIC_RELAXED, __HIP_MEMORY_SCOPE_AGENT); }
__device__ __forceinline__ unsigned xb_add(unsigned* p, unsigned v) { return __hip_atomic_fetch_add(p, v, __ATOMIC_RELAXED, __HIP_MEMORY_SCOPE_AGENT); }
__device__ __forceinline__ unsigned xb_xcc_id() { return (unsigned)__builtin_amdgcn_s_getreg((3 << 11) | 20) & 0xFu; }
#define XB_SPIN(cond, bar) do { unsigned _sp = 0; while (cond) { __builtin_amdgcn_s_sleep(1); \
    if ((++_sp & 255u) == 0u) { if (xb_ld(&(bar)[XB_TMO])) break; if (_sp > XB_SPIN_CAP) { atomicAdd(&(bar)[XB_TMO], 1u); break; } } } } while (0)

struct XcdBarrier {
    unsigned* bar; unsigned x;
    volatile LAS unsigned* st;
};
__device__ __forceinline__ XcdBarrier xcd_barrier_post(unsigned* bar, volatile LAS unsigned* st) {
    XcdBarrier b; b.bar = bar; b.x = (unsigned)__builtin_amdgcn_readfirstlane((int)xb_xcc_id()); b.st = st;
    if (threadIdx.x == 0) (void)xb_add(&bar[XB_XCNT(b.x)], 1u);
    return b;
}
__device__ __forceinline__ void xcd_barrier_complete(unsigned* bar, unsigned x, unsigned& nloc, unsigned& nx) {
    const unsigned G = gridDim.x * gridDim.y * gridDim.z;
    unsigned sum, cnt, mine, sp = 0u;
    for (;;) {
        sum = 0u; cnt = 0u; mine = 0u;
#pragma unroll
        for (unsigned j = 0; j < 16; ++j) { const unsigned c = xb_ld(&bar[XB_XCNT(j)]); sum += c; cnt += (c > 0u) ? 1u : 0u; mine = (j == x) ? c : mine; }
        if (sum == G) break;
        __builtin_amdgcn_s_sleep(1);
        if ((++sp & 255u) == 0u) { if (xb_ld(&bar[XB_TMO])) break; if (sp > XB_SPIN_CAP) { atomicAdd(&bar[XB_TMO], 1u); break; } }
    }
    nloc = mine > 0u ? mine : 1u; nx = cnt > 0u ? cnt : 1u;
}
__device__ __forceinline__ void xcd_barrier(const XcdBarrier& b) {
    asm volatile("s_waitcnt vmcnt(0)" ::: "memory");
    __syncthreads();
    unsigned bx = b.x; asm volatile("" : "+s"(bx));
    if (threadIdx.x == 0) {
        unsigned* bar = b.bar;
        __builtin_amdgcn_s_waitcnt(0);
        unsigned nloc = b.st[0], nx = b.st[1];
        if (nloc == 0u) { xcd_barrier_complete(bar, bx, nloc, nx); b.st[0] = nloc; b.st[1] = nx; }
        const unsigned old = xb_add(&bar[XB_XSUB(bx)], 1u);
        const unsigned gen = old / nloc;
        if (old + 1u == (gen + 1u) * nloc) {
            __builtin_amdgcn_fence(__ATOMIC_RELEASE, "agent");
            asm volatile("s_waitcnt vmcnt(0)" ::: "memory");
            const unsigned og = xb_add(&bar[XB_TOP], 1u);
            const unsigned tg = og / nx;
            if (og + 1u == (tg + 1u) * nx) xb_add(&bar[XB_TOPGEN], 1u);
            else XB_SPIN(xb_ld(&bar[XB_TOPGEN]) == tg, bar);
            __builtin_amdgcn_fence(__ATOMIC_ACQUIRE, "agent");
            xb_add(&bar[XB_XGEN(bx)], 1u);
            asm volatile("s_waitcnt vmcnt(0)" ::: "memory");
        } else {
            XB_SPIN(xb_ld(&bar[XB_XGEN(bx)]) == gen, bar);
            __builtin_amdgcn_fence(__ATOMIC_ACQUIRE, "agent");
            asm volatile("s_waitcnt vmcnt(0)" ::: "memory");
        }
    }
    __syncthreads();
}

#ifndef PROBE_MASK
#define PROBE_MASK 0u
#endif
#ifndef REP2_SKIP
#define REP2_SKIP 0
#endif
#ifndef REP2_SKIP
#define REP2_SKIP 0
#endif
#ifndef REP2_SKIP
#define REP2_SKIP 0
#endif
#ifndef REP2_SKIP
#define REP2_SKIP 0
#endif
#ifndef REP2_SKIP
#define REP2_SKIP 0
#endif
#ifndef REP2_SKIP
#define REP2_SKIP 0
#endif
#ifndef REP3_SKIP
#define REP3_SKIP 0
#endif
#ifndef REP_PHASE
#define REP_PHASE (-1)
#define REP_L 1
#define REP_N 1
#endif
constexpr int FUSED_LDS = G_LDS + 16;
__global__ void __launch_bounds__(512, 2) k_fused(Params p0) {
    extern __shared__ __attribute__((aligned(16))) char dsm[];
    KP p; (Params&)p = p0; p.wb = __builtin_amdgcn_readfirstlane((int)threadIdx.x) & ~63;
    if (threadIdx.x == 0) *(uint4*)(dsm + G_LDS) = make_uint4(0u, 0u, 0u, 0u);
    __syncthreads();
    XcdBarrier bar = xcd_barrier_post((unsigned*)(p.ws + WS_BAR), (volatile LAS unsigned*)(dsm + G_LDS));
    char* sm = dsm;
    bf16_t* shm = (bf16_t*)dsm;
    const int bid = blockIdx.x, nb = gridDim.x;
#if PROBE_MASK
    unsigned long long* stamps = (unsigned long long*)(p.ws + WS_BAR + 14336);
    int nstamp = 0;
#define STAMP() do { if (bid == 0 && threadIdx.x == 0) stamps[nstamp] = wall_clock64(); ++nstamp; } while (0)
    STAMP();
#else
#define STAMP() do { } while (0)
#endif
    for (int _r = 0; _r < (REP_PHASE == 20 ? REP_N : 1); ++_r) {
        phase_ada(p, bid, nb);
        phase_convert_dense(p, 0, bid, nb, (float*)sm);
        phase_convert_dense(p, 1, bid, nb, (float*)sm);
        phase_convert_lora(p, bid, nb);
        xcd_barrier(bar); STAMP();
    }
    phase_ada2(p, bid, nb);
    xcd_barrier(bar); STAMP();
#define RUN(k, body) { const int _n = (REP_PHASE == (k) && l == REP_L) ? REP_N : 1; for (int _r = 0; _r < _n; ++_r) { body; xcd_barrier(bar); STAMP(); } }
    for (int l = 0; l < DEPTH; ++l) {
        RUN(0, phase_norm1(p, l, bid, nb));
        RUN(1, phase_inproj(p, l, bid, nb, shm));
        RUN(2, { if (!(REP2_SKIP & 1) || _r == 0) phase_rwprep(p, l, bid, nb, sm); if (!(REP2_SKIP & 2) || _r == 0) phase_atprep(p, l, bid, nb, sm); });
        RUN(11, phase_cprep(p, bid, nb, sm));
        RUN(3, {
            if (bid < CS_BLOCKS) { if (!(REP3_SKIP & 1) || _r == 0) phase_cscan(p, bid, sm); }
            else if ((bid & 1) == 0) {
                const int hb = (bid - CS_BLOCKS) >> 1; const int hn = (nb - CS_BLOCKS + 1) >> 1;
                if (!(REP3_SKIP & 4) || _r == 0) phase_attn(p, l, hb, hn, sm);
                if (!(REP3_SKIP & 2) || _r == 0) phase_gmlp(p, l, hb, hn, sm);
            }
            conv_pull(p, l, sm);
            });
        RUN(4, phase_rwpost(p, l, bid, nb));
        RUN(5, phase_oproj(p, l, bid, nb, shm));
        RUN(6, phase_norm2_route(p, l, bid, nb, sm, _r > 0));
        RUN(7, phase_slots(p, l, bid, nb, sm));
        RUN(8, phase_moe1(p, l, bid, nb, shm));
        RUN(9, phase_moe2(p, l, bid, nb, shm));
        RUN(10, phase_combine(p, l, bid, nb, sm, _r + 1 < _n));
    }
#if PROBE_MASK
    if (bid == 0 && threadIdx.x == 0) {
        unsigned long long ticks = 0;
        for (int i = 0; i + 1 < nstamp; ++i) if ((PROBE_MASK >> i) & 1u) ticks += stamps[i + 1] - stamps[i];
        float v = (float)ticks * 10.0f;
        if (PROBE_MASK == 0x40000000u) v = 1.0e5f;
        p.out[0] = v;
    }
#endif
}

extern "C" void kernel_launch(void* const* d_in, const int* in_sizes, int n_in, void* d_out, int out_size, void* d_ws, size_t ws_size, hipStream_t stream) {
    if (n_in != 35 || out_size != SEQ * D || ws_size < WS_END) {
        fprintf(stderr, "kernel_launch: unexpected shapes: n_in %d out %d ws %zu (need %zu)\n", n_in, out_size, ws_size, (size_t)WS_END);
        return;
    }
    static int grid = 0;
    if (!grid) {
        int dev = 0, cus = 0, per_cu = 0;
        (void)hipGetDevice(&dev);
        (void)hipDeviceGetAttribute(&cus, hipDeviceAttributeMultiprocessorCount, dev);
        (void)hipFuncSetAttribute((const void*)k_fused, hipFuncAttributeMaxDynamicSharedMemorySize, FUSED_LDS);
        (void)hipOccupancyMaxActiveBlocksPerMultiprocessor(&per_cu, (const void*)k_fused, NT, FUSED_LDS);
        if (per_cu < 1) fprintf(stderr, "kernel_launch: occupancy query says %d workgroups per CU; launching one per CU anyway\n", per_cu);
        grid = cus;
        if (grid <= CS_BLOCKS) grid = 0;
    }
    if (!grid) { fprintf(stderr, "kernel_launch: bad grid\n"); return; }
    Params p{};
    const float** f = (const float**)&p;
    for (int i = 0; i < 35; ++i) f[i] = (const float*)d_in[i];
    p.out = (float*)d_out;
    p.ws = (char*)d_ws;
    (void)hipMemsetAsync(d_ws, 0, WS_ZERO_END, stream);
    hipLaunchKernelGGL(k_fused, dim3(grid), dim3(NT), FUSED_LDS, stream, p);
}
```

```cpp
#include <hip/hip_runtime.h>
#include <stdint.h>
#include <stdio.h>

typedef unsigned short bf16_t;
typedef short bf16x8 __attribute__((ext_vector_type(8)));
typedef float f32x4 __attribute__((ext_vector_type(4)));
typedef unsigned u32x4 __attribute__((ext_vector_type(4)));
typedef unsigned u32x2 __attribute__((ext_vector_type(2)));
typedef float f32x16 __attribute__((ext_vector_type(16)));

constexpr int D = 2048, SEQ = 8192, CTXL = 256, NTOK = SEQ + CTXL, DEPTH = 2;
constexpr int RW = 512, RWP = 1920, GMW = 512, INP = 4480;
constexpr int COL_GM = 1920, COL_AT = 2944, COL_K = 3968, COL_V = 4224;
constexpr int NE = 64, NEX = 65, EFF = 512, TOPK = 8;
constexpr int SLOT_CAP = 92416;
constexpr int MAX_TILES = SLOT_CAP / 256;
constexpr int INP_PAD = 4608;
constexpr int NT = 512;

constexpr size_t al256(size_t x) { return (x + 255) & ~(size_t)255; }
constexpr size_t WS_BAR = 0;
constexpr size_t WS_CNT = 16384;
constexpr size_t WS_MOD = WS_CNT + 1024;
constexpr size_t WS_ZERO_END = al256(WS_MOD + (size_t)2 * 2 * 12288 * 4);
constexpr size_t WS_WINT = WS_ZERO_END;
constexpr size_t WS_WOT = WS_WINT + (size_t)2 * INP_PAD * D * 2;
constexpr size_t WS_W13T = WS_WOT + (size_t)2 * D * D * 2;
constexpr size_t WS_W2T = WS_W13T + (size_t)2 * NEX * 1024 * D * 2;
constexpr size_t WS_H = WS_W2T + (size_t)2 * NEX * D * EFF * 2;
constexpr size_t WS_P = WS_H + (size_t)NTOK * D * 2;
constexpr size_t WS_REC = WS_P + (size_t)NTOK * INP * 4;
constexpr size_t WS_YD = WS_REC + (size_t)2 * 8 * NTOK * 384 * 4;
constexpr size_t WS_G = WS_YD + (size_t)2 * NTOK * RW * 4;
constexpr size_t WS_BV = WS_G + (size_t)NTOK * RW * 4;
constexpr size_t WS_GMR = WS_BV + (size_t)NTOK * RW * 4;
constexpr size_t WS_YCAT = al256(WS_GMR + (size_t)NTOK * 4);
constexpr size_t WS_Q = WS_YCAT + (size_t)NTOK * D * 2;
constexpr size_t WS_K = WS_Q + (size_t)NTOK * 1024 * 4;
constexpr size_t WS_X1 = WS_K + (size_t)NTOK * 256 * 4;
constexpr size_t WS_X2C = WS_X1 + (size_t)NTOK * D * 4;
constexpr size_t WS_TOKE = WS_X2C + (size_t)CTXL * D * 4;
constexpr size_t WS_TOKP = WS_TOKE + (size_t)NTOK * 8 * 4;
constexpr size_t WS_TOKW = WS_TOKP + (size_t)NTOK * 8 * 4;
constexpr size_t WS_SLOTT = WS_TOKW + (size_t)NTOK * 8 * 4;
constexpr size_t WS_SLOTW = al256(WS_SLOTT + (size_t)SLOT_CAP * 4);
constexpr size_t WS_TILE = al256(WS_SLOTW + (size_t)SLOT_CAP * 4);
constexpr size_t WS_ACT = al256(WS_TILE + (size_t)(MAX_TILES + 64) * 4);
constexpr size_t WS_MODP = WS_ACT + (size_t)SLOT_CAP * EFF * 2;
constexpr size_t WS_TOKS = WS_MODP + (size_t)2 * 2 * 32 * 12288 * 4;
constexpr size_t WS_OUTS = WS_TOKS + (size_t)NTOK * 8 * 4;
constexpr size_t WS_WLT = WS_OUTS + (size_t)SLOT_CAP * D * 2;
constexpr size_t WS_ROPE = WS_WLT + (size_t)2 * RW * 384 * 2;
constexpr size_t WS_RT = WS_ROPE + (size_t)192 * 16 * 2 * 4;
constexpr size_t WS_FR = WS_RT + (size_t)2 * 2 * NE * D * 2;
constexpr size_t WS_END = WS_FR + (size_t)16 * (NTOK / 16) * 12800;

struct Params {
    const float *x, *c, *ctx, *c_ctx, *w_ada, *b_ada, *norm1_g, *norm2_g, *w_in, *w_o;
    const float *rw_mu, *rw_w0, *rw_w2, *rw_a0, *rw_a2, *rw_g2, *rw_kk, *rw_ka, *rw_rk, *rw_ln_g, *rw_ln_b;
    const float *gm_norm_g, *gm_ws, *gm_b, *at_qn, *at_kn, *at_sink;
    const float *moe_router, *moe_bias, *moe_wg, *moe_wu, *moe_wd, *sh_wg, *sh_wu, *sh_wd;
    float* out;
    char* ws;
};

__device__ __forceinline__ bf16_t f2bf(float f) {
    unsigned u = __float_as_uint(f);
    u += 0x7fffu + ((u >> 16) & 1u);
    return (bf16_t)(u >> 16);
}
typedef __bf16 bf16x2n __attribute__((ext_vector_type(2)));
typedef float f32x2n __attribute__((ext_vector_type(2)));
__device__ __forceinline__ unsigned pack_bf2(float lo, float hi) { const f32x2n v = {lo, hi}; const bf16x2n b2 = __builtin_convertvector(v, bf16x2n); return __builtin_bit_cast(unsigned, b2); }
__device__ __forceinline__ int olane() { int t; asm volatile("v_mbcnt_lo_u32_b32 %0, -1, 0\n\tv_mbcnt_hi_u32_b32 %0, -1, %0" : "=v"(t)); return t; }
__device__ __forceinline__ float bperm(float v, int src_lane) { return __int_as_float(__builtin_amdgcn_ds_bpermute(src_lane << 2, __float_as_int(v))); }
template <int CTRL> __device__ __forceinline__ float dppf(float v) {
    return __int_as_float(__builtin_amdgcn_update_dpp(0, __float_as_int(v), CTRL, 0xf, 0xf, true));
}
__device__ __forceinline__ float red16(float v) {
    v += dppf<0xB1>(v); v += dppf<0x4E>(v); v += dppf<0x124>(v); v += dppf<0x128>(v); return v;
}
__device__ __forceinline__ float wave_sum(float v) {
    const int lane = olane();
    v = red16(v);
    v += bperm(v, lane ^ 16); v += bperm(v, lane ^ 32);
    return v;
}
__device__ __forceinline__ float wave_max(float v) {
    const int lane = olane();
    v = fmaxf(v, dppf<0xB1>(v)); v = fmaxf(v, dppf<0x4E>(v)); v = fmaxf(v, dppf<0x124>(v)); v = fmaxf(v, dppf<0x128>(v));
    v = fmaxf(v, bperm(v, lane ^ 16)); v = fmaxf(v, bperm(v, lane ^ 32));
    return v;
}
__device__ __forceinline__ float max8(float v) {
    const int lane = olane();
    v = fmaxf(v, dppf<0xB1>(v)); v = fmaxf(v, dppf<0x4E>(v)); v = fmaxf(v, bperm(v, lane ^ 4));
    return v;
}
__device__ __forceinline__ float fexp(float x) { return __builtin_amdgcn_exp2f(x * 1.4426950408889634f); }
__device__ __forceinline__ float flog(float x) { return __builtin_amdgcn_logf(x) * 0.6931471805599453f; }
__device__ __forceinline__ float frcp(float x) { return __builtin_amdgcn_rcpf(x); }
__device__ __forceinline__ float sigmoidf_(float x) { return frcp(1.f + fexp(-x)); }
__device__ __forceinline__ float siluf_(float x) { return x * frcp(1.f + fexp(-x)); }
__device__ __forceinline__ float ftanh(float u) { const float e = fexp(-2.f * fabsf(u)); const float t = (1.f - e) * frcp(1.f + e); return u < 0.f ? -t : t; }
__device__ __forceinline__ float gelu_tanh(float x) {
    const float u = 0.7978845608028654f * (x + 0.044715f * x * x * x);
    const float hx = 0.5f * x;
    return fmaf(hx, ftanh(u), hx);
}
__device__ __forceinline__ float softplusf_(float x) { return fmaxf(x, 0.f) + flog(1.f + fexp(-fabsf(x))); }

struct RowSrc { const float* a; const float* b; };
__device__ __forceinline__ const float* rowp(const RowSrc& r, int row) { return row < SEQ ? r.a + (size_t)row * D : r.b + (size_t)(row - SEQ) * D; }
struct RowDst { float* a; float* b; };
__device__ __forceinline__ float* rowp(const RowDst& r, int row) { return row < SEQ ? r.a + (size_t)row * D : r.b + (size_t)(row - SEQ) * D; }

__device__ __forceinline__ RowSrc layer_in(const Params& p, int l) {
    RowSrc r; if (l == 0) { r.a = p.x; r.b = p.ctx; } else { float* x1 = (float*)(p.ws + WS_X1); r.a = x1; r.b = x1 + (size_t)SEQ * D; } return r;
}
__device__ __forceinline__ RowDst layer_out(const Params& p, int l) {
    RowDst r; if (l == 0) { float* x1 = (float*)(p.ws + WS_X1); r.a = x1; r.b = x1 + (size_t)SEQ * D; } else { r.a = p.out; r.b = (float*)(p.ws + WS_X2C); } return r;
}
__device__ __forceinline__ const float* modp(const Params& p, int l, int row, int which) {
    return (const float*)(p.ws + WS_MOD) + ((size_t)(l * 2 + (row < SEQ ? 0 : 1)) * 6 + which) * D;
}
__device__ __forceinline__ int ntok_of(int l) { return l == DEPTH - 1 ? SEQ : NTOK; }
struct KP : Params { int wb; };
__device__ __forceinline__ int otid(int wb) {
    int t; asm volatile("v_mbcnt_lo_u32_b32 %0, -1, 0\n\tv_mbcnt_hi_u32_b32 %0, -1, %0" : "=v"(t));
    return t | wb;
}

__device__ __forceinline__ void phase_ada(const KP& p, int bid, int nb) {
    float* part = (float*)(p.ws + WS_MODP);
    const int tid = otid(p.wb);
    for (int u = bid; u < 2 * 6 * 32; u += nb) {
        const int l = u / (6 * 32), r = u % (6 * 32), cg = r / 32, kc = r % 32;
        const int n = cg * 2048 + tid * 4;
        const float* w = p.w_ada + (size_t)l * D * 12288 + (size_t)(kc * 64) * 12288 + n;
        f32x4 a0 = {0, 0, 0, 0}, a1 = {0, 0, 0, 0};
#pragma unroll 8
        for (int k = 0; k < 64; ++k) {
            const f32x4 wv = *(const f32x4*)(w + (size_t)k * 12288);
            const float c0 = siluf_(p.c[kc * 64 + k]), c1 = siluf_(p.c_ctx[kc * 64 + k]);
            a0 += wv * c0; a1 += wv * c1;
        }
        *(f32x4*)(part + ((size_t)((l * 2 + 0) * 32 + kc)) * 12288 + n) = a0;
        *(f32x4*)(part + ((size_t)((l * 2 + 1) * 32 + kc)) * 12288 + n) = a1;
    }
}
__device__ __forceinline__ void phase_ada2(const KP& p, int bid, int nb) {
    const float* part = (const float*)(p.ws + WS_MODP);
    float* mod = (float*)(p.ws + WS_MOD);
    for (int i = bid * NT + otid(p.wb); i < 2 * 2 * 12288; i += nb * NT) {
        const int ls = i / 12288, n = i % 12288, l = ls >> 1;
        float acc = p.b_ada[(size_t)l * 12288 + n];
        float pv[32];
#pragma unroll
        for (int kc = 0; kc < 32; ++kc) pv[kc] = part[((size_t)(ls * 32 + kc)) * 12288 + n];
#pragma unroll
        for (int kc = 0; kc < 32; ++kc) acc += pv[kc];
        mod[i] = acc;
    }
}

struct TJob { const float* src; bf16_t* dst; int K, N, batch; size_t sstride, dstride; int mode; };
__device__ __forceinline__ void tconv_pair(const TJob& j, int t0, float* tiles  , int tid) {
    const int half = tid >> 8, ht = tid & 255;
    float* tile = tiles + half * (64 * 65);
    const int tk = j.K / 64, tn = j.N / 64, ntl = j.batch * tk * tn;
    const int t = t0 + half;
    const bool on = t < ntl;
    const int b = t / (tk * tn), r = t % (tk * tn), kt = r / tn, nt = r % tn;
    __syncthreads();
    if (on) {
        const float* src = j.src + (size_t)b * j.sstride + (size_t)(kt * 64) * j.N + nt * 64;
#pragma unroll
        for (int i = 0; i < 4; ++i) {
            const int k = i * 16 + (ht >> 4), n = (ht & 15) * 4;
            const f32x4 v = *(const f32x4*)(src + (size_t)k * j.N + n);
            tile[k * 65 + n + 0] = v[0]; tile[k * 65 + n + 1] = v[1]; tile[k * 65 + n + 2] = v[2]; tile[k * 65 + n + 3] = v[3];
        }
    }
    __syncthreads();
    if (on) {
        const int n = ht >> 2, kq = (ht & 3) * 16;
        int ng = nt * 64 + n;
        if (j.mode == 1) ng = 32 * (ng >> 4) + (ng & 15);
        else if (j.mode == 2) ng = 32 * (ng >> 4) + 16 + (ng & 15);
        bf16_t* dst = j.dst + (size_t)b * j.dstride + (size_t)ng * j.K + kt * 64 + kq;
        u32x4 w0, w1;
#pragma unroll
        for (int i = 0; i < 4; ++i) { w0[i] = pack_bf2(tile[(kq + 2 * i) * 65 + n], tile[(kq + 2 * i + 1) * 65 + n]); w1[i] = pack_bf2(tile[(kq + 8 + 2 * i) * 65 + n], tile[(kq + 8 + 2 * i + 1) * 65 + n]); }
        *(u32x4*)(dst) = w0;
        *(u32x4*)(dst + 8) = w1;
    }
}
__device__ __forceinline__ void phase_tconv(const TJob& j, int bid, int nb, float* tiles  , int wb) {
    const int tid = otid(wb);
    const int ntl = j.batch * (j.K / 64) * (j.N / 64);
    for (int t0 = bid * 2; t0 < ntl; t0 += nb * 2) tconv_pair(j, t0, tiles, tid);
}
__device__ __forceinline__ void phase_convert_dense(const KP& p, int l, int bid, int nb, float* tile) {
    TJob j;
    j = {p.w_in + (size_t)l * D * INP, (bf16_t*)(p.ws + WS_WINT) + (size_t)l * INP_PAD * D, D, INP, 1, 0, 0, 0}; phase_tconv(j, bid, nb, tile, p.wb);
    j = {p.w_o + (size_t)l * D * D, (bf16_t*)(p.ws + WS_WOT) + (size_t)l * D * D, D, D, 1, 0, 0, 0}; phase_tconv(j, bid, nb, tile, p.wb);
}
constexpr int CQ_ITEM = 16;
constexpr int CQ_T_BIG = NE * (D / 64) * (EFF / 64);
constexpr int CQ_T_SH = (D / 64) * (EFF / 64);
constexpr int CQ_IPL = (3 * CQ_T_BIG + 3 * CQ_T_SH) / CQ_ITEM;
constexpr int CT_LD = 68;
__device__ __forceinline__ void conv_item(const KP& p, int l, int item, float* tiles  , int tid) {
    int t = item * CQ_ITEM;
    bf16_t* w13 = (bf16_t*)(p.ws + WS_W13T) + (size_t)l * NEX * 1024 * D;
    bf16_t* w2 = (bf16_t*)(p.ws + WS_W2T) + (size_t)l * NEX * D * EFF;
    TJob j;
    if (t < CQ_T_BIG) j = {p.moe_wg + (size_t)l * NE * D * EFF, w13, D, EFF, NE, (size_t)D * EFF, (size_t)1024 * D, 1};
    else if (t < 2 * CQ_T_BIG) { t -= CQ_T_BIG; j = {p.moe_wu + (size_t)l * NE * D * EFF, w13, D, EFF, NE, (size_t)D * EFF, (size_t)1024 * D, 2}; }
    else if (t < 3 * CQ_T_BIG) { t -= 2 * CQ_T_BIG; j = {p.moe_wd + (size_t)l * NE * EFF * D, w2, EFF, D, NE, (size_t)EFF * D, (size_t)D * EFF, 0}; }
    else if (t < 3 * CQ_T_BIG + CQ_T_SH) { t -= 3 * CQ_T_BIG; j = {p.sh_wg + (size_t)l * D * EFF, w13 + (size_t)NE * 1024 * D, D, EFF, 1, 0, 0, 1}; }
    else if (t < 3 * CQ_T_BIG + 2 * CQ_T_SH) { t -= 3 * CQ_T_BIG + CQ_T_SH; j = {p.sh_wu + (size_t)l * D * EFF, w13 + (size_t)NE * 1024 * D, D, EFF, 1, 0, 0, 2}; }
    else { t -= 3 * CQ_T_BIG + 2 * CQ_T_SH; j = {p.sh_wd + (size_t)l * EFF * D, w2 + (size_t)NE * D * EFF, EFF, D, 1, 0, 0, 0}; }
    const int half = tid >> 8, ht = tid & 255;
    float* tile = tiles + half * (64 * CT_LD);
    const int tk = j.K / 64, tn = j.N / 64;
    const int lk = ht >> 4, ln = (ht & 15) * 4;
    const int sn = ht >> 2, skq = (ht & 3) * 16;
    f32x4 v[4];
#define CT_SRC(tt) (j.src + (size_t)((tt) / (tk * tn)) * j.sstride + (size_t)((((tt) % (tk * tn)) / tn) * 64) * j.N + (((tt) % (tk * tn)) % tn) * 64)
    { const float* src = CT_SRC(t + half);
#pragma unroll
      for (int i = 0; i < 4; ++i) v[i] = __builtin_nontemporal_load((const f32x4*)(src + (size_t)(lk + 16 * i) * j.N + ln)); }
#pragma unroll 1
    for (int st = 0; st < CQ_ITEM; st += 2) {
        const int tt = t + st + half;
        __syncthreads();
#pragma unroll
        for (int i = 0; i < 4; ++i) *(f32x4*)(tile + (lk + 16 * i) * CT_LD + ln) = v[i];
        __syncthreads();
        if (st + 2 < CQ_ITEM) {
            const float* src = CT_SRC(tt + 2);
#pragma unroll
            for (int i = 0; i < 4; ++i) v[i] = __builtin_nontemporal_load((const f32x4*)(src + (size_t)(lk + 16 * i) * j.N + ln));
        }
        const int b = tt / (tk * tn), r = tt % (tk * tn), kt = r / tn, nt = r % tn;
        int ng = nt * 64 + sn;
        if (j.mode == 1) ng = 32 * (ng >> 4) + (ng & 15);
        else if (j.mode == 2) ng = 32 * (ng >> 4) + 16 + (ng & 15);
        bf16_t* dst = j.dst + (size_t)b * j.dstride + (size_t)ng * j.K + kt * 64 + skq;
        u32x4 w0, w1;
#pragma unroll
        for (int i = 0; i < 4; ++i) { w0[i] = pack_bf2(tile[(skq + 2 * i) * CT_LD + sn], tile[(skq + 2 * i + 1) * CT_LD + sn]); w1[i] = pack_bf2(tile[(skq + 8 + 2 * i) * CT_LD + sn], tile[(skq + 8 + 2 * i + 1) * CT_LD + sn]); }
        __builtin_nontemporal_store(w0, (u32x4*)(dst));
        __builtin_nontemporal_store(w1, (u32x4*)(dst + 8));
    }
#undef CT_SRC
}
__device__ __forceinline__ void conv_pull(const KP& p, int l, char* smem) {
    int* qhead = (int*)(p.ws + WS_CNT) + 200 + l;
    float* tiles = (float*)smem;
    int* sh = (int*)(smem + 2 * 64 * CT_LD * 4);
    const int tid = otid(p.wb);
    __syncthreads();
    if (tid == 0) sh[0] = __hip_atomic_fetch_add(qhead, 1, __ATOMIC_RELAXED, __HIP_MEMORY_SCOPE_AGENT);
    __syncthreads();
    int item = sh[0];
    while (item < CQ_IPL) {
        int nxt = 0;
        if (tid == 0) nxt = __hip_atomic_fetch_add(qhead, 1, __ATOMIC_RELAXED, __HIP_MEMORY_SCOPE_AGENT);
        conv_item(p, l, item, tiles, tid);
        __syncthreads();
        if (tid == 0) sh[0] = nxt;
        __syncthreads();
        item = sh[0];
    }
}

__device__ __forceinline__ void conv_pull_n(const KP& p, int l, char* smem, int n) {
    int* qhead = (int*)(p.ws + WS_CNT) + 200 + l;
    float* tiles = (float*)smem;
    int* sh = (int*)(smem + 2 * 64 * CT_LD * 4);
    const int tid = otid(p.wb);
    for (int k = 0; k < n; ++k) {
        __syncthreads();
        if (tid == 0) sh[0] = __hip_atomic_fetch_add(qhead, 1, __ATOMIC_RELAXED, __HIP_MEMORY_SCOPE_AGENT);
        __syncthreads();
        const int item = sh[0];
        if (item >= CQ_IPL) break;
        conv_item(p, l, item, tiles, tid);
    }
}

__device__ __forceinline__ void phase_convert_lora(const KP& p, int bid, int nb) {
    bf16_t* WLT = (bf16_t*)(p.ws + WS_WLT);
    const int tid = otid(p.wb);
    for (int i = bid * NT + tid; i < 2 * D * NE; i += nb * NT) {
        const int l = i / (D * NE), r = i % (D * NE), k = r / NE, e = r % NE;
        const float x = p.moe_router[i];
        const bf16_t hi = f2bf(x); const bf16_t lo = f2bf(x - __uint_as_float((unsigned)hi << 16));
        bf16_t* rt = (bf16_t*)(p.ws + WS_RT) + (size_t)l * 2 * NE * D;
        const size_t fo = ((size_t)((k >> 5) * 4 + (e >> 4)) * 64 + ((k >> 3) & 3) * 16 + (e & 15)) * 8 + (k & 7);
        rt[fo] = hi; rt[(size_t)NE * D + fo] = lo;
    }
    for (int i = bid * NT + tid; i < 192 * 16; i += nb * NT) {
        const int pos = i >> 4, f = i & 15;
        const float ang = (float)(pos < 128 ? pos : pos - 128) * powf(10000.f, -(float)f / 16.f);
        float* rt = (float*)(p.ws + WS_ROPE) + (size_t)i * 2;
        rt[0] = cosf(ang); rt[1] = sinf(ang);
    }
    for (int i = bid * NT + tid; i < 2 * RW * 384; i += nb * NT) {
        const int l = i / (RW * 384), r = i % (RW * 384), k = r / RW, c = r % RW;
        float v;
        if (k < 128) v = p.rw_w2[((size_t)l * 2 * 64 + k) * RW + c];
        else if (k < 256) v = p.rw_a2[((size_t)l * 2 * 64 + (k - 128)) * RW + c];
        else v = p.rw_g2[((size_t)l * 128 + (k - 256)) * RW + c];
        WLT[((size_t)l * RW + c) * 384 + k] = f2bf(v);
    }
}

__device__ __forceinline__ void phase_norm1(const KP& p, int l, int bid, int nb) {
    const RowSrc in = layer_in(p, l);
    bf16_t* H = (bf16_t*)(p.ws + WS_H);
    const float* g = p.norm1_g + (size_t)l * D;
    const int tid = otid(p.wb), wid = tid >> 6, lane = tid & 63;
    for (int row = bid * 8 + wid; row < NTOK; row += nb * 8) {
        const float* xr = rowp(in, row);
        const float* sh = modp(p, l, row, 0);
        const float* sc = modp(p, l, row, 1);
        f32x4 v[8]; float ss = 0.f;
#pragma unroll
        for (int i = 0; i < 8; ++i) { v[i] = *(const f32x4*)(xr + i * 256 + lane * 4); ss += v[i][0] * v[i][0] + v[i][1] * v[i][1] + v[i][2] * v[i][2] + v[i][3] * v[i][3]; }
        ss = wave_sum(ss);
        const float rstd = rsqrtf(ss * (1.f / D) + 1e-6f);
#pragma unroll
        for (int i = 0; i < 8; ++i) {
            const int c = i * 256 + lane * 4;
            const f32x4 gv = *(const f32x4*)(g + c), shv = *(const f32x4*)(sh + c), scv = *(const f32x4*)(sc + c);
            float o[4];
#pragma unroll
            for (int j = 0; j < 4; ++j) { const float t = v[i][j] * rstd * gv[j]; o[j] = fmaf(t, scv[j], t) + shv[j]; }
            u32x2 w; w[0] = pack_bf2(o[0], o[1]); w[1] = pack_bf2(o[2], o[3]);
            *(u32x2*)(H + (size_t)row * D + c) = w;
        }
    }
}

constexpr int G_HT = 128 * 64;
constexpr int G_LDS = 8 * G_HT * 2;
__device__ __forceinline__ int g_lds_byte(int r, int c) {
    const int st = (r >> 4) * 2 + (c >> 5), rr = r & 15, cc = c & 31, ob = rr * 64 + cc * 2;
    return st * 1024 + (ob ^ (((ob >> 9) & 1) << 5));
}
__device__ __forceinline__ void g_stage_rc(int b, int& R, int& C) {
    const int st = b / 1024, sb = b % 1024, swz = sb ^ (((sb >> 9) & 1) << 5);
    R = (st >> 1) * 16 + swz / 64; C = (st & 1) * 32 + (swz % 64) / 2;
}
struct GOff { unsigned ao[2][2], bo; };
#define SA(b, h) (shm + ((b) * 2 + (h)) * G_HT)
#define SB(b, h) (shm + (4 + (b) * 2 + (h)) * G_HT)
#define STG_A(P, h, kt) do { _Pragma("unroll") for (int _i = 0; _i < 2; ++_i) \
    __builtin_amdgcn_global_load_lds((const unsigned*)((const char*)(A + (kt) * 64) + o.ao[h][_i]), (unsigned*)((char*)(P) + tz * 16 + _i * 8192), 16, 0, 0); } while (0)
#define STG_B(P, h, kt) do { _Pragma("unroll") for (int _i = 0; _i < 2; ++_i) \
    __builtin_amdgcn_global_load_lds((const unsigned*)((const char*)(Bt + ((h) * (PERM ? 32 : 128) + _i * (PERM ? 128 : 64)) * K + (kt) * 64) + o.bo), (unsigned*)((char*)(P) + tz * 16 + _i * 8192), 16, 0, 0); } while (0)
template <bool PERM, class ARow>
__device__ __forceinline__ void gemm_offsets(ARow arow, const int K, const int wb, GOff& o) {
    const int tz = otid(wb);
    int r, c; g_stage_rc(tz * 16, r, c);
    const int rb = PERM ? (64 * (r >> 5) + 8 * ((r & 15) >> 2) + 4 * ((r >> 4) & 1) + (r & 3)) : r;
    o.bo = (unsigned)((rb * K + c) * 2);
#pragma unroll
    for (int h = 0; h < 2; ++h)
#pragma unroll
        for (int i = 0; i < 2; ++i) o.ao[h][i] = (unsigned)((arow(h * 128 + i * 64 + r) + c) * 2);
}
template <bool PERM>
__device__ __forceinline__ void gemm_issue(const bf16_t* __restrict__ A, const bf16_t* __restrict__ Bt, const int K, const GOff& o, bf16_t* shm, const int wb) {
    const int tz = otid(wb);
    STG_B(SB(0, 0), 0, 0); STG_A(SA(0, 0), 0, 0);
    STG_B(SB(0, 1), 1, 0); STG_A(SA(0, 1), 1, 0);
    STG_B(SB(1, 0), 0, 1); STG_A(SA(1, 0), 0, 1); STG_B(SB(1, 1), 1, 1); STG_A(SA(1, 1), 1, 1);
}
template <bool PERM>
__device__ __forceinline__ void gemm_main(const bf16_t* __restrict__ A, const bf16_t* __restrict__ Bt, const int K, const GOff& o, f32x4 (&acc)[2][2][4][2], bf16_t* shm, const int wb, const int nst) {
#define LDA(dst, b, h) _Pragma("unroll") for (int m = 0; m < 4; ++m) _Pragma("unroll") for (int k = 0; k < 2; ++k) \
    dst[m][k] = *reinterpret_cast<const bf16x8*>((const char*)SA(b, h) + g_lds_byte(wr * 64 + m * 16 + fr, k * 32 + fq * 8))
#define LDB(dst, b, h) _Pragma("unroll") for (int n = 0; n < 2; ++n) _Pragma("unroll") for (int k = 0; k < 2; ++k) \
    dst[n][k] = *reinterpret_cast<const bf16x8*>((const char*)SB(b, h) + g_lds_byte(wc * 32 + n * 16 + fr, k * 32 + fq * 8))
#define MMA(ai, bj, Af, Bf) do { __builtin_amdgcn_s_setprio(1); \
    _Pragma("unroll") for (int m = 0; m < 4; ++m) _Pragma("unroll") for (int n = 0; n < 2; ++n) _Pragma("unroll") for (int k = 0; k < 2; ++k) \
        acc[ai][bj][m][n] = __builtin_amdgcn_mfma_f32_16x16x32_bf16(Bf[n][k], Af[m][k], acc[ai][bj][m][n], 0, 0, 0); \
    __builtin_amdgcn_s_setprio(0); } while (0)
#define WAIT_V(n) asm volatile("s_waitcnt vmcnt(" #n ")" ::: "memory")
#define WAIT_L(n) asm volatile("s_waitcnt lgkmcnt(" #n ")" ::: "memory")
#define BAR __builtin_amdgcn_s_barrier()
#define SCHED __builtin_amdgcn_sched_barrier(0)
    int tz = otid(wb);
    int wid = tz >> 6, lane = tz & 63, wr = wid >> 2, wc = wid & 3, fr = lane & 15, fq = lane >> 4;
#pragma unroll
    for (int a = 0; a < 2; ++a)
#pragma unroll
        for (int b = 0; b < 2; ++b)
#pragma unroll
            for (int m = 0; m < 4; ++m)
#pragma unroll
                for (int n = 0; n < 2; ++n) acc[a][b][m][n] = (f32x4){0.f, 0.f, 0.f, 0.f};
    bf16x8 At[4][2], B0[2][2], B1[2][2];
    const int nt = K / 64;
    if (nst >= 32) WAIT_V(32); else if (nst >= 16) WAIT_V(16); else WAIT_V(0);
    BAR;
    if (wr == 1) BAR;
    for (int t = 0; t < nt - 2; t += 2) {
        int tn = t; asm volatile("" : "+s"(tn));
        LDB(B0, 0, 0); SCHED; LDA(At, 0, 0); if (tn) STG_A(SA(1, 1), 1, t + 1);
        WAIT_L(8); BAR; WAIT_L(0); MMA(0, 0, At, B0); BAR; SCHED;
        LDB(B1, 0, 1); STG_B(SB(0, 0), 0, t + 2);
        BAR; WAIT_L(0); MMA(0, 1, At, B1); BAR;
        LDA(At, 0, 1); STG_A(SA(0, 0), 0, t + 2);
        BAR; WAIT_L(0); MMA(1, 0, At, B0); BAR; SCHED;
        STG_B(SB(0, 1), 1, t + 2);
        if (tn) WAIT_V(6);
        BAR; MMA(1, 1, At, B1); BAR;
        LDB(B0, 1, 0); SCHED; LDA(At, 1, 0); STG_A(SA(0, 1), 1, t + 2);
        WAIT_L(8); BAR; WAIT_L(0); MMA(0, 0, At, B0); BAR; SCHED;
        LDB(B1, 1, 1); STG_B(SB(1, 0), 0, t + 3);
        BAR; WAIT_L(0); MMA(0, 1, At, B1); BAR;
        LDA(At, 1, 1); STG_A(SA(1, 0), 0, t + 3);
        BAR; WAIT_L(0); MMA(1, 0, At, B0); BAR; SCHED;
        STG_B(SB(1, 1), 1, t + 3);
        WAIT_V(6); BAR; MMA(1, 1, At, B1); BAR;
    }
    { LDB(B0, 0, 0); WAIT_V(0); LDA(At, 0, 0); STG_A(SA(1, 1), 1, nt - 1);
      BAR; WAIT_L(0); MMA(0, 0, At, B0); BAR;
      LDB(B1, 0, 1); BAR; WAIT_L(0); MMA(0, 1, At, B1); BAR;
      LDA(At, 0, 1); WAIT_V(4); BAR; WAIT_L(0); MMA(1, 0, At, B0); MMA(1, 1, At, B1); BAR; }
    { LDB(B0, 1, 0); LDA(At, 1, 0); WAIT_V(2); BAR; WAIT_L(0); MMA(0, 0, At, B0); BAR;
      LDB(B1, 1, 1); WAIT_V(0); BAR; WAIT_L(0); MMA(0, 1, At, B1); BAR;
      LDA(At, 1, 1); BAR; WAIT_L(0); MMA(1, 0, At, B0); MMA(1, 1, At, B1); BAR; }
    if (wr == 0) BAR;
#undef LDA
#undef LDB
#undef MMA
#undef WAIT_V
#undef WAIT_L
#undef BAR
#undef SCHED
}
#undef SA
#undef SB
#undef STG_A
#undef STG_B
struct GU { const bf16_t* A; const bf16_t* Bt; int i0, i1, i2, i3; };
template <bool PERM, class Mk, class Row, class Epi>
__device__ __forceinline__ void gemm_phase(const int nwg, const int bid, const int nb, const int K, bf16_t* shm, const int wb, Mk mk, Row row, Epi epi) {
    int L = bid;
    if (L >= nwg) return;
    GU cur = mk(L);
    GOff oc;
    gemm_offsets<PERM>([&](int r) { return row(cur, r); }, K, wb, oc);
    gemm_issue<PERM>(cur.A, cur.Bt, K, oc, shm, wb);
    int nst = 0;
    for (;;) {
        f32x4 acc[2][2][4][2];
        gemm_main<PERM>(cur.A, cur.Bt, K, oc, acc, shm, wb, nst);
        const int Ln = L + nb;
        const bool more = Ln < nwg;
        GU nxt = cur; GOff on = oc;
        if (more) {
            nxt = mk(Ln);
            gemm_offsets<PERM>([&](int r) { return row(nxt, r); }, K, wb, on);
            gemm_issue<PERM>(nxt.A, nxt.Bt, K, on, shm, wb);
        }
        nst = epi(cur, acc);
        if (!more) break;
        cur = nxt; oc = on; L = Ln;
    }
}
#define G_IDX int _tz = otid(p.wb); const int _wid = _tz >> 6, _lane = _tz & 63, wr = _wid >> 2, wc = _wid & 3, fr = _lane & 15, fq = _lane >> 4
__device__ __forceinline__ int xcd_remap(int L, int nwg) {
    const int q = nwg / 8, r = nwg % 8, xcd = L % 8, off = L / 8;
    return (xcd < r ? xcd * (q + 1) : r * (q + 1) + (xcd - r) * q) + off;
}
__device__ __forceinline__ void dense_tile(int wgid, int nM, int nN, int& pm, int& pn) {
    const int nig = 8 * nN, gid = wgid / nig, fm = gid * 8, gsz = (nM - fm) < 8 ? (nM - fm) : 8;
    pm = fm + ((wgid % nig) % gsz); pn = (wgid % nig) / gsz;
}

__device__ __forceinline__ void phase_inproj(const KP& p, int l, int bid, int nb, bf16_t* shm) {
    const bf16_t* H = (const bf16_t*)(p.ws + WS_H);
    const bf16_t* Bt = (const bf16_t*)(p.ws + WS_WINT) + (size_t)l * INP_PAD * D;
    float* P = (float*)(p.ws + WS_P);
    constexpr int nM = NTOK / 256, nN = INP_PAD / 256, nwg = nM * nN;
    gemm_phase<false>(nwg, bid, nb, D, shm, p.wb,
        [&](int L) { int pm, pn; dense_tile(xcd_remap(L, nwg), nM, nN, pm, pn); GU u; u.A = H; u.Bt = Bt + (size_t)(pn * 256) * D; u.i0 = pm * 256; u.i1 = pn * 256; u.i2 = 0; u.i3 = 0; return u; },
        [&](const GU& u, int r) { return (u.i0 + r) * D; },
        [&](const GU& u, f32x4 (&acc)[2][2][4][2]) {
            const int m0 = u.i0, n0 = u.i1;
            G_IDX;
#pragma unroll
            for (int ai = 0; ai < 2; ++ai)
#pragma unroll
                for (int m = 0; m < 4; ++m) {
                    float* prow = P + (size_t)(m0 + ai * 128 + wr * 64 + m * 16 + fr) * INP + n0 + wc * 32 + fq * 4;
#pragma unroll
                    for (int bj = 0; bj < 2; ++bj)
#pragma unroll
                        for (int n = 0; n < 2; ++n)
                            if (n0 + bj * 128 + wc * 32 + n * 16 + fq * 4 < INP) *(f32x4*)(prow + bj * 128 + n * 16) = acc[ai][bj][m][n];
                }
            return n0 + 256 <= INP ? 32 : 16;
        });
}

__device__ __forceinline__ int scan_pos(int d, int row) {
    if (row >= SEQ) { const int c = row - SEQ; return d == 0 ? c : (CTXL - 1 - c); }
    return CTXL + (d == 0 ? row : (SEQ - 1 - row));
}
__device__ __forceinline__ int scan_row(int d, int s) {
    if (s < CTXL) return SEQ + (d == 0 ? s : (CTXL - 1 - s));
    const int q = s - CTXL; return d == 0 ? q : (SEQ - 1 - q);
}
constexpr int RP_TB = 11;
constexpr int RP_LD = 392;
__device__ __forceinline__ f32x4 shifted4(const float* P, int row, int col, const float* mu) {
    const f32x4 cur = *(const f32x4*)(P + (size_t)row * INP + col);
    const bool first = (row == 0) || (row == SEQ), last = (row == SEQ - 1) || (row == NTOK - 1);
    f32x4 prev = {0.f, 0.f, 0.f, 0.f}, nxt = {0.f, 0.f, 0.f, 0.f};
    if (!first) prev = *(const f32x4*)(P + (size_t)(row - 1) * INP + col);
    if (!last) nxt = *(const f32x4*)(P + (size_t)(row + 1) * INP + col);
    const f32x4 m0 = *(const f32x4*)(mu + col), m1 = *(const f32x4*)(mu + RWP + col);
    return cur + m0 * (prev - cur) + m1 * (nxt - cur);
}
__device__ __forceinline__ float shifted(const float* P, int row, int col, float mu0, float mu1) {
    const float cur = P[(size_t)row * INP + col];
    const bool first = (row == 0) || (row == SEQ), last = (row == SEQ - 1) || (row == NTOK - 1);
    const float prev = first ? 0.f : P[(size_t)(row - 1) * INP + col];
    const float nxt = last ? 0.f : P[(size_t)(row + 1) * INP + col];
    return cur + mu0 * (prev - cur) + mu1 * (nxt - cur);
}
constexpr int SL_LD = 1924;
constexpr int SL_OFF = 16384;
__device__ __forceinline__ f32x4 slab4(const float* slab, int lr, bool first, bool last, int col, const float* mu) {
    const float* s = slab + (lr + 1) * SL_LD + col;
    const f32x4 cur = *(const f32x4*)s;
    f32x4 prev = {0.f, 0.f, 0.f, 0.f}, nxt = {0.f, 0.f, 0.f, 0.f};
    if (!first) prev = *(const f32x4*)(s - SL_LD);
    if (!last) nxt = *(const f32x4*)(s + SL_LD);
    const f32x4 m0 = *(const f32x4*)(mu + col), m1 = *(const f32x4*)(mu + RWP + col);
    return cur + m0 * (prev - cur) + m1 * (nxt - cur);
}
__device__ __forceinline__ void phase_rwprep(const KP& p, int l, int bid, int nb, char* smem) {
    const float* P = (const float*)(p.ws + WS_P);
    float* RECW = (float*)(p.ws + WS_REC);
    bf16_t* RECD = (bf16_t*)(RECW + (size_t)16 * NTOK * 64);
    bf16_t* RECS = RECD + (size_t)16 * NTOK * 128;
    float* G = (float*)(p.ws + WS_G);
    float* BV = (float*)(p.ws + WS_BV);
    float* GMR = (float*)(p.ws + WS_GMR);
    const bf16_t* WLT = (const bf16_t*)(p.ws + WS_WLT) + (size_t)l * RW * 384;
    float* slab = (float*)(smem + SL_OFF);
    bf16_t* lin = (bf16_t*)smem;
    const float* mu = p.rw_mu + (size_t)l * 2 * RWP;
    const float* w0 = p.rw_w0 + (size_t)l * 2 * RW;
    const float* a0 = p.rw_a0 + (size_t)l * 2 * RW;
    const float* kkw = p.rw_kk + (size_t)l * RW;
    const float* kaw = p.rw_ka + (size_t)l * RW;
    const float* rkw = p.rw_rk + (size_t)l * RW;
    const int tid = otid(p.wb), wid = tid >> 6, lane = tid & 63, t16 = lane & 15, g = lane >> 4;
    for (int blk = bid; blk < NTOK / RP_TB; blk += nb) {
        const int t0 = blk * RP_TB;
        __syncthreads();
        if (tid < 480) {
            f32x4 sv[RP_TB + 2];
#pragma unroll
            for (int q = 0; q < RP_TB + 2; ++q) {
                int gr = t0 - 1 + q; gr = gr < 0 ? 0 : (gr > NTOK - 1 ? NTOK - 1 : gr);
                sv[q] = *(const f32x4*)(P + (size_t)gr * INP + tid * 4);
            }
#pragma unroll
            for (int q = 0; q < RP_TB + 2; ++q) *(f32x4*)(slab + q * SL_LD + tid * 4) = sv[q];
        }
        __syncthreads();
        for (int i = tid; i < RP_TB * 384; i += NT) {
            const int tt = i / 384, j = i % 384, col = 1536 + j, row = t0 + tt;
            const bool first = (row == 0) || (row == SEQ), last = (row == SEQ - 1) || (row == NTOK - 1);
            const float* sp = slab + (tt + 1) * SL_LD + col;
            const float cur = sp[0], prev = first ? 0.f : sp[-SL_LD], nxt = last ? 0.f : sp[SL_LD];
            const float v = cur + mu[col] * (prev - cur) + mu[RWP + col] * (nxt - cur);
            lin[tt * RP_LD + j] = f2bf(j < 128 ? ftanh(v) : (j < 256 ? v : sigmoidf_(v)));
        }
        __syncthreads();
        for (int q = wid; q < RP_TB; q += 8) {
            const int row = t0 + q; float ss = 0.f;
#pragma unroll
            for (int i = 0; i < 8; ++i) { const float gv = gelu_tanh(P[(size_t)row * INP + COL_GM + GMW + i * 64 + lane]); ss += gv * gv; }
            ss = wave_sum(ss);
            if (lane == 0) GMR[row] = rsqrtf(ss * (1.f / GMW) + 1e-6f);
        }
        const bool live = t16 < RP_TB;
        const int lr = live ? t16 : RP_TB - 1, row = t0 + lr;
        const bool rfirst = (row == 0) || (row == SEQ), rlast = (row == SEQ - 1) || (row == NTOK - 1);
        float nrm2 = 0.f, bon = 0.f;
#pragma unroll
        for (int tl = 0; tl < 4; ++tl) {
            const int c = wid * 64 + tl * 16 + g * 4;
            const f32x4 r4 = slab4(slab, lr, rfirst, rlast, c, mu), k4 = slab4(slab, lr, rfirst, rlast, 512 + c, mu);
            const f32x4 kq = k4 * *(const f32x4*)(kkw + c), rk = *(const f32x4*)(rkw + c);
#pragma unroll
            for (int e = 0; e < 4; ++e) { nrm2 += kq[e] * kq[e]; bon += r4[e] * k4[e] * rk[e]; }
        }
        nrm2 += bperm(nrm2, lane ^ 16); nrm2 += bperm(nrm2, lane ^ 32);
        bon += bperm(bon, lane ^ 16); bon += bperm(bon, lane ^ 32);
        const float inrm = 1.f / fmaxf(sqrtf(nrm2), 1e-12f);
        const bf16_t* lrow = lin + (live ? t16 : RP_TB - 1) * RP_LD + g * 8;
#pragma unroll 1
        for (int tl = 0; tl < 4; ++tl) {
            f32x4 acc[5];
#pragma unroll
            for (int m = 0; m < 5; ++m) acc[m] = (f32x4){0.f, 0.f, 0.f, 0.f};
            const bf16_t* wrow = WLT + (size_t)(wid * 64 + tl * 16 + t16) * 384 + g * 8;
#pragma unroll
            for (int ks = 0; ks < 12; ++ks) {
                const int m = ks < 8 ? (ks >> 1) : 4;
                acc[m] = __builtin_amdgcn_mfma_f32_16x16x32_bf16(*(const bf16x8*)(wrow + ks * 32), *(const bf16x8*)(lrow + ks * 32), acc[m], 0, 0, 0);
            }
            const int c = wid * 64 + tl * 16 + g * 4, ci = tl * 16 + g * 4;
            const f32x4 r4 = slab4(slab, lr, rfirst, rlast, c, mu), k4 = slab4(slab, lr, rfirst, rlast, 512 + c, mu), v4 = slab4(slab, lr, rfirst, rlast, 1024 + c, mu);
            const f32x4 kq = k4 * *(const f32x4*)(kkw + c) * inrm;
            if (live) {
                *(f32x4*)(G + (size_t)row * RW + c) = acc[4];
                *(f32x4*)(BV + (size_t)row * RW + c) = v4 * bon;
            }
            const f32x4 ka = *(const f32x4*)(kaw + c);
#pragma unroll
            for (int d = 0; d < 2; ++d) {
                const f32x4 w0v = *(const f32x4*)(w0 + d * RW + c), a0v = *(const f32x4*)(a0 + d * RW + c);
                f32x4 decay, av, kd;
#pragma unroll
                for (int e = 0; e < 4; ++e) {
                    const float wlog = -softplusf_(-(w0v[e] + acc[d][e])) - 0.5f;
                    decay[e] = fexp(-fexp(wlog));
                    av[e] = sigmoidf_(a0v[e] + acc[2 + d][e]);
                    kd[e] = k4[e] * (1.f + (av[e] - 1.f) * ka[e]);
                }
                if (live) {
                    *(f32x4*)(RECW + ((size_t)(d * 8 + wid) * NTOK + row) * 64 + ci) = decay;
                    bf16_t* rd = RECD + ((size_t)(d * 8 + wid) * NTOK + row) * 128 + ci;
                    const f32x4 bq = kq * av;
                    u32x2 w1, w2; w1[0] = pack_bf2(bq[0], bq[1]); w1[1] = pack_bf2(bq[2], bq[3]); w2[0] = pack_bf2(kd[0], kd[1]); w2[1] = pack_bf2(kd[2], kd[3]);
                    *(u32x2*)(rd) = w1; *(u32x2*)(rd + 64) = w2;
                    if (d == 0) {
                        bf16_t* rs = RECS + ((size_t)wid * NTOK + row) * 192 + ci;
                        u32x2 a1, a2, a3; a1[0] = pack_bf2(kq[0], kq[1]); a1[1] = pack_bf2(kq[2], kq[3]); a2[0] = pack_bf2(r4[0], r4[1]); a2[1] = pack_bf2(r4[2], r4[3]); a3[0] = pack_bf2(v4[0], v4[1]); a3[1] = pack_bf2(v4[2], v4[3]);
                        *(u32x2*)(rs) = a1; *(u32x2*)(rs + 64) = a2; *(u32x2*)(rs + 128) = a3;
                    }
                }
            }
        }
    }
}

constexpr int SC_TS = 16;
constexpr int SCAN_BLOCKS = 128;
constexpr int SC_OPB = SC_TS * 384;
constexpr int SC_SBW = SC_TS * 64 * 4;
constexpr int SC_LDS = (2 * SC_OPB + 2 * 2 * SC_SBW) * 4;
#define SC_LD(slot, s) { const float* b_ = buf + (s) * 384 + 4 * l16; qw[slot] = *(const f32x4*)(b_); qk[slot] = *(const f32x4*)(b_ + 64); \
    qb[slot] = *(const f32x4*)(b_ + 128); qd[slot] = *(const f32x4*)(b_ + 192); qv[slot] = buf[(s) * 384 + 320 + i]; }
__device__ __forceinline__ void scan_chunk(const float* buf, float* sb, int l16, int lane, int i, f32x4& S) {
    f32x4 qw[3], qk[3], qb[3], qd[3]; float qv[3];
    SC_LD(0, 0); SC_LD(1, 1);
#pragma unroll
    for (int s = 0; s < SC_TS; ++s) {
        const int sl = s % 3;
        if (s + 2 < SC_TS) SC_LD((s + 2) % 3, s + 2);
        const f32x4 pk = S * qk[sl];
        const float sa = -red16((pk[0] + pk[1]) + (pk[2] + pk[3]));
        S = (S * qw[sl] + qd[sl] * qv[sl]) + qb[sl] * sa;
        *(f32x4*)(sb + (s * 64 + lane) * 4) = S;
    }
}
#define SC_LOAD(R, ch) { const float* _g = rec + (size_t)(ch) * SC_OPB + lt * 4; _Pragma("unroll") for (int q = 0; q < 12; ++q) R[q] = *(const f32x4*)(_g + q * 512); }
#define SC_WRITE(R, B) { float* _l = (B) + lt * 4; _Pragma("unroll") for (int q = 0; q < 12; ++q) *(f32x4*)(_l + q * 512) = R[q]; }
__device__ __forceinline__ void phase_scan(const KP& p, int bid, char* smem) {
    const float* REC = (const float*)(p.ws + WS_REC);
    float* YD = (float*)(p.ws + WS_YD);
    float* B0 = (float*)smem;
    float* B1 = B0 + SC_OPB;
    float* SB0 = B1 + SC_OPB;
    float* SB1 = SB0 + 2 * SC_SBW;
    const int tid = otid(p.wb), wid = tid >> 6, lane = tid & 63, l16 = lane & 15;
    const int xcd = bid & 7, slot = bid >> 3, dh = xcd * 2 + (slot >> 3), rq = slot & 7;
    const int d = dh >> 3, h = dh & 7;
    const float* rec = REC + (size_t)dh * NTOK * 384;
    constexpr int NCH = NTOK / SC_TS;
    if (wid >= 6) {
        __syncthreads();
        for (int c = 0; c <= NCH; ++c) __syncthreads();
    } else if (wid >= 4) {
        const int lt = tid - 256;
        f32x4 R0[12], R1[12];
        SC_LOAD(R0, 0); SC_WRITE(R0, B0);
        SC_LOAD(R1, 1); SC_LOAD(R0, 2);
        __syncthreads();
        for (int c = 0; c < NCH; c += 2) {
            if (c + 1 < NCH) SC_WRITE(R1, B1);
            if (c + 3 < NCH) SC_LOAD(R1, c + 3);
            __syncthreads();
            if (c + 2 < NCH) SC_WRITE(R0, B0);
            if (c + 4 < NCH) SC_LOAD(R0, c + 4);
            __syncthreads();
        }
        __syncthreads();
    } else if (wid >= 2) {
        const int cw = wid - 2, dstep = d == 0 ? 1 : -1;
        float* yout = YD + (size_t)d * NTOK * RW + h * 64 + rq * 8 + cw * 4 + (lane >> 4);
        f32x4 rr[SC_TS];
#define SC_RLOAD(B) { _Pragma("unroll") for (int s = 0; s < SC_TS; ++s) rr[s] = *(const f32x4*)((B) + s * 384 + 256 + 4 * l16); }
#define SC_READOUT(SB, ch) { float yv = 0.f; \
            _Pragma("unroll") for (int s = 0; s < SC_TS; ++s) { const f32x4 sv = *(const f32x4*)((SB) + cw * SC_SBW + (s * 64 + lane) * 4); const f32x4 py = sv * rr[s]; \
                const float y = red16((py[0] + py[1]) + (py[2] + py[3])); yv = (l16 == s) ? y : yv; } \
            yout[(size_t)(scan_row(d, (ch) * SC_TS) + dstep * l16) * RW] = yv; }
        __syncthreads();
        SC_RLOAD(B0);
        __syncthreads();
        for (int c = 1; c < NCH; c += 2) {
            SC_READOUT(SB0, c - 1); SC_RLOAD(B1);
            __syncthreads();
            SC_READOUT(SB1, c);
            if (c + 1 < NCH) SC_RLOAD(B0);
            __syncthreads();
        }
    } else {
        const int i = rq * 8 + wid * 4 + (lane >> 4);
        f32x4 S = {0.f, 0.f, 0.f, 0.f};
        __syncthreads();
        for (int c = 0; c < NCH; c += 2) {
            scan_chunk(B0, SB0 + wid * SC_SBW, l16, lane, i, S);
            __syncthreads();
            scan_chunk(B1, SB1 + wid * SC_SBW, l16, lane, i, S);
            __syncthreads();
        }
        __syncthreads();
    }
}

constexpr int CK = 16, NCHK = NTOK / CK;
constexpr int FR_B = 12800;
constexpr int FR_AT = 0, FR_RT = 2048, FR_SM = 4096, FR_BT = 6144  , FR_VF = 10240, FR_GC = 12288;
template <int SH> __device__ __forceinline__ float row_shr1(float v) {
    return __int_as_float(__builtin_amdgcn_update_dpp(0x3f800000, __float_as_int(v), 0x110 + SH, 0xf, 0xf, false));
}
__device__ __forceinline__ bf16x8 frag8(const float (&v)[16], int q) {
    u32x4 w; w[0] = pack_bf2(v[4 * q], v[4 * q + 1]); w[1] = pack_bf2(v[4 * q + 2], v[4 * q + 3]); w[2] = pack_bf2(v[4 * q + 4], v[4 * q + 5]); w[3] = pack_bf2(v[4 * q + 6], v[4 * q + 7]);
    return __builtin_bit_cast(bf16x8, w);
}
__device__ __forceinline__ bf16x8 frag4(const f32x4 a) {
    u32x4 w; w[0] = pack_bf2(a[0], a[1]); w[1] = pack_bf2(a[2], a[3]); w[2] = 0u; w[3] = 0u;
    return __builtin_bit_cast(bf16x8, w);
}
__device__ __forceinline__ bf16x8 frag4u(unsigned lo, unsigned hi) { u32x4 w; w[0] = lo; w[1] = hi; w[2] = 0u; w[3] = 0u; return __builtin_bit_cast(bf16x8, w); }
#define MM(a, b, c) __builtin_amdgcn_mfma_f32_16x16x32_bf16(a, b, c, 0, 0, 0)
__device__ __forceinline__ void phase_cprep(const KP& p, int bid, int nb, char* smem) {
    const float* RECW = (const float*)(p.ws + WS_REC);
    const bf16_t* RECD = (const bf16_t*)(RECW + (size_t)16 * NTOK * 64);
    const bf16_t* RECS = RECD + (size_t)16 * NTOK * 128;
    char* FR = p.ws + WS_FR;
    const int tid = otid(p.wb), wid = tid >> 6, lane = tid & 63, t = lane & 15, g = lane >> 4;
    bf16_t* zt = (bf16_t*)smem + wid * 2048;
    const f32x4 Z4 = {0.f, 0.f, 0.f, 0.f};
    for (int u = bid * 8 + wid; u < 16 * NCHK; u += nb * 8) {
        const int dh = u / NCHK, c = u % NCHK;
        const int d = dh >> 3, hh = dh & 7;
        const int row = scan_row(d, c * CK + t);
        const float* pw = RECW + ((size_t)dh * NTOK + row) * 64;
        const bf16_t* pd = RECD + ((size_t)dh * NTOK + row) * 128;
        const bf16_t* ps = RECS + ((size_t)hh * NTOK + row) * 192;
        float w_[16], kk[16], bb[16], kd[16], rr[16];
#pragma unroll
        for (int q = 0; q < 4; ++q) {
            const int jo = 32 * (q >> 1) + 16 * (q & 1) + 4 * g;
            const f32x4 a0 = *(const f32x4*)(pw + jo);
            const u32x2 ub = *(const u32x2*)(pd + jo), uk = *(const u32x2*)(pd + 64 + jo), ukk = *(const u32x2*)(ps + jo), ur = *(const u32x2*)(ps + 64 + jo);
#pragma unroll
            for (int e = 0; e < 4; ++e) {
                w_[4 * q + e] = a0[e];
                bb[4 * q + e] = __uint_as_float((e & 1) ? (ub[e >> 1] & 0xffff0000u) : (ub[e >> 1] << 16));
                kd[4 * q + e] = __uint_as_float((e & 1) ? (uk[e >> 1] & 0xffff0000u) : (uk[e >> 1] << 16));
                kk[4 * q + e] = __uint_as_float((e & 1) ? (ukk[e >> 1] & 0xffff0000u) : (ukk[e >> 1] << 16));
                rr[4 * q + e] = __uint_as_float((e & 1) ? (ur[e >> 1] & 0xffff0000u) : (ur[e >> 1] << 16));
            }
        }
        float gam[16], At[16], Bh[16], Kh[16], Rt[16], Bt[16], Kt[16];
#pragma unroll
        for (int k = 0; k < 16; ++k) {
            float x = w_[k];
            x *= row_shr1<1>(x); x *= row_shr1<2>(x); x *= row_shr1<4>(x); x *= row_shr1<8>(x);
            gam[k] = x;
        }
#pragma unroll
        for (int k = 0; k < 16; ++k) {
            const float gp = row_shr1<1>(gam[k]), gc = bperm(gam[k], (lane & 48) | 15), ig = frcp(gam[k]);
            At[k] = kk[k] * gp; Bh[k] = bb[k] * ig; Kh[k] = kd[k] * ig; Rt[k] = rr[k] * gam[k];
            Bt[k] = -Bh[k] * gc; Kt[k] = Kh[k] * gc;
        }
        const bf16x8 fA0 = frag8(At, 0), fA1 = frag8(At, 2), fB0 = frag8(Bh, 0), fB1 = frag8(Bh, 2), fK0 = frag8(Kh, 0), fK1 = frag8(Kh, 2), fR0 = frag8(Rt, 0), fR1 = frag8(Rt, 2);
        f32x4 X = MM(fA1, fB1, MM(fA0, fB0, Z4));
        f32x4 XT = MM(fB1, fA1, MM(fB0, fA0, Z4));
        f32x4 Lak = MM(fA1, fK1, MM(fA0, fK0, Z4));
        f32x4 LrbT = MM(fB1, fR1, MM(fB0, fR0, Z4));
        f32x4 LrkT = MM(fK1, fR1, MM(fK0, fR0, Z4));
        f32x4 T, TT;
#pragma unroll
        for (int r = 0; r < 4; ++r) {
            const int row = 4 * g + r;
            X[r] = t < row ? -X[r] : 0.f;
            XT[r] = row < t ? -XT[r] : 0.f;
            Lak[r] = t < row ? Lak[r] : 0.f;
            LrbT[r] = row <= t ? -LrbT[r] : 0.f;
            LrkT[r] = row <= t ? LrkT[r] : 0.f;
            const float id = row == t ? 1.f : 0.f;
            T[r] = id + X[r]; TT[r] = id + XT[r];
        }
#pragma unroll
        for (int it = 0; it < 3; ++it) {
            const f32x4 X2 = MM(frag4(XT), frag4(X), Z4), X2T = MM(frag4(X), frag4(XT), Z4);
            const f32x4 Tn = MM(frag4(TT), frag4(X2), T), TTn = MM(frag4(X2), frag4(TT), TT);
            X = X2; XT = X2T; T = Tn; TT = TTn;
        }
        const f32x4 TLT = MM(frag4(Lak), frag4(TT), Z4);
#pragma unroll
        for (int q = 0; q < 4; ++q)
#pragma unroll
            for (int e = 0; e < 4; ++e) {
                const int j = 32 * (q >> 1) + 16 * (q & 1) + 4 * g + e;
                zt[j * 16 + t] = f2bf(Bt[4 * q + e]); zt[1024 + j * 16 + t] = f2bf(Kt[4 * q + e]);
            }
        char* fb = FR + ((size_t)dh * NCHK + c) * FR_B;
        *(bf16x8*)(fb + FR_AT + lane * 16) = fA0; *(bf16x8*)(fb + FR_AT + 1024 + lane * 16) = fA1;
        *(bf16x8*)(fb + FR_RT + lane * 16) = fR0; *(bf16x8*)(fb + FR_RT + 1024 + lane * 16) = fR1;
        {
            u32x4 s0, s1;
            s0[0] = pack_bf2(TT[0], TT[1]); s0[1] = pack_bf2(TT[2], TT[3]); s0[2] = pack_bf2(TLT[0], TLT[1]); s0[3] = pack_bf2(TLT[2], TLT[3]);
            s1[0] = pack_bf2(LrbT[0], LrbT[1]); s1[1] = pack_bf2(LrbT[2], LrbT[3]); s1[2] = pack_bf2(LrkT[0], LrkT[1]); s1[3] = pack_bf2(LrkT[2], LrkT[3]);
            *(u32x4*)(fb + FR_SM + lane * 32) = s0; *(u32x4*)(fb + FR_SM + lane * 32 + 16) = s1;
        }
#pragma unroll
        for (int jt = 0; jt < 4; ++jt) {
            {
                const u32x2 b2 = *(const u32x2*)(zt + (16 * jt + t) * 16 + 4 * g), k2 = *(const u32x2*)(zt + 1024 + (16 * jt + t) * 16 + 4 * g);
                u32x4 bk; bk[0] = b2[0]; bk[1] = b2[1]; bk[2] = k2[0]; bk[3] = k2[1];
                *(u32x4*)(fb + FR_BT + jt * 1024 + lane * 16) = bk;
            }
            const int dstp = d == 0 ? 1 : -1;
            const bf16_t* vp = RECS + ((size_t)hh * NTOK + scan_row(d, c * CK + 4 * g)) * 192 + 128 + 16 * jt + t;
            u32x2 vw; vw[0] = (unsigned)vp[0] | ((unsigned)vp[dstp * 192] << 16); vw[1] = (unsigned)vp[2 * dstp * 192] | ((unsigned)vp[3 * dstp * 192] << 16);
            *(u32x2*)(fb + FR_VF + jt * 512 + lane * 8) = vw;
        }
        if (t == 15) {
#pragma unroll
            for (int q = 0; q < 4; ++q) { f32x4 gv = {gam[4 * q], gam[4 * q + 1], gam[4 * q + 2], gam[4 * q + 3]}; *(f32x4*)(fb + FR_GC + (32 * (q >> 1) + 16 * (q & 1) + 4 * g) * 4) = gv; }
        }
    }
}

constexpr int CS_BLOCKS = 16, CS_R = 3;
__device__ __forceinline__ void phase_cscan(const KP& p, int bid, char* smem) {
    const char* FRs = p.ws + WS_FR + (size_t)bid * NCHK * FR_B;
    float* YD = (float*)(p.ws + WS_YD);
    const int tid = otid(p.wb), wid = tid >> 6, lane = tid & 63, c16 = lane & 15, g = lane >> 4;
    const int d = bid >> 3, h = bid & 7;
    if (wid >= 4) {
        const int lw = wid - 4;
        const bool tail = lw == 0;
        u32x4 fifo[16][3]; unsigned ftl[16];
#define CS_LD(k, ch) { const char* _s = FRs + (size_t)(ch) * FR_B + lane * 16; \
            _Pragma("unroll") for (int _q = 0; _q < 3; ++_q) fifo[k][_q] = *(const u32x4*)(_s + (lw + 4 * _q) * 1024); \
            if (tail) ftl[k] = *(const unsigned*)(FRs + (size_t)(ch) * FR_B + 12288 + lane * 4); }
#define CS_WR(k, ch) { char* _d = smem + ((ch) % CS_R) * FR_B + lane * 16; \
            _Pragma("unroll") for (int _q = 0; _q < 3; ++_q) *(u32x4*)(_d + (lw + 4 * _q) * 1024) = fifo[k][_q]; \
            if (tail) *(unsigned*)(smem + ((ch) % CS_R) * FR_B + 12288 + lane * 4) = ftl[k]; }
#define CS_BAR() { asm volatile("" ::: "memory"); __builtin_amdgcn_s_barrier(); asm volatile("" ::: "memory"); }
#define CS_PERIOD(r) { if (pch + (r) + 1 < NCHK) CS_WR(((r) + 1) & 15, pch + (r) + 1); if (pch + (r) + 17 < NCHK) CS_LD(((r) + 1) & 15, pch + (r) + 17); CS_BAR(); }
        CS_LD(0, 0); CS_LD(1, 1); CS_LD(2, 2); CS_LD(3, 3); CS_LD(4, 4); CS_LD(5, 5); CS_LD(6, 6); CS_LD(7, 7);
        CS_LD(8, 8); CS_LD(9, 9); CS_LD(10, 10); CS_LD(11, 11); CS_LD(12, 12); CS_LD(13, 13); CS_LD(14, 14); CS_LD(15, 15);
        CS_WR(0, 0); CS_LD(0, 16);
        CS_BAR();
        for (int pch = 0; pch < NCHK; pch += 16) {
            CS_PERIOD(0); CS_PERIOD(1); CS_PERIOD(2); CS_PERIOD(3); CS_PERIOD(4); CS_PERIOD(5); CS_PERIOD(6); CS_PERIOD(7);
            CS_PERIOD(8); CS_PERIOD(9); CS_PERIOD(10); CS_PERIOD(11); CS_PERIOD(12); CS_PERIOD(13); CS_PERIOD(14); CS_PERIOD(15);
        }
    } else {
        const int it = wid, dstep = d == 0 ? 1 : -1;
        float* yout = YD + (size_t)d * NTOK * RW + h * 64 + it * 16 + c16;
        const f32x4 Z4 = {0.f, 0.f, 0.f, 0.f};
        f32x4 ST[4] = {Z4, Z4, Z4, Z4};
        asm volatile("" ::: "memory"); __builtin_amdgcn_s_barrier(); asm volatile("" ::: "memory");
        for (int pch = 0; pch < NCHK; ++pch) {
            const char* sb = smem + (pch % CS_R) * FR_B;
            const bf16x8 A0 = *(const bf16x8*)(sb + FR_AT + lane * 16), A1 = *(const bf16x8*)(sb + FR_AT + 1024 + lane * 16);
            const bf16x8 R0 = *(const bf16x8*)(sb + FR_RT + lane * 16), R1 = *(const bf16x8*)(sb + FR_RT + 1024 + lane * 16);
            const bf16x8 TTL = *(const bf16x8*)(sb + FR_SM + lane * 32), LRR = *(const bf16x8*)(sb + FR_SM + lane * 32 + 16);
            const u32x2 vf = *(const u32x2*)(sb + FR_VF + it * 512 + lane * 8);
            u32x4 b0, b1;
            b0[0] = pack_bf2(ST[0][0], ST[0][1]); b0[1] = pack_bf2(ST[0][2], ST[0][3]); b0[2] = pack_bf2(ST[1][0], ST[1][1]); b0[3] = pack_bf2(ST[1][2], ST[1][3]);
            b1[0] = pack_bf2(ST[2][0], ST[2][1]); b1[1] = pack_bf2(ST[2][2], ST[2][3]); b1[2] = pack_bf2(ST[3][0], ST[3][1]); b1[3] = pack_bf2(ST[3][2], ST[3][3]);
            const bf16x8 Bs0 = __builtin_bit_cast(bf16x8, b0), Bs1 = __builtin_bit_cast(bf16x8, b1);
            const f32x4 Q = MM(A1, Bs1, MM(A0, Bs0, Z4));
            u32x4 qv; qv[0] = pack_bf2(Q[0], Q[1]); qv[1] = pack_bf2(Q[2], Q[3]); qv[2] = vf[0]; qv[3] = vf[1];
            const f32x4 P = MM(TTL, __builtin_bit_cast(bf16x8, qv), Z4);
            u32x4 pv; pv[0] = pack_bf2(P[0], P[1]); pv[1] = pack_bf2(P[2], P[3]); pv[2] = vf[0]; pv[3] = vf[1];
            const bf16x8 PV = __builtin_bit_cast(bf16x8, pv);
            const f32x4 Y = MM(LRR, PV, MM(R1, Bs1, MM(R0, Bs0, Z4)));
#pragma unroll
            for (int jt = 0; jt < 4; ++jt) {
                const f32x4 gc = *(const f32x4*)(sb + FR_GC + (16 * jt + 4 * g) * 4);
                const bf16x8 bk = *(const bf16x8*)(sb + FR_BT + jt * 1024 + lane * 16);
                ST[jt] = MM(bk, PV, ST[jt] * gc);
            }
            const int row0 = scan_row(d, pch * CK) + dstep * 4 * g;
#pragma unroll
            for (int r = 0; r < 4; ++r) yout[(size_t)(row0 + dstep * r) * RW] = Y[r];
            asm volatile("" ::: "memory"); __builtin_amdgcn_s_barrier(); asm volatile("" ::: "memory");
        }
    }
}
#undef MM

__device__ __forceinline__ void phase_rwpost(const KP& p, int l, int bid, int nb) {
    const float* YD = (const float*)(p.ws + WS_YD);
    const float* G = (const float*)(p.ws + WS_G);
    const float* BV = (const float*)(p.ws + WS_BV);
    bf16_t* Y = (bf16_t*)(p.ws + WS_YCAT);
    const float* lng = p.rw_ln_g + (size_t)l * RW;
    const float* lnb = p.rw_ln_b + (size_t)l * RW;
    const int tid = otid(p.wb), wid = tid >> 6, lane = tid & 63;
#pragma unroll 2
    for (int u = bid * 8 + wid; u < NTOK * 2; u += nb * 8) {
        const int row = u >> 1, c = (u & 1) * 256 + lane * 4;
        const f32x4 y = *(const f32x4*)(YD + (size_t)row * RW + c) + *(const f32x4*)(YD + ((size_t)NTOK + row) * RW + c);
        const f32x4 bv = *(const f32x4*)(BV + (size_t)row * RW + c), gt = *(const f32x4*)(G + (size_t)row * RW + c);
        const f32x4 lg = *(const f32x4*)(lng + c), lb = *(const f32x4*)(lnb + c);
        const float mean = red16((y[0] + y[1]) + (y[2] + y[3])) * (1.f / 64);
        const f32x4 dv = y - mean;
        const float var = red16((dv[0] * dv[0] + dv[1] * dv[1]) + (dv[2] * dv[2] + dv[3] * dv[3])) * (1.f / 64);
        const float rs = rsqrtf(var + 64e-5f);
        float o[4];
#pragma unroll
        for (int e = 0; e < 4; ++e) o[e] = (dv[e] * rs * lg[e] + lb[e] + bv[e]) * gt[e];
        u32x2 w; w[0] = pack_bf2(o[0], o[1]); w[1] = pack_bf2(o[2], o[3]);
        *(u32x2*)(Y + (size_t)row * D + c) = w;
    }
}

constexpr int GM_LD = 136;
__device__ __forceinline__ void phase_gmlp(const KP& p, int l, int bid, int nb, char* smem) {
    const float* P = (const float*)(p.ws + WS_P);
    const float* GMR = (const float*)(p.ws + WS_GMR);
    bf16_t* Y = (bf16_t*)(p.ws + WS_YCAT);
    bf16_t* vt = (bf16_t*)smem;
    const float* ng = p.gm_norm_g + (size_t)l * GMW;
    const int tid = otid(p.wb), wid = tid >> 6, lane = tid & 63, r = lane & 31, h = lane >> 5, mt = wid >> 1, nt = wid & 1;
    for (int u = bid; u < (NTOK / 128) * 8; u += nb) {
        const int n = u >> 3, g = u & 7, t0 = n * 128;
        const float* ws = p.gm_ws + ((size_t)l * 8 + g) * 128 * 128;
        const float* bs = p.gm_b + ((size_t)l * 8 + g) * 128;
        __syncthreads();
        {
            const int c = tid & 63, qp0 = tid >> 6;
            const float gn = ng[g * 64 + c];
#pragma unroll
            for (int i = 0; i < 8; ++i) {
                const int q = (qp0 + 8 * i) * 2;
                const float v0 = gelu_tanh(P[(size_t)(t0 + q) * INP + COL_GM + GMW + g * 64 + c]) * GMR[t0 + q] * gn;
                const float v1 = gelu_tanh(P[(size_t)(t0 + q + 1) * INP + COL_GM + GMW + g * 64 + c]) * GMR[t0 + q + 1] * gn;
                *(unsigned*)(vt + c * GM_LD + q) = pack_bf2(v0, v1);
            }
        }
        __syncthreads();
        f32x16 acc;
#pragma unroll
        for (int i = 0; i < 16; ++i) acc[i] = 0.f;
        const float* arow = ws + (size_t)(mt * 32 + r) * 128 + h * 8;
#pragma unroll
        for (int ks = 0; ks < 8; ++ks) {
            const f32x4 a0 = *(const f32x4*)(arow + ks * 16), a1 = *(const f32x4*)(arow + ks * 16 + 4);
            u32x4 aw; aw[0] = pack_bf2(a0[0], a0[1]); aw[1] = pack_bf2(a0[2], a0[3]); aw[2] = pack_bf2(a1[0], a1[1]); aw[3] = pack_bf2(a1[2], a1[3]);
            const bf16x8 bfr = *(const bf16x8*)(vt + (nt * 32 + r) * GM_LD + ks * 16 + h * 8);
            acc = __builtin_amdgcn_mfma_f32_32x32x16_bf16(__builtin_bit_cast(bf16x8, aw), bfr, acc, 0, 0, 0);
        }
        const int c = nt * 32 + r;
#pragma unroll
        for (int i = 0; i < 16; ++i) {
            const int pp = mt * 32 + (i & 3) + 8 * (i >> 2) + 4 * h;
            const float uu = gelu_tanh(P[(size_t)(t0 + pp) * INP + COL_GM + g * 64 + c]);
            Y[(size_t)(t0 + pp) * D + 512 + g * 64 + c] = f2bf(uu * (acc[i] + bs[pp]));
        }
    }
}

__device__ __forceinline__ void phase_atprep(const KP& p, int l, int bid, int nb, char* smem) {
    const float* P = (const float*)(p.ws + WS_P);
    bf16_t* Qb = (bf16_t*)(p.ws + WS_Q);
    bf16_t* Kb = (bf16_t*)(p.ws + WS_K);
    bf16_t* VT = Kb + (size_t)NTOK * 256;
    const float* qn = p.at_qn + (size_t)l * 64;
    const float* kn = p.at_kn + (size_t)l * 64;
    const int tid = otid(p.wb);
    const float* rope = (const float*)(p.ws + WS_ROPE);
#pragma unroll 2
    for (int i = bid * NT + tid; i < NTOK * 80; i += nb * NT) {
        const int vec = i >> 2, j = i & 3, row = vec / 20, hv = vec % 20;
        const bool isq = hv < 16;
        const float* src = P + (size_t)row * INP + (isq ? COL_AT + hv * 64 : COL_K + (hv - 16) * 64) + 4 * j;
        const float* gn = (isq ? qn : kn) + 4 * j;
        f32x4 x[4]; float ss = 0.f;
#pragma unroll
        for (int m = 0; m < 4; ++m) { x[m] = *(const f32x4*)(src + 16 * m); ss += x[m][0] * x[m][0] + x[m][1] * x[m][1] + x[m][2] * x[m][2] + x[m][3] * x[m][3]; }
        ss += dppf<0xB1>(ss); ss += dppf<0x4E>(ss);
        const float sc = rsqrtf(ss * (1.f / 64) + 1e-6f) * (isq ? 0.125f : 1.f);
#pragma unroll
        for (int m = 0; m < 4; ++m) x[m] = x[m] * *(const f32x4*)(gn + 16 * m) * sc;
        if (row < SEQ) {
#pragma unroll
            for (int sec = 0; sec < 2; ++sec) {
                const float* rt = rope + (size_t)((sec == 0 ? (row >> 6) : (128 + (row & 63))) * 16) * 2;
                const f32x4 c0 = *(const f32x4*)(rt + 8 * j), c1 = *(const f32x4*)(rt + 8 * j + 4);
                f32x4& a = x[2 * sec]; f32x4& b2 = x[2 * sec + 1];
                const float cs[4] = {c0[0], c0[2], c1[0], c1[2]}, sn[4] = {c0[1], c0[3], c1[1], c1[3]};
#pragma unroll
                for (int e = 0; e < 4; ++e) { const float x1 = a[e], x2 = b2[e]; a[e] = x1 * cs[e] - x2 * sn[e]; b2[e] = x2 * cs[e] + x1 * sn[e]; }
            }
        }
        bf16_t* dst = (isq ? (Qb + (size_t)row * 1024 + hv * 64) : (Kb + (size_t)row * 256 + (hv - 16) * 64)) + 4 * j;
#pragma unroll
        for (int m = 0; m < 4; ++m) { u32x2 w; w[0] = pack_bf2(x[m][0], x[m][1]); w[1] = pack_bf2(x[m][2], x[m][3]); *(u32x2*)(dst + 16 * m) = w; }
    }
    float* tile = (float*)smem;
    for (int u = bid; u < (NTOK / 64) * 4; u += nb) {
        const int t0 = (u >> 2) * 64, kvh = u & 3;
        __syncthreads();
        {
            const int tok = tid >> 3, d8 = (tid & 7) * 8;
            const float* src = P + (size_t)(t0 + tok) * INP + COL_V + kvh * 64 + d8;
            const f32x4 a = *(const f32x4*)src, b2 = *(const f32x4*)(src + 4);
#pragma unroll
            for (int i = 0; i < 4; ++i) { tile[tok * 65 + d8 + i] = a[i]; tile[tok * 65 + d8 + 4 + i] = b2[i]; }
        }
        __syncthreads();
        {
            const int d = tid >> 3, tk = (tid & 7) * 8;
            u32x4 w;
#pragma unroll
            for (int i = 0; i < 4; ++i) w[i] = pack_bf2(tile[(tk + 2 * i) * 65 + d], tile[(tk + 2 * i + 1) * 65 + d]);
            *(u32x4*)(VT + (size_t)(kvh * 64 + d) * NTOK + t0 + tk) = w;
        }
    }
}

constexpr int AT_LD = 72;
constexpr int AT_TILE = 64 * AT_LD;
__device__ __forceinline__ void phase_attn(const KP& p, int l, int bid, int nb, char* smem) {
    const bf16_t* Qb = (const bf16_t*)(p.ws + WS_Q);
    const bf16_t* Kb = (const bf16_t*)(p.ws + WS_K);
    const bf16_t* VT = Kb + (size_t)NTOK * 256;
    bf16_t* Y = (bf16_t*)(p.ws + WS_YCAT);
    bf16_t* Kc = (bf16_t*)smem;
    bf16_t* Vc = Kc + AT_TILE;
    const int tid = otid(p.wb), wid = tid >> 6, lane = tid & 63, q = lane & 31, h = lane >> 5, g = wid >> 1, qh = wid & 1;
    const int srow = tid >> 3, sseg = tid & 7;
    const int voff = srow * AT_LD + (sseg >> 2) * 32 + ((sseg >> 1) & 1) * 16 + (sseg & 1) * 4;
    for (int u = bid; u < (NTOK / 64) * 4; u += nb) {
        const int qt = u >> 2, kvh = u & 3, t0 = qt * 64, head = kvh * 4 + g, qrow = t0 + qh * 32 + q;
        int c_lo = 0, n_local = 0;
        if (t0 < SEQ) { c_lo = 2 - (t0 >> 6); if (c_lo < 0) c_lo = 0; int c_hi = (SEQ + 64 - t0) >> 6; if (c_hi > 4) c_hi = 4; n_local = c_hi - c_lo + 1; }
        const int nch = n_local + 4;
        bf16x8 qf[4];
#pragma unroll
        for (int ks = 0; ks < 4; ++ks) qf[ks] = *(const bf16x8*)(Qb + (size_t)qrow * 1024 + head * 64 + ks * 16 + h * 8);
        f32x16 O0, O1;
#pragma unroll
        for (int r = 0; r < 16; ++r) { O0[r] = 0.f; O1[r] = 0.f; }
        float m = p.at_sink[(size_t)l * 16 + head], lsum = h == 0 ? 1.f : 0.f;
        u32x4 rk, rv;
        {
            const int k0 = n_local > 0 ? (t0 - 128 + 64 * c_lo) : SEQ;
            rk = *(const u32x4*)(Kb + (size_t)(k0 + srow) * 256 + kvh * 64 + sseg * 8);
            rv = *(const u32x4*)(VT + (size_t)(kvh * 64 + srow) * NTOK + k0 + sseg * 8);
        }
        for (int ci = 0; ci < nch; ++ci) {
            const bool local = ci < n_local;
            const int k0 = local ? (t0 - 128 + 64 * (c_lo + ci)) : (SEQ + 64 * (ci - n_local));
            __syncthreads();
            *(u32x4*)(Kc + srow * AT_LD + sseg * 8) = rk;
            { u32x2 lo, hi; lo[0] = rv[0]; lo[1] = rv[1]; hi[0] = rv[2]; hi[1] = rv[3]; *(u32x2*)(Vc + voff) = lo; *(u32x2*)(Vc + voff + 8) = hi; }
            __syncthreads();
            if (ci + 1 < nch) {
                const int kn = (ci + 1 < n_local) ? (t0 - 128 + 64 * (c_lo + ci + 1)) : (SEQ + 64 * (ci + 1 - n_local));
                rk = *(const u32x4*)(Kb + (size_t)(kn + srow) * 256 + kvh * 64 + sseg * 8);
                rv = *(const u32x4*)(VT + (size_t)(kvh * 64 + srow) * NTOK + kn + sseg * 8);
            }
            f32x16 s0, s1;
#pragma unroll
            for (int r = 0; r < 16; ++r) { s0[r] = 0.f; s1[r] = 0.f; }
#pragma unroll
            for (int ks = 0; ks < 4; ++ks) {
                const bf16x8 k0f = *(const bf16x8*)(Kc + q * AT_LD + ks * 16 + h * 8);
                const bf16x8 k1f = *(const bf16x8*)(Kc + (32 + q) * AT_LD + ks * 16 + h * 8);
                s0 = __builtin_amdgcn_mfma_f32_32x32x16_bf16(k0f, qf[ks], s0, 0, 0, 0);
                s1 = __builtin_amdgcn_mfma_f32_32x32x16_bf16(k1f, qf[ks], s1, 0, 0, 0);
            }
            if (local) {
                const int base = k0 + 4 * h - qrow;
#pragma unroll
                for (int r = 0; r < 16; ++r) {
                    const int d0 = base + (r & 3) + 8 * (r >> 2), d1 = d0 + 32;
                    if (d0 > 128 || d0 < -128) s0[r] = -INFINITY;
                    if (d1 > 128 || d1 < -128) s1[r] = -INFINITY;
                }
            }
            float mx = fmaxf(s0[0], s1[0]);
#pragma unroll
            for (int r = 1; r < 16; ++r) mx = fmaxf(mx, fmaxf(s0[r], s1[r]));
            mx = fmaxf(mx, bperm(mx, lane ^ 32));
            const float mnew = fmaxf(m, mx);
            const float alpha = __expf(m - mnew);
            m = mnew; lsum *= alpha;
#pragma unroll
            for (int r = 0; r < 16; ++r) { O0[r] *= alpha; O1[r] *= alpha; }
            float ps = 0.f;
#pragma unroll
            for (int r = 0; r < 16; ++r) { s0[r] = __expf(s0[r] - m); s1[r] = __expf(s1[r] - m); ps += s0[r] + s1[r]; }
            lsum += ps;
            bf16x8 pf[2][2];
#pragma unroll
            for (int s = 0; s < 2; ++s) {
                u32x4 w0, w1;
#pragma unroll
                for (int i = 0; i < 4; ++i) { w0[i] = pack_bf2(s0[8 * s + 2 * i], s0[8 * s + 2 * i + 1]); w1[i] = pack_bf2(s1[8 * s + 2 * i], s1[8 * s + 2 * i + 1]); }
                pf[0][s] = __builtin_bit_cast(bf16x8, w0); pf[1][s] = __builtin_bit_cast(bf16x8, w1);
            }
#pragma unroll
            for (int kb = 0; kb < 2; ++kb)
#pragma unroll
                for (int s = 0; s < 2; ++s) {
                    const bf16x8 v0f = *(const bf16x8*)(Vc + q * AT_LD + kb * 32 + s * 16 + h * 8);
                    const bf16x8 v1f = *(const bf16x8*)(Vc + (32 + q) * AT_LD + kb * 32 + s * 16 + h * 8);
                    O0 = __builtin_amdgcn_mfma_f32_32x32x16_bf16(v0f, pf[kb][s], O0, 0, 0, 0);
                    O1 = __builtin_amdgcn_mfma_f32_32x32x16_bf16(v1f, pf[kb][s], O1, 0, 0, 0);
                }
        }
        lsum += bperm(lsum, lane ^ 32);
        const float inv = 1.f / lsum;
        bf16_t* yo = Y + (size_t)qrow * D + 1024 + head * 64 + 4 * h;
#pragma unroll
        for (int rg = 0; rg < 4; ++rg) {
            u32x2 w0, w1;
            w0[0] = pack_bf2(O0[4 * rg] * inv, O0[4 * rg + 1] * inv); w0[1] = pack_bf2(O0[4 * rg + 2] * inv, O0[4 * rg + 3] * inv);
            w1[0] = pack_bf2(O1[4 * rg] * inv, O1[4 * rg + 1] * inv); w1[1] = pack_bf2(O1[4 * rg + 2] * inv, O1[4 * rg + 3] * inv);
            *(u32x2*)(yo + 8 * rg) = w0;
            *(u32x2*)(yo + 32 + 8 * rg) = w1;
        }
    }
}

__device__ __forceinline__ void phase_oproj(const KP& p, int l, int bid, int nb, bf16_t* shm) {
    const bf16_t* Y = (const bf16_t*)(p.ws + WS_YCAT);
    const bf16_t* Bt = (const bf16_t*)(p.ws + WS_WOT) + (size_t)l * D * D;
    const RowSrc in = layer_in(p, l);
    const RowDst out = layer_out(p, l);
    const int nM = ntok_of(l) / 256, nN = D / 256, nwg = nM * nN;
    gemm_phase<false>(nwg, bid, nb, D, shm, p.wb,
        [&](int L) { int pm, pn; dense_tile(xcd_remap(L, nwg), nM, nN, pm, pn); GU u; u.A = Y; u.Bt = Bt + (size_t)(pn * 256) * D; u.i0 = pm * 256; u.i1 = pn * 256; u.i2 = 0; u.i3 = 0; return u; },
        [&](const GU& u, int r) { return (u.i0 + r) * D; },
        [&](const GU& u, f32x4 (&acc)[2][2][4][2]) {
            const int m0 = u.i0, n0 = u.i1;
            G_IDX;
#pragma unroll
            for (int ai = 0; ai < 2; ++ai)
#pragma unroll
                for (int m = 0; m < 4; ++m) {
                    const int row = m0 + ai * 128 + wr * 64 + m * 16 + fr;
                    const float* xi = rowp(in, row);
                    float* xo = rowp(out, row);
                    const float* g1 = modp(p, l, row, 2);
#pragma unroll
                    for (int bj = 0; bj < 2; ++bj)
#pragma unroll
                        for (int n = 0; n < 2; ++n) {
                            const int col = n0 + bj * 128 + wc * 32 + n * 16 + fq * 4;
                            *(f32x4*)(xo + col) = *(const f32x4*)(xi + col) + *(const f32x4*)(g1 + col) * acc[ai][bj][m][n];
                        }
                }
            return 32;
        });
}

constexpr int RT_R = 33;
constexpr int RT_C = 48;
__device__ __forceinline__ void phase_norm2_route(const KP& p, int l, int bid, int nb, char* smem, const bool dummy = false) {
    const RowDst xs = layer_out(p, l);
    bf16_t* H = (bf16_t*)(p.ws + WS_H);
    bf16_t* HL = (bf16_t*)(p.ws + WS_P);
    int* wcnt = (int*)(p.ws + WS_MODP);
    int* tokE = (int*)(p.ws + WS_TOKE);
    int* tokP = (int*)(p.ws + WS_TOKP);
    float* tokW = (float*)(p.ws + WS_TOKW);
    const float* g = p.norm2_g + (size_t)l * D;
    const bf16_t* RTH = (const bf16_t*)(p.ws + WS_RT) + (size_t)l * 2 * NE * D;
    const bf16_t* RTL = RTH + (size_t)NE * D;
    const float* rbias = p.moe_bias + (size_t)l * NE;
    float* part = (float*)smem;
    float* mA = (float*)smem;
    float* mB = mA + 2 * D;
    int* lcnt = (int*)(part + 8 * 64 * RT_C);
    const int tid = otid(p.wb), wid = tid >> 6, lane = tid & 63, c16 = lane & 15, g4 = lane >> 4;
    const int ntok = ntok_of(l), nsteps = (ntok + RT_R - 1) / RT_R;
    __syncthreads();
    if (tid < 64) lcnt[tid] = 0;
    int step = 0;
    for (int blk = bid; blk < nsteps; blk += nb, ++step) {
        const int t0 = blk * RT_R;
        __syncthreads();
        auto issue = [&](f32x4 (&v)[2][8], const int q0) {
#pragma unroll
            for (int q = 0; q < 2; ++q) {
                const int rr = wid + 8 * (q0 + q);
                const int row = (rr < RT_R && t0 + rr < ntok) ? t0 + rr : t0;
                const float* xr = rowp(xs, row);
#pragma unroll
                for (int i = 0; i < 8; ++i) v[q][i] = *(const f32x4*)(xr + i * 256 + lane * 4);
            }
        };
        auto proc = [&](f32x4 (&v)[2][8], const int q0) {
            int rowq[2]; bool liveq[2]; const float* maq[2]; const float* mbq[2]; float rstd[2];
#pragma unroll
            for (int q = 0; q < 2; ++q) {
                const int rr = wid + 8 * (q0 + q);
                liveq[q] = rr < RT_R && t0 + rr < ntok;
                rowq[q] = liveq[q] ? t0 + rr : t0;
                maq[q] = mA + (rowq[q] < SEQ ? 0 : D); mbq[q] = mB + (rowq[q] < SEQ ? 0 : D);
                float ss = 0.f;
#pragma unroll
                for (int i = 0; i < 8; ++i) ss += v[q][i][0] * v[q][i][0] + v[q][i][1] * v[q][i][1] + v[q][i][2] * v[q][i][2] + v[q][i][3] * v[q][i][3];
                rstd[q] = rsqrtf(wave_sum(ss) * (1.f / D) + 1e-6f);
            }
#pragma unroll
            for (int i = 0; i < 8; ++i) {
                const int c = i * 256 + lane * 4;
#pragma unroll
                for (int q = 0; q < 2; ++q) {
                    const f32x4 av = *(const f32x4*)(maq[q] + c), bv = *(const f32x4*)(mbq[q] + c);
                    float o[4]; unsigned hi[4]; float lo[4];
#pragma unroll
                    for (int j = 0; j < 4; ++j) { o[j] = fmaf(v[q][i][j] * rstd[q], av[j], bv[j]); hi[j] = f2bf(o[j]); lo[j] = o[j] - __uint_as_float(hi[j] << 16); }
                    u32x2 wh, wl; wh[0] = hi[0] | (hi[1] << 16); wh[1] = hi[2] | (hi[3] << 16); wl[0] = pack_bf2(lo[0], lo[1]); wl[1] = pack_bf2(lo[2], lo[3]);
                    if (liveq[q]) { *(u32x2*)(H + (size_t)rowq[q] * D + c) = wh; *(u32x2*)(HL + (size_t)rowq[q] * D + c) = wl; }
                }
            }
        };
        f32x4 va[2][8], vb[2][8];
        issue(va, 0);
        for (int i = tid; i < 2 * (D / 4); i += NT) {
            const int si = i / (D / 4), c = (i % (D / 4)) * 4;
            const f32x4 gv = *(const f32x4*)(g + c), shv = *(const f32x4*)(modp(p, l, si ? SEQ : 0, 3) + c), scv = *(const f32x4*)(modp(p, l, si ? SEQ : 0, 4) + c);
            *(f32x4*)(mA + si * D + c) = gv * scv + gv;
            *(f32x4*)(mB + si * D + c) = shv;
        }
        __syncthreads();
        issue(vb, 2);
        proc(va, 0);
        if (wid == 0) issue(va, 4);
        proc(vb, 2);
        if (wid == 0) proc(va, 4);
        __syncthreads();
        {
            f32x4 acc[4][3];
#pragma unroll
            for (int et = 0; et < 4; ++et)
#pragma unroll
                for (int ct = 0; ct < 3; ++ct) acc[et][ct] = (f32x4){0.f, 0.f, 0.f, 0.f};
            unsigned bo[3];
#pragma unroll
            for (int ct = 0; ct < 3; ++ct) {
                int hr = 16 * ct + c16; hr = hr < RT_R ? hr : RT_R - 1;
                int row = t0 + hr; row = row < ntok ? row : ntok - 1;
                bo[ct] = (unsigned)row * D + wid * 256 + g4 * 8;
            }
            const bf16_t* ah = RTH + (size_t)(wid * 8) * 2048 + lane * 8;
            const bf16_t* al = RTL + (size_t)(wid * 8) * 2048 + lane * 8;
#pragma unroll 2
            for (int ks = 0; ks < 8; ++ks) {
                bf16x8 bhf[3], blf[3];
#pragma unroll
                for (int ct = 0; ct < 3; ++ct) { bhf[ct] = *(const bf16x8*)(H + bo[ct] + ks * 32); blf[ct] = *(const bf16x8*)(HL + bo[ct] + ks * 32); }
#pragma unroll
                for (int et = 0; et < 4; ++et) {
                    const bf16x8 ahf = *(const bf16x8*)(ah + (ks * 4 + et) * 512), alf = *(const bf16x8*)(al + (ks * 4 + et) * 512);
#pragma unroll
                    for (int ct = 0; ct < 3; ++ct) {
                        acc[et][ct] = __builtin_amdgcn_mfma_f32_16x16x32_bf16(ahf, bhf[ct], acc[et][ct], 0, 0, 0);
                        acc[et][ct] = __builtin_amdgcn_mfma_f32_16x16x32_bf16(ahf, blf[ct], acc[et][ct], 0, 0, 0);
                        acc[et][ct] = __builtin_amdgcn_mfma_f32_16x16x32_bf16(alf, bhf[ct], acc[et][ct], 0, 0, 0);
                    }
                }
            }
#pragma unroll
            for (int et = 0; et < 4; ++et)
#pragma unroll
                for (int ct = 0; ct < 3; ++ct)
#pragma unroll
                    for (int r = 0; r < 4; ++r) part[(wid * 64 + et * 16 + g4 * 4 + r) * RT_C + ct * 16 + c16] = acc[et][ct][r];
        }
        __syncthreads();
#pragma unroll 1
        for (int q0 = 0; q0 < 5; q0 += 2) {
            if (q0 == 4 && wid != 0) break;
            bool liveq[2]; int rowq[2], rrq[2]; float score[2], biased[2], val[2]; int sel[2];
#pragma unroll
            for (int q = 0; q < 2; ++q) {
                const int rr = wid + 8 * (q0 + q);
                rrq[q] = rr; liveq[q] = rr < RT_R && t0 + rr < ntok; rowq[q] = t0 + rr;
                const int rc = rr < RT_R ? rr : RT_R - 1;
                float logit = 0.f;
#pragma unroll
                for (int kq = 0; kq < 8; ++kq) logit += part[(kq * 64 + lane) * RT_C + rc];
                score[q] = sigmoidf_(logit); biased[q] = score[q] + rbias[lane]; sel[q] = -1;
            }
            const int gbase = lane & ~7, mygrp = lane >> 3;
#pragma unroll
            for (int q = 0; q < 2; ++q) {
                const float m1 = max8(biased[q]);
                const unsigned long long eq = __ballot(biased[q] == m1);
                const unsigned geq = (unsigned)((eq >> gbase) & 0xffull);
                const int first = gbase + (__ffs(geq) - 1);
                const float m2 = max8((lane == first) ? -INFINITY : biased[q]);
                const float gs = m1 + m2;
                int rank = 0;
#pragma unroll
                for (int k = 0; k < 8; ++k) { const float o = bperm(gs, k * 8); rank += (o > gs || (o == gs && k < mygrp)) ? 1 : 0; }
                val[q] = rank < 4 ? biased[q] : -INFINITY;
            }
#pragma unroll
            for (int j = 0; j < TOPK; ++j)
#pragma unroll
                for (int q = 0; q < 2; ++q) {
                    const float mx = wave_max(val[q]);
                    const unsigned long long bm = __ballot(val[q] == mx);
                    const int win = __ffsll((long long)bm) - 1;
                    if (lane == win) { sel[q] = j; val[q] = -INFINITY; }
                }
#pragma unroll
            for (int q = 0; q < 2; ++q) {
                const float ssum = wave_sum(sel[q] >= 0 ? score[q] : 0.f);
                if (liveq[q] && sel[q] >= 0) {
                    const int lr = atomicAdd(lcnt + lane, 1);
                    if (!dummy) { tokE[(size_t)rowq[q] * 8 + sel[q]] = lane; tokP[(size_t)rowq[q] * 8 + sel[q]] = lr; tokW[(size_t)rowq[q] * 8 + sel[q]] = score[q] * frcp(ssum) * 2.5f; }
                }
            }
        }
    }
    __syncthreads();
    if (tid < 64) wcnt[bid * 64 + tid] = lcnt[tid];
}

__device__ __forceinline__ void phase_slots(const KP& p, int l, int bid, int nb, char* smem) {
    int* cnt = (int*)(p.ws + WS_CNT) + l * 64;
    const int* tokE = (const int*)(p.ws + WS_TOKE);
    const int* tokP = (const int*)(p.ws + WS_TOKP);
    int* slotT = (int*)(p.ws + WS_SLOTT);
    int* tile = (int*)(p.ws + WS_TILE);
    int* tokS = (int*)(p.ws + WS_TOKS);
    const int* wcnt = (const int*)(p.ws + WS_MODP);
    int* off = (int*)smem;
    int* tot = off + 80;
    int* seg = tot + 64;
    int* bt = seg + 512;
    const int tid = otid(p.wb);
    const int ntok = ntok_of(l);
    __syncthreads();
    {
        const int e = tid & 63, sg = tid >> 6, S = (nb + 7) / 8, w0 = sg * S, w1 = (w0 + S < nb) ? w0 + S : nb;
        int sum = 0;
        int wv[32];
        const bool fits = S <= 32;
        if (fits) {
#pragma unroll
            for (int k = 0; k < 32; ++k) wv[k] = (w0 + k < w1) ? wcnt[(w0 + k) * 64 + e] : 0;
#pragma unroll
            for (int k = 0; k < 32; ++k) sum += wv[k];
        } else {
            for (int w = w0; w < w1; ++w) sum += wcnt[w * 64 + e];
        }
        seg[sg * 64 + e] = sum;
        __syncthreads();
        int run = 0;
        for (int k = 0; k < sg; ++k) run += seg[k * 64 + e];
        if (sg == 7) tot[e] = run + sum;
        if (fits) {
#pragma unroll
            for (int k = 0; k < 32; ++k) if (w0 + k < w1) { bt[(w0 + k) * 64 + e] = run; run += wv[k]; }
        } else {
            for (int w = w0; w < w1; ++w) { bt[w * 64 + e] = run; run += wcnt[w * 64 + e]; }
        }
    }
    __syncthreads();
    if (tid == 0) {
        int o = 0;
        for (int e = 0; e < NE; ++e) { off[e] = o; o += (tot[e] + 255) / 256 * 256; }
        off[NE] = o; off[NE + 1] = o + ntok;
    }
    if (bid == 0 && tid < 64) cnt[tid] = tot[tid];
    __syncthreads();
    if (bid == 0 && tid == 0) ((int*)(p.ws + WS_CNT))[192 + l] = off[NE];
    int nbo = nb; asm volatile("" : "+s"(nbo));
    const int gt = bid * NT + tid, gs = nbo * NT;
    for (int i = gt; i < ntok * 8; i += gs) { const int e = tokE[i]; const int s = off[e] + bt[(((i >> 3) / RT_R) % nbo) * 64 + e] + tokP[i]; slotT[s] = i >> 3; tokS[i] = s; }
    for (int i = gt; i < ntok; i += gs) slotT[off[NE] + i] = i;
    for (int i = gt; i < NE * 256; i += gs) { const int e = i >> 8, j = i & 255; const int s = off[e] + tot[e] + j; if (s < off[e + 1]) slotT[s] = -1; }
    if (bid == 0) {
        const int nt = off[NE + 1] / 256;
        if (tid == 0) tile[0] = nt;
        for (int i = tid; i < nt; i += NT) {
            const int s = i * 256; int e = 0;
            for (int k = 1; k <= NE; ++k) if (s >= off[k]) e = k;
            int nv = 256;
            if (e < NE) { const int left = off[e] + tot[e] - s; nv = left < 256 ? left : 256; }
            tile[1 + i] = e | (nv << 8);
        }
    }
}

__device__ __forceinline__ void phase_moe1(const KP& p, int l, int bid, int nb, bf16_t* shm) {
    const bf16_t* H = (const bf16_t*)(p.ws + WS_H);
    const bf16_t* W13 = (const bf16_t*)(p.ws + WS_W13T) + (size_t)l * NEX * 1024 * D;
    const int* slotT = (const int*)(p.ws + WS_SLOTT);
    const int* tile = (const int*)(p.ws + WS_TILE);
    bf16_t* ACT = (bf16_t*)(p.ws + WS_ACT);
    const int nt = tile[0], nwg = nt * 4;
    gemm_phase<false>(nwg, bid, nb, D, shm, p.wb,
        [&](int L) { const int wg = xcd_remap(L, nwg), ti = wg >> 2, ct = wg & 3, e = tile[1 + ti] & 255; GU u; u.A = H; u.Bt = W13 + ((size_t)e * 1024 + ct * 256) * D; u.i0 = ti * 256; u.i1 = ct * 256; u.i2 = 0; u.i3 = 0; return u; },
        [&](const GU& u, int r) { const int t = slotT[u.i0 + r]; return (t < 0 ? 0 : t) * D; },
        [&](const GU& u, f32x4 (&acc)[2][2][4][2]) {
            const int s0 = u.i0, n0 = u.i1;
            G_IDX;
#pragma unroll
            for (int ai = 0; ai < 2; ++ai)
#pragma unroll
                for (int m = 0; m < 4; ++m) {
                    const int slot = s0 + ai * 128 + wr * 64 + m * 16 + fr;
#pragma unroll
                    for (int bj = 0; bj < 2; ++bj) {
                        const int ch = (n0 + bj * 128 + wc * 32) / 2 + fq * 4;
                        float a[4];
#pragma unroll
                        for (int r = 0; r < 4; ++r) a[r] = siluf_(acc[ai][bj][m][0][r]) * acc[ai][bj][m][1][r];
                        u32x2 w; w[0] = pack_bf2(a[0], a[1]); w[1] = pack_bf2(a[2], a[3]);
                        *(u32x2*)(ACT + (size_t)slot * EFF + ch) = w;
                    }
                }
            return 16;
        });
}

__device__ __forceinline__ void phase_moe2(const KP& p, int l, int bid, int nb, bf16_t* shm) {
    const bf16_t* ACT = (const bf16_t*)(p.ws + WS_ACT);
    const bf16_t* W2 = (const bf16_t*)(p.ws + WS_W2T) + (size_t)l * NEX * D * EFF;
    const int* tile = (const int*)(p.ws + WS_TILE);
    bf16_t* OUTS = (bf16_t*)(p.ws + WS_OUTS);
    const int nt = tile[0], nwg = nt * 8;
    for (int k = (bid >> 3) & 3; k > 0; --k) __builtin_amdgcn_s_sleep(127);
    gemm_phase<true>(nwg, bid, nb, EFF, shm, p.wb,
        [&](int L) { const int wg = xcd_remap(L, nwg), ti = wg >> 3, ct = wg & 7, te = tile[1 + ti], e = te & 255; GU u; u.A = ACT; u.Bt = W2 + ((size_t)e * D + ct * 256) * EFF; u.i0 = ti * 256; u.i1 = ct * 256; u.i2 = te >> 8; u.i3 = 0; return u; },
        [&](const GU& u, int r) { return (u.i0 + r) * EFF; },
        [&](const GU& u, f32x4 (&acc)[2][2][4][2]) {
            const int s0 = u.i0, n0 = u.i1, nvalid = u.i2;
            G_IDX;
            const bool odd = fr & 1;
#pragma unroll
            for (int ai = 0; ai < 2; ++ai)
#pragma unroll
                for (int m = 0; m < 4; ++m) {
                    const int rp = ai * 128 + wr * 64 + m * 16 + (fr & ~1);
                    u32x4 c0, c1, dA, dB;
                    c0[0] = pack_bf2(acc[ai][0][m][0][0], acc[ai][0][m][0][1]); c0[1] = pack_bf2(acc[ai][0][m][0][2], acc[ai][0][m][0][3]);
                    c0[2] = pack_bf2(acc[ai][0][m][1][0], acc[ai][0][m][1][1]); c0[3] = pack_bf2(acc[ai][0][m][1][2], acc[ai][0][m][1][3]);
                    c1[0] = pack_bf2(acc[ai][1][m][0][0], acc[ai][1][m][0][1]); c1[1] = pack_bf2(acc[ai][1][m][0][2], acc[ai][1][m][0][3]);
                    c1[2] = pack_bf2(acc[ai][1][m][1][0], acc[ai][1][m][1][1]); c1[3] = pack_bf2(acc[ai][1][m][1][2], acc[ai][1][m][1][3]);
#pragma unroll
                    for (int q = 0; q < 4; ++q) {
                        const unsigned snd = odd ? c0[q] : c1[q];
                        const unsigned rcv = (unsigned)__builtin_amdgcn_update_dpp(0, (int)snd, 0xB1, 0xf, 0xf, true);
                        dA[q] = odd ? rcv : c0[q]; dB[q] = odd ? c1[q] : rcv;
                    }
                    bf16_t* o = OUTS + (size_t)(s0 + rp) * D + n0 + wc * 64 + fq * 8 + (odd ? 32 : 0);
                    if (rp < nvalid) *(u32x4*)o = dA;
                    if (rp + 1 < nvalid) *(u32x4*)(o + D) = dB;
                }
            return nvalid == 256 ? 16 : 0;
        });
}

__device__ __forceinline__ void phase_combine(const KP& p, int l, int bid, int nb, char* smem, const bool dummy = false) {
    const bf16_t* OUTS = (const bf16_t*)(p.ws + WS_OUTS);
    const int* tokS = (const int*)(p.ws + WS_TOKS);
    const float* tokW = (const float*)(p.ws + WS_TOKW);
    const int* cnt = (const int*)(p.ws + WS_CNT) + l * 64;
    const RowDst out = layer_out(p, l);
    int* sh0 = (int*)smem;
    const int tid = otid(p.wb), half = tid >> 8, ht = tid & 255;
    __syncthreads();
    if (tid == 0) sh0[0] = ((const int*)(p.ws + WS_CNT))[192 + l];
    __syncthreads();
    const int shared0 = sh0[0];
    const int ntok = ntok_of(l);
    const bool fuse = !dummy && l + 1 < DEPTH && ntok == NTOK;
    float* red = (float*)smem + 16;
    bf16_t* Hn = (bf16_t*)(p.ws + WS_H);
    int par = 0;
    for (int row = bid * 2 + half; row < ntok; row += nb * 2) {
        float* xr = rowp(out, row);
        const float* g2 = modp(p, l, row, 5);
        const int c = ht * 8;
        float acc[8];
        {
            const u32x4 v = *(const u32x4*)(OUTS + (size_t)(shared0 + row) * D + c);
#pragma unroll
            for (int q = 0; q < 4; ++q) { acc[2 * q] = __uint_as_float(v[q] << 16); acc[2 * q + 1] = __uint_as_float(v[q] & 0xffff0000u); }
        }
#pragma unroll
        for (int j = 0; j < TOPK; ++j) {
            const int s = tokS[(size_t)row * 8 + j]; const float w = tokW[(size_t)row * 8 + j];
            const u32x4 v = *(const u32x4*)(OUTS + (size_t)s * D + c);
#pragma unroll
            for (int q = 0; q < 4; ++q) { acc[2 * q] += w * __uint_as_float(v[q] << 16); acc[2 * q + 1] += w * __uint_as_float(v[q] & 0xffff0000u); }
        }
        const f32x4 g0 = *(const f32x4*)(g2 + c), g1 = *(const f32x4*)(g2 + c + 4);
        f32x4 x0 = *(const f32x4*)(xr + c), x1 = *(const f32x4*)(xr + c + 4);
#pragma unroll
        for (int q = 0; q < 4; ++q) { x0[q] += g0[q] * acc[q]; x1[q] += g1[q] * acc[4 + q]; }
        if (!dummy || x0[0] == 1234.5f) { *(f32x4*)(xr + c) = x0; *(f32x4*)(xr + c + 4) = x1; }
        if (fuse) {
            float ss = 0.f;
#pragma unroll
            for (int q = 0; q < 4; ++q) ss += x0[q] * x0[q] + x1[q] * x1[q];
            ss = wave_sum(ss);
            float* slot = red + par * 8 + half * 4;
            if ((ht & 63) == 0) slot[ht >> 6] = ss;
            __syncthreads();
            const float rstd = rsqrtf(((slot[0] + slot[1]) + (slot[2] + slot[3])) * (1.f / D) + 1e-6f);
            par ^= 1;
            const float* gn = p.norm1_g + (size_t)(l + 1) * D + c;
            const float* shp = modp(p, l + 1, row, 0) + c;
            const float* scp = modp(p, l + 1, row, 1) + c;
            const f32x4 ga = *(const f32x4*)gn, gb = *(const f32x4*)(gn + 4), sa = *(const f32x4*)shp, sb = *(const f32x4*)(shp + 4), ca = *(const f32x4*)scp, cb = *(const f32x4*)(scp + 4);
            float o[8];
#pragma unroll
            for (int q = 0; q < 4; ++q) {
                const float ta = x0[q] * rstd * ga[q], tb = x1[q] * rstd * gb[q];
                o[q] = fmaf(ta, ca[q], ta) + sa[q]; o[4 + q] = fmaf(tb, cb[q], tb) + sb[q];
            }
            u32x4 w; w[0] = pack_bf2(o[0], o[1]); w[1] = pack_bf2(o[2], o[3]); w[2] = pack_bf2(o[4], o[5]); w[3] = pack_bf2(o[6], o[7]);
            *(u32x4*)(Hn + (size_t)row * D + c) = w;
        }
    }
}

#define XB_TMO      128
#define XB_XCNT(j)  (256  + 64 * (j))
#define XB_XSUB(j)  (1280 + 64 * (j))
#define XB_XGEN(j)  (2304 + 64 * (j))
#define XB_TOP      3328
#define XB_TOPGEN   3392
#define XCD_BAR_WORDS 3456
#define XB_SPIN_CAP (1u << 18)
#define LAS __attribute__((address_space(3)))

__device__ __forceinline__ unsigned xb_ld(unsigned* p)              { return __hip_atomic_load(p, __ATOMIC_RELAXED, __HIP_MEMORY_SCOPE_AGENT); }
__device__ __forceinline__ unsigned xb_add(unsigned* p, unsigned v) { return __hip_atomic_fetch_add(p, v, __ATOMIC_RELAXED, __HIP_MEMORY_SCOPE_AGENT); }
__device__ __forceinline__ unsigned xb_xcc_id() { return (unsigned)__builtin_amdgcn_s_getreg((3 << 11) | 20) & 0xFu; }
#define XB_SPIN(cond, bar) do { unsigned _sp = 0; while (cond) { __builtin_amdgcn_s_sleep(1); \
    if ((++_sp & 255u) == 0u) { if (xb_ld(&(bar)[XB_TMO])) break; if (_sp > XB_SPIN_CAP) { atomicAdd(&(bar)[XB_TMO], 1u); break; } } } } while (0)

struct XcdBarrier {
    unsigned* bar; unsigned x;
    volatile LAS unsigned* st;
};
__device__ __forceinline__ XcdBarrier xcd_barrier_post(unsigned* bar, volatile LAS unsigned* st) {
    XcdBarrier b; b.bar = bar; b.x = (unsigned)__builtin_amdgcn_readfirstlane((int)xb_xcc_id()); b.st = st;
    if (threadIdx.x == 0) (void)xb_add(&bar[XB_XCNT(b.x)], 1u);
    return b;
}
__device__ __forceinline__ void xcd_barrier_complete(unsigned* bar, unsigned x, unsigned& nloc, unsigned& nx) {
    const unsigned G = gridDim.x * gridDim.y * gridDim.z;
    unsigned sum, cnt, mine, sp = 0u;
    for (;;) {
        sum = 0u; cnt = 0u; mine = 0u;
#pragma unroll
        for (unsigned j = 0; j < 16; ++j) { const unsigned c = xb_ld(&bar[XB_XCNT(j)]); sum += c; cnt += (c > 0u) ? 1u : 0u; mine = (j == x) ? c : mine; }
        if (sum == G) break;
        __builtin_amdgcn_s_sleep(1);
        if ((++sp & 255u) == 0u) { if (xb_ld(&bar[XB_TMO])) break; if (sp > XB_SPIN_CAP) { atomicAdd(&bar[XB_TMO], 1u); break; } }
    }
    nloc = mine > 0u ? mine : 1u; nx = cnt > 0u ? cnt : 1u;
}
__device__ __forceinline__ void xcd_barrier(const XcdBarrier& b) {
    asm volatile("s_waitcnt vmcnt(0)" ::: "memory");
    __syncthreads();
    unsigned bx = b.x; asm volatile("" : "+s"(bx));
    if (threadIdx.x == 0) {
        unsigned* bar = b.bar;
        __builtin_amdgcn_s_waitcnt(0);
        unsigned nloc = b.st[0], nx = b.st[1];
        if (nloc == 0u) { xcd_barrier_complete(bar, bx, nloc, nx); b.st[0] = nloc; b.st[1] = nx; }
        const unsigned old = xb_add(&bar[XB_XSUB(bx)], 1u);
        const unsigned gen = old / nloc;
        if (old + 1u == (gen + 1u) * nloc) {
            __builtin_amdgcn_fence(__ATOMIC_RELEASE, "agent");
            asm volatile("s_waitcnt vmcnt(0)" ::: "memory");
            const unsigned og = xb_add(&bar[XB_TOP], 1u);
            const unsigned tg = og / nx;
            if (og + 1u == (tg + 1u) * nx) xb_add(&bar[XB_TOPGEN], 1u);
            else XB_SPIN(xb_ld(&bar[XB_TOPGEN]) == tg, bar);
            __builtin_amdgcn_fence(__ATOMIC_ACQUIRE, "agent");
            xb_add(&bar[XB_XGEN(bx)], 1u);
            asm volatile("s_waitcnt vmcnt(0)" ::: "memory");
        } else {
            XB_SPIN(xb_ld(&bar[XB_XGEN(bx)]) == gen, bar);
            __builtin_amdgcn_fence(__ATOMIC_ACQUIRE, "agent");
            asm volatile("s_waitcnt vmcnt(0)" ::: "memory");
        }
    }
    __syncthreads();
}

#ifndef PROBE_MASK
#define PROBE_MASK 0u
#endif
#ifndef REP2_SKIP
#define REP2_SKIP 0
#endif
#ifndef REP2_SKIP
#define REP2_SKIP 0
#endif
#ifndef REP2_SKIP
#define REP2_SKIP 0
#endif
#ifndef REP2_SKIP
#define REP2_SKIP 0
#endif
#ifndef REP2_SKIP
#define REP2_SKIP 0
#endif
#ifndef REP2_SKIP
#define REP2_SKIP 0
#endif
#ifndef REP3_SKIP
#define REP3_SKIP 0
#endif
#ifndef REP_PHASE
#define REP_PHASE (-1)
#define REP_L 1
#define REP_N 1
#endif
constexpr int FUSED_LDS = G_LDS + 16;
__global__ void __launch_bounds__(512, 2) k_fused(Params p0) {
    extern __shared__ __attribute__((aligned(16))) char dsm[];
    KP p; (Params&)p = p0; p.wb = __builtin_amdgcn_readfirstlane((int)threadIdx.x) & ~63;
    if (threadIdx.x == 0) *(uint4*)(dsm + G_LDS) = make_uint4(0u, 0u, 0u, 0u);
    __syncthreads();
    XcdBarrier bar = xcd_barrier_post((unsigned*)(p.ws + WS_BAR), (volatile LAS unsigned*)(dsm + G_LDS));
    char* sm = dsm;
    bf16_t* shm = (bf16_t*)dsm;
    const int bid = blockIdx.x, nb = gridDim.x;
#if PROBE_MASK
    unsigned long long* stamps = (unsigned long long*)(p.ws + WS_BAR + 14336);
    int nstamp = 0;
#define STAMP() do { if (bid == 0 && threadIdx.x == 0) stamps[nstamp] = wall_clock64(); ++nstamp; } while (0)
    STAMP();
#else
#define STAMP() do { } while (0)
#endif
    for (int _r = 0; _r < (REP_PHASE == 20 ? REP_N : 1); ++_r) {
        phase_ada(p, bid, nb);
        phase_convert_dense(p, 0, bid, nb, (float*)sm);
        phase_convert_dense(p, 1, bid, nb, (float*)sm);
        phase_convert_lora(p, bid, nb);
        xcd_barrier(bar); STAMP();
    }
    phase_ada2(p, bid, nb);
    xcd_barrier(bar); STAMP();
#define RUN(k, body) { const int _n = (REP_PHASE == (k) && l == REP_L) ? REP_N : 1; for (int _r = 0; _r < _n; ++_r) { body; xcd_barrier(bar); STAMP(); } }
    for (int l = 0; l < DEPTH; ++l) {
        if (l == 0 || REP_PHASE >= 0) RUN(0, phase_norm1(p, l, bid, nb));
        RUN(1, {
            phase_inproj(p, l, bid, nb, shm);
            int mine = 0; int rounds = 0;
            int nbo = nb; asm volatile("" : "+s"(nbo));
            for (int L = bid; L < (NTOK / 256) * (INP_PAD / 256); L += nbo) ++mine;
            for (int L = 0; L < (NTOK / 256) * (INP_PAD / 256); L += nbo) ++rounds;
            if (mine < rounds) conv_pull_n(p, l, sm, 3);
            });
        RUN(2, { if (!(REP2_SKIP & 1) || _r == 0) phase_rwprep(p, l, bid, nb, sm); if (!(REP2_SKIP & 2) || _r == 0) phase_atprep(p, l, bid, nb, sm); });
        RUN(11, phase_cprep(p, bid, nb, sm));
        RUN(3, {
            if (bid < CS_BLOCKS) { if (!(REP3_SKIP & 1) || _r == 0) phase_cscan(p, bid, sm); }
            else if ((bid & 1) == 0) {
                const int hb = (bid - CS_BLOCKS) >> 1; const int hn = (nb - CS_BLOCKS + 1) >> 1;
                if (!(REP3_SKIP & 4) || _r == 0) phase_attn(p, l, hb, hn, sm);
                if (!(REP3_SKIP & 2) || _r == 0) phase_gmlp(p, l, hb, hn, sm);
            }
            conv_pull(p, l, sm);
            });
        RUN(4, phase_rwpost(p, l, bid, nb));
        RUN(5, {
            phase_oproj(p, l, bid, nb, shm);
            int mine = 0; int rounds = 0;
            int nbo = nb; asm volatile("" : "+s"(nbo));
            for (int L = bid; L < (ntok_of(l) / 256) * (D / 256); L += nbo) ++mine;
            for (int L = 0; L < (ntok_of(l) / 256) * (D / 256); L += nbo) ++rounds;
            if (mine < rounds) conv_pull_n(p, l, sm, 2);
            });
        RUN(6, phase_norm2_route(p, l, bid, nb, sm, _r > 0));
        RUN(7, phase_slots(p, l, bid, nb, sm));
        RUN(8, phase_moe1(p, l, bid, nb, shm));
        RUN(9, phase_moe2(p, l, bid, nb, shm));
        RUN(10, phase_combine(p, l, bid, nb, sm, _r + 1 < _n));
    }
#if PROBE_MASK
    if (bid == 0 && threadIdx.x == 0) {
        unsigned long long ticks = 0;
        for (int i = 0; i + 1 < nstamp; ++i) if ((PROBE_MASK >> i) & 1u) ticks += stamps[i + 1] - stamps[i];
        float v = (float)ticks * 10.0f;
        if (PROBE_MASK == 0x40000000u) v = 1.0e5f;
        p.out[0] = v;
    }
#endif
}

extern "C" void kernel_launch(void* const* d_in, const int* in_sizes, int n_in, void* d_out, int out_size, void* d_ws, size_t ws_size, hipStream_t stream) {
    if (n_in != 35 || out_size != SEQ * D || ws_size < WS_END) {
        fprintf(stderr, "kernel_launch: unexpected shapes: n_in %d out %d ws %zu (need %zu)\n", n_in, out_size, ws_size, (size_t)WS_END);
        return;
    }
    static int grid = 0;
    if (!grid) {
        int dev = 0, cus = 0, per_cu = 0;
        (void)hipGetDevice(&dev);
        (void)hipDeviceGetAttribute(&cus, hipDeviceAttributeMultiprocessorCount, dev);
        (void)hipFuncSetAttribute((const void*)k_fused, hipFuncAttributeMaxDynamicSharedMemorySize, FUSED_LDS);
        (void)hipOccupancyMaxActiveBlocksPerMultiprocessor(&per_cu, (const void*)k_fused, NT, FUSED_LDS);
        if (per_cu < 1) fprintf(stderr, "kernel_launch: occupancy query says %d workgroups per CU; launching one per CU anyway\n", per_cu);
        grid = cus;
        if (grid <= CS_BLOCKS) grid = 0;
    }
    if (!grid) { fprintf(stderr, "kernel_launch: bad grid\n"); return; }
    Params p{};
    const float** f = (const float**)&p;
    for (int i = 0; i < 35; ++i) f[i] = (const float*)d_in[i];
    p.out = (float*)d_out;
    p.ws = (char*)d_ws;
    (void)hipMemsetAsync(d_ws, 0, WS_ZERO_END, stream);
    hipLaunchKernelGGL(k_fused, dim3(grid), dim3(NT), FUSED_LDS, stream, p);
}
```
